# Optimizing an MI355X kernel written in HIP

```python
import jax, jax.numpy as jnp
from jax import lax
import numpy as np

D_MODEL = 1024
BATCH = 4
SEQ = 4096
DEPTH = 2

N_MEM = 256
ATT_GROUPS = ((128, 1), (512, 4), (2048, 16))
N_ATT_GROUPS = len(ATT_GROUPS)
ATT_HEADS = 4
ATT_HEAD_DIM = 128
ATT_WIDTH = ATT_HEADS * ATT_HEAD_DIM
Q_BLOCK = 128
HGRN_EXPAND = 128
HGRN_WIDTH = D_MODEL
HGRN_HEADS = HGRN_WIDTH // HGRN_EXPAND
HGRN_CHUNK = 64
D_FF = 2816
X_HEADS = 4
X_HEAD_DIM = D_MODEL // X_HEADS
ROPE_THETA = 10000.0
EPS = 1e-6
IN_SIZES = (N_ATT_GROUPS * ATT_WIDTH,) * 3 + (HGRN_WIDTH,) * 4 + (D_MODEL,) * 2
N_IN = sum(IN_SIZES)

kernel_name = "hybrid_dilated_attn_hgrn2_macaron_block"


def rms_norm(x, g):
    xf = x.astype(jnp.float32)
    y = xf * lax.rsqrt(jnp.mean(xf * xf, axis=-1, keepdims=True) + EPS)
    return (y * g.astype(jnp.float32)).astype(x.dtype)


def swiglu(h, w_gu, w_down):
    gate, up = jnp.split(h @ w_gu, 2, axis=-1)
    return (jax.nn.silu(gate) * up) @ w_down


def rope_tables(positions, dim, dtype):
    inv_freq = ROPE_THETA ** (-jnp.arange(0, dim, 2, dtype=jnp.float32) / dim)
    ang = positions.astype(jnp.float32)[..., None] * inv_freq
    cos = jnp.cos(ang)[:, :, None, None, :].astype(dtype)
    sin = jnp.sin(ang)[:, :, None, None, :].astype(dtype)
    return cos, sin


def apply_rope(x, cos, sin):
    x1, x2 = jnp.split(x, 2, axis=-1)
    return jnp.concatenate([x1 * cos - x2 * sin, x2 * cos + x1 * sin], axis=-1)


def dilated_attention(q, k, v):
    B, T, G, H, dh = q.shape
    n_blk = T // Q_BLOCK
    scale = dh ** -0.5
    k_groups = [k[:, :, gi] for gi in range(G)]
    v_groups = [v[:, :, gi] for gi in range(G)]

    def block(b):
        t0 = b * Q_BLOCK
        tq = t0 + jnp.arange(Q_BLOCK)
        q_blk = lax.dynamic_slice_in_dim(q, t0, Q_BLOCK, axis=1)
        outs, lses = [], []
        for gi, (window, dil) in enumerate(ATT_GROUPS):
            j = jnp.arange(window // dil + 1)
            idx = tq[:, None] - dil * j[None, :]
            valid = idx >= 0
            idx = jnp.maximum(idx, 0)
            k_sel = k_groups[gi][:, idx]
            v_sel = v_groups[gi][:, idx]
            s = jnp.einsum('bqhd,bqjhd->bqhj', q_blk[:, :, gi], k_sel,
                           preferred_element_type=jnp.float32) * scale
            s = jnp.where(valid[None, :, None, :], s, -jnp.inf)
            m = jnp.max(s, axis=-1, keepdims=True)
            p = jnp.exp(s - m)
            den = jnp.sum(p, axis=-1)
            o = jnp.einsum('bqhj,bqjhd->bqhd', p, v_sel.astype(jnp.float32)) / den[..., None]
            outs.append(o)
            lses.append(m[..., 0] + jnp.log(den))
        w = jax.nn.softmax(jnp.stack(lses, axis=-1), axis=-1)
        o = jnp.einsum('bqhgd,bqhg->bqhd', jnp.stack(outs, axis=-2), w)
        return o.astype(q.dtype)

    o = lax.map(block, jnp.arange(n_blk))
    return o.transpose(1, 0, 2, 3, 4).reshape(B, T, H * dh)


def hgrn2_recurrence(q, f_logit, i, lb):
    B, T, H, N = q.shape
    C = HGRN_CHUNK
    NC = T // C
    lb = lb.reshape(H, N).astype(jnp.float32)
    f = lb + (1.0 - lb) * jax.nn.sigmoid(f_logit.astype(jnp.float32))
    g = jnp.log(f)
    k = 1.0 - f
    qs = q.astype(jnp.float32) * (N ** -0.5)

    def to_chunks(a):
        return a.reshape(B, NC, C, H, a.shape[-1]).transpose(1, 0, 3, 2, 4)

    causal = jnp.tril(jnp.ones((C, C), dtype=bool))

    def step(S, inp):
        qc, kc, vc, gc = inp
        b = jnp.cumsum(gc, axis=2)
        diff = b[:, :, :, None, :] - b[:, :, None, :, :]
        decay = jnp.exp(jnp.where(causal[:, :, None], diff, -jnp.inf))
        A = jnp.einsum('bhtn,bhsn,bhtsn->bhts', qc, kc, decay)
        o = (jnp.einsum('bhts,bhsv->bhtv', A, vc)
             + jnp.einsum('bhtn,bhnv->bhtv', qc * jnp.exp(b), S))
        b_last = b[:, :, -1:, :]
        S = (jnp.exp(b_last[:, :, 0, :])[..., None] * S
             + jnp.einsum('bhsn,bhsv->bhnv', kc * jnp.exp(b_last - b), vc))
        return S, o

    S0 = jnp.zeros((B, H, N, i.shape[-1]), jnp.float32)
    _, o = lax.scan(step, S0, (to_chunks(qs), to_chunks(k),
                               to_chunks(i.astype(jnp.float32)), to_chunks(g)))
    return o.transpose(1, 0, 3, 2, 4).reshape(B, T, H, -1)


def cross_attention(h, mem_n, wq, wkv, wo):
    B, T, _ = h.shape
    M = mem_n.shape[1]
    q = (h @ wq).reshape(B, T, X_HEADS, X_HEAD_DIM)
    k, v = jnp.split(mem_n @ wkv, 2, axis=-1)
    k = k.reshape(B, M, X_HEADS, X_HEAD_DIM)
    v = v.reshape(B, M, X_HEADS, X_HEAD_DIM)
    s = jnp.einsum('bthd,bmhd->bhtm', q, k, preferred_element_type=jnp.float32) * (X_HEAD_DIM ** -0.5)
    p = jax.nn.softmax(s, axis=-1)
    o = jnp.einsum('bhtm,bmhd->bthd', p, v.astype(jnp.float32)).astype(h.dtype)
    return o.reshape(B, T, X_HEADS * X_HEAD_DIM) @ wo


def setup_inputs(seed: int = 0) -> dict:
    key = jax.random.key(seed)
    ks = iter(jax.random.split(key, 32))
    f32 = jnp.float32

    def w(shape, fan_in):
        return jax.random.normal(next(ks), shape, f32) * (fan_in ** -0.5)

    def gain(shape):
        return 1.0 + 0.02 * jax.random.normal(next(ks), shape, f32)

    L = DEPTH
    return {
        "x": jax.random.normal(next(ks), (BATCH, SEQ, D_MODEL), f32),
        "mem": jax.random.normal(next(ks), (BATCH, N_MEM, D_MODEL), f32),
        "positions": jnp.broadcast_to(jnp.arange(SEQ, dtype=jnp.int32), (BATCH, SEQ)),
        "ffn1_norm": gain((L, D_MODEL)),
        "ffn1_w_gu": w((L, D_MODEL, 2 * D_FF), D_MODEL),
        "ffn1_w_down": w((L, D_FF, D_MODEL), D_FF),
        "mix_norm": gain((L, D_MODEL)),
        "w_in": w((L, D_MODEL, N_IN), D_MODEL),
        "hgrn_lower_bounds": 0.1 * jax.random.normal(next(ks), (L, HGRN_WIDTH), f32),
        "hgrn_head_norm": gain((L, HGRN_WIDTH)),
        "w_att_branch": w((L, ATT_WIDTH, D_MODEL), ATT_WIDTH),
        "w_hgrn_branch": w((L, HGRN_WIDTH, D_MODEL), HGRN_WIDTH),
        "w_mix_out": w((L, D_MODEL, D_MODEL), D_MODEL),
        "xattn_norm": gain((L, D_MODEL)),
        "mem_norm": gain((L, D_MODEL)),
        "xattn_wq": w((L, D_MODEL, X_HEADS * X_HEAD_DIM), D_MODEL),
        "xattn_wkv": w((L, D_MODEL, 2 * X_HEADS * X_HEAD_DIM), D_MODEL),
        "xattn_wo": w((L, X_HEADS * X_HEAD_DIM, D_MODEL), X_HEADS * X_HEAD_DIM),
        "ffn2_norm": gain((L, D_MODEL)),
        "ffn2_w_gu": w((L, D_MODEL, 2 * D_FF), D_MODEL),
        "ffn2_w_down": w((L, D_FF, D_MODEL), D_FF),
        "final_norm": gain((D_MODEL,)),
    }


def reference(x, mem, positions, ffn1_norm, ffn1_w_gu, ffn1_w_down, mix_norm, w_in,
              hgrn_lower_bounds, hgrn_head_norm, w_att_branch, w_hgrn_branch, w_mix_out,
              xattn_norm, mem_norm, xattn_wq, xattn_wkv, xattn_wo,
              ffn2_norm, ffn2_w_gu, ffn2_w_down, final_norm):
    B, T, _ = x.shape
    cos, sin = rope_tables(positions, ATT_HEAD_DIM, x.dtype)
    lb_p = jax.nn.softmax(hgrn_lower_bounds.astype(jnp.float32), axis=0)
    lb_all = jnp.cumsum(lb_p, axis=0) - lb_p[0]
    split_at = [sum(IN_SIZES[:n]) for n in range(1, len(IN_SIZES))]

    for l in range(DEPTH):
        x = x + 0.5 * swiglu(rms_norm(x, ffn1_norm[l]), ffn1_w_gu[l], ffn1_w_down[l])

        h = rms_norm(x, mix_norm[l])
        z = h @ w_in[l]
        q_a, k_a, v_a, q_b, f_b, i_b, og_b, gate_a, gate_b = jnp.split(z, split_at, axis=-1)
        att_shape = (B, T, N_ATT_GROUPS, ATT_HEADS, ATT_HEAD_DIM)
        q_a = apply_rope(q_a.reshape(att_shape), cos, sin)
        k_a = apply_rope(k_a.reshape(att_shape), cos, sin)
        v_a = v_a.reshape(att_shape)
        y_a = dilated_attention(q_a, k_a, v_a) @ w_att_branch[l]

        hg_shape = (B, T, HGRN_HEADS, HGRN_EXPAND)
        o_b = hgrn2_recurrence(q_b.reshape(hg_shape), f_b.reshape(hg_shape),
                               i_b.reshape(hg_shape), lb_all[l])
        o_b = rms_norm(o_b, hgrn_head_norm[l].reshape(HGRN_HEADS, HGRN_EXPAND))
        o_b = o_b.reshape(B, T, HGRN_WIDTH).astype(x.dtype) * jax.nn.silu(og_b)
        y_b = o_b @ w_hgrn_branch[l]

        merged = jax.nn.sigmoid(gate_a) * y_a + jax.nn.sigmoid(gate_b) * y_b
        x = x + merged @ w_mix_out[l]

        x = x + cross_attention(rms_norm(x, xattn_norm[l]), rms_norm(mem, mem_norm[l]),
                                xattn_wq[l], xattn_wkv[l], xattn_wo[l])

        x = x + 0.5 * swiglu(rms_norm(x, ffn2_norm[l]), ffn2_w_gu[l], ffn2_w_down[l])

    return rms_norm(x, final_norm)
```

```cpp
#include <hip/hip_runtime.h>
#include <hip/hip_cooperative_groups.h>
#include <cstdio>
#include <cstdint>
namespace cg = cooperative_groups;
namespace pg8 {
#define PG8_LAS __attribute__((address_space(3)))
typedef unsigned short bf16_t;
typedef short bf16x8 __attribute__((ext_vector_type(8)));
typedef float f32x4 __attribute__((ext_vector_type(4)));
typedef unsigned u32x4 __attribute__((ext_vector_type(4)));
constexpr int BM = 256, BK = 64, HALF = 128, HTB = HALF * BK * 2  , STAGE_BYTES = 8 * HTB, NXCD = 8, WGM = 8;

__host__ __device__ __forceinline__ int lds_byte(int r, int c) { const int st = (r >> 4) * 2 + (c >> 5), rr = r & 15, cc = c & 31, ob = rr * 64 + cc * 2; return st * 1024 + (ob ^ (((ob >> 9) & 1) << 5)); }
__host__ __device__ __forceinline__ void stage_rc(int b, int& R, int& C) { const int st = b / 1024, sb = b % 1024, swz = sb ^ (((sb >> 9) & 1) << 5); R = (st >> 1) * 16 + swz / 64; C = (st & 1) * 32 + (swz % 64) / 2; }
__host__ __device__ __forceinline__ int perm32(int rho) { const int n = rho >> 4, i = rho & 15; return 8 * (i >> 2) + 4 * n + (i & 3); }

struct Unit { int pm, pn; };
struct Gemm { const bf16_t* A; const bf16_t* Bt; int M, N, K, lda, ldb; };

struct StaticOrder {
    int nM, nN, nwg, G, c;
    __host__ __device__ void init(int M, int N, int G_, int c_) { nM = M / BM; nN = N / BM; nwg = nM * nN; G = G_; c = c_; }
    __host__ __device__ bool next(int i, Unit& u) const {
        const long L = (long)i * G + c; if (L >= nwg) return false;
        int wgid = (int)L; { const int q = nwg / NXCD, r = nwg % NXCD, xcd = wgid % NXCD, off = wgid / NXCD; wgid = (xcd < r ? xcd * (q + 1) : r * (q + 1) + (xcd - r) * q) + off; }
        const int nig = WGM * nN, gid = wgid / nig, fm = gid * WGM, gsz = (nM - fm) < WGM ? (nM - fm) : WGM;
        u.pm = fm + ((wgid % nig) % gsz); u.pn = (wgid % nig) / gsz; return true;
    }
    __device__ __forceinline__ void a_ready(const Unit&) const {}
    __device__ __forceinline__ void done(const Unit&) const {}
};

template <class Epi, class Sched, bool ALIGN_EPI = false, bool SP2 = false>
__device__ __forceinline__ void gemm_phase(PG8_LAS unsigned char* lds, const Gemm g, const Sched& S, const Epi& E) {
    int tid_ = threadIdx.x; asm volatile("" : "+v"(tid_)); const int tid = tid_, wid = __builtin_amdgcn_readfirstlane(tid >> 6), lane = tid & 63, wr = wid >> 2, wc = wid & 3, fr = lane & 15, fq = lane >> 4;
    const int K = g.K, nt = K / BK;
    unsigned voffA[2], voffB[2];
#pragma unroll
    for (int i = 0; i < 2; ++i) { int R, C; stage_rc(tid * 16 + i * 8192, R, C); const int Rb = Epi::PERM ? ((R & ~31) + perm32(R & 31)) : R;
        voffA[i] = (unsigned)(R * g.lda + C) * 2u; voffB[i] = (unsigned)(Rb * g.ldb + C) * 2u; }
    const size_t kstep = (size_t)(BK * 2);
    const size_t hstepA = (size_t)HALF * g.lda * 2, hstepB = (size_t)HALF * g.ldb * 2;
    const size_t tstepA = 2 * hstepA, tstepB = 2 * hstepB;
    const unsigned ldsw = (unsigned)wid * 1024u;
    const int aoff = lds_byte(wr * 64 + fr, fq * 8), boff = lds_byte(wc * 32 + fr, fq * 8);
#define PG8_SA(b, h) (((b) * 2 + (h)) * HTB)
#define PG8_SB(b, h) ((4 + (b) * 2 + (h)) * HTB)
#define PG8_STAGE(bufoff, gbase, voff) do { _Pragma("unroll") for (int _i = 0; _i < 2; ++_i) \
        __builtin_amdgcn_global_load_lds((const unsigned*)((const char*)(gbase) + (voff)[_i]), (PG8_LAS unsigned*)(lds + (bufoff) + ldsw + _i * 8192), 16, 0, 0); } while (0)
#define PG8_LDA(dst, b, h) do { _Pragma("unroll") for (int m = 0; m < 4; ++m) _Pragma("unroll") for (int k = 0; k < 2; ++k) dst[m][k] = *(const PG8_LAS bf16x8*)(lds + PG8_SA(b, h) + aoff + m * 2048 + k * 1024); } while (0)
#define PG8_LDB(dst, b, h) do { _Pragma("unroll") for (int n = 0; n < 2; ++n) _Pragma("unroll") for (int k = 0; k < 2; ++k) dst[n][k] = *(const PG8_LAS bf16x8*)(lds + PG8_SB(b, h) + boff + n * 2048 + k * 1024); } while (0)
#define PG8_MMA(ai, bj, At, Bt) do { __builtin_amdgcn_s_setprio(1); _Pragma("unroll") for (int m = 0; m < 4; ++m) _Pragma("unroll") for (int n = 0; n < 2; ++n) _Pragma("unroll") for (int k = 0; k < 2; ++k) \
        acc[ai][bj][m][n] = __builtin_amdgcn_mfma_f32_16x16x32_bf16(Bt[n][k], At[m][k], acc[ai][bj][m][n], 0, 0, 0); __builtin_amdgcn_s_setprio(0); } while (0)
#define PG8_WAIT_V(n) asm volatile("s_waitcnt vmcnt(" #n ")" ::: "memory")
#define PG8_WAIT_L(n) asm volatile("s_waitcnt lgkmcnt(" #n ")" ::: "memory")
#define PG8_BAR __builtin_amdgcn_s_barrier()
#define PG8_SCHED __builtin_amdgcn_sched_barrier(0)
    Unit cur, nxt; int ui = 0;
    if (!S.next(0, cur)) return;
    f32x4 acc[2][2][4][2];
#pragma unroll
    for (int a = 0; a < 2; ++a)
#pragma unroll
        for (int b = 0; b < 2; ++b)
#pragma unroll
            for (int m = 0; m < 4; ++m)
#pragma unroll
                for (int n = 0; n < 2; ++n) acc[a][b][m][n] = (f32x4){0.f, 0.f, 0.f, 0.f};
    bf16x8 At[4][2], B0[2][2], B1[2][2];
    const char* cA = (const char*)g.A + (size_t)cur.pm * tstepA; const char* cB = (const char*)g.Bt + (size_t)cur.pn * tstepB;
    S.a_ready(cur);
    if constexpr (SP2) {
        PG8_STAGE(PG8_SB(0, 0), cB, voffB); PG8_STAGE(PG8_SB(0, 1), cB + hstepB, voffB); PG8_STAGE(PG8_SA(0, 0), cA, voffA); PG8_STAGE(PG8_SA(0, 1), cA + hstepA, voffA);
        if (wr == 1) PG8_BAR;
        PG8_WAIT_V(2); PG8_BAR;
        PG8_STAGE(PG8_SB(1, 0), cB + kstep, voffB); PG8_STAGE(PG8_SA(1, 0), cA + kstep, voffA); PG8_STAGE(PG8_SB(1, 1), cB + hstepB + kstep, voffB);
        PG8_WAIT_V(6); PG8_BAR;
    } else {
        PG8_STAGE(PG8_SB(0, 0), cB, voffB); PG8_STAGE(PG8_SA(0, 0), cA, voffA); PG8_STAGE(PG8_SB(0, 1), cB + hstepB, voffB); PG8_STAGE(PG8_SA(0, 1), cA + hstepA, voffA);
        if (wr == 1) PG8_BAR;
        PG8_WAIT_V(4); PG8_BAR;
        PG8_STAGE(PG8_SB(1, 0), cB + kstep, voffB); PG8_STAGE(PG8_SA(1, 0), cA + kstep, voffA); PG8_STAGE(PG8_SB(1, 1), cB + hstepB + kstep, voffB);
        PG8_WAIT_V(6); PG8_BAR;
    }
    for (;;) {
        const bool has_next = S.next(ui + 1, nxt);
        const char* nA = has_next ? (const char*)g.A + (size_t)nxt.pm * tstepA : cA; const char* nB = has_next ? (const char*)g.Bt + (size_t)nxt.pn * tstepB : cB;
        for (int t = 0; t < nt; t += 2) {
            const bool last = (t == nt - 2);
            const char* a1 = cA + (size_t)(t + 1) * kstep;
            const char* a2 = last ? nA : cA + (size_t)(t + 2) * kstep; const char* b2 = last ? nB : cB + (size_t)(t + 2) * kstep;
            const char* a3 = a2 + kstep; const char* b3 = b2 + kstep;
            if (last && has_next) S.a_ready(nxt);
            if constexpr (SP2) {
            PG8_LDB(B0, 0, 0); PG8_LDB(B1, 0, 1); PG8_SCHED; PG8_LDA(At, 0, 0); PG8_STAGE(PG8_SA(1, 1), a1 + hstepA, voffA);
            PG8_WAIT_V(8); PG8_WAIT_L(0); PG8_BAR; PG8_MMA(0, 0, At, B0); PG8_MMA(0, 1, At, B1); PG8_BAR; PG8_SCHED;
            PG8_LDA(At, 0, 1); PG8_STAGE(PG8_SB(0, 0), b2, voffB); PG8_STAGE(PG8_SB(0, 1), b2 + hstepB, voffB); PG8_STAGE(PG8_SA(0, 0), a2, voffA);
            PG8_WAIT_V(8); PG8_WAIT_L(0); PG8_BAR; PG8_MMA(1, 0, At, B0); PG8_MMA(1, 1, At, B1); PG8_BAR; PG8_SCHED;
            PG8_LDB(B0, 1, 0); PG8_LDB(B1, 1, 1); PG8_SCHED; PG8_LDA(At, 1, 0); PG8_STAGE(PG8_SA(0, 1), a2 + hstepA, voffA);
            PG8_WAIT_V(8); PG8_WAIT_L(0); PG8_BAR; PG8_MMA(0, 0, At, B0); PG8_MMA(0, 1, At, B1); PG8_BAR; PG8_SCHED;
            PG8_LDA(At, 1, 1); PG8_STAGE(PG8_SB(1, 0), b3, voffB); PG8_STAGE(PG8_SB(1, 1), b3 + hstepB, voffB); PG8_STAGE(PG8_SA(1, 0), a3, voffA);
            PG8_WAIT_V(8); PG8_WAIT_L(0); PG8_BAR; PG8_MMA(1, 0, At, B0); PG8_MMA(1, 1, At, B1); PG8_BAR; PG8_SCHED;
            } else {
            PG8_LDB(B0, 0, 0); PG8_SCHED; PG8_LDA(At, 0, 0); PG8_STAGE(PG8_SA(1, 1), a1 + hstepA, voffA);
            PG8_WAIT_L(8); PG8_BAR; PG8_WAIT_L(0); PG8_MMA(0, 0, At, B0); PG8_BAR; PG8_SCHED;
            PG8_LDB(B1, 0, 1); PG8_STAGE(PG8_SB(0, 0), b2, voffB);
            PG8_BAR; PG8_WAIT_L(0); PG8_MMA(0, 1, At, B1); PG8_BAR;
            PG8_LDA(At, 0, 1); PG8_STAGE(PG8_SA(0, 0), a2, voffA);
            PG8_BAR; PG8_WAIT_L(0); PG8_MMA(1, 0, At, B0); PG8_BAR; PG8_SCHED;
            PG8_STAGE(PG8_SB(0, 1), b2 + hstepB, voffB);
            PG8_WAIT_V(6); PG8_BAR; PG8_MMA(1, 1, At, B1); PG8_BAR;
            PG8_LDB(B0, 1, 0); PG8_SCHED; PG8_LDA(At, 1, 0); PG8_STAGE(PG8_SA(0, 1), a2 + hstepA, voffA);
            PG8_WAIT_L(8); PG8_BAR; PG8_WAIT_L(0); PG8_MMA(0, 0, At, B0); PG8_BAR; PG8_SCHED;
            PG8_LDB(B1, 1, 1); PG8_STAGE(PG8_SB(1, 0), b3, voffB);
            PG8_BAR; PG8_WAIT_L(0); PG8_MMA(0, 1, At, B1); PG8_BAR;
            PG8_LDA(At, 1, 1); PG8_STAGE(PG8_SA(1, 0), a3, voffA);
            PG8_BAR; PG8_WAIT_L(0); PG8_MMA(1, 0, At, B0); PG8_BAR; PG8_SCHED;
            PG8_STAGE(PG8_SB(1, 1), b3 + hstepB, voffB);
            PG8_WAIT_V(6); PG8_BAR; PG8_MMA(1, 1, At, B1); PG8_BAR;
            }
        }
        if constexpr (ALIGN_EPI) { if (wr == 0) PG8_BAR; }
        if constexpr (!Epi::AFTER_DRAIN) { E(acc, cur, wr, wc, fr, fq); S.done(cur); }
        if (!has_next) break;
#pragma unroll
        for (int a = 0; a < 2; ++a)
#pragma unroll
            for (int b = 0; b < 2; ++b)
#pragma unroll
                for (int m = 0; m < 4; ++m)
#pragma unroll
                    for (int n = 0; n < 2; ++n) acc[a][b][m][n] = (f32x4){0.f, 0.f, 0.f, 0.f};
        cur = nxt; cA = nA; cB = nB; ++ui;
        if constexpr (ALIGN_EPI) { if (wr == 1) PG8_BAR; }
    }
    PG8_WAIT_V(0);
    if constexpr (!ALIGN_EPI) { if (wr == 0) PG8_BAR; }
    PG8_BAR;
    if constexpr (Epi::AFTER_DRAIN) { E.fused(acc, cur, wr, wc, fr, fq, lds, wid, lane); S.done(cur); }
#undef PG8_SA
#undef PG8_SB
#undef PG8_STAGE
#undef PG8_LDA
#undef PG8_LDB
#undef PG8_MMA
#undef PG8_WAIT_V
#undef PG8_WAIT_L
#undef PG8_BAR
#undef PG8_SCHED
}
}

#define DI __device__ __forceinline__
#define LAS __attribute__((address_space(3)))
typedef unsigned short bf16;
typedef short bf16x8 __attribute__((ext_vector_type(8)));
typedef short s16x4 __attribute__((ext_vector_type(4)));
typedef float f32x4 __attribute__((ext_vector_type(4)));
typedef unsigned u32x4 __attribute__((ext_vector_type(4)));
typedef unsigned u32x2 __attribute__((ext_vector_type(2)));
using pg8::Unit;

constexpr int NB = 4, T = 4096, D = 1024, M = NB * T, DFF = 2816, NMEM = 256, MROWS = NB * NMEM;
constexpr int NATT = 4608, NH2 = 4096;
constexpr float EPS = 1e-6f;
constexpr int LDS_BYTES = 147456;

constexpr size_t MiB = 1u << 20;
constexpr size_t W_GU1 = 0, W_DN1 = W_GU1 + (size_t)2 * DFF * D * 2, W_IN = W_DN1 + (size_t)D * DFF * 2, W_AB = W_IN + (size_t)10752 * D * 2,
                 W_HB = W_AB + (size_t)D * 512 * 2, W_MO = W_HB + (size_t)D * D * 2, W_Q = W_MO + (size_t)D * D * 2, W_KV = W_Q + (size_t)D * D * 2,
                 W_O = W_KV + (size_t)2 * D * D * 2, W_GU2 = W_O + (size_t)D * D * 2, W_DN2 = W_GU2 + (size_t)2 * DFF * D * 2, W_END = W_DN2 + (size_t)D * DFF * 2;
static_assert(W_END <= 68 * MiB, "weights");
constexpr size_t WS_XB = 68 * MiB, WS_Z = 100 * MiB, WS_OG = 244 * MiB, WS_AO = 292 * MiB, WS_COS = 308 * MiB, WS_SIN = 312 * MiB, WS_MEMN = 316 * MiB,
                 WS_MEMK = 320 * MiB, WS_MEMVT = 322 * MiB, WS_SSQ = 324 * MiB, WS_DEC = 325 * MiB, WS_LSE = 326 * MiB, WS_END = 327 * MiB;

DI float bf2f(unsigned short h) { return __uint_as_float((unsigned)h << 16); }
DI unsigned f2bf(float f) { unsigned u = __float_as_uint(f); return (u + 0x7fffu + ((u >> 16) & 1u)) >> 16; }
DI unsigned pk2(float lo, float hi) { return f2bf(lo) | (f2bf(hi) << 16); }
DI float lo16(unsigned u) { return __uint_as_float(u << 16); }
DI float hi16(unsigned u) { return __uint_as_float(u & 0xffff0000u); }
DI float wave_sum(float v) {
#pragma unroll
    for (int o = 1; o < 64; o <<= 1) v += __shfl_xor(v, o);
    return v;
}
DI float sigmoidf_(float x) { return 1.0f / (1.0f + __expf(-x)); }
DI bf16x8 mk8(u32x4 v) { return __builtin_bit_cast(bf16x8, v); }
#define MFMA16(a, b, c) __builtin_amdgcn_mfma_f32_16x16x32_bf16((a), (b), (c), 0, 0, 0)

DI float row_rstd(const float* ssq, int row) {
    const f32x4* p = (const f32x4*)(ssq + (size_t)row * 16);
    const f32x4 a = p[0], b = p[1], c = p[2], d = p[3];
    const float s = ((a[0] + a[1]) + (a[2] + a[3])) + ((b[0] + b[1]) + (b[2] + b[3])) + ((c[0] + c[1]) + (c[2] + c[3])) + ((d[0] + d[1]) + (d[2] + d[3]));
    return 1.0f / sqrtf(s * (1.0f / D) + EPS);
}
struct EpiZ {
    static constexpr bool PERM = true, AFTER_DRAIN = false;
    bf16* O; int ldc; const float* ssq;
    DI void operator()(const f32x4 (&acc)[2][2][4][2], const Unit& u, int wr, int wc, int fr, int fq) const {
        const int row0 = u.pm * 256 + wr * 64 + fr, col0 = u.pn * 256 + wc * 32 + 8 * fq;
#pragma unroll
        for (int ai = 0; ai < 2; ++ai)
#pragma unroll
            for (int m = 0; m < 4; ++m) {
                const int row = row0 + ai * 128 + m * 16;
                const float rs = ssq ? row_rstd(ssq, row) : 1.0f;
                bf16* rowp = O + (size_t)row * ldc + col0;
#pragma unroll
                for (int bj = 0; bj < 2; ++bj) {
                    const f32x4 v0 = acc[ai][bj][m][0] * rs, v1 = acc[ai][bj][m][1] * rs;
                    u32x4 w; w.x = pk2(v0[0], v0[1]); w.y = pk2(v0[2], v0[3]); w.z = pk2(v1[0], v1[1]); w.w = pk2(v1[2], v1[3]);
                    *(u32x4*)(rowp + bj * 128) = w;
                }
            }
    }
};
struct EpiSwiglu {
    static constexpr bool PERM = true, AFTER_DRAIN = false;
    bf16* H; const float* ssq;
    DI void operator()(const f32x4 (&acc)[2][2][4][2], const Unit& u, int wr, int wc, int fr, int fq) const {
        const int row0 = u.pm * 256 + wr * 64 + fr, col0 = u.pn * 128 + wc * 32 + 8 * fq;
#pragma unroll
        for (int ai = 0; ai < 2; ++ai)
#pragma unroll
            for (int m = 0; m < 4; ++m) {
                const int row = row0 + ai * 128 + m * 16;
                const float rs = row_rstd(ssq, row);
                float h[8];
#pragma unroll
                for (int n = 0; n < 2; ++n)
#pragma unroll
                    for (int e = 0; e < 4; ++e) { const float g = acc[ai][0][m][n][e] * rs, up = acc[ai][1][m][n][e] * rs; h[4 * n + e] = g * sigmoidf_(g) * up; }
                u32x4 w; w.x = pk2(h[0], h[1]); w.y = pk2(h[2], h[3]); w.z = pk2(h[4], h[5]); w.w = pk2(h[6], h[7]);
                *(u32x4*)(H + (size_t)row * DFF + col0) = w;
            }
    }
};
struct EpiResid {
    static constexpr bool PERM = false, AFTER_DRAIN = false;
    const float* xin; float* xout; bf16* Xb; float* ssq; float alpha;
    DI void operator()(const f32x4 (&acc)[2][2][4][2], const Unit& u, int wr, int wc, int fr, int fq) const {
        const int row0 = u.pm * 256 + wr * 64 + fr, col0 = u.pn * 256 + wc * 32 + 4 * fq;
#pragma unroll
        for (int ai = 0; ai < 2; ++ai)
#pragma unroll
            for (int m = 0; m < 4; ++m) {
                const int row = row0 + ai * 128 + m * 16; float ss = 0.f;
#pragma unroll
                for (int bj = 0; bj < 2; ++bj)
#pragma unroll
                    for (int n = 0; n < 2; ++n) {
                        const size_t off = (size_t)row * D + col0 + bj * 128 + n * 16;
                        const f32x4 x = *(const f32x4*)(xin + off) + acc[ai][bj][m][n] * alpha;
                        *(f32x4*)(xout + off) = x;
                        u32x2 w; w.x = pk2(x[0], x[1]); w.y = pk2(x[2], x[3]); *(u32x2*)(Xb + off) = w;
                        ss += (x[0] * x[0] + x[1] * x[1]) + (x[2] * x[2] + x[3] * x[3]);
                    }
                ss += __shfl_xor(ss, 16); ss += __shfl_xor(ss, 32);
                if (fq == 0) ssq[(size_t)row * 16 + u.pn * 4 + wc] = ss;
            }
    }
};
template <bool ADD> struct EpiGate {
    static constexpr bool PERM = true, AFTER_DRAIN = false;
    const bf16* Gt; int ldg; bf16* Mg; int ldm;
    DI void operator()(const f32x4 (&acc)[2][2][4][2], const Unit& u, int wr, int wc, int fr, int fq) const {
        const int row0 = u.pm * 256 + wr * 64 + fr, col0 = u.pn * 256 + wc * 32 + 8 * fq;
#pragma unroll
        for (int ai = 0; ai < 2; ++ai)
#pragma unroll
            for (int m = 0; m < 4; ++m) {
                const int row = row0 + ai * 128 + m * 16;
#pragma unroll
                for (int bj = 0; bj < 2; ++bj) {
                    const u32x4 gv = *(const u32x4*)(Gt + (size_t)row * ldg + col0 + bj * 128);
                    bf16* mp = Mg + (size_t)row * ldm + col0 + bj * 128;
                    u32x4 pv = (u32x4){0u, 0u, 0u, 0u}; if (ADD) pv = *(const u32x4*)mp;
                    float r[8];
#pragma unroll
                    for (int q = 0; q < 4; ++q) {
                        const float a0 = acc[ai][bj][m][q >> 1][(q & 1) * 2], a1 = acc[ai][bj][m][q >> 1][(q & 1) * 2 + 1];
                        r[2 * q] = sigmoidf_(lo16(gv[q])) * a0 + (ADD ? lo16(pv[q]) : 0.f);
                        r[2 * q + 1] = sigmoidf_(hi16(gv[q])) * a1 + (ADD ? hi16(pv[q]) : 0.f);
                    }
                    u32x4 w; w.x = pk2(r[0], r[1]); w.y = pk2(r[2], r[3]); w.z = pk2(r[4], r[5]); w.w = pk2(r[6], r[7]);
                    *(u32x4*)mp = w;
                }
            }
    }
};

template <class Epi>
DI void run_gemm(LAS unsigned char* lds, const bf16* A, int lda, const bf16* Bt, int ldb, int Mr, int N, int K, int G, int c, const Epi& E) {
    pg8::Gemm g{A, Bt, Mr, N, K, lda, ldb}; pg8::StaticOrder S; S.init(Mr, N, G, c);
    pg8::gemm_phase<Epi, pg8::StaticOrder, true, true>(lds, g, S, E);
}

DI void conv_item(const float* W, int K, int Nsrc, int Nout, bool GU, const float* gain, bf16* WT, LAS float* scr, int item, int lane) {
    const int nblk = Nout / 32, kb = item / nblk, nb = item % nblk, k0 = 64 * kb, n0 = 32 * nb;
    const int src0 = GU ? (((n0 & 255) >> 7) * DFF + 128 * (n0 >> 8) + (n0 & 127)) : n0;
#pragma unroll 8
    for (int i = 0; i < 32; ++i) { const int kk = 2 * i + (lane >> 5); const float g = gain ? gain[k0 + kk] : 1.0f;
        scr[kk * 33 + (lane & 31)] = W[(size_t)(k0 + kk) * Nsrc + src0 + (lane & 31)] * g; }
    asm volatile("s_waitcnt lgkmcnt(0)" ::: "memory");
    const int c = lane & 7;
#pragma unroll
    for (int j = 0; j < 4; ++j) { const int n = (lane >> 3) + 8 * j; const LAS float* s = scr + (8 * c) * 33 + n;
        u32x4 o; o.x = pk2(s[0 * 33], s[1 * 33]); o.y = pk2(s[2 * 33], s[3 * 33]); o.z = pk2(s[4 * 33], s[5 * 33]); o.w = pk2(s[6 * 33], s[7 * 33]);
        *(u32x4*)(WT + (size_t)(n0 + n) * K + k0 + 8 * c) = o; }
    asm volatile("s_waitcnt lgkmcnt(0)" ::: "memory");
}

struct Args { const void* in[22]; float* out; unsigned char* ws; };

DI void conv_weights(const Args& a, int l, LAS unsigned char* L, int gw, int NGW, int wave, int lane) {
    LAS float* scr = (LAS float*)(L + wave * 16384);
    unsigned char* ws = a.ws;
    int it = gw;
#define CONV(idx, K_, Ns_, No_, GU_, gidx, dst_) { const float* Wp = (const float*)a.in[idx] + (size_t)l * (K_) * (Ns_); const float* gp = (gidx) >= 0 ? (const float*)a.in[(gidx) >= 0 ? (gidx) : 0] + (size_t)l * (K_) : nullptr; \
        const int nitems = ((K_) / 64) * ((No_) / 32); for (; it < nitems; it += NGW) conv_item(Wp, K_, Ns_, No_, GU_, gp, (bf16*)(ws + (dst_)), scr, it, lane); it -= nitems; }
    CONV(4, D, 2 * DFF, 2 * DFF, true, 3, W_GU1)
    CONV(5, DFF, D, D, false, -1, W_DN1)
    CONV(7, D, 10752, 10752, false, 6, W_IN)
    CONV(10, 512, D, D, false, -1, W_AB)
    CONV(11, D, D, D, false, -1, W_HB)
    CONV(12, D, D, D, false, -1, W_MO)
    CONV(15, D, D, D, false, 13, W_Q)
    CONV(16, D, 2 * D, 2 * D, false, -1, W_KV)
    CONV(17, D, D, D, false, -1, W_O)
    CONV(19, D, 2 * DFF, 2 * DFF, true, 18, W_GU2)
    CONV(20, DFF, D, D, false, -1, W_DN2)
#undef CONV
}

DI void prologue_misc(const Args& a, int gw, int NGW, int lane, int gtid, int NGT) {
    unsigned char* ws = a.ws;
    const float* x = (const float*)a.in[0];
    bf16* Xb = (bf16*)(ws + WS_XB); float* ssq = (float*)(ws + WS_SSQ);
    for (int m = gw; m < M; m += NGW) {
        const f32x4* xr = (const f32x4*)(x + (size_t)m * D) + lane; float s = 0.f;
        unsigned long long* o8 = (unsigned long long*)(Xb + (size_t)m * D) + lane;
#pragma unroll
        for (int j = 0; j < 4; ++j) { const f32x4 v = xr[64 * j]; s += (v[0] * v[0] + v[1] * v[1]) + (v[2] * v[2] + v[3] * v[3]);
            o8[64 * j] = (unsigned long long)pk2(v[0], v[1]) | ((unsigned long long)pk2(v[2], v[3]) << 32); }
        s = wave_sum(s);
        if (lane < 16) ssq[(size_t)m * 16 + lane] = lane == 0 ? s : 0.f;
    }
    const float* mem = (const float*)a.in[1]; const float* mnorm = (const float*)a.in[14]; bf16* memN = (bf16*)(ws + WS_MEMN);
    for (int r = gw; r < 2 * MROWS; r += NGW) {
        const int l = r / MROWS, m = r % MROWS;
        const f32x4* xr = (const f32x4*)(mem + (size_t)m * D) + lane; const f32x4* gr = (const f32x4*)(mnorm + (size_t)l * D) + lane;
        f32x4 v[4]; float s = 0.f;
#pragma unroll
        for (int j = 0; j < 4; ++j) { v[j] = xr[64 * j]; s += (v[j][0] * v[j][0] + v[j][1] * v[j][1]) + (v[j][2] * v[j][2] + v[j][3] * v[j][3]); }
        const float rs = 1.0f / sqrtf(wave_sum(s) * (1.0f / D) + EPS);
        unsigned long long* o8 = (unsigned long long*)(memN + (size_t)r * D) + lane;
#pragma unroll
        for (int j = 0; j < 4; ++j) { const f32x4 g = gr[64 * j]; const f32x4 y = v[j] * rs * g;
            o8[64 * j] = (unsigned long long)pk2(y[0], y[1]) | ((unsigned long long)pk2(y[2], y[3]) << 32); }
    }
    const int* pos = (const int*)a.in[2]; float* cosT = (float*)(ws + WS_COS); float* sinT = (float*)(ws + WS_SIN);
    for (int idx = gtid; idx < M * 64; idx += NGT) {
        const int row = idx >> 6, i = idx & 63;
        const float inv = exp2f(-(float)(2 * i) * (1.0f / 128.0f) * 13.287712379549449f);
        const float ang = (float)pos[row] * inv;
        double rv = (double)ang * 0.15915494309189535; rv -= floor(rv);
        const float fr = (float)rv;
        cosT[idx] = __builtin_amdgcn_cosf(fr); sinT[idx] = __builtin_amdgcn_sinf(fr);
    }
}

DI void rope8(u32x4 x1, u32x4 x2, const float* cp, const float* sp, u32x4& o1, u32x4& o2) {
    const f32x4 c0 = *(const f32x4*)cp, c1 = *(const f32x4*)(cp + 4), s0 = *(const f32x4*)sp, s1 = *(const f32x4*)(sp + 4);
#pragma unroll
    for (int q = 0; q < 4; ++q) {
        const float ca = q < 2 ? c0[2 * q] : c1[2 * q - 4], cb = q < 2 ? c0[2 * q + 1] : c1[2 * q - 3];
        const float sa = q < 2 ? s0[2 * q] : s1[2 * q - 4], sb = q < 2 ? s0[2 * q + 1] : s1[2 * q - 3];
        const float a0 = lo16(x1[q]), a1 = hi16(x1[q]), b0 = lo16(x2[q]), b1 = hi16(x2[q]);
        o1[q] = pk2(a0 * ca - b0 * sa, a1 * cb - b1 * sb);
        o2[q] = pk2(b0 * ca + a0 * sa, b1 * cb + a1 * sb);
    }
}
constexpr int KSTR = 272, VSTR = 528, KL_BYTES = 256 * KSTR;
DI unsigned vt_off(int dh, int kgrp) { return (unsigned)(dh * VSTR + ((kgrp ^ ((dh >> 3) & 7)) << 3)); }

DI void dil_attn_phase(LAS unsigned char* L, const bf16* Z, const float* cosT, const float* sinT, bf16* OG, float* LSE, int G, int bid, int tid) {
    const int wid = __builtin_amdgcn_readfirstlane(tid >> 6), lane = tid & 63, fr = lane & 15, fq = lane >> 4;
    LAS unsigned char* KL = L; LAS unsigned char* VL = L + KL_BYTES;
    for (int unit = bid; unit < 1536; unit += G) {
        const int j = unit & 31, h = (unit >> 5) & 3, gb = unit >> 7, g = gb % 3, b = gb / 3;
        const int dsh = 2 * g, Lseg = T >> dsh;
        const int p0 = 128 * j, r = p0 / Lseg, u0 = p0 & (Lseg - 1);
        const int tokbase = b * T + r;
        const int colq = g * 512 + h * 128, colk = 1536 + colq, colv = 3072 + colq;
        __syncthreads();
#pragma unroll
        for (int i = 0; i < 4; ++i) {
            const int p = tid + 512 * i, kk = p >> 3, pc = p & 7, uu = u0 - 128 + kk;
            u32x4 o1 = (u32x4){0u, 0u, 0u, 0u}, o2 = o1;
            if (uu >= 0) { const size_t tok = (size_t)(tokbase + (uu << dsh)); const bf16* kp = Z + tok * NATT + colk + 8 * pc;
                rope8(*(const u32x4*)kp, *(const u32x4*)(kp + 64), cosT + tok * 64 + 8 * pc, sinT + tok * 64 + 8 * pc, o1, o2); }
            *(LAS u32x4*)(KL + kk * KSTR + 16 * pc) = o1; *(LAS u32x4*)(KL + kk * KSTR + 128 + 16 * pc) = o2;
        }
#pragma unroll
        for (int i = 0; i < 8; ++i) {
            const int p = tid + 512 * i, kk = p >> 4, cb = p & 15, uu = u0 - 128 + kk;
            u32x4 x = (u32x4){0u, 0u, 0u, 0u};
            if (uu >= 0) x = *(const u32x4*)(Z + (size_t)(tokbase + (uu << dsh)) * NATT + colv + 8 * cb);
            const unsigned base = (unsigned)((((kk >> 2) ^ (cb & 7)) << 3) + (kk & 3) * 2);
#pragma unroll
            for (int jj = 0; jj < 8; ++jj) *(LAS unsigned short*)(VL + (8 * cb + jj) * VSTR + base) = (unsigned short)(x[jj >> 1] >> (16 * (jj & 1)));
        }
        const int qi = 16 * wid + fr; const size_t tq = (size_t)(tokbase + ((u0 + qi) << dsh));
        bf16x8 qf[4];
#pragma unroll
        for (int k2 = 0; k2 < 2; ++k2) { const int i0 = 32 * k2 + 8 * fq; const bf16* qp = Z + tq * NATT + colq + i0; u32x4 o1, o2;
            rope8(*(const u32x4*)qp, *(const u32x4*)(qp + 64), cosT + tq * 64 + i0, sinT + tq * 64 + i0, o1, o2); qf[k2] = mk8(o1); qf[k2 + 2] = mk8(o2); }
        __syncthreads();
        const int tw = wid & ~1;
        f32x4 s[10];
#pragma unroll
        for (int tix = 0; tix < 10; ++tix) { s[tix] = (f32x4){0.f, 0.f, 0.f, 0.f}; const int kt = tw + tix;
#pragma unroll
            for (int k4 = 0; k4 < 4; ++k4) { const bf16x8 av = *(const LAS bf16x8*)(KL + (16 * kt + fr) * KSTR + (32 * k4 + 8 * fq) * 2); s[tix] = MFMA16(av, qf[k4], s[tix]); } }
        const float scale = 0.08838834764831845f; float mx = -INFINITY;
#pragma unroll
        for (int tix = 0; tix < 10; ++tix)
#pragma unroll
            for (int e = 0; e < 4; ++e) { const int kk = 16 * (tw + tix) + 4 * fq + e; const bool ok = (kk >= qi) && (kk <= qi + 128) && (u0 - 128 + kk >= 0);
                const float v = ok ? s[tix][e] * scale : -INFINITY; s[tix][e] = v; mx = fmaxf(mx, v); }
        mx = fmaxf(mx, __shfl_xor(mx, 16)); mx = fmaxf(mx, __shfl_xor(mx, 32));
        float den = 0.f;
#pragma unroll
        for (int tix = 0; tix < 10; ++tix)
#pragma unroll
            for (int e = 0; e < 4; ++e) { const float p = __expf(s[tix][e] - mx); s[tix][e] = p; den += p; }
        den += __shfl_xor(den, 16); den += __shfl_xor(den, 32);
        bf16x8 pf[5];
#pragma unroll
        for (int pp = 0; pp < 5; ++pp) { u32x4 pw; pw.x = pk2(s[2 * pp][0], s[2 * pp][1]); pw.y = pk2(s[2 * pp][2], s[2 * pp][3]); pw.z = pk2(s[2 * pp + 1][0], s[2 * pp + 1][1]); pw.w = pk2(s[2 * pp + 1][2], s[2 * pp + 1][3]); pf[pp] = mk8(pw); }
        f32x4 o[8];
#pragma unroll
        for (int dt = 0; dt < 8; ++dt) { o[dt] = (f32x4){0.f, 0.f, 0.f, 0.f};
            const int dh = 16 * dt + fr, sw = (2 * dt + (fr >> 3)) & 7;
            const LAS unsigned char* va = VL + dh * VSTR + 32 * tw + ((fq ^ sw) << 3); const LAS unsigned char* vb2 = VL + dh * VSTR + 32 * tw + (((fq + 4) ^ sw) << 3);
#pragma unroll
            for (int pp = 0; pp < 5; ++pp) { const s16x4 lo = *(const LAS s16x4*)(va + 64 * pp), hi = *(const LAS s16x4*)(vb2 + 64 * pp);
                const bf16x8 vb = __builtin_shufflevector(lo, hi, 0, 1, 2, 3, 4, 5, 6, 7); o[dt] = MFMA16(pf[pp], vb, o[dt]); }
        }
        const float inv = 1.0f / den, lse = mx + __logf(den);
#pragma unroll
        for (int e = 0; e < 4; ++e) { const float iq = __shfl(inv, 4 * fq + e);
            bf16* op = OG + (size_t)(tokbase + ((u0 + 16 * wid + 4 * fq + e) << dsh)) * 1536 + colq + fr;
#pragma unroll
            for (int dt = 0; dt < 8; ++dt) op[16 * dt] = (bf16)f2bf(o[dt][e] * iq); }
        if (lane < 16) LSE[tq * 12 + g * 4 + h] = lse;
    }
}

DI void merge_phase(const bf16* OG, const float* LSE, bf16* AO, int gtid, int NGT) {
    for (int idx = gtid; idx < M * 64; idx += NGT) {
        const int tok = idx >> 6, h = (idx >> 4) & 3, c = idx & 15;
        const float l0 = LSE[(size_t)tok * 12 + h], l1 = LSE[(size_t)tok * 12 + 4 + h], l2 = LSE[(size_t)tok * 12 + 8 + h];
        const float mx = fmaxf(l0, fmaxf(l1, l2)); float w0 = __expf(l0 - mx), w1 = __expf(l1 - mx), w2 = __expf(l2 - mx); const float inv = 1.0f / (w0 + w1 + w2); w0 *= inv; w1 *= inv; w2 *= inv;
        const bf16* p = OG + (size_t)tok * 1536 + h * 128 + 8 * c;
        const u32x4 a = *(const u32x4*)p, b = *(const u32x4*)(p + 512), d = *(const u32x4*)(p + 1024); u32x4 o;
#pragma unroll
        for (int q = 0; q < 4; ++q) o[q] = pk2(w0 * lo16(a[q]) + w1 * lo16(b[q]) + w2 * lo16(d[q]), w0 * hi16(a[q]) + w1 * hi16(b[q]) + w2 * hi16(d[q]));
        *(u32x4*)(AO + (size_t)tok * 512 + h * 128 + 8 * c) = o;
    }
}

DI void xattn_stage_vt(LAS unsigned char* VL, const bf16* memVT, int b, int h, int hh, int tid) {
#pragma unroll
    for (int i = 0; i < 8; ++i) { const int p = tid + 512 * i, dhr = p >> 5, c = p & 31;
        const u32x4 x = *(const u32x4*)(memVT + (size_t)(h * 256 + 128 * hh + dhr) * MROWS + b * NMEM + 8 * c);
        u32x2 lo, hi; lo.x = x.x; lo.y = x.y; hi.x = x.z; hi.y = x.w;
        *(LAS u32x2*)(VL + vt_off(dhr, 2 * c)) = lo; *(LAS u32x2*)(VL + vt_off(dhr, 2 * c + 1)) = hi; }
}
DI void xattn_phase(LAS unsigned char* L, const bf16* Qx, const bf16* memK, const bf16* memVT, bf16* Ox, int G, int bid, int tid) {
    const int wid = __builtin_amdgcn_readfirstlane(tid >> 6), lane = tid & 63, fr = lane & 15, fq = lane >> 4;
    LAS unsigned char* KL = L; LAS unsigned char* VL = L + KL_BYTES;
    for (int unit = bid; unit < 512; unit += G) {
        const int j = unit & 31, h = (unit >> 5) & 3, b = unit >> 7;
        const int tok0 = b * T + 128 * j; const size_t tq = (size_t)(tok0 + 16 * wid + fr);
        bf16x8 qf[8];
#pragma unroll
        for (int k = 0; k < 8; ++k) qf[k] = *(const bf16x8*)(Qx + tq * D + h * 256 + 32 * k + 8 * fq);
        f32x4 s[16];
#pragma unroll
        for (int kt = 0; kt < 16; ++kt) s[kt] = (f32x4){0.f, 0.f, 0.f, 0.f};
#pragma unroll
        for (int hh = 0; hh < 2; ++hh) {
            __syncthreads();
#pragma unroll
            for (int i = 0; i < 8; ++i) { const int p = tid + 512 * i, m = p >> 4, cb = p & 15;
                *(LAS u32x4*)(KL + m * KSTR + 16 * cb) = *(const u32x4*)(memK + (size_t)(b * NMEM + m) * D + h * 256 + 128 * hh + 8 * cb); }
            if (hh == 0) xattn_stage_vt(VL, memVT, b, h, 0, tid);
            __syncthreads();
#pragma unroll
            for (int kt = 0; kt < 16; ++kt)
#pragma unroll
                for (int k4 = 0; k4 < 4; ++k4) { const bf16x8 av = *(const LAS bf16x8*)(KL + (16 * kt + fr) * KSTR + (32 * k4 + 8 * fq) * 2); s[kt] = MFMA16(av, qf[4 * hh + k4], s[kt]); }
        }
        float mx = -INFINITY;
#pragma unroll
        for (int kt = 0; kt < 16; ++kt)
#pragma unroll
            for (int e = 0; e < 4; ++e) { const float v = s[kt][e] * 0.0625f; s[kt][e] = v; mx = fmaxf(mx, v); }
        mx = fmaxf(mx, __shfl_xor(mx, 16)); mx = fmaxf(mx, __shfl_xor(mx, 32));
        float den = 0.f;
#pragma unroll
        for (int kt = 0; kt < 16; ++kt)
#pragma unroll
            for (int e = 0; e < 4; ++e) { const float p = __expf(s[kt][e] - mx); s[kt][e] = p; den += p; }
        den += __shfl_xor(den, 16); den += __shfl_xor(den, 32);
        bf16x8 pf[8];
#pragma unroll
        for (int pp = 0; pp < 8; ++pp) { u32x4 pw; pw.x = pk2(s[2 * pp][0], s[2 * pp][1]); pw.y = pk2(s[2 * pp][2], s[2 * pp][3]); pw.z = pk2(s[2 * pp + 1][0], s[2 * pp + 1][1]); pw.w = pk2(s[2 * pp + 1][2], s[2 * pp + 1][3]); pf[pp] = mk8(pw); }
        const float inv = 1.0f / den; float iq[4];
#pragma unroll
        for (int e = 0; e < 4; ++e) iq[e] = __shfl(inv, 4 * fq + e);
#pragma unroll
        for (int hh = 0; hh < 2; ++hh) {
            if (hh == 1) { __syncthreads(); xattn_stage_vt(VL, memVT, b, h, 1, tid); __syncthreads(); }
            f32x4 o[8];
#pragma unroll
            for (int dt = 0; dt < 8; ++dt) { o[dt] = (f32x4){0.f, 0.f, 0.f, 0.f};
                const int dh = 16 * dt + fr, sw = (2 * dt + (fr >> 3)) & 7;
                const LAS unsigned char* va = VL + dh * VSTR + ((fq ^ sw) << 3); const LAS unsigned char* vb2 = VL + dh * VSTR + (((fq + 4) ^ sw) << 3);
#pragma unroll
                for (int pp = 0; pp < 8; ++pp) { const s16x4 lo = *(const LAS s16x4*)(va + 64 * pp), hi = *(const LAS s16x4*)(vb2 + 64 * pp);
                    const bf16x8 vb = __builtin_shufflevector(lo, hi, 0, 1, 2, 3, 4, 5, 6, 7); o[dt] = MFMA16(pf[pp], vb, o[dt]); }
            }
#pragma unroll
            for (int e = 0; e < 4; ++e) { bf16* op = Ox + (size_t)(tok0 + 16 * wid + 4 * fq + e) * D + h * 256 + 128 * hh + fr;
#pragma unroll
                for (int dt = 0; dt < 8; ++dt) op[16 * dt] = (bf16)f2bf(o[dt][e] * iq[e]); }
        }
    }
}

constexpr int H1_QA = 0, H1_KA = 64 * 272, H1_VT = 2 * 64 * 272, H1_TOT = H1_VT + 128 * 144;
DI void hgrn1_phase(LAS unsigned char* L, bf16* Z2, const float* lbraw, int layer, float* DEC, unsigned long long* OI, int G, int bid, int tid) {
    const int wid = __builtin_amdgcn_readfirstlane(tid >> 6), lane = tid & 63, fr = lane & 15, fq = lane >> 4;
    const int n = tid & 127, rg = tid >> 7, tt = wid & 3, vh = wid >> 2;
    LAS float* TOT = (LAS float*)(L + H1_TOT);
    for (int unit = bid; unit < 2048; unit += G) {
        const int c = unit & 63, h = (unit >> 6) & 7, b = unit >> 9, tok0 = b * T + 64 * c, ch = h * 128 + n;
        float lbv = 0.f;
        if (layer > 0) { const float e0 = lbraw[ch], e1 = lbraw[D + ch]; lbv = 1.0f / (1.0f + expf(e0 - e1)); }
        float q[16], cs[16], kg[16]; unsigned short vr[16];
        bf16* base = Z2 + (size_t)(tok0 + 16 * rg) * NH2 + ch;
#pragma unroll
        for (int r = 0; r < 16; ++r) { const bf16* p = base + (size_t)r * NH2; q[r] = bf2f(p[0]); cs[r] = bf2f(p[1024]); vr[r] = p[2048]; }
        float run = 0.f;
#pragma unroll
        for (int r = 0; r < 16; ++r) { const float fl = cs[r]; const float sg = 1.0f / (1.0f + __expf(-fl)); const float f = lbv + (1.0f - lbv) * sg;
            kg[r] = (1.0f - lbv) / (1.0f + __expf(fl)); run += __logf(f); cs[r] = run; }
        asm volatile("s_waitcnt vmcnt(0)" ::: "memory");
        TOT[rg * 128 + n] = run;
        __syncthreads();
        const float t0 = TOT[n], t1 = TOT[128 + n], t2 = TOT[256 + n], t3 = TOT[384 + n];
        const float off = rg == 0 ? 0.f : (rg == 1 ? t0 : (rg == 2 ? t0 + t1 : t0 + t1 + t2));
        const float bmid = t0 + t1, blast = (t0 + t1) + (t2 + t3);
        const float qscale = 0.08838834764831845f;
        float kh[16];
#pragma unroll
        for (int r = 0; r < 16; ++r) { const float bt = off + cs[r]; const float qs = q[r] * qscale; const int row = 16 * rg + r;
            base[(size_t)r * NH2] = (bf16)f2bf(qs * __expf(bt));
            *(LAS unsigned short*)(L + H1_QA + row * 272 + n * 2) = (unsigned short)f2bf(qs * __expf(bt - bmid));
            *(LAS unsigned short*)(L + H1_KA + row * 272 + n * 2) = (unsigned short)f2bf(kg[r] * __expf(bmid - bt));
            kh[r] = kg[r] * __expf(blast - bt); }
        u32x4 k0, k1, v0, v1;
#pragma unroll
        for (int qd = 0; qd < 4; ++qd) { k0[qd] = pk2(kh[2 * qd], kh[2 * qd + 1]); k1[qd] = pk2(kh[8 + 2 * qd], kh[9 + 2 * qd]);
            v0[qd] = (unsigned)vr[2 * qd] | ((unsigned)vr[2 * qd + 1] << 16); v1[qd] = (unsigned)vr[8 + 2 * qd] | ((unsigned)vr[9 + 2 * qd] << 16); }
        bf16* slot = Z2 + (size_t)(tok0 + (n >> 1)) * NH2 + h * 128 + (n & 1) * 64 + 16 * rg;
        *(u32x4*)(slot + 1024) = k0; *(u32x4*)(slot + 1024 + 8) = k1;
        *(u32x4*)(slot + 2048) = v0; *(u32x4*)(slot + 2048 + 8) = v1;
        *(LAS u32x4*)(L + H1_VT + n * 144 + 32 * rg) = v0; *(LAS u32x4*)(L + H1_VT + n * 144 + 32 * rg + 16) = v1;
        if (rg == 0) DEC[(size_t)unit * 128 + n] = __expf(blast);
        __syncthreads();
        bf16x8 bq[4];
#pragma unroll
        for (int k4 = 0; k4 < 4; ++k4) bq[k4] = *(const LAS bf16x8*)(L + H1_QA + (16 * tt + fr) * 272 + (32 * k4 + 8 * fq) * 2);
        f32x4 at[4];
#pragma unroll
        for (int st = 0; st < 4; ++st) { at[st] = (f32x4){0.f, 0.f, 0.f, 0.f};
            if (st <= tt) {
#pragma unroll
                for (int k4 = 0; k4 < 4; ++k4) { const bf16x8 av = *(const LAS bf16x8*)(L + H1_KA + (16 * st + fr) * 272 + (32 * k4 + 8 * fq) * 2); at[st] = MFMA16(av, bq[k4], at[st]); }
                if (st == tt) {
#pragma unroll
                    for (int e = 0; e < 4; ++e) if (4 * fq + e > fr) at[st][e] = 0.f; }
            } }
        bf16x8 pf[2];
#pragma unroll
        for (int pp = 0; pp < 2; ++pp) { u32x4 pw; pw.x = pk2(at[2 * pp][0], at[2 * pp][1]); pw.y = pk2(at[2 * pp][2], at[2 * pp][3]); pw.z = pk2(at[2 * pp + 1][0], at[2 * pp + 1][1]); pw.w = pk2(at[2 * pp + 1][2], at[2 * pp + 1][3]); pf[pp] = mk8(pw); }
#pragma unroll
        for (int vi = 0; vi < 4; ++vi) { const int vt = 4 * vh + vi; f32x4 o = (f32x4){0.f, 0.f, 0.f, 0.f};
#pragma unroll
            for (int pp = 0; pp < 2; ++pp) { const LAS unsigned char* vp = L + H1_VT + (16 * vt + fr) * 144 + (32 * pp + 4 * fq) * 2;
                const s16x4 lo = *(const LAS s16x4*)vp, hi = *(const LAS s16x4*)(vp + 32);
                const bf16x8 vb = __builtin_shufflevector(lo, hi, 0, 1, 2, 3, 4, 5, 6, 7); o = MFMA16(pf[pp], vb, o); }
            OI[((size_t)(unit * 4 + tt) * 8 + vt) * 64 + lane] = (unsigned long long)pk2(o[0], o[1]) | ((unsigned long long)pk2(o[2], o[3]) << 32); }
    }
}

constexpr int H2_BUF = 36352, H2_KHT = 17408, H2_DEC = 35840, H2_PART = 3 * H2_BUF;
DI void hgrn2_phase(LAS unsigned char* L, bf16* Z2, const float* DEC, const unsigned long long* OI, const float* gain, int bh, int tid) {
    const int w = __builtin_amdgcn_readfirstlane(tid >> 6), lane = tid & 63, fr = lane & 15, fq = lane >> 4;
    const int b = bh >> 3, h = bh & 7, unit0 = bh * 64, vcol = 16 * w + fr;
    const float gn = gain[h * 128 + vcol];
    u32x4 sq[2], sk[2]; f32x4 sd = (f32x4){0.f, 0.f, 0.f, 0.f};
#define H2_LOAD(cc) do { const int tok0_ = b * T + 64 * (cc); _Pragma("unroll") for (int i = 0; i < 2; ++i) { const int p = tid + 512 * i, row = p >> 4, cb = p & 15; \
        const bf16* rp = Z2 + (size_t)(tok0_ + row) * NH2 + h * 128 + 8 * cb; sq[i] = *(const u32x4*)rp; sk[i] = *(const u32x4*)(rp + 1024); } \
        if (tid < 32) sd = *(const f32x4*)(DEC + (size_t)(unit0 + (cc)) * 128 + 4 * tid); } while (0)
#define H2_WRITE(bi) do { LAS unsigned char* B_ = L + (bi) * H2_BUF; _Pragma("unroll") for (int i = 0; i < 2; ++i) { const int p = tid + 512 * i, row = p >> 4, cb = p & 15; \
        *(LAS u32x4*)(B_ + row * 272 + 16 * cb) = sq[i]; *(LAS u32x4*)(B_ + H2_KHT + (2 * row + (cb >> 3)) * 144 + 16 * (cb & 7)) = sk[i]; } \
        if (tid < 32) *(LAS f32x4*)(B_ + H2_DEC + 16 * tid) = sd; } while (0)
    u32x4 vtf[2]; unsigned long long oi[4]; unsigned short og[16];
#define H2_PRIV(cc, VT_, OI_, OG_) do { const int tok0_ = b * T + 64 * (cc); \
        const bf16* vp_ = Z2 + (size_t)(tok0_ + (vcol >> 1)) * NH2 + 2048 + h * 128 + (vcol & 1) * 64 + 8 * fq; VT_[0] = *(const u32x4*)vp_; VT_[1] = *(const u32x4*)(vp_ + 32); \
        _Pragma("unroll") for (int tt_ = 0; tt_ < 4; ++tt_) { OI_[tt_] = OI[((size_t)((unit0 + (cc)) * 4 + tt_) * 8 + w) * 64 + lane]; \
            _Pragma("unroll") for (int e_ = 0; e_ < 4; ++e_) OG_[4 * tt_ + e_] = Z2[(size_t)(tok0_ + 16 * tt_ + 4 * fq + e_) * NH2 + 3072 + h * 128 + vcol]; } } while (0)
    H2_LOAD(0); H2_WRITE(0); H2_PRIV(0, vtf, oi, og);
    f32x4 S[8];
#pragma unroll
    for (int nt = 0; nt < 8; ++nt) S[nt] = (f32x4){0.f, 0.f, 0.f, 0.f};
    __syncthreads();
    for (int c = 0; c < 64; ++c) {
        const int cur = c % 3; LAS unsigned char* Bc = L + cur * H2_BUF;
        u32x4 nvt[2]; unsigned long long noi[4]; unsigned short nog[16];
        const int cn = c + 1 < 64 ? c + 1 : c;
        H2_LOAD(cn); H2_PRIV(cn, nvt, noi, nog);
        f32x4 o[4];
#pragma unroll
        for (int tt = 0; tt < 4; ++tt) { const unsigned lo = (unsigned)oi[tt], hi = (unsigned)(oi[tt] >> 32); o[tt] = (f32x4){lo16(lo), hi16(lo), lo16(hi), hi16(hi)}; }
        bf16x8 sb[4];
#pragma unroll
        for (int np = 0; np < 4; ++np) { u32x4 pw; pw.x = pk2(S[2 * np][0], S[2 * np][1]); pw.y = pk2(S[2 * np][2], S[2 * np][3]); pw.z = pk2(S[2 * np + 1][0], S[2 * np + 1][1]); pw.w = pk2(S[2 * np + 1][2], S[2 * np + 1][3]); sb[np] = mk8(pw); }
#pragma unroll
        for (int tt = 0; tt < 4; ++tt)
#pragma unroll
            for (int np = 0; np < 4; ++np) { const LAS unsigned char* qp = Bc + (16 * tt + fr) * 272 + (32 * np + 4 * fq) * 2;
                const s16x4 lo = *(const LAS s16x4*)qp, hi = *(const LAS s16x4*)(qp + 32);
                const bf16x8 av = __builtin_shufflevector(lo, hi, 0, 1, 2, 3, 4, 5, 6, 7); o[tt] = MFMA16(av, sb[np], o[tt]); }
        LAS float* PART = (LAS float*)(L + H2_PART + (c & 1) * 2048);
#pragma unroll
        for (int tt = 0; tt < 4; ++tt) { f32x4 q2 = o[tt] * o[tt];
#pragma unroll
            for (int sh = 1; sh < 16; sh <<= 1) { q2[0] += __shfl_xor(q2[0], sh); q2[1] += __shfl_xor(q2[1], sh); q2[2] += __shfl_xor(q2[2], sh); q2[3] += __shfl_xor(q2[3], sh); }
            if (fr == 0) *(LAS f32x4*)(PART + w * 64 + 16 * tt + 4 * fq) = q2; }
        if (c + 1 < 64) H2_WRITE((c + 1) % 3);
        __syncthreads();
        const int tok0 = b * T + 64 * c;
#pragma unroll
        for (int tt = 0; tt < 4; ++tt) { f32x4 rs = (f32x4){0.f, 0.f, 0.f, 0.f};
#pragma unroll
            for (int w2 = 0; w2 < 8; ++w2) rs += *(const LAS f32x4*)(PART + w2 * 64 + 16 * tt + 4 * fq);
#pragma unroll
            for (int e = 0; e < 4; ++e) { const float rstd = 1.0f / sqrtf(rs[e] * (1.0f / 128.0f) + EPS); const float gv = bf2f(og[4 * tt + e]);
                Z2[(size_t)(tok0 + 16 * tt + 4 * fq + e) * NH2 + 3072 + h * 128 + vcol] = (bf16)f2bf(o[tt][e] * rstd * gn * (gv * sigmoidf_(gv))); } }
#pragma unroll
        for (int nt = 0; nt < 8; ++nt) { const f32x4 dv = *(const LAS f32x4*)(Bc + H2_DEC + (16 * nt + 4 * fq) * 4); S[nt] = S[nt] * dv;
#pragma unroll
            for (int ks = 0; ks < 2; ++ks) { const bf16x8 av = *(const LAS bf16x8*)(Bc + H2_KHT + (16 * nt + fr) * 144 + (32 * ks + 8 * fq) * 2); S[nt] = MFMA16(av, mk8(vtf[ks]), S[nt]); } }
        vtf[0] = nvt[0]; vtf[1] = nvt[1];
#pragma unroll
        for (int i = 0; i < 4; ++i) oi[i] = noi[i];
#pragma unroll
        for (int i = 0; i < 16; ++i) og[i] = nog[i];
    }
#undef H2_LOAD
#undef H2_WRITE
#undef H2_PRIV
}

#define GSYNC() cg::this_grid().sync()
#define FRESH() unsigned char* ws = a.ws; asm volatile("" : "+s"(ws)); int tid = threadIdx.x; asm volatile("" : "+v"(tid)); \
    const int lane = tid & 63, wave = __builtin_amdgcn_readfirstlane(tid >> 6); int G = gridDim.x, bid = blockIdx.x; asm volatile("" : "+s"(G), "+s"(bid)); \
    const int gw = bid * 8 + wave, NGW = G * 8, gtid = bid * 512 + tid, NGT = G * 512; float* X = a.out; asm volatile("" : "+s"(X)); \
    bf16* Xb = (bf16*)(ws + WS_XB); float* ssq = (float*)(ws + WS_SSQ); bf16* Z = (bf16*)(ws + WS_Z); \
    (void)lane; (void)gw; (void)NGW; (void)gtid; (void)NGT; (void)Xb; (void)ssq; (void)Z; (void)X;

__global__ void __launch_bounds__(512, 2) fwd_megakernel(Args a) {
    extern __shared__ __attribute__((aligned(16))) unsigned char lds_raw[];
    LAS unsigned char* L = (LAS unsigned char*)lds_raw;

    { FRESH(); conv_weights(a, 0, L, gw, NGW, wave, lane); }
    { FRESH(); prologue_misc(a, gw, NGW, lane, gtid, NGT); }
    GSYNC();

    for (int l = 0; l < 2; ++l) {
        if (l > 0) { { FRESH(); conv_weights(a, l, L, gw, NGW, wave, lane); } GSYNC(); }
        { FRESH(); run_gemm(L, Xb, D, (const bf16*)(ws + W_GU1), D, M, 2 * DFF, D, G, bid, EpiSwiglu{Z, ssq}); }
        GSYNC();
        { FRESH(); run_gemm(L, Z, DFF, (const bf16*)(ws + W_DN1), DFF, M, D, DFF, G, bid, EpiResid{l == 0 ? (const float*)a.in[0] : X, X, Xb, ssq, 0.5f}); }
        GSYNC();
        { FRESH(); run_gemm(L, Xb, D, (const bf16*)(ws + W_IN), D, M, NATT, D, G, bid, EpiZ{Z, NATT, ssq}); }
        GSYNC();
        { FRESH(); dil_attn_phase(L, Z, (const float*)(ws + WS_COS), (const float*)(ws + WS_SIN), (bf16*)(ws + WS_OG), (float*)(ws + WS_LSE), G, bid, tid); }
        GSYNC();
        { FRESH(); run_gemm(L, Xb, D, (const bf16*)(ws + W_IN) + (size_t)NATT * D, D, M, NH2, D, G, bid, EpiZ{Z, NH2, ssq}); }
        { FRESH(); merge_phase((const bf16*)(ws + WS_OG), (const float*)(ws + WS_LSE), (bf16*)(ws + WS_AO), gtid, NGT); }
        GSYNC();
        { FRESH(); hgrn1_phase(L, Z, (const float*)a.in[8], l, (float*)(ws + WS_DEC), (unsigned long long*)(ws + WS_OG), G, bid, tid); }
        GSYNC();
        { FRESH();
          if (bid < 32) hgrn2_phase(L, Z, (const float*)(ws + WS_DEC), (const unsigned long long*)(ws + WS_OG), (const float*)a.in[9] + (size_t)l * D, bid, tid);
          else {
            const bf16* memN = (const bf16*)(ws + WS_MEMN) + (size_t)l * MROWS * D; const bf16* Wkv = (const bf16*)(ws + W_KV);
            run_gemm(L, memN, D, Wkv, D, MROWS, D, D, G - 32, bid - 32, EpiZ{(bf16*)(ws + WS_MEMK), D, nullptr});
            run_gemm(L, Wkv + (size_t)D * D, D, memN, D, D, MROWS, D, G - 32, G - 1 - bid, EpiZ{(bf16*)(ws + WS_MEMVT), MROWS, nullptr});
          } }
        GSYNC();
        { FRESH(); run_gemm(L, Xb, D, (const bf16*)(ws + W_IN) + (size_t)(NATT + NH2) * D, D, M, 2048, D, G, bid, EpiZ{Z, NH2, ssq}); }
        GSYNC();
        { FRESH(); run_gemm(L, (const bf16*)(ws + WS_AO), 512, (const bf16*)(ws + W_AB), 512, M, D, 512, G, bid, EpiGate<false>{Z, NH2, Z + 2048, NH2}); }
        { FRESH(); run_gemm(L, Z + 3072, NH2, (const bf16*)(ws + W_HB), D, M, D, D, G, bid, EpiGate<true>{Z + 1024, NH2, Z + 2048, NH2}); }
        GSYNC();
        { FRESH(); run_gemm(L, Z + 2048, NH2, (const bf16*)(ws + W_MO), D, M, D, D, G, bid, EpiResid{X, X, Xb, ssq, 1.0f}); }
        GSYNC();
        { FRESH(); run_gemm(L, Xb, D, (const bf16*)(ws + W_Q), D, M, D, D, G, bid, EpiZ{Z, D, ssq}); }
        GSYNC();
        { FRESH(); xattn_phase(L, Z, (const bf16*)(ws + WS_MEMK), (const bf16*)(ws + WS_MEMVT), Z + (size_t)M * D, G, bid, tid); }
        GSYNC();
        { FRESH(); run_gemm(L, Z + (size_t)M * D, D, (const bf16*)(ws + W_O), D, M, D, D, G, bid, EpiResid{X, X, Xb, ssq, 1.0f}); }
        GSYNC();
        { FRESH(); run_gemm(L, Xb, D, (const bf16*)(ws + W_GU2), D, M, 2 * DFF, D, G, bid, EpiSwiglu{Z, ssq}); }
        GSYNC();
        { FRESH(); run_gemm(L, Z, DFF, (const bf16*)(ws + W_DN2), DFF, M, D, DFF, G, bid, EpiResid{X, X, Xb, ssq, 0.5f}); }
        GSYNC();
    }
    { FRESH();
      const float* fg = (const float*)a.in[21];
      for (int m = gw; m < M; m += NGW) {
        f32x4* xr = (f32x4*)(X + (size_t)m * D) + lane; const f32x4* gr = (const f32x4*)fg + lane;
        f32x4 v[4]; float s = 0.f;
#pragma unroll
        for (int j = 0; j < 4; ++j) { v[j] = xr[64 * j]; s += (v[j][0] * v[j][0] + v[j][1] * v[j][1]) + (v[j][2] * v[j][2] + v[j][3] * v[j][3]); }
        const float rs = 1.0f / sqrtf(wave_sum(s) * (1.0f / D) + EPS);
#pragma unroll
        for (int j = 0; j < 4; ++j) xr[64 * j] = v[j] * rs * gr[64 * j];
      } }
}

extern "C" void kernel_launch(void* const* d_in, const int* in_sizes, int n_in, void* d_out, int out_size, void* d_ws, size_t ws_size, hipStream_t stream) {
    static int grid = 0;
    if (grid == 0) {
        if (n_in != 22 || out_size != M * D || ws_size < WS_END) { fprintf(stderr, "kernel_launch: unexpected shapes (n_in %d out %d ws %zu)\n", n_in, out_size, ws_size); grid = -1; return; }
        int dev = 0, cus = 0, per_cu = 0;
        hipGetDevice(&dev); hipDeviceGetAttribute(&cus, hipDeviceAttributeMultiprocessorCount, dev);
        hipFuncSetAttribute((const void*)fwd_megakernel, hipFuncAttributeMaxDynamicSharedMemorySize, LDS_BYTES);
        hipOccupancyMaxActiveBlocksPerMultiprocessor(&per_cu, (const void*)fwd_megakernel, 512, LDS_BYTES);
        if (per_cu < 1) { fprintf(stderr, "kernel_launch: occupancy query reports %d blocks per CU\n", per_cu); grid = -1; return; }
        grid = cus;
        if (grid < 64) { fprintf(stderr, "kernel_launch: too few CUs (%d)\n", grid); grid = -1; return; }
    }
    if (grid < 0) return;
    Args a{};
    for (int i = 0; i < 22; ++i) a.in[i] = d_in[i];
    a.out = (float*)d_out; a.ws = (unsigned char*)d_ws;
    void* args[] = {&a};
    hipError_t e = hipLaunchCooperativeKernel((const void*)fwd_megakernel, dim3(grid), dim3(512), args, LDS_BYTES, stream);
    if (e != hipSuccess) fprintf(stderr, "cooperative launch failed: %s (grid %d)\n", hipGetErrorString(e), grid);
}
```

```cpp
#include <hip/hip_runtime.h>
#include <hip/hip_cooperative_groups.h>
#include <cstdio>
#include <cstdint>
namespace cg = cooperative_groups;
namespace pg8 {
#define PG8_LAS __attribute__((address_space(3)))
typedef unsigned short bf16_t;
typedef short bf16x8 __attribute__((ext_vector_type(8)));
typedef float f32x4 __attribute__((ext_vector_type(4)));
typedef unsigned u32x4 __attribute__((ext_vector_type(4)));
constexpr int BM = 256, BK = 64, HALF = 128, HTB = HALF * BK * 2  , STAGE_BYTES = 8 * HTB, NXCD = 8, WGM = 8;

__host__ __device__ __forceinline__ int lds_byte(int r, int c) { const int st = (r >> 4) * 2 + (c >> 5), rr = r & 15, cc = c & 31, ob = rr * 64 + cc * 2; return st * 1024 + (ob ^ (((ob >> 9) & 1) << 5)); }
__host__ __device__ __forceinline__ void stage_rc(int b, int& R, int& C) { const int st = b / 1024, sb = b % 1024, swz = sb ^ (((sb >> 9) & 1) << 5); R = (st >> 1) * 16 + swz / 64; C = (st & 1) * 32 + (swz % 64) / 2; }
__host__ __device__ __forceinline__ int perm32(int rho) { const int n = rho >> 4, i = rho & 15; return 8 * (i >> 2) + 4 * n + (i & 3); }

struct Unit { int pm, pn; };
struct Gemm { const bf16_t* A; const bf16_t* Bt; int M, N, K, lda, ldb; };

struct StaticOrder {
    int nM, nN, nwg, G, c;
    __host__ __device__ void init(int M, int N, int G_, int c_) { nM = M / BM; nN = N / BM; nwg = nM * nN; G = G_; c = c_; }
    __host__ __device__ bool next(int i, Unit& u) const {
        const long L = (long)i * G + c; if (L >= nwg) return false;
        int wgid = (int)L; { const int q = nwg / NXCD, r = nwg % NXCD, xcd = wgid % NXCD, off = wgid / NXCD; wgid = (xcd < r ? xcd * (q + 1) : r * (q + 1) + (xcd - r) * q) + off; }
        const int nig = WGM * nN, gid = wgid / nig, fm = gid * WGM, gsz = (nM - fm) < WGM ? (nM - fm) : WGM;
        u.pm = fm + ((wgid % nig) % gsz); u.pn = (wgid % nig) / gsz; return true;
    }
    __device__ __forceinline__ void a_ready(const Unit&) const {}
    __device__ __forceinline__ void done(const Unit&) const {}
};

template <class Epi, class Sched, bool ALIGN_EPI = false, bool SP2 = false>
__device__ __forceinline__ void gemm_phase(PG8_LAS unsigned char* lds, const Gemm g, const Sched& S, const Epi& E) {
    int tid_ = threadIdx.x; asm volatile("" : "+v"(tid_)); const int tid = tid_, wid = __builtin_amdgcn_readfirstlane(tid >> 6), lane = tid & 63, wr = wid >> 2, wc = wid & 3, fr = lane & 15, fq = lane >> 4;
    const int K = g.K, nt = K / BK;
    unsigned voffA[2], voffB[2];
#pragma unroll
    for (int i = 0; i < 2; ++i) { int R, C; stage_rc(tid * 16 + i * 8192, R, C); const int Rb = Epi::PERM ? ((R & ~31) + perm32(R & 31)) : R;
        voffA[i] = (unsigned)(R * g.lda + C) * 2u; voffB[i] = (unsigned)(Rb * g.ldb + C) * 2u; }
    const size_t kstep = (size_t)(BK * 2);
    const size_t hstepA = (size_t)HALF * g.lda * 2, hstepB = (size_t)HALF * g.ldb * 2;
    const size_t tstepA = 2 * hstepA, tstepB = 2 * hstepB;
    const unsigned ldsw = (unsigned)wid * 1024u;
    const int aoff = lds_byte(wr * 64 + fr, fq * 8), boff = lds_byte(wc * 32 + fr, fq * 8);
#define PG8_SA(b, h) (((b) * 2 + (h)) * HTB)
#define PG8_SB(b, h) ((4 + (b) * 2 + (h)) * HTB)
#define PG8_STAGE(bufoff, gbase, voff) do { _Pragma("unroll") for (int _i = 0; _i < 2; ++_i) \
        __builtin_amdgcn_global_load_lds((const unsigned*)((const char*)(gbase) + (voff)[_i]), (PG8_LAS unsigned*)(lds + (bufoff) + ldsw + _i * 8192), 16, 0, 0); } while (0)
#define PG8_LDA(dst, b, h) do { _Pragma("unroll") for (int m = 0; m < 4; ++m) _Pragma("unroll") for (int k = 0; k < 2; ++k) dst[m][k] = *(const PG8_LAS bf16x8*)(lds + PG8_SA(b, h) + aoff + m * 2048 + k * 1024); } while (0)
#define PG8_LDB(dst, b, h) do { _Pragma("unroll") for (int n = 0; n < 2; ++n) _Pragma("unroll") for (int k = 0; k < 2; ++k) dst[n][k] = *(const PG8_LAS bf16x8*)(lds + PG8_SB(b, h) + boff + n * 2048 + k * 1024); } while (0)
#define PG8_MMA(ai, bj, At, Bt) do { __builtin_amdgcn_s_setprio(1); _Pragma("unroll") for (int m = 0; m < 4; ++m) _Pragma("unroll") for (int n = 0; n < 2; ++n) _Pragma("unroll") for (int k = 0; k < 2; ++k) \
        acc[ai][bj][m][n] = __builtin_amdgcn_mfma_f32_16x16x32_bf16(Bt[n][k], At[m][k], acc[ai][bj][m][n], 0, 0, 0); __builtin_amdgcn_s_setprio(0); } while (0)
#define PG8_WAIT_V(n) asm volatile("s_waitcnt vmcnt(" #n ")" ::: "memory")
#define PG8_WAIT_L(n) asm volatile("s_waitcnt lgkmcnt(" #n ")" ::: "memory")
#define PG8_BAR __builtin_amdgcn_s_barrier()
#define PG8_SCHED __builtin_amdgcn_sched_barrier(0)
    Unit cur, nxt; int ui = 0;
    if (!S.next(0, cur)) return;
    f32x4 acc[2][2][4][2];
#pragma unroll
    for (int a = 0; a < 2; ++a)
#pragma unroll
        for (int b = 0; b < 2; ++b)
#pragma unroll
            for (int m = 0; m < 4; ++m)
#pragma unroll
                for (int n = 0; n < 2; ++n) acc[a][b][m][n] = (f32x4){0.f, 0.f, 0.f, 0.f};
    bf16x8 At[4][2], B0[2][2], B1[2][2];
    const char* cA = (const char*)g.A + (size_t)cur.pm * tstepA; const char* cB = (const char*)g.Bt + (size_t)cur.pn * tstepB;
    S.a_ready(cur);
    if constexpr (SP2) {
        PG8_STAGE(PG8_SB(0, 0), cB, voffB); PG8_STAGE(PG8_SB(0, 1), cB + hstepB, voffB); PG8_STAGE(PG8_SA(0, 0), cA, voffA); PG8_STAGE(PG8_SA(0, 1), cA + hstepA, voffA);
        if (wr == 1) PG8_BAR;
        PG8_WAIT_V(2); PG8_BAR;
        PG8_STAGE(PG8_SB(1, 0), cB + kstep, voffB); PG8_STAGE(PG8_SA(1, 0), cA + kstep, voffA); PG8_STAGE(PG8_SB(1, 1), cB + hstepB + kstep, voffB);
        PG8_WAIT_V(6); PG8_BAR;
    } else {
        PG8_STAGE(PG8_SB(0, 0), cB, voffB); PG8_STAGE(PG8_SA(0, 0), cA, voffA); PG8_STAGE(PG8_SB(0, 1), cB + hstepB, voffB); PG8_STAGE(PG8_SA(0, 1), cA + hstepA, voffA);
        if (wr == 1) PG8_BAR;
        PG8_WAIT_V(4); PG8_BAR;
        PG8_STAGE(PG8_SB(1, 0), cB + kstep, voffB); PG8_STAGE(PG8_SA(1, 0), cA + kstep, voffA); PG8_STAGE(PG8_SB(1, 1), cB + hstepB + kstep, voffB);
        PG8_WAIT_V(6); PG8_BAR;
    }
    for (;;) {
        const bool has_next = S.next(ui + 1, nxt);
        const char* nA = has_next ? (const char*)g.A + (size_t)nxt.pm * tstepA : cA; const char* nB = has_next ? (const char*)g.Bt + (size_t)nxt.pn * tstepB : cB;
        for (int t = 0; t < nt; t += 2) {
            const bool last = (t == nt - 2);
            const char* a1 = cA + (size_t)(t + 1) * kstep;
            const char* a2 = last ? nA : cA + (size_t)(t + 2) * kstep; const char* b2 = last ? nB : cB + (size_t)(t + 2) * kstep;
            const char* a3 = a2 + kstep; const char* b3 = b2 + kstep;
            if (last && has_next) S.a_ready(nxt);
            if constexpr (SP2) {
            PG8_LDB(B0, 0, 0); PG8_LDB(B1, 0, 1); PG8_SCHED; PG8_LDA(At, 0, 0); PG8_STAGE(PG8_SA(1, 1), a1 + hstepA, voffA);
            PG8_WAIT_V(8); PG8_WAIT_L(0); PG8_BAR; PG8_MMA(0, 0, At, B0); PG8_MMA(0, 1, At, B1); PG8_BAR; PG8_SCHED;
            PG8_LDA(At, 0, 1); PG8_STAGE(PG8_SB(0, 0), b2, voffB); PG8_STAGE(PG8_SB(0, 1), b2 + hstepB, voffB); PG8_STAGE(PG8_SA(0, 0), a2, voffA);
            PG8_WAIT_V(8); PG8_WAIT_L(0); PG8_BAR; PG8_MMA(1, 0, At, B0); PG8_MMA(1, 1, At, B1); PG8_BAR; PG8_SCHED;
            PG8_LDB(B0, 1, 0); PG8_LDB(B1, 1, 1); PG8_SCHED; PG8_LDA(At, 1, 0); PG8_STAGE(PG8_SA(0, 1), a2 + hstepA, voffA);
            PG8_WAIT_V(8); PG8_WAIT_L(0); PG8_BAR; PG8_MMA(0, 0, At, B0); PG8_MMA(0, 1, At, B1); PG8_BAR; PG8_SCHED;
            PG8_LDA(At, 1, 1); PG8_STAGE(PG8_SB(1, 0), b3, voffB); PG8_STAGE(PG8_SB(1, 1), b3 + hstepB, voffB); PG8_STAGE(PG8_SA(1, 0), a3, voffA);
            PG8_WAIT_V(8); PG8_WAIT_L(0); PG8_BAR; PG8_MMA(1, 0, At, B0); PG8_MMA(1, 1, At, B1); PG8_BAR; PG8_SCHED;
            } else {
            PG8_LDB(B0, 0, 0); PG8_SCHED; PG8_LDA(At, 0, 0); PG8_STAGE(PG8_SA(1, 1), a1 + hstepA, voffA);
            PG8_WAIT_L(8); PG8_BAR; PG8_WAIT_L(0); PG8_MMA(0, 0, At, B0); PG8_BAR; PG8_SCHED;
            PG8_LDB(B1, 0, 1); PG8_STAGE(PG8_SB(0, 0), b2, voffB);
            PG8_BAR; PG8_WAIT_L(0); PG8_MMA(0, 1, At, B1); PG8_BAR;
            PG8_LDA(At, 0, 1); PG8_STAGE(PG8_SA(0, 0), a2, voffA);
            PG8_BAR; PG8_WAIT_L(0); PG8_MMA(1, 0, At, B0); PG8_BAR; PG8_SCHED;
            PG8_STAGE(PG8_SB(0, 1), b2 + hstepB, voffB);
            PG8_WAIT_V(6); PG8_BAR; PG8_MMA(1, 1, At, B1); PG8_BAR;
            PG8_LDB(B0, 1, 0); PG8_SCHED; PG8_LDA(At, 1, 0); PG8_STAGE(PG8_SA(0, 1), a2 + hstepA, voffA);
            PG8_WAIT_L(8); PG8_BAR; PG8_WAIT_L(0); PG8_MMA(0, 0, At, B0); PG8_BAR; PG8_SCHED;
            PG8_LDB(B1, 1, 1); PG8_STAGE(PG8_SB(1, 0), b3, voffB);
            PG8_BAR; PG8_WAIT_L(0); PG8_MMA(0, 1, At, B1); PG8_BAR;
            PG8_LDA(At, 1, 1); PG8_STAGE(PG8_SA(1, 0), a3, voffA);
            PG8_BAR; PG8_WAIT_L(0); PG8_MMA(1, 0, At, B0); PG8_BAR; PG8_SCHED;
            PG8_STAGE(PG8_SB(1, 1), b3 + hstepB, voffB);
            PG8_WAIT_V(6); PG8_BAR; PG8_MMA(1, 1, At, B1); PG8_BAR;
            }
        }
        if constexpr (ALIGN_EPI) { if (wr == 0) PG8_BAR; }
        if constexpr (!Epi::AFTER_DRAIN) { E(acc, cur, wr, wc, fr, fq); S.done(cur); }
        if (!has_next) break;
#pragma unroll
        for (int a = 0; a < 2; ++a)
#pragma unroll
            for (int b = 0; b < 2; ++b)
#pragma unroll
                for (int m = 0; m < 4; ++m)
#pragma unroll
                    for (int n = 0; n < 2; ++n) acc[a][b][m][n] = (f32x4){0.f, 0.f, 0.f, 0.f};
        cur = nxt; cA = nA; cB = nB; ++ui;
        if constexpr (ALIGN_EPI) { if (wr == 1) PG8_BAR; }
    }
    PG8_WAIT_V(0);
    if constexpr (!ALIGN_EPI) { if (wr == 0) PG8_BAR; }
    PG8_BAR;
    if constexpr (Epi::AFTER_DRAIN) { E.fused(acc, cur, wr, wc, fr, fq, lds, wid, lane); S.done(cur); }
#undef PG8_SA
#undef PG8_SB
#undef PG8_STAGE
#undef PG8_LDA
#undef PG8_LDB
#undef PG8_MMA
#undef PG8_WAIT_V
#undef PG8_WAIT_L
#undef PG8_BAR
#undef PG8_SCHED
}
}

#define DI __device__ __forceinline__
#define LAS __attribute__((address_space(3)))
typedef unsigned short bf16;
typedef short bf16x8 __attribute__((ext_vector_type(8)));
typedef short s16x4 __attribute__((ext_vector_type(4)));
typedef float f32x4 __attribute__((ext_vector_type(4)));
typedef unsigned u32x4 __attribute__((ext_vector_type(4)));
typedef unsigned u32x2 __attribute__((ext_vector_type(2)));
using pg8::Unit;

constexpr int NB = 4, T = 4096, D = 1024, M = NB * T, DFF = 2816, NMEM = 256, MROWS = NB * NMEM;
constexpr int NATT = 4608, NH2 = 4096;
constexpr float EPS = 1e-6f;
constexpr int LDS_BYTES = 147456;

constexpr size_t MiB = 1u << 20;
constexpr size_t W_GU1 = 0, W_DN1 = W_GU1 + (size_t)2 * DFF * D * 2, W_IN = W_DN1 + (size_t)D * DFF * 2, W_AB = W_IN + (size_t)10752 * D * 2,
                 W_HB = W_AB + (size_t)D * 512 * 2, W_MO = W_HB + (size_t)D * D * 2, W_Q = W_MO + (size_t)D * D * 2, W_KV = W_Q + (size_t)D * D * 2,
                 W_O = W_KV + (size_t)2 * D * D * 2, W_GU2 = W_O + (size_t)D * D * 2, W_DN2 = W_GU2 + (size_t)2 * DFF * D * 2, W_END = W_DN2 + (size_t)D * DFF * 2;
static_assert(W_END <= 68 * MiB, "weights");
constexpr size_t WS_XB = 68 * MiB, WS_Z = 100 * MiB, WS_OG = 244 * MiB, WS_AO = 292 * MiB, WS_COS = 308 * MiB, WS_SIN = 312 * MiB, WS_MEMN = 316 * MiB,
                 WS_MEMK = 320 * MiB, WS_MEMVT = 322 * MiB, WS_SSQ = 324 * MiB, WS_DEC = 325 * MiB, WS_LSE = 326 * MiB, WS_CTL = 327 * MiB, CTL_BYTES = 65536, WS_END = 327 * MiB + CTL_BYTES;

DI float bf2f(unsigned short h) { return __uint_as_float((unsigned)h << 16); }
DI unsigned f2bf(float f) { unsigned u = __float_as_uint(f); return (u + 0x7fffu + ((u >> 16) & 1u)) >> 16; }
DI unsigned pk2(float lo, float hi) { return f2bf(lo) | (f2bf(hi) << 16); }
DI float lo16(unsigned u) { return __uint_as_float(u << 16); }
DI float hi16(unsigned u) { return __uint_as_float(u & 0xffff0000u); }
DI float wave_sum(float v) {
#pragma unroll
    for (int o = 1; o < 64; o <<= 1) v += __shfl_xor(v, o);
    return v;
}
DI float sigmoidf_(float x) { return 1.0f / (1.0f + __expf(-x)); }
DI bf16x8 mk8(u32x4 v) { return __builtin_bit_cast(bf16x8, v); }
#define MFMA16(a, b, c) __builtin_amdgcn_mfma_f32_16x16x32_bf16((a), (b), (c), 0, 0, 0)

DI float row_rstd(const float* ssq, int row) {
    const f32x4* p = (const f32x4*)(ssq + (size_t)row * 16);
    const f32x4 a = p[0], b = p[1], c = p[2], d = p[3];
    const float s = ((a[0] + a[1]) + (a[2] + a[3])) + ((b[0] + b[1]) + (b[2] + b[3])) + ((c[0] + c[1]) + (c[2] + c[3])) + ((d[0] + d[1]) + (d[2] + d[3]));
    return 1.0f / sqrtf(s * (1.0f / D) + EPS);
}
struct EpiZ {
    static constexpr bool PERM = true, AFTER_DRAIN = false;
    bf16* O; int ldc; const float* ssq;
    DI void operator()(const f32x4 (&acc)[2][2][4][2], const Unit& u, int wr, int wc, int fr, int fq) const {
        const int row0 = u.pm * 256 + wr * 64 + fr, col0 = u.pn * 256 + wc * 32 + 8 * fq;
#pragma unroll
        for (int ai = 0; ai < 2; ++ai)
#pragma unroll
            for (int m = 0; m < 4; ++m) {
                const int row = row0 + ai * 128 + m * 16;
                const float rs = ssq ? row_rstd(ssq, row) : 1.0f;
                bf16* rowp = O + (size_t)row * ldc + col0;
#pragma unroll
                for (int bj = 0; bj < 2; ++bj) {
                    const f32x4 v0 = acc[ai][bj][m][0] * rs, v1 = acc[ai][bj][m][1] * rs;
                    u32x4 w; w.x = pk2(v0[0], v0[1]); w.y = pk2(v0[2], v0[3]); w.z = pk2(v1[0], v1[1]); w.w = pk2(v1[2], v1[3]);
                    *(u32x4*)(rowp + bj * 128) = w;
                }
            }
    }
};
struct EpiSwiglu {
    static constexpr bool PERM = true, AFTER_DRAIN = false;
    bf16* H; const float* ssq;
    DI void operator()(const f32x4 (&acc)[2][2][4][2], const Unit& u, int wr, int wc, int fr, int fq) const {
        const int row0 = u.pm * 256 + wr * 64 + fr, col0 = u.pn * 128 + wc * 32 + 8 * fq;
#pragma unroll
        for (int ai = 0; ai < 2; ++ai)
#pragma unroll
            for (int m = 0; m < 4; ++m) {
                const int row = row0 + ai * 128 + m * 16;
                const float rs = row_rstd(ssq, row);
                float h[8];
#pragma unroll
                for (int n = 0; n < 2; ++n)
#pragma unroll
                    for (int e = 0; e < 4; ++e) { const float g = acc[ai][0][m][n][e] * rs, up = acc[ai][1][m][n][e] * rs; h[4 * n + e] = g * sigmoidf_(g) * up; }
                u32x4 w; w.x = pk2(h[0], h[1]); w.y = pk2(h[2], h[3]); w.z = pk2(h[4], h[5]); w.w = pk2(h[6], h[7]);
                *(u32x4*)(H + (size_t)row * DFF + col0) = w;
            }
    }
};
struct EpiResid {
    static constexpr bool PERM = false, AFTER_DRAIN = false;
    const float* xin; float* xout; bf16* Xb; float* ssq; float alpha;
    DI void operator()(const f32x4 (&acc)[2][2][4][2], const Unit& u, int wr, int wc, int fr, int fq) const {
        const int row0 = u.pm * 256 + wr * 64 + fr, col0 = u.pn * 256 + wc * 32 + 4 * fq;
#pragma unroll
        for (int ai = 0; ai < 2; ++ai)
#pragma unroll
            for (int m = 0; m < 4; ++m) {
                const int row = row0 + ai * 128 + m * 16; float ss = 0.f;
#pragma unroll
                for (int bj = 0; bj < 2; ++bj)
#pragma unroll
                    for (int n = 0; n < 2; ++n) {
                        const size_t off = (size_t)row * D + col0 + bj * 128 + n * 16;
                        const f32x4 x = *(const f32x4*)(xin + off) + acc[ai][bj][m][n] * alpha;
                        *(f32x4*)(xout + off) = x;
                        u32x2 w; w.x = pk2(x[0], x[1]); w.y = pk2(x[2], x[3]); *(u32x2*)(Xb + off) = w;
                        ss += (x[0] * x[0] + x[1] * x[1]) + (x[2] * x[2] + x[3] * x[3]);
                    }
                ss += __shfl_xor(ss, 16); ss += __shfl_xor(ss, 32);
                if (fq == 0) ssq[(size_t)row * 16 + u.pn * 4 + wc] = ss;
            }
    }
};
template <bool ADD> struct EpiGate {
    static constexpr bool PERM = true, AFTER_DRAIN = false;
    const bf16* Gt; int ldg; bf16* Mg; int ldm;
    DI void operator()(const f32x4 (&acc)[2][2][4][2], const Unit& u, int wr, int wc, int fr, int fq) const {
        const int row0 = u.pm * 256 + wr * 64 + fr, col0 = u.pn * 256 + wc * 32 + 8 * fq;
#pragma unroll
        for (int ai = 0; ai < 2; ++ai)
#pragma unroll
            for (int m = 0; m < 4; ++m) {
                const int row = row0 + ai * 128 + m * 16;
#pragma unroll
                for (int bj = 0; bj < 2; ++bj) {
                    const u32x4 gv = *(const u32x4*)(Gt + (size_t)row * ldg + col0 + bj * 128);
                    bf16* mp = Mg + (size_t)row * ldm + col0 + bj * 128;
                    u32x4 pv = (u32x4){0u, 0u, 0u, 0u}; if (ADD) pv = *(const u32x4*)mp;
                    float r[8];
#pragma unroll
                    for (int q = 0; q < 4; ++q) {
                        const float a0 = acc[ai][bj][m][q >> 1][(q & 1) * 2], a1 = acc[ai][bj][m][q >> 1][(q & 1) * 2 + 1];
                        r[2 * q] = sigmoidf_(lo16(gv[q])) * a0 + (ADD ? lo16(pv[q]) : 0.f);
                        r[2 * q + 1] = sigmoidf_(hi16(gv[q])) * a1 + (ADD ? hi16(pv[q]) : 0.f);
                    }
                    u32x4 w; w.x = pk2(r[0], r[1]); w.y = pk2(r[2], r[3]); w.z = pk2(r[4], r[5]); w.w = pk2(r[6], r[7]);
                    *(u32x4*)mp = w;
                }
            }
    }
};

template <class Epi>
DI void run_gemm(LAS unsigned char* lds, const bf16* A, int lda, const bf16* Bt, int ldb, int Mr, int N, int K, int G, int c, const Epi& E) {
    pg8::Gemm g{A, Bt, Mr, N, K, lda, ldb}; pg8::StaticOrder S; S.init(Mr, N, G, c);
    pg8::gemm_phase<Epi, pg8::StaticOrder, true, true>(lds, g, S, E);
}

DI void conv_item(const float* W, int K, int Nsrc, int Nout, bool GU, const float* gain, bf16* WT, LAS float* scr, int item, int lane) {
    const int nblk = Nout / 32, kb = item / nblk, nb = item % nblk, k0 = 64 * kb, n0 = 32 * nb;
    const int src0 = GU ? (((n0 & 255) >> 7) * DFF + 128 * (n0 >> 8) + (n0 & 127)) : n0;
#pragma unroll 8
    for (int i = 0; i < 32; ++i) { const int kk = 2 * i + (lane >> 5); const float g = gain ? gain[k0 + kk] : 1.0f;
        scr[kk * 33 + (lane & 31)] = W[(size_t)(k0 + kk) * Nsrc + src0 + (lane & 31)] * g; }
    asm volatile("s_waitcnt lgkmcnt(0)" ::: "memory");
    const int c = lane & 7;
#pragma unroll
    for (int j = 0; j < 4; ++j) { const int n = (lane >> 3) + 8 * j; const LAS float* s = scr + (8 * c) * 33 + n;
        u32x4 o; o.x = pk2(s[0 * 33], s[1 * 33]); o.y = pk2(s[2 * 33], s[3 * 33]); o.z = pk2(s[4 * 33], s[5 * 33]); o.w = pk2(s[6 * 33], s[7 * 33]);
        *(u32x4*)(WT + (size_t)(n0 + n) * K + k0 + 8 * c) = o; }
    asm volatile("s_waitcnt lgkmcnt(0)" ::: "memory");
}

struct Args { const void* in[22]; float* out; unsigned char* ws; };

DI void conv_weights(const Args& a, int l, LAS unsigned char* L, int gw, int NGW, int wave, int lane) {
    LAS float* scr = (LAS float*)(L + wave * 16384);
    unsigned char* ws = a.ws;
    int it = gw;
#define CONV(idx, K_, Ns_, No_, GU_, gidx, dst_) { const float* Wp = (const float*)a.in[idx] + (size_t)l * (K_) * (Ns_); const float* gp = (gidx) >= 0 ? (const float*)a.in[(gidx) >= 0 ? (gidx) : 0] + (size_t)l * (K_) : nullptr; \
        const int nitems = ((K_) / 64) * ((No_) / 32); for (; it < nitems; it += NGW) conv_item(Wp, K_, Ns_, No_, GU_, gp, (bf16*)(ws + (dst_)), scr, it, lane); it -= nitems; }
    CONV(4, D, 2 * DFF, 2 * DFF, true, 3, W_GU1)
    CONV(5, DFF, D, D, false, -1, W_DN1)
    CONV(7, D, 10752, 10752, false, 6, W_IN)
    CONV(10, 512, D, D, false, -1, W_AB)
    CONV(11, D, D, D, false, -1, W_HB)
    CONV(12, D, D, D, false, -1, W_MO)
    CONV(15, D, D, D, false, 13, W_Q)
    CONV(16, D, 2 * D, 2 * D, false, -1, W_KV)
    CONV(17, D, D, D, false, -1, W_O)
    CONV(19, D, 2 * DFF, 2 * DFF, true, 18, W_GU2)
    CONV(20, DFF, D, D, false, -1, W_DN2)
#undef CONV
}

DI void prologue_misc(const Args& a, int gw, int NGW, int lane, int gtid, int NGT) {
    unsigned char* ws = a.ws;
    const float* x = (const float*)a.in[0];
    bf16* Xb = (bf16*)(ws + WS_XB); float* ssq = (float*)(ws + WS_SSQ);
    for (int m = gw; m < M; m += NGW) {
        const f32x4* xr = (const f32x4*)(x + (size_t)m * D) + lane; float s = 0.f;
        unsigned long long* o8 = (unsigned long long*)(Xb + (size_t)m * D) + lane;
#pragma unroll
        for (int j = 0; j < 4; ++j) { const f32x4 v = xr[64 * j]; s += (v[0] * v[0] + v[1] * v[1]) + (v[2] * v[2] + v[3] * v[3]);
            o8[64 * j] = (unsigned long long)pk2(v[0], v[1]) | ((unsigned long long)pk2(v[2], v[3]) << 32); }
        s = wave_sum(s);
        if (lane < 16) ssq[(size_t)m * 16 + lane] = lane == 0 ? s : 0.f;
    }
    const float* mem = (const float*)a.in[1]; const float* mnorm = (const float*)a.in[14]; bf16* memN = (bf16*)(ws + WS_MEMN);
    for (int r = gw; r < 2 * MROWS; r += NGW) {
        const int l = r / MROWS, m = r % MROWS;
        const f32x4* xr = (const f32x4*)(mem + (size_t)m * D) + lane; const f32x4* gr = (const f32x4*)(mnorm + (size_t)l * D) + lane;
        f32x4 v[4]; float s = 0.f;
#pragma unroll
        for (int j = 0; j < 4; ++j) { v[j] = xr[64 * j]; s += (v[j][0] * v[j][0] + v[j][1] * v[j][1]) + (v[j][2] * v[j][2] + v[j][3] * v[j][3]); }
        const float rs = 1.0f / sqrtf(wave_sum(s) * (1.0f / D) + EPS);
        unsigned long long* o8 = (unsigned long long*)(memN + (size_t)r * D) + lane;
#pragma unroll
        for (int j = 0; j < 4; ++j) { const f32x4 g = gr[64 * j]; const f32x4 y = v[j] * rs * g;
            o8[64 * j] = (unsigned long long)pk2(y[0], y[1]) | ((unsigned long long)pk2(y[2], y[3]) << 32); }
    }
    const int* pos = (const int*)a.in[2]; float* cosT = (float*)(ws + WS_COS); float* sinT = (float*)(ws + WS_SIN);
    for (int idx = gtid; idx < M * 64; idx += NGT) {
        const int row = idx >> 6, i = idx & 63;
        const float inv = exp2f(-(float)(2 * i) * (1.0f / 128.0f) * 13.287712379549449f);
        const float ang = (float)pos[row] * inv;
        double rv = (double)ang * 0.15915494309189535; rv -= floor(rv);
        const float fr = (float)rv;
        cosT[idx] = __builtin_amdgcn_cosf(fr); sinT[idx] = __builtin_amdgcn_sinf(fr);
    }
}

DI void rope8(u32x4 x1, u32x4 x2, const float* cp, const float* sp, u32x4& o1, u32x4& o2) {
    const f32x4 c0 = *(const f32x4*)cp, c1 = *(const f32x4*)(cp + 4), s0 = *(const f32x4*)sp, s1 = *(const f32x4*)(sp + 4);
#pragma unroll
    for (int q = 0; q < 4; ++q) {
        const float ca = q < 2 ? c0[2 * q] : c1[2 * q - 4], cb = q < 2 ? c0[2 * q + 1] : c1[2 * q - 3];
        const float sa = q < 2 ? s0[2 * q] : s1[2 * q - 4], sb = q < 2 ? s0[2 * q + 1] : s1[2 * q - 3];
        const float a0 = lo16(x1[q]), a1 = hi16(x1[q]), b0 = lo16(x2[q]), b1 = hi16(x2[q]);
        o1[q] = pk2(a0 * ca - b0 * sa, a1 * cb - b1 * sb);
        o2[q] = pk2(b0 * ca + a0 * sa, b1 * cb + a1 * sb);
    }
}
constexpr int KSTR = 272, VSTR = 528, KL_BYTES = 256 * KSTR;
DI unsigned vt_off(int dh, int kgrp) { return (unsigned)(dh * VSTR + ((kgrp ^ ((dh >> 3) & 7)) << 3)); }

DI void dil_attn_phase(LAS unsigned char* L, const bf16* Z, const float* cosT, const float* sinT, bf16* OG, float* LSE, int G, int bid, int tid) {
    const int wid = __builtin_amdgcn_readfirstlane(tid >> 6), lane = tid & 63, fr = lane & 15, fq = lane >> 4;
    LAS unsigned char* KL = L; LAS unsigned char* VL = L + KL_BYTES;
    for (int unit = bid; unit < 1536; unit += G) {
        const int j = unit & 31, h = (unit >> 5) & 3, gb = unit >> 7, g = gb % 3, b = gb / 3;
        const int dsh = 2 * g, Lseg = T >> dsh;
        const int p0 = 128 * j, r = p0 / Lseg, u0 = p0 & (Lseg - 1);
        const int tokbase = b * T + r;
        const int colq = g * 512 + h * 128, colk = 1536 + colq, colv = 3072 + colq;
        __syncthreads();
#pragma unroll
        for (int i = 0; i < 4; ++i) {
            const int p = tid + 512 * i, kk = p >> 3, pc = p & 7, uu = u0 - 128 + kk;
            u32x4 o1 = (u32x4){0u, 0u, 0u, 0u}, o2 = o1;
            if (uu >= 0) { const size_t tok = (size_t)(tokbase + (uu << dsh)); const bf16* kp = Z + tok * NATT + colk + 8 * pc;
                rope8(*(const u32x4*)kp, *(const u32x4*)(kp + 64), cosT + tok * 64 + 8 * pc, sinT + tok * 64 + 8 * pc, o1, o2); }
            *(LAS u32x4*)(KL + kk * KSTR + 16 * pc) = o1; *(LAS u32x4*)(KL + kk * KSTR + 128 + 16 * pc) = o2;
        }
#pragma unroll
        for (int i = 0; i < 8; ++i) {
            const int p = tid + 512 * i, kk = p >> 4, cb = p & 15, uu = u0 - 128 + kk;
            u32x4 x = (u32x4){0u, 0u, 0u, 0u};
            if (uu >= 0) x = *(const u32x4*)(Z + (size_t)(tokbase + (uu << dsh)) * NATT + colv + 8 * cb);
            const unsigned base = (unsigned)((((kk >> 2) ^ (cb & 7)) << 3) + (kk & 3) * 2);
#pragma unroll
            for (int jj = 0; jj < 8; ++jj) *(LAS unsigned short*)(VL + (8 * cb + jj) * VSTR + base) = (unsigned short)(x[jj >> 1] >> (16 * (jj & 1)));
        }
        const int qi = 16 * wid + fr; const size_t tq = (size_t)(tokbase + ((u0 + qi) << dsh));
        bf16x8 qf[4];
#pragma unroll
        for (int k2 = 0; k2 < 2; ++k2) { const int i0 = 32 * k2 + 8 * fq; const bf16* qp = Z + tq * NATT + colq + i0; u32x4 o1, o2;
            rope8(*(const u32x4*)qp, *(const u32x4*)(qp + 64), cosT + tq * 64 + i0, sinT + tq * 64 + i0, o1, o2); qf[k2] = mk8(o1); qf[k2 + 2] = mk8(o2); }
        __syncthreads();
        const int tw = wid & ~1;
        f32x4 s[10];
#pragma unroll
        for (int tix = 0; tix < 10; ++tix) { s[tix] = (f32x4){0.f, 0.f, 0.f, 0.f}; const int kt = tw + tix;
#pragma unroll
            for (int k4 = 0; k4 < 4; ++k4) { const bf16x8 av = *(const LAS bf16x8*)(KL + (16 * kt + fr) * KSTR + (32 * k4 + 8 * fq) * 2); s[tix] = MFMA16(av, qf[k4], s[tix]); } }
        const float scale = 0.08838834764831845f; float mx = -INFINITY;
#pragma unroll
        for (int tix = 0; tix < 10; ++tix)
#pragma unroll
            for (int e = 0; e < 4; ++e) { const int kk = 16 * (tw + tix) + 4 * fq + e; const bool ok = (kk >= qi) && (kk <= qi + 128) && (u0 - 128 + kk >= 0);
                const float v = ok ? s[tix][e] * scale : -INFINITY; s[tix][e] = v; mx = fmaxf(mx, v); }
        mx = fmaxf(mx, __shfl_xor(mx, 16)); mx = fmaxf(mx, __shfl_xor(mx, 32));
        float den = 0.f;
#pragma unroll
        for (int tix = 0; tix < 10; ++tix)
#pragma unroll
            for (int e = 0; e < 4; ++e) { const float p = __expf(s[tix][e] - mx); s[tix][e] = p; den += p; }
        den += __shfl_xor(den, 16); den += __shfl_xor(den, 32);
        bf16x8 pf[5];
#pragma unroll
        for (int pp = 0; pp < 5; ++pp) { u32x4 pw; pw.x = pk2(s[2 * pp][0], s[2 * pp][1]); pw.y = pk2(s[2 * pp][2], s[2 * pp][3]); pw.z = pk2(s[2 * pp + 1][0], s[2 * pp + 1][1]); pw.w = pk2(s[2 * pp + 1][2], s[2 * pp + 1][3]); pf[pp] = mk8(pw); }
        f32x4 o[8];
#pragma unroll
        for (int dt = 0; dt < 8; ++dt) { o[dt] = (f32x4){0.f, 0.f, 0.f, 0.f};
            const int dh = 16 * dt + fr, sw = (2 * dt + (fr >> 3)) & 7;
            const LAS unsigned char* va = VL + dh * VSTR + 32 * tw + ((fq ^ sw) << 3); const LAS unsigned char* vb2 = VL + dh * VSTR + 32 * tw + (((fq + 4) ^ sw) << 3);
#pragma unroll
            for (int pp = 0; pp < 5; ++pp) { const s16x4 lo = *(const LAS s16x4*)(va + 64 * pp), hi = *(const LAS s16x4*)(vb2 + 64 * pp);
                const bf16x8 vb = __builtin_shufflevector(lo, hi, 0, 1, 2, 3, 4, 5, 6, 7); o[dt] = MFMA16(pf[pp], vb, o[dt]); }
        }
        const float inv = 1.0f / den, lse = mx + __logf(den);
#pragma unroll
        for (int e = 0; e < 4; ++e) { const float iq = __shfl(inv, 4 * fq + e);
            bf16* op = OG + (size_t)(tokbase + ((u0 + 16 * wid + 4 * fq + e) << dsh)) * 1536 + colq + fr;
#pragma unroll
            for (int dt = 0; dt < 8; ++dt) op[16 * dt] = (bf16)f2bf(o[dt][e] * iq); }
        if (lane < 16) LSE[tq * 12 + g * 4 + h] = lse;
    }
}

DI void merge_phase(const bf16* OG, const float* LSE, bf16* AO, int gtid, int NGT) {
    for (int idx = gtid; idx < M * 64; idx += NGT) {
        const int tok = idx >> 6, h = (idx >> 4) & 3, c = idx & 15;
        const float l0 = LSE[(size_t)tok * 12 + h], l1 = LSE[(size_t)tok * 12 + 4 + h], l2 = LSE[(size_t)tok * 12 + 8 + h];
        const float mx = fmaxf(l0, fmaxf(l1, l2)); float w0 = __expf(l0 - mx), w1 = __expf(l1 - mx), w2 = __expf(l2 - mx); const float inv = 1.0f / (w0 + w1 + w2); w0 *= inv; w1 *= inv; w2 *= inv;
        const bf16* p = OG + (size_t)tok * 1536 + h * 128 + 8 * c;
        const u32x4 a = *(const u32x4*)p, b = *(const u32x4*)(p + 512), d = *(const u32x4*)(p + 1024); u32x4 o;
#pragma unroll
        for (int q = 0; q < 4; ++q) o[q] = pk2(w0 * lo16(a[q]) + w1 * lo16(b[q]) + w2 * lo16(d[q]), w0 * hi16(a[q]) + w1 * hi16(b[q]) + w2 * hi16(d[q]));
        *(u32x4*)(AO + (size_t)tok * 512 + h * 128 + 8 * c) = o;
    }
}

DI void xattn_stage_vt(LAS unsigned char* VL, const bf16* memVT, int b, int h, int hh, int tid) {
#pragma unroll
    for (int i = 0; i < 8; ++i) { const int p = tid + 512 * i, dhr = p >> 5, c = p & 31;
        const u32x4 x = *(const u32x4*)(memVT + (size_t)(h * 256 + 128 * hh + dhr) * MROWS + b * NMEM + 8 * c);
        u32x2 lo, hi; lo.x = x.x; lo.y = x.y; hi.x = x.z; hi.y = x.w;
        *(LAS u32x2*)(VL + vt_off(dhr, 2 * c)) = lo; *(LAS u32x2*)(VL + vt_off(dhr, 2 * c + 1)) = hi; }
}
DI void xattn_phase(LAS unsigned char* L, const bf16* Qx, const bf16* memK, const bf16* memVT, bf16* Ox, int G, int bid, int tid) {
    const int wid = __builtin_amdgcn_readfirstlane(tid >> 6), lane = tid & 63, fr = lane & 15, fq = lane >> 4;
    LAS unsigned char* KL = L; LAS unsigned char* VL = L + KL_BYTES;
    for (int unit = bid; unit < 512; unit += G) {
        const int j = unit & 31, h = (unit >> 5) & 3, b = unit >> 7;
        const int tok0 = b * T + 128 * j; const size_t tq = (size_t)(tok0 + 16 * wid + fr);
        bf16x8 qf[8];
#pragma unroll
        for (int k = 0; k < 8; ++k) qf[k] = *(const bf16x8*)(Qx + tq * D + h * 256 + 32 * k + 8 * fq);
        f32x4 s[16];
#pragma unroll
        for (int kt = 0; kt < 16; ++kt) s[kt] = (f32x4){0.f, 0.f, 0.f, 0.f};
#pragma unroll
        for (int hh = 0; hh < 2; ++hh) {
            __syncthreads();
#pragma unroll
            for (int i = 0; i < 8; ++i) { const int p = tid + 512 * i, m = p >> 4, cb = p & 15;
                *(LAS u32x4*)(KL + m * KSTR + 16 * cb) = *(const u32x4*)(memK + (size_t)(b * NMEM + m) * D + h * 256 + 128 * hh + 8 * cb); }
            if (hh == 0) xattn_stage_vt(VL, memVT, b, h, 0, tid);
            __syncthreads();
#pragma unroll
            for (int kt = 0; kt < 16; ++kt)
#pragma unroll
                for (int k4 = 0; k4 < 4; ++k4) { const bf16x8 av = *(const LAS bf16x8*)(KL + (16 * kt + fr) * KSTR + (32 * k4 + 8 * fq) * 2); s[kt] = MFMA16(av, qf[4 * hh + k4], s[kt]); }
        }
        float mx = -INFINITY;
#pragma unroll
        for (int kt = 0; kt < 16; ++kt)
#pragma unroll
            for (int e = 0; e < 4; ++e) { const float v = s[kt][e] * 0.0625f; s[kt][e] = v; mx = fmaxf(mx, v); }
        mx = fmaxf(mx, __shfl_xor(mx, 16)); mx = fmaxf(mx, __shfl_xor(mx, 32));
        float den = 0.f;
#pragma unroll
        for (int kt = 0; kt < 16; ++kt)
#pragma unroll
            for (int e = 0; e < 4; ++e) { const float p = __expf(s[kt][e] - mx); s[kt][e] = p; den += p; }
        den += __shfl_xor(den, 16); den += __shfl_xor(den, 32);
        bf16x8 pf[8];
#pragma unroll
        for (int pp = 0; pp < 8; ++pp) { u32x4 pw; pw.x = pk2(s[2 * pp][0], s[2 * pp][1]); pw.y = pk2(s[2 * pp][2], s[2 * pp][3]); pw.z = pk2(s[2 * pp + 1][0], s[2 * pp + 1][1]); pw.w = pk2(s[2 * pp + 1][2], s[2 * pp + 1][3]); pf[pp] = mk8(pw); }
        const float inv = 1.0f / den; float iq[4];
#pragma unroll
        for (int e = 0; e < 4; ++e) iq[e] = __shfl(inv, 4 * fq + e);
#pragma unroll
        for (int hh = 0; hh < 2; ++hh) {
            if (hh == 1) { __syncthreads(); xattn_stage_vt(VL, memVT, b, h, 1, tid); __syncthreads(); }
            f32x4 o[8];
#pragma unroll
            for (int dt = 0; dt < 8; ++dt) { o[dt] = (f32x4){0.f, 0.f, 0.f, 0.f};
                const int dh = 16 * dt + fr, sw = (2 * dt + (fr >> 3)) & 7;
                const LAS unsigned char* va = VL + dh * VSTR + ((fq ^ sw) << 3); const LAS unsigned char* vb2 = VL + dh * VSTR + (((fq + 4) ^ sw) << 3);
#pragma unroll
                for (int pp = 0; pp < 8; ++pp) { const s16x4 lo = *(const LAS s16x4*)(va + 64 * pp), hi = *(const LAS s16x4*)(vb2 + 64 * pp);
                    const bf16x8 vb = __builtin_shufflevector(lo, hi, 0, 1, 2, 3, 4, 5, 6, 7); o[dt] = MFMA16(pf[pp], vb, o[dt]); }
            }
#pragma unroll
            for (int e = 0; e < 4; ++e) { bf16* op = Ox + (size_t)(tok0 + 16 * wid + 4 * fq + e) * D + h * 256 + 128 * hh + fr;
#pragma unroll
                for (int dt = 0; dt < 8; ++dt) op[16 * dt] = (bf16)f2bf(o[dt][e] * iq[e]); }
        }
    }
}

constexpr int H1_QA = 0, H1_KA = 64 * 272, H1_VT = 2 * 64 * 272, H1_TOT = H1_VT + 128 * 144;
template <bool DRY> DI void hgrn1_phase(LAS unsigned char* L, bf16* Z2, const float* lbraw, int layer, float* DEC, unsigned long long* OI, int G, int bid, int tid) {
    const int wid = __builtin_amdgcn_readfirstlane(tid >> 6), lane = tid & 63, fr = lane & 15, fq = lane >> 4;
    const int n = tid & 127, rg = tid >> 7, tt = wid & 3, vh = wid >> 2;
    LAS float* TOT = (LAS float*)(L + H1_TOT);
    for (int unit = bid; unit < 2048; unit += G) {
        const int c = unit & 63, h = (unit >> 6) & 7, b = unit >> 9, tok0 = b * T + 64 * c, ch = h * 128 + n;
        float lbv = 0.f;
        if (layer > 0) { const float e0 = lbraw[ch], e1 = lbraw[D + ch]; lbv = 1.0f / (1.0f + expf(e0 - e1)); }
        float q[16], cs[16], kg[16]; unsigned short vr[16];
        bf16* base = Z2 + (size_t)(tok0 + 16 * rg) * NH2 + ch;
#pragma unroll
        for (int r = 0; r < 16; ++r) { const bf16* p = base + (size_t)r * NH2; q[r] = bf2f(p[0]); cs[r] = bf2f(p[1024]); vr[r] = p[2048]; }
        float run = 0.f;
#pragma unroll
        for (int r = 0; r < 16; ++r) { const float fl = cs[r]; const float sg = 1.0f / (1.0f + __expf(-fl)); const float f = lbv + (1.0f - lbv) * sg;
            kg[r] = (1.0f - lbv) / (1.0f + __expf(fl)); run += __logf(f); cs[r] = run; }
        asm volatile("s_waitcnt vmcnt(0)" ::: "memory");
        TOT[rg * 128 + n] = run;
        __syncthreads();
        const float t0 = TOT[n], t1 = TOT[128 + n], t2 = TOT[256 + n], t3 = TOT[384 + n];
        const float off = rg == 0 ? 0.f : (rg == 1 ? t0 : (rg == 2 ? t0 + t1 : t0 + t1 + t2));
        const float bmid = t0 + t1, blast = (t0 + t1) + (t2 + t3);
        const float qscale = 0.08838834764831845f;
        float kh[16];
#pragma unroll
        for (int r = 0; r < 16; ++r) { const float bt = off + cs[r]; const float qs = q[r] * qscale; const int row = 16 * rg + r;
            if (!DRY) base[(size_t)r * NH2] = (bf16)f2bf(qs * __expf(bt));
            *(LAS unsigned short*)(L + H1_QA + row * 272 + n * 2) = (unsigned short)f2bf(qs * __expf(bt - bmid));
            *(LAS unsigned short*)(L + H1_KA + row * 272 + n * 2) = (unsigned short)f2bf(kg[r] * __expf(bmid - bt));
            kh[r] = kg[r] * __expf(blast - bt); }
        u32x4 k0, k1, v0, v1;
#pragma unroll
        for (int qd = 0; qd < 4; ++qd) { k0[qd] = pk2(kh[2 * qd], kh[2 * qd + 1]); k1[qd] = pk2(kh[8 + 2 * qd], kh[9 + 2 * qd]);
            v0[qd] = (unsigned)vr[2 * qd] | ((unsigned)vr[2 * qd + 1] << 16); v1[qd] = (unsigned)vr[8 + 2 * qd] | ((unsigned)vr[9 + 2 * qd] << 16); }
        bf16* slot = Z2 + (size_t)(tok0 + (n >> 1)) * NH2 + h * 128 + (n & 1) * 64 + 16 * rg;
        if (!DRY) { *(u32x4*)(slot + 1024) = k0; *(u32x4*)(slot + 1024 + 8) = k1;
        *(u32x4*)(slot + 2048) = v0; *(u32x4*)(slot + 2048 + 8) = v1; }
        *(LAS u32x4*)(L + H1_VT + n * 144 + 32 * rg) = v0; *(LAS u32x4*)(L + H1_VT + n * 144 + 32 * rg + 16) = v1;
        if (!DRY && rg == 0) DEC[(size_t)unit * 128 + n] = __expf(blast);
        __syncthreads();
        bf16x8 bq[4];
#pragma unroll
        for (int k4 = 0; k4 < 4; ++k4) bq[k4] = *(const LAS bf16x8*)(L + H1_QA + (16 * tt + fr) * 272 + (32 * k4 + 8 * fq) * 2);
        f32x4 at[4];
#pragma unroll
        for (int st = 0; st < 4; ++st) { at[st] = (f32x4){0.f, 0.f, 0.f, 0.f};
            if (st <= tt) {
#pragma unroll
                for (int k4 = 0; k4 < 4; ++k4) { const bf16x8 av = *(const LAS bf16x8*)(L + H1_KA + (16 * st + fr) * 272 + (32 * k4 + 8 * fq) * 2); at[st] = MFMA16(av, bq[k4], at[st]); }
                if (st == tt) {
#pragma unroll
                    for (int e = 0; e < 4; ++e) if (4 * fq + e > fr) at[st][e] = 0.f; }
            } }
        bf16x8 pf[2];
#pragma unroll
        for (int pp = 0; pp < 2; ++pp) { u32x4 pw; pw.x = pk2(at[2 * pp][0], at[2 * pp][1]); pw.y = pk2(at[2 * pp][2], at[2 * pp][3]); pw.z = pk2(at[2 * pp + 1][0], at[2 * pp + 1][1]); pw.w = pk2(at[2 * pp + 1][2], at[2 * pp + 1][3]); pf[pp] = mk8(pw); }
#pragma unroll
        for (int vi = 0; vi < 4; ++vi) { const int vt = 4 * vh + vi; f32x4 o = (f32x4){0.f, 0.f, 0.f, 0.f};
#pragma unroll
            for (int pp = 0; pp < 2; ++pp) { const LAS unsigned char* vp = L + H1_VT + (16 * vt + fr) * 144 + (32 * pp + 4 * fq) * 2;
                const s16x4 lo = *(const LAS s16x4*)vp, hi = *(const LAS s16x4*)(vp + 32);
                const bf16x8 vb = __builtin_shufflevector(lo, hi, 0, 1, 2, 3, 4, 5, 6, 7); o = MFMA16(pf[pp], vb, o); }
            if (!DRY) OI[((size_t)(unit * 4 + tt) * 8 + vt) * 64 + lane] = (unsigned long long)pk2(o[0], o[1]) | ((unsigned long long)pk2(o[2], o[3]) << 32); }
    }
}

constexpr int H2_BUF = 36352, H2_KHT = 17408, H2_DEC = 35840, H2_PART = 3 * H2_BUF;
template <bool DRY> DI void hgrn2_phase(LAS unsigned char* L, bf16* Z2, const float* DEC, const unsigned long long* OI, const float* gain, int bh, int tid) {
    const int w = __builtin_amdgcn_readfirstlane(tid >> 6), lane = tid & 63, fr = lane & 15, fq = lane >> 4;
    const int b = bh >> 3, h = bh & 7, unit0 = bh * 64, vcol = 16 * w + fr;
    const float gn = gain[h * 128 + vcol];
    u32x4 sq[2], sk[2]; f32x4 sd = (f32x4){0.f, 0.f, 0.f, 0.f};
#define H2_LOAD(cc) do { const int tok0_ = b * T + 64 * (cc); _Pragma("unroll") for (int i = 0; i < 2; ++i) { const int p = tid + 512 * i, row = p >> 4, cb = p & 15; \
        const bf16* rp = Z2 + (size_t)(tok0_ + row) * NH2 + h * 128 + 8 * cb; sq[i] = *(const u32x4*)rp; sk[i] = *(const u32x4*)(rp + 1024); } \
        if (tid < 32) sd = *(const f32x4*)(DEC + (size_t)(unit0 + (cc)) * 128 + 4 * tid); } while (0)
#define H2_WRITE(bi) do { LAS unsigned char* B_ = L + (bi) * H2_BUF; _Pragma("unroll") for (int i = 0; i < 2; ++i) { const int p = tid + 512 * i, row = p >> 4, cb = p & 15; \
        *(LAS u32x4*)(B_ + row * 272 + 16 * cb) = sq[i]; *(LAS u32x4*)(B_ + H2_KHT + (2 * row + (cb >> 3)) * 144 + 16 * (cb & 7)) = sk[i]; } \
        if (tid < 32) *(LAS f32x4*)(B_ + H2_DEC + 16 * tid) = sd; } while (0)
    u32x4 vtf[2]; unsigned long long oi[4]; unsigned short og[16];
#define H2_PRIV(cc, VT_, OI_, OG_) do { const int tok0_ = b * T + 64 * (cc); \
        const bf16* vp_ = Z2 + (size_t)(tok0_ + (vcol >> 1)) * NH2 + 2048 + h * 128 + (vcol & 1) * 64 + 8 * fq; VT_[0] = *(const u32x4*)vp_; VT_[1] = *(const u32x4*)(vp_ + 32); \
        _Pragma("unroll") for (int tt_ = 0; tt_ < 4; ++tt_) { OI_[tt_] = OI[((size_t)((unit0 + (cc)) * 4 + tt_) * 8 + w) * 64 + lane]; \
            _Pragma("unroll") for (int e_ = 0; e_ < 4; ++e_) OG_[4 * tt_ + e_] = Z2[(size_t)(tok0_ + 16 * tt_ + 4 * fq + e_) * NH2 + 3072 + h * 128 + vcol]; } } while (0)
    H2_LOAD(0); H2_WRITE(0); H2_PRIV(0, vtf, oi, og);
    f32x4 S[8];
#pragma unroll
    for (int nt = 0; nt < 8; ++nt) S[nt] = (f32x4){0.f, 0.f, 0.f, 0.f};
    __syncthreads();
    for (int c = 0; c < 64; ++c) {
        const int cur = c % 3; LAS unsigned char* Bc = L + cur * H2_BUF;
        u32x4 nvt[2]; unsigned long long noi[4]; unsigned short nog[16];
        const int cn = c + 1 < 64 ? c + 1 : c;
        H2_LOAD(cn); H2_PRIV(cn, nvt, noi, nog);
        f32x4 o[4];
#pragma unroll
        for (int tt = 0; tt < 4; ++tt) { const unsigned lo = (unsigned)oi[tt], hi = (unsigned)(oi[tt] >> 32); o[tt] = (f32x4){lo16(lo), hi16(lo), lo16(hi), hi16(hi)}; }
        bf16x8 sb[4];
#pragma unroll
        for (int np = 0; np < 4; ++np) { u32x4 pw; pw.x = pk2(S[2 * np][0], S[2 * np][1]); pw.y = pk2(S[2 * np][2], S[2 * np][3]); pw.z = pk2(S[2 * np + 1][0], S[2 * np + 1][1]); pw.w = pk2(S[2 * np + 1][2], S[2 * np + 1][3]); sb[np] = mk8(pw); }
#pragma unroll
        for (int tt = 0; tt < 4; ++tt)
#pragma unroll
            for (int np = 0; np < 4; ++np) { const LAS unsigned char* qp = Bc + (16 * tt + fr) * 272 + (32 * np + 4 * fq) * 2;
                const s16x4 lo = *(const LAS s16x4*)qp, hi = *(const LAS s16x4*)(qp + 32);
                const bf16x8 av = __builtin_shufflevector(lo, hi, 0, 1, 2, 3, 4, 5, 6, 7); o[tt] = MFMA16(av, sb[np], o[tt]); }
        LAS float* PART = (LAS float*)(L + H2_PART + (c & 1) * 2048);
#pragma unroll
        for (int tt = 0; tt < 4; ++tt) { f32x4 q2 = o[tt] * o[tt];
#pragma unroll
            for (int sh = 1; sh < 16; sh <<= 1) { q2[0] += __shfl_xor(q2[0], sh); q2[1] += __shfl_xor(q2[1], sh); q2[2] += __shfl_xor(q2[2], sh); q2[3] += __shfl_xor(q2[3], sh); }
            if (fr == 0) *(LAS f32x4*)(PART + w * 64 + 16 * tt + 4 * fq) = q2; }
        if (c + 1 < 64) H2_WRITE((c + 1) % 3);
        __syncthreads();
        const int tok0 = b * T + 64 * c;
#pragma unroll
        for (int tt = 0; tt < 4; ++tt) { f32x4 rs = (f32x4){0.f, 0.f, 0.f, 0.f};
#pragma unroll
            for (int w2 = 0; w2 < 8; ++w2) rs += *(const LAS f32x4*)(PART + w2 * 64 + 16 * tt + 4 * fq);
#pragma unroll
            for (int e = 0; e < 4; ++e) { const float rstd = 1.0f / sqrtf(rs[e] * (1.0f / 128.0f) + EPS); const float gv = bf2f(og[4 * tt + e]);
                const float ov_ = o[tt][e] * rstd * gn * (gv * sigmoidf_(gv)); if (!DRY || ov_ == 12345.678f) Z2[(size_t)(tok0 + 16 * tt + 4 * fq + e) * NH2 + 3072 + h * 128 + vcol] = (bf16)f2bf(ov_); } }
#pragma unroll
        for (int nt = 0; nt < 8; ++nt) { const f32x4 dv = *(const LAS f32x4*)(Bc + H2_DEC + (16 * nt + 4 * fq) * 4); S[nt] = S[nt] * dv;
#pragma unroll
            for (int ks = 0; ks < 2; ++ks) { const bf16x8 av = *(const LAS bf16x8*)(Bc + H2_KHT + (16 * nt + fr) * 144 + (32 * ks + 8 * fq) * 2); S[nt] = MFMA16(av, mk8(vtf[ks]), S[nt]); } }
        vtf[0] = nvt[0]; vtf[1] = nvt[1];
#pragma unroll
        for (int i = 0; i < 4; ++i) oi[i] = noi[i];
#pragma unroll
        for (int i = 0; i < 16; ++i) og[i] = nog[i];
    }
#undef H2_LOAD
#undef H2_WRITE
#undef H2_PRIV
}

#define XB_TMO      128
#define XB_XCNT(j)  (256  + 64 * (j))
#define XB_XSUB(j)  (1280 + 64 * (j))
#define XB_XGEN(j)  (2304 + 64 * (j))
#define XB_TOP      3328
#define XB_TOPGEN   3392
#define XCD_BAR_WORDS 3456
#define XB_SPIN_CAP (1u << 18)

__device__ __forceinline__ unsigned xb_ld(unsigned* p)              { return __hip_atomic_load(p, __ATOMIC_RELAXED, __HIP_MEMORY_SCOPE_AGENT); }
__device__ __forceinline__ unsigned xb_add(unsigned* p, unsigned v) { return __hip_atomic_fetch_add(p, v, __ATOMIC_RELAXED, __HIP_MEMORY_SCOPE_AGENT); }
__device__ __forceinline__ unsigned xb_xcc_id() { return (unsigned)__builtin_amdgcn_s_getreg((3 << 11) | 20) & 0xFu; }
#define XB_SPIN(cond, bar) do { unsigned _sp = 0; while (cond) { __builtin_amdgcn_s_sleep(1); \
    if ((++_sp & 255u) == 0u) { if (xb_ld(&(bar)[XB_TMO])) break; if (_sp > XB_SPIN_CAP) { atomicAdd(&(bar)[XB_TMO], 1u); break; } } } } while (0)

struct XcdBarrier {
    unsigned* bar; unsigned x;
    volatile LAS unsigned* st;
};

__device__ __forceinline__ XcdBarrier xcd_barrier_post(unsigned* bar, volatile LAS unsigned* st) {
    XcdBarrier b; b.bar = bar; b.x = xb_xcc_id(); b.st = st;
    if (threadIdx.x == 0) (void)xb_add(&bar[XB_XCNT(b.x)], 1u);
    return b;
}
__device__ __forceinline__ void xcd_barrier_complete(unsigned* bar, unsigned x, unsigned& nloc, unsigned& nx) {
    const unsigned G = gridDim.x * gridDim.y * gridDim.z;
    unsigned sum, cnt, mine, sp = 0u;
    for (;;) {
        sum = 0u; cnt = 0u; mine = 0u;
#pragma unroll
        for (unsigned j = 0; j < 16; ++j) { const unsigned c = xb_ld(&bar[XB_XCNT(j)]); sum += c; cnt += (c > 0u) ? 1u : 0u; mine = (j == x) ? c : mine; }
        if (sum == G) break;
        __builtin_amdgcn_s_sleep(1);
        if ((++sp & 255u) == 0u) { if (xb_ld(&bar[XB_TMO])) break; if (sp > XB_SPIN_CAP) { atomicAdd(&bar[XB_TMO], 1u); break; } }
    }
    nloc = mine > 0u ? mine : 1u; nx = cnt > 0u ? cnt : 1u;
}

__device__ __forceinline__ void xcd_barrier(const XcdBarrier& b) {
    asm volatile("s_waitcnt vmcnt(0)" ::: "memory");
    __syncthreads();
    if (threadIdx.x == 0) {
        unsigned* bar = b.bar;
        __builtin_amdgcn_s_waitcnt(0);
        unsigned nloc = b.st[0], nx = b.st[1];
        if (nloc == 0u) { xcd_barrier_complete(bar, b.x, nloc, nx); b.st[0] = nloc; b.st[1] = nx; }
        const unsigned old = xb_add(&bar[XB_XSUB(b.x)], 1u);
        const unsigned gen = old / nloc;
        if (old + 1u == (gen + 1u) * nloc) {
            __builtin_amdgcn_fence(__ATOMIC_RELEASE, "agent");
            asm volatile("s_waitcnt vmcnt(0)" ::: "memory");
            const unsigned og = xb_add(&bar[XB_TOP], 1u);
            const unsigned tg = og / nx;
            if (og + 1u == (tg + 1u) * nx) xb_add(&bar[XB_TOPGEN], 1u);
            else XB_SPIN(xb_ld(&bar[XB_TOPGEN]) == tg, bar);
            __builtin_amdgcn_fence(__ATOMIC_ACQUIRE, "agent");
            xb_add(&bar[XB_XGEN(b.x)], 1u);
            asm volatile("s_waitcnt vmcnt(0)" ::: "memory");
        } else {
            XB_SPIN(xb_ld(&bar[XB_XGEN(b.x)]) == gen, bar);
            __builtin_amdgcn_fence(__ATOMIC_ACQUIRE, "agent");
            asm volatile("s_waitcnt vmcnt(0)" ::: "memory");
        }
    }
    __syncthreads();
}

#ifndef PROBE_SYNC
#define PROBE_SYNC 0
#endif
#ifndef PROBE_ATT
#define PROBE_ATT 0
#endif
#ifndef PROBE_GEMM
#define PROBE_GEMM 0
#endif
#ifndef PROBE_HG
#define PROBE_HG 0
#endif
#ifndef PROBE_CONV
#define PROBE_CONV 0
#endif
#define GSYNC() do { xcd_barrier(xbar); if (PROBE_SYNC) xcd_barrier(xbar); } while (0)
#define REP(n) for (int rep_ = 0; rep_ < 1 + (n); ++rep_)
#define FRESH() unsigned char* ws = a.ws; asm volatile("" : "+s"(ws)); int tid = threadIdx.x; asm volatile("" : "+v"(tid)); \
    const int lane = tid & 63, wave = __builtin_amdgcn_readfirstlane(tid >> 6); int G = gridDim.x, bid = blockIdx.x; asm volatile("" : "+s"(G), "+s"(bid)); \
    const int gw = bid * 8 + wave, NGW = G * 8, gtid = bid * 512 + tid, NGT = G * 512; float* X = a.out; asm volatile("" : "+s"(X)); \
    bf16* Xb = (bf16*)(ws + WS_XB); float* ssq = (float*)(ws + WS_SSQ); bf16* Z = (bf16*)(ws + WS_Z); \
    (void)lane; (void)gw; (void)NGW; (void)gtid; (void)NGT; (void)Xb; (void)ssq; (void)Z; (void)X;

__global__ void __launch_bounds__(512, 2) fwd_megakernel(Args a) {
    extern __shared__ __attribute__((aligned(16))) unsigned char lds_raw[];
    LAS unsigned char* L = (LAS unsigned char*)lds_raw;
    volatile LAS unsigned* MISC = (volatile LAS unsigned*)(L + LDS_BYTES - 64);
    if (threadIdx.x < 16) MISC[threadIdx.x] = 0u;
    __syncthreads();
    const XcdBarrier xbar = xcd_barrier_post((unsigned*)(a.ws + WS_CTL), MISC);

    REP(PROBE_CONV) { FRESH(); conv_weights(a, 0, L, gw, NGW, wave, lane); }
    { FRESH(); prologue_misc(a, gw, NGW, lane, gtid, NGT); }
    cg::this_grid().sync();

    for (int l = 0; l < 2; ++l) {
        if (l > 0) { REP(PROBE_CONV) { FRESH(); conv_weights(a, l, L, gw, NGW, wave, lane); } GSYNC(); }
        REP(PROBE_GEMM) { FRESH(); run_gemm(L, Xb, D, (const bf16*)(ws + W_GU1), D, M, 2 * DFF, D, G, bid, EpiSwiglu{Z, ssq}); }
        GSYNC();
        { FRESH(); run_gemm(L, Z, DFF, (const bf16*)(ws + W_DN1), DFF, M, D, DFF, G, bid, EpiResid{l == 0 ? (const float*)a.in[0] : X, X, Xb, ssq, 0.5f}); }
        GSYNC();
        REP(PROBE_GEMM) { FRESH(); run_gemm(L, Xb, D, (const bf16*)(ws + W_IN), D, M, NATT, D, G, bid, EpiZ{Z, NATT, ssq}); }
        GSYNC();
        REP(PROBE_ATT) { FRESH(); dil_attn_phase(L, Z, (const float*)(ws + WS_COS), (const float*)(ws + WS_SIN), (bf16*)(ws + WS_OG), (float*)(ws + WS_LSE), G, bid, tid); }
        GSYNC();
        REP(PROBE_GEMM) { FRESH(); run_gemm(L, Xb, D, (const bf16*)(ws + W_IN) + (size_t)NATT * D, D, M, NH2, D, G, bid, EpiZ{Z, NH2, ssq}); }
        { FRESH(); merge_phase((const bf16*)(ws + WS_OG), (const float*)(ws + WS_LSE), (bf16*)(ws + WS_AO), gtid, NGT); }
        GSYNC();
#if PROBE_HG
        { FRESH(); hgrn1_phase<true>(L, Z, (const float*)a.in[8], l, (float*)(ws + WS_DEC), (unsigned long long*)(ws + WS_OG), G, bid, tid); }
#endif
        { FRESH(); hgrn1_phase<false>(L, Z, (const float*)a.in[8], l, (float*)(ws + WS_DEC), (unsigned long long*)(ws + WS_OG), G, bid, tid); }
        GSYNC();
        { FRESH();
#if PROBE_HG
          if (bid < 32) { hgrn2_phase<true>(L, Z, (const float*)(ws + WS_DEC), (const unsigned long long*)(ws + WS_OG), (const float*)a.in[9] + (size_t)l * D, bid, tid); __syncthreads(); }
#endif
          if (bid < 32) hgrn2_phase<false>(L, Z, (const float*)(ws + WS_DEC), (const unsigned long long*)(ws + WS_OG), (const float*)a.in[9] + (size_t)l * D, bid, tid);
          else {
            const bf16* memN = (const bf16*)(ws + WS_MEMN) + (size_t)l * MROWS * D; const bf16* Wkv = (const bf16*)(ws + W_KV);
            run_gemm(L, memN, D, Wkv, D, MROWS, D, D, G - 32, bid - 32, EpiZ{(bf16*)(ws + WS_MEMK), D, nullptr});
            run_gemm(L, Wkv + (size_t)D * D, D, memN, D, D, MROWS, D, G - 32, G - 1 - bid, EpiZ{(bf16*)(ws + WS_MEMVT), MROWS, nullptr});
          } }
        GSYNC();
        REP(PROBE_GEMM) { FRESH(); run_gemm(L, Xb, D, (const bf16*)(ws + W_IN) + (size_t)(NATT + NH2) * D, D, M, 2048, D, G, bid, EpiZ{Z, NH2, ssq}); }
        GSYNC();
        { FRESH(); run_gemm(L, (const bf16*)(ws + WS_AO), 512, (const bf16*)(ws + W_AB), 512, M, D, 512, G, bid, EpiGate<false>{Z, NH2, Z + 2048, NH2}); }
        { FRESH(); run_gemm(L, Z + 3072, NH2, (const bf16*)(ws + W_HB), D, M, D, D, G, bid, EpiGate<true>{Z + 1024, NH2, Z + 2048, NH2}); }
        GSYNC();
        { FRESH(); run_gemm(L, Z + 2048, NH2, (const bf16*)(ws + W_MO), D, M, D, D, G, bid, EpiResid{X, X, Xb, ssq, 1.0f}); }
        GSYNC();
        REP(PROBE_GEMM) { FRESH(); run_gemm(L, Xb, D, (const bf16*)(ws + W_Q), D, M, D, D, G, bid, EpiZ{Z, D, ssq}); }
        GSYNC();
        REP(PROBE_ATT) { FRESH(); xattn_phase(L, Z, (const bf16*)(ws + WS_MEMK), (const bf16*)(ws + WS_MEMVT), Z + (size_t)M * D, G, bid, tid); }
        GSYNC();
        { FRESH(); run_gemm(L, Z + (size_t)M * D, D, (const bf16*)(ws + W_O), D, M, D, D, G, bid, EpiResid{X, X, Xb, ssq, 1.0f}); }
        GSYNC();
        REP(PROBE_GEMM) { FRESH(); run_gemm(L, Xb, D, (const bf16*)(ws + W_GU2), D, M, 2 * DFF, D, G, bid, EpiSwiglu{Z, ssq}); }
        GSYNC();
        { FRESH(); run_gemm(L, Z, DFF, (const bf16*)(ws + W_DN2), DFF, M, D, DFF, G, bid, EpiResid{X, X, Xb, ssq, 0.5f}); }
        GSYNC();
    }
    { FRESH();
      const float* fg = (const float*)a.in[21];
      for (int m = gw; m < M; m += NGW) {
        f32x4* xr = (f32x4*)(X + (size_t)m * D) + lane; const f32x4* gr = (const f32x4*)fg + lane;
        f32x4 v[4]; float s = 0.f;
#pragma unroll
        for (int j = 0; j < 4; ++j) { v[j] = xr[64 * j]; s += (v[j][0] * v[j][0] + v[j][1] * v[j][1]) + (v[j][2] * v[j][2] + v[j][3] * v[j][3]); }
        const float rs = 1.0f / sqrtf(wave_sum(s) * (1.0f / D) + EPS);
#pragma unroll
        for (int j = 0; j < 4; ++j) xr[64 * j] = v[j] * rs * gr[64 * j];
      } }
}

extern "C" void kernel_launch(void* const* d_in, const int* in_sizes, int n_in, void* d_out, int out_size, void* d_ws, size_t ws_size, hipStream_t stream) {
    static int grid = 0;
    if (grid == 0) {
        if (n_in != 22 || out_size != M * D || ws_size < WS_END) { fprintf(stderr, "kernel_launch: unexpected shapes (n_in %d out %d ws %zu)\n", n_in, out_size, ws_size); grid = -1; return; }
        int dev = 0, cus = 0, per_cu = 0;
        hipGetDevice(&dev); hipDeviceGetAttribute(&cus, hipDeviceAttributeMultiprocessorCount, dev);
        hipFuncSetAttribute((const void*)fwd_megakernel, hipFuncAttributeMaxDynamicSharedMemorySize, LDS_BYTES);
        hipOccupancyMaxActiveBlocksPerMultiprocessor(&per_cu, (const void*)fwd_megakernel, 512, LDS_BYTES);
        if (per_cu < 1) { fprintf(stderr, "kernel_launch: occupancy query reports %d blocks per CU\n", per_cu); grid = -1; return; }
        grid = cus;
        if (grid < 64) { fprintf(stderr, "kernel_launch: too few CUs (%d)\n", grid); grid = -1; return; }
    }
    if (grid < 0) return;
    if (hipMemsetAsync((char*)d_ws + WS_CTL, 0, CTL_BYTES, stream) != hipSuccess) { fprintf(stderr, "kernel_launch: memset failed\n"); return; }
    Args a{};
    for (int i = 0; i < 22; ++i) a.in[i] = d_in[i];
    a.out = (float*)d_out; a.ws = (unsigned char*)d_ws;
    void* args[] = {&a};
    hipError_t e = hipLaunchCooperativeKernel((const void*)fwd_megakernel, dim3(grid), dim3(512), args, LDS_BYTES, stream);
    if (e != hipSuccess) fprintf(stderr, "cooperative launch failed: %s (grid %d)\n", hipGetErrorString(e), grid);
}
```

```cpp
#include <hip/hip_runtime.h>
#include <hip/hip_cooperative_groups.h>
#include <cstdio>
#include <cstdint>
namespace cg = cooperative_groups;
namespace pg8 {
#define PG8_LAS __attribute__((address_space(3)))
typedef unsigned short bf16_t;
typedef short bf16x8 __attribute__((ext_vector_type(8)));
typedef float f32x4 __attribute__((ext_vector_type(4)));
typedef unsigned u32x4 __attribute__((ext_vector_type(4)));
constexpr int BM = 256, BK = 64, HALF = 128, HTB = HALF * BK * 2  , STAGE_BYTES = 8 * HTB, NXCD = 8, WGM = 8;

__host__ __device__ __forceinline__ int lds_byte(int r, int c) { const int st = (r >> 4) * 2 + (c >> 5), rr = r & 15, cc = c & 31, ob = rr * 64 + cc * 2; return st * 1024 + (ob ^ (((ob >> 9) & 1) << 5)); }
__host__ __device__ __forceinline__ void stage_rc(int b, int& R, int& C) { const int st = b / 1024, sb = b % 1024, swz = sb ^ (((sb >> 9) & 1) << 5); R = (st >> 1) * 16 + swz / 64; C = (st & 1) * 32 + (swz % 64) / 2; }
__host__ __device__ __forceinline__ int perm32(int rho) { const int n = rho >> 4, i = rho & 15; return 8 * (i >> 2) + 4 * n + (i & 3); }

struct Unit { int pm, pn; };
struct Gemm { const bf16_t* A; const bf16_t* Bt; int M, N, K, lda, ldb; };

struct StaticOrder {
    int nM, nN, nwg, G, c;
    __host__ __device__ void init(int M, int N, int G_, int c_) { nM = M / BM; nN = N / BM; nwg = nM * nN; G = G_; c = c_; }
    __host__ __device__ bool next(int i, Unit& u) const {
        const long L = (long)i * G + c; if (L >= nwg) return false;
        int wgid = (int)L; { const int q = nwg / NXCD, r = nwg % NXCD, xcd = wgid % NXCD, off = wgid / NXCD; wgid = (xcd < r ? xcd * (q + 1) : r * (q + 1) + (xcd - r) * q) + off; }
        const int nig = WGM * nN, gid = wgid / nig, fm = gid * WGM, gsz = (nM - fm) < WGM ? (nM - fm) : WGM;
        u.pm = fm + ((wgid % nig) % gsz); u.pn = (wgid % nig) / gsz; return true;
    }
    __device__ __forceinline__ void a_ready(const Unit&) const {}
    __device__ __forceinline__ void done(const Unit&) const {}
};

template <class Epi, class Sched, bool ALIGN_EPI = false, bool SP2 = false>
__device__ __forceinline__ void gemm_phase(PG8_LAS unsigned char* lds, const Gemm g, const Sched& S, const Epi& E) {
    int tid_ = threadIdx.x; asm volatile("" : "+v"(tid_)); const int tid = tid_, wid = __builtin_amdgcn_readfirstlane(tid >> 6), lane = tid & 63, wr = wid >> 2, wc = wid & 3, fr = lane & 15, fq = lane >> 4;
    const int K = g.K, nt = K / BK;
    unsigned voffA[2], voffB[2];
#pragma unroll
    for (int i = 0; i < 2; ++i) { int R, C; stage_rc(tid * 16 + i * 8192, R, C); const int Rb = Epi::PERM ? ((R & ~31) + perm32(R & 31)) : R;
        voffA[i] = (unsigned)(R * g.lda + C) * 2u; voffB[i] = (unsigned)(Rb * g.ldb + C) * 2u; }
    const size_t kstep = (size_t)(BK * 2);
    const size_t hstepA = (size_t)HALF * g.lda * 2, hstepB = (size_t)HALF * g.ldb * 2;
    const size_t tstepA = 2 * hstepA, tstepB = 2 * hstepB;
    const unsigned ldsw = (unsigned)wid * 1024u;
    const int aoff = lds_byte(wr * 64 + fr, fq * 8), boff = lds_byte(wc * 32 + fr, fq * 8);
#define PG8_SA(b, h) (((b) * 2 + (h)) * HTB)
#define PG8_SB(b, h) ((4 + (b) * 2 + (h)) * HTB)
#define PG8_STAGE(bufoff, gbase, voff) do { _Pragma("unroll") for (int _i = 0; _i < 2; ++_i) \
        __builtin_amdgcn_global_load_lds((const unsigned*)((const char*)(gbase) + (voff)[_i]), (PG8_LAS unsigned*)(lds + (bufoff) + ldsw + _i * 8192), 16, 0, 0); } while (0)
#define PG8_LDA(dst, b, h) do { _Pragma("unroll") for (int m = 0; m < 4; ++m) _Pragma("unroll") for (int k = 0; k < 2; ++k) dst[m][k] = *(const PG8_LAS bf16x8*)(lds + PG8_SA(b, h) + aoff + m * 2048 + k * 1024); } while (0)
#define PG8_LDB(dst, b, h) do { _Pragma("unroll") for (int n = 0; n < 2; ++n) _Pragma("unroll") for (int k = 0; k < 2; ++k) dst[n][k] = *(const PG8_LAS bf16x8*)(lds + PG8_SB(b, h) + boff + n * 2048 + k * 1024); } while (0)
#define PG8_MMA(ai, bj, At, Bt) do { __builtin_amdgcn_s_setprio(1); _Pragma("unroll") for (int m = 0; m < 4; ++m) _Pragma("unroll") for (int n = 0; n < 2; ++n) _Pragma("unroll") for (int k = 0; k < 2; ++k) \
        acc[ai][bj][m][n] = __builtin_amdgcn_mfma_f32_16x16x32_bf16(Bt[n][k], At[m][k], acc[ai][bj][m][n], 0, 0, 0); __builtin_amdgcn_s_setprio(0); } while (0)
#define PG8_WAIT_V(n) asm volatile("s_waitcnt vmcnt(" #n ")" ::: "memory")
#define PG8_WAIT_L(n) asm volatile("s_waitcnt lgkmcnt(" #n ")" ::: "memory")
#define PG8_BAR __builtin_amdgcn_s_barrier()
#define PG8_SCHED __builtin_amdgcn_sched_barrier(0)
    Unit cur, nxt; int ui = 0;
    if (!S.next(0, cur)) return;
    f32x4 acc[2][2][4][2];
#pragma unroll
    for (int a = 0; a < 2; ++a)
#pragma unroll
        for (int b = 0; b < 2; ++b)
#pragma unroll
            for (int m = 0; m < 4; ++m)
#pragma unroll
                for (int n = 0; n < 2; ++n) acc[a][b][m][n] = (f32x4){0.f, 0.f, 0.f, 0.f};
    bf16x8 At[4][2], B0[2][2], B1[2][2];
    const char* cA = (const char*)g.A + (size_t)cur.pm * tstepA; const char* cB = (const char*)g.Bt + (size_t)cur.pn * tstepB;
    S.a_ready(cur);
    if constexpr (SP2) {
        PG8_STAGE(PG8_SB(0, 0), cB, voffB); PG8_STAGE(PG8_SB(0, 1), cB + hstepB, voffB); PG8_STAGE(PG8_SA(0, 0), cA, voffA); PG8_STAGE(PG8_SA(0, 1), cA + hstepA, voffA);
        if (wr == 1) PG8_BAR;
        PG8_WAIT_V(2); PG8_BAR;
        PG8_STAGE(PG8_SB(1, 0), cB + kstep, voffB); PG8_STAGE(PG8_SA(1, 0), cA + kstep, voffA); PG8_STAGE(PG8_SB(1, 1), cB + hstepB + kstep, voffB);
        PG8_WAIT_V(6); PG8_BAR;
    } else {
        PG8_STAGE(PG8_SB(0, 0), cB, voffB); PG8_STAGE(PG8_SA(0, 0), cA, voffA); PG8_STAGE(PG8_SB(0, 1), cB + hstepB, voffB); PG8_STAGE(PG8_SA(0, 1), cA + hstepA, voffA);
        if (wr == 1) PG8_BAR;
        PG8_WAIT_V(4); PG8_BAR;
        PG8_STAGE(PG8_SB(1, 0), cB + kstep, voffB); PG8_STAGE(PG8_SA(1, 0), cA + kstep, voffA); PG8_STAGE(PG8_SB(1, 1), cB + hstepB + kstep, voffB);
        PG8_WAIT_V(6); PG8_BAR;
    }
    for (;;) {
        const bool has_next = S.next(ui + 1, nxt);
        const char* nA = has_next ? (const char*)g.A + (size_t)nxt.pm * tstepA : cA; const char* nB = has_next ? (const char*)g.Bt + (size_t)nxt.pn * tstepB : cB;
        for (int t = 0; t < nt; t += 2) {
            const bool last = (t == nt - 2);
            const char* a1 = cA + (size_t)(t + 1) * kstep;
            const char* a2 = last ? nA : cA + (size_t)(t + 2) * kstep; const char* b2 = last ? nB : cB + (size_t)(t + 2) * kstep;
            const char* a3 = a2 + kstep; const char* b3 = b2 + kstep;
            if (last && has_next) S.a_ready(nxt);
            if constexpr (SP2) {
            PG8_LDB(B0, 0, 0); PG8_LDB(B1, 0, 1); PG8_SCHED; PG8_LDA(At, 0, 0); PG8_STAGE(PG8_SA(1, 1), a1 + hstepA, voffA);
            PG8_WAIT_V(8); PG8_WAIT_L(0); PG8_BAR; PG8_MMA(0, 0, At, B0); PG8_MMA(0, 1, At, B1); PG8_BAR; PG8_SCHED;
            PG8_LDA(At, 0, 1); PG8_STAGE(PG8_SB(0, 0), b2, voffB); PG8_STAGE(PG8_SB(0, 1), b2 + hstepB, voffB); PG8_STAGE(PG8_SA(0, 0), a2, voffA);
            PG8_WAIT_V(8); PG8_WAIT_L(0); PG8_BAR; PG8_MMA(1, 0, At, B0); PG8_MMA(1, 1, At, B1); PG8_BAR; PG8_SCHED;
            PG8_LDB(B0, 1, 0); PG8_LDB(B1, 1, 1); PG8_SCHED; PG8_LDA(At, 1, 0); PG8_STAGE(PG8_SA(0, 1), a2 + hstepA, voffA);
            PG8_WAIT_V(8); PG8_WAIT_L(0); PG8_BAR; PG8_MMA(0, 0, At, B0); PG8_MMA(0, 1, At, B1); PG8_BAR; PG8_SCHED;
            PG8_LDA(At, 1, 1); PG8_STAGE(PG8_SB(1, 0), b3, voffB); PG8_STAGE(PG8_SB(1, 1), b3 + hstepB, voffB); PG8_STAGE(PG8_SA(1, 0), a3, voffA);
            PG8_WAIT_V(8); PG8_WAIT_L(0); PG8_BAR; PG8_MMA(1, 0, At, B0); PG8_MMA(1, 1, At, B1); PG8_BAR; PG8_SCHED;
            } else {
            PG8_LDB(B0, 0, 0); PG8_SCHED; PG8_LDA(At, 0, 0); PG8_STAGE(PG8_SA(1, 1), a1 + hstepA, voffA);
            PG8_WAIT_L(8); PG8_BAR; PG8_WAIT_L(0); PG8_MMA(0, 0, At, B0); PG8_BAR; PG8_SCHED;
            PG8_LDB(B1, 0, 1); PG8_STAGE(PG8_SB(0, 0), b2, voffB);
            PG8_BAR; PG8_WAIT_L(0); PG8_MMA(0, 1, At, B1); PG8_BAR;
            PG8_LDA(At, 0, 1); PG8_STAGE(PG8_SA(0, 0), a2, voffA);
            PG8_BAR; PG8_WAIT_L(0); PG8_MMA(1, 0, At, B0); PG8_BAR; PG8_SCHED;
            PG8_STAGE(PG8_SB(0, 1), b2 + hstepB, voffB);
            PG8_WAIT_V(6); PG8_BAR; PG8_MMA(1, 1, At, B1); PG8_BAR;
            PG8_LDB(B0, 1, 0); PG8_SCHED; PG8_LDA(At, 1, 0); PG8_STAGE(PG8_SA(0, 1), a2 + hstepA, voffA);
            PG8_WAIT_L(8); PG8_BAR; PG8_WAIT_L(0); PG8_MMA(0, 0, At, B0); PG8_BAR; PG8_SCHED;
            PG8_LDB(B1, 1, 1); PG8_STAGE(PG8_SB(1, 0), b3, voffB);
            PG8_BAR; PG8_WAIT_L(0); PG8_MMA(0, 1, At, B1); PG8_BAR;
            PG8_LDA(At, 1, 1); PG8_STAGE(PG8_SA(1, 0), a3, voffA);
            PG8_BAR; PG8_WAIT_L(0); PG8_MMA(1, 0, At, B0); PG8_BAR; PG8_SCHED;
            PG8_STAGE(PG8_SB(1, 1), b3 + hstepB, voffB);
            PG8_WAIT_V(6); PG8_BAR; PG8_MMA(1, 1, At, B1); PG8_BAR;
            }
        }
        if constexpr (ALIGN_EPI) { if (wr == 0) PG8_BAR; }
        if constexpr (!Epi::AFTER_DRAIN) { E(acc, cur, wr, wc, fr, fq); S.done(cur); }
        if (!has_next) break;
#pragma unroll
        for (int a = 0; a < 2; ++a)
#pragma unroll
            for (int b = 0; b < 2; ++b)
#pragma unroll
                for (int m = 0; m < 4; ++m)
#pragma unroll
                    for (int n = 0; n < 2; ++n) acc[a][b][m][n] = (f32x4){0.f, 0.f, 0.f, 0.f};
        cur = nxt; cA = nA; cB = nB; ++ui;
        if constexpr (ALIGN_EPI) { if (wr == 1) PG8_BAR; }
    }
    PG8_WAIT_V(0);
    if constexpr (!ALIGN_EPI) { if (wr == 0) PG8_BAR; }
    PG8_BAR;
    if constexpr (Epi::AFTER_DRAIN) { E.fused(acc, cur, wr, wc, fr, fq, lds, wid, lane); S.done(cur); }
#undef PG8_SA
#undef PG8_SB
#undef PG8_STAGE
#undef PG8_LDA
#undef PG8_LDB
#undef PG8_MMA
#undef PG8_WAIT_V
#undef PG8_WAIT_L
#undef PG8_BAR
#undef PG8_SCHED
}
}

#define DI __device__ __forceinline__
#define LAS __attribute__((address_space(3)))
typedef unsigned short bf16;
typedef short bf16x8 __attribute__((ext_vector_type(8)));
typedef short s16x4 __attribute__((ext_vector_type(4)));
typedef float f32x4 __attribute__((ext_vector_type(4)));
typedef unsigned u32x4 __attribute__((ext_vector_type(4)));
typedef unsigned u32x2 __attribute__((ext_vector_type(2)));
using pg8::Unit;

constexpr int NB = 4, T = 4096, D = 1024, M = NB * T, DFF = 2816, NMEM = 256, MROWS = NB * NMEM;
constexpr int NATT = 4608, NH2 = 4096;
constexpr float EPS = 1e-6f;
constexpr int LDS_BYTES = 147456;

constexpr size_t MiB = 1u << 20;
constexpr size_t W_GU1 = 0, W_DN1 = W_GU1 + (size_t)2 * DFF * D * 2, W_IN = W_DN1 + (size_t)D * DFF * 2, W_AB = W_IN + (size_t)10752 * D * 2,
                 W_HB = W_AB + (size_t)D * 512 * 2, W_MO = W_HB + (size_t)D * D * 2, W_Q = W_MO + (size_t)D * D * 2, W_KV = W_Q + (size_t)D * D * 2,
                 W_O = W_KV + (size_t)2 * D * D * 2, W_GU2 = W_O + (size_t)D * D * 2, W_DN2 = W_GU2 + (size_t)2 * DFF * D * 2, W_END = W_DN2 + (size_t)D * DFF * 2;
static_assert(W_END <= 68 * MiB, "weights");
constexpr size_t WS_XB = 68 * MiB, WS_Z = 100 * MiB, WS_OG = 244 * MiB, WS_AO = 292 * MiB, WS_COS = 308 * MiB, WS_SIN = 312 * MiB, WS_MEMN = 316 * MiB,
                 WS_MEMK = 320 * MiB, WS_MEMVT = 322 * MiB, WS_SSQ = 324 * MiB, WS_DEC = 325 * MiB, WS_LSE = 326 * MiB, WS_CTL = 327 * MiB, CTL_BYTES = 65536, WS_END = 327 * MiB + CTL_BYTES;

DI float bf2f(unsigned short h) { return __uint_as_float((unsigned)h << 16); }
typedef __bf16 bf2_t __attribute__((ext_vector_type(2)));
typedef float f32x2_t __attribute__((ext_vector_type(2)));
DI unsigned pk2(float lo, float hi) { const bf2_t r = __builtin_convertvector((f32x2_t){lo, hi}, bf2_t); return __builtin_bit_cast(unsigned, r); }
DI unsigned f2bf(float f) { return pk2(f, 0.f) & 0xffffu; }
template <int N> DI float rr_add(float v) { return v + __int_as_float(__builtin_amdgcn_update_dpp(0, __float_as_int(v), 0x120 + N, 0xf, 0xf, false)); }
DI float row16_sum(float v) { v = rr_add<1>(v); v = rr_add<2>(v); v = rr_add<4>(v); v = rr_add<8>(v); return v; }
#define LBAR() do { asm volatile("s_waitcnt lgkmcnt(0)" ::: "memory"); __builtin_amdgcn_s_barrier(); asm volatile("" ::: "memory"); } while (0)
DI float lo16(unsigned u) { return __uint_as_float(u << 16); }
DI float hi16(unsigned u) { return __uint_as_float(u & 0xffff0000u); }
DI float wave_sum(float v) {
#pragma unroll
    for (int o = 1; o < 64; o <<= 1) v += __shfl_xor(v, o);
    return v;
}
DI float sigmoidf_(float x) { return 1.0f / (1.0f + __expf(-x)); }
DI bf16x8 mk8(u32x4 v) { return __builtin_bit_cast(bf16x8, v); }
#define MFMA16(a, b, c) __builtin_amdgcn_mfma_f32_16x16x32_bf16((a), (b), (c), 0, 0, 0)

DI float row_rstd(const float* ssq, int row) {
    const f32x4* p = (const f32x4*)(ssq + (size_t)row * 16);
    const f32x4 a = p[0], b = p[1], c = p[2], d = p[3];
    const float s = ((a[0] + a[1]) + (a[2] + a[3])) + ((b[0] + b[1]) + (b[2] + b[3])) + ((c[0] + c[1]) + (c[2] + c[3])) + ((d[0] + d[1]) + (d[2] + d[3]));
    return 1.0f / sqrtf(s * (1.0f / D) + EPS);
}
struct EpiZ {
    static constexpr bool PERM = true, AFTER_DRAIN = false;
    bf16* O; int ldc; const float* ssq;
    DI void operator()(const f32x4 (&acc)[2][2][4][2], const Unit& u, int wr, int wc, int fr, int fq) const {
        const int row0 = u.pm * 256 + wr * 64 + fr, col0 = u.pn * 256 + wc * 32 + 8 * fq;
#pragma unroll
        for (int ai = 0; ai < 2; ++ai)
#pragma unroll
            for (int m = 0; m < 4; ++m) {
                const int row = row0 + ai * 128 + m * 16;
                const float rs = ssq ? row_rstd(ssq, row) : 1.0f;
                bf16* rowp = O + (size_t)row * ldc + col0;
#pragma unroll
                for (int bj = 0; bj < 2; ++bj) {
                    const f32x4 v0 = acc[ai][bj][m][0] * rs, v1 = acc[ai][bj][m][1] * rs;
                    u32x4 w; w.x = pk2(v0[0], v0[1]); w.y = pk2(v0[2], v0[3]); w.z = pk2(v1[0], v1[1]); w.w = pk2(v1[2], v1[3]);
                    *(u32x4*)(rowp + bj * 128) = w;
                }
            }
    }
};
struct EpiSwiglu {
    static constexpr bool PERM = true, AFTER_DRAIN = false;
    bf16* H; const float* ssq;
    DI void operator()(const f32x4 (&acc)[2][2][4][2], const Unit& u, int wr, int wc, int fr, int fq) const {
        const int row0 = u.pm * 256 + wr * 64 + fr, col0 = u.pn * 128 + wc * 32 + 8 * fq;
#pragma unroll
        for (int ai = 0; ai < 2; ++ai)
#pragma unroll
            for (int m = 0; m < 4; ++m) {
                const int row = row0 + ai * 128 + m * 16;
                const float rs = row_rstd(ssq, row);
                float h[8];
#pragma unroll
                for (int n = 0; n < 2; ++n)
#pragma unroll
                    for (int e = 0; e < 4; ++e) { const float g = acc[ai][0][m][n][e] * rs, up = acc[ai][1][m][n][e] * rs; h[4 * n + e] = g * sigmoidf_(g) * up; }
                u32x4 w; w.x = pk2(h[0], h[1]); w.y = pk2(h[2], h[3]); w.z = pk2(h[4], h[5]); w.w = pk2(h[6], h[7]);
                *(u32x4*)(H + (size_t)row * DFF + col0) = w;
            }
    }
};
struct EpiResid {
    static constexpr bool PERM = false, AFTER_DRAIN = false;
    const float* xin; float* xout; bf16* Xb; float* ssq; float alpha;
    DI void operator()(const f32x4 (&acc)[2][2][4][2], const Unit& u, int wr, int wc, int fr, int fq) const {
        const int row0 = u.pm * 256 + wr * 64 + fr, col0 = u.pn * 256 + wc * 32 + 4 * fq;
#pragma unroll
        for (int ai = 0; ai < 2; ++ai)
#pragma unroll
            for (int m = 0; m < 4; ++m) {
                const int row = row0 + ai * 128 + m * 16; float ss = 0.f;
#pragma unroll
                for (int bj = 0; bj < 2; ++bj)
#pragma unroll
                    for (int n = 0; n < 2; ++n) {
                        const size_t off = (size_t)row * D + col0 + bj * 128 + n * 16;
                        const f32x4 x = *(const f32x4*)(xin + off) + acc[ai][bj][m][n] * alpha;
                        *(f32x4*)(xout + off) = x;
                        u32x2 w; w.x = pk2(x[0], x[1]); w.y = pk2(x[2], x[3]); *(u32x2*)(Xb + off) = w;
                        ss += (x[0] * x[0] + x[1] * x[1]) + (x[2] * x[2] + x[3] * x[3]);
                    }
                ss += __shfl_xor(ss, 16); ss += __shfl_xor(ss, 32);
                if (fq == 0) ssq[(size_t)row * 16 + u.pn * 4 + wc] = ss;
            }
    }
};
template <bool ADD> struct EpiGate {
    static constexpr bool PERM = true, AFTER_DRAIN = false;
    const bf16* Gt; int ldg; bf16* Mg; int ldm;
    DI void operator()(const f32x4 (&acc)[2][2][4][2], const Unit& u, int wr, int wc, int fr, int fq) const {
        const int row0 = u.pm * 256 + wr * 64 + fr, col0 = u.pn * 256 + wc * 32 + 8 * fq;
#pragma unroll
        for (int ai = 0; ai < 2; ++ai)
#pragma unroll
            for (int m = 0; m < 4; ++m) {
                const int row = row0 + ai * 128 + m * 16;
#pragma unroll
                for (int bj = 0; bj < 2; ++bj) {
                    const u32x4 gv = *(const u32x4*)(Gt + (size_t)row * ldg + col0 + bj * 128);
                    bf16* mp = Mg + (size_t)row * ldm + col0 + bj * 128;
                    u32x4 pv = (u32x4){0u, 0u, 0u, 0u}; if (ADD) pv = *(const u32x4*)mp;
                    float r[8];
#pragma unroll
                    for (int q = 0; q < 4; ++q) {
                        const float a0 = acc[ai][bj][m][q >> 1][(q & 1) * 2], a1 = acc[ai][bj][m][q >> 1][(q & 1) * 2 + 1];
                        r[2 * q] = sigmoidf_(lo16(gv[q])) * a0 + (ADD ? lo16(pv[q]) : 0.f);
                        r[2 * q + 1] = sigmoidf_(hi16(gv[q])) * a1 + (ADD ? hi16(pv[q]) : 0.f);
                    }
                    u32x4 w; w.x = pk2(r[0], r[1]); w.y = pk2(r[2], r[3]); w.z = pk2(r[4], r[5]); w.w = pk2(r[6], r[7]);
                    *(u32x4*)mp = w;
                }
            }
    }
};

template <class Epi>
DI void run_gemm(LAS unsigned char* lds, const bf16* A, int lda, const bf16* Bt, int ldb, int Mr, int N, int K, int G, int c, const Epi& E) {
    pg8::Gemm g{A, Bt, Mr, N, K, lda, ldb}; pg8::StaticOrder S; S.init(Mr, N, G, c);
    pg8::gemm_phase<Epi, pg8::StaticOrder, true, true>(lds, g, S, E);
}

DI void conv_item(const float* W, int K, int Nsrc, int Nout, bool GU, const float* gain, bf16* WT, LAS float* scr, int item, int lane) {
    const int nblk = Nout / 32, kb = item / nblk, nb = item % nblk, k0 = 64 * kb, n0 = 32 * nb;
    const int src0 = GU ? (((n0 & 255) >> 7) * DFF + 128 * (n0 >> 8) + (n0 & 127)) : n0;
#pragma unroll 8
    for (int i = 0; i < 32; ++i) { const int kk = 2 * i + (lane >> 5); const float g = gain ? gain[k0 + kk] : 1.0f;
        scr[kk * 33 + (lane & 31)] = W[(size_t)(k0 + kk) * Nsrc + src0 + (lane & 31)] * g; }
    asm volatile("s_waitcnt lgkmcnt(0)" ::: "memory");
    const int c = lane & 7;
#pragma unroll
    for (int j = 0; j < 4; ++j) { const int n = (lane >> 3) + 8 * j; const LAS float* s = scr + (8 * c) * 33 + n;
        u32x4 o; o.x = pk2(s[0 * 33], s[1 * 33]); o.y = pk2(s[2 * 33], s[3 * 33]); o.z = pk2(s[4 * 33], s[5 * 33]); o.w = pk2(s[6 * 33], s[7 * 33]);
        *(u32x4*)(WT + (size_t)(n0 + n) * K + k0 + 8 * c) = o; }
    asm volatile("s_waitcnt lgkmcnt(0)" ::: "memory");
}

struct Args { const void* in[22]; float* out; unsigned char* ws; };

DI void conv_weights(const Args& a, int l, LAS unsigned char* L, int gw, int NGW, int wave, int lane) {
    LAS float* scr = (LAS float*)(L + wave * 16384);
    unsigned char* ws = a.ws;
    int it = gw;
#define CONV(idx, K_, Ns_, No_, GU_, gidx, dst_) { const float* Wp = (const float*)a.in[idx] + (size_t)l * (K_) * (Ns_); const float* gp = (gidx) >= 0 ? (const float*)a.in[(gidx) >= 0 ? (gidx) : 0] + (size_t)l * (K_) : nullptr; \
        const int nitems = ((K_) / 64) * ((No_) / 32); for (; it < nitems; it += NGW) conv_item(Wp, K_, Ns_, No_, GU_, gp, (bf16*)(ws + (dst_)), scr, it, lane); it -= nitems; }
    CONV(4, D, 2 * DFF, 2 * DFF, true, 3, W_GU1)
    CONV(5, DFF, D, D, false, -1, W_DN1)
    CONV(7, D, 10752, 10752, false, 6, W_IN)
    CONV(10, 512, D, D, false, -1, W_AB)
    CONV(11, D, D, D, false, -1, W_HB)
    CONV(12, D, D, D, false, -1, W_MO)
    CONV(15, D, D, D, false, 13, W_Q)
    CONV(16, D, 2 * D, 2 * D, false, -1, W_KV)
    CONV(17, D, D, D, false, -1, W_O)
    CONV(19, D, 2 * DFF, 2 * DFF, true, 18, W_GU2)
    CONV(20, DFF, D, D, false, -1, W_DN2)
#undef CONV
}

DI void prologue_misc(const Args& a, int gw, int NGW, int lane, int gtid, int NGT) {
    unsigned char* ws = a.ws;
    const float* x = (const float*)a.in[0];
    bf16* Xb = (bf16*)(ws + WS_XB); float* ssq = (float*)(ws + WS_SSQ);
    for (int m = gw; m < M; m += NGW) {
        const f32x4* xr = (const f32x4*)(x + (size_t)m * D) + lane; float s = 0.f;
        unsigned long long* o8 = (unsigned long long*)(Xb + (size_t)m * D) + lane;
#pragma unroll
        for (int j = 0; j < 4; ++j) { const f32x4 v = xr[64 * j]; s += (v[0] * v[0] + v[1] * v[1]) + (v[2] * v[2] + v[3] * v[3]);
            o8[64 * j] = (unsigned long long)pk2(v[0], v[1]) | ((unsigned long long)pk2(v[2], v[3]) << 32); }
        s = wave_sum(s);
        if (lane < 16) ssq[(size_t)m * 16 + lane] = lane == 0 ? s : 0.f;
    }
    const float* mem = (const float*)a.in[1]; const float* mnorm = (const float*)a.in[14]; bf16* memN = (bf16*)(ws + WS_MEMN);
    for (int r = gw; r < 2 * MROWS; r += NGW) {
        const int l = r / MROWS, m = r % MROWS;
        const f32x4* xr = (const f32x4*)(mem + (size_t)m * D) + lane; const f32x4* gr = (const f32x4*)(mnorm + (size_t)l * D) + lane;
        f32x4 v[4]; float s = 0.f;
#pragma unroll
        for (int j = 0; j < 4; ++j) { v[j] = xr[64 * j]; s += (v[j][0] * v[j][0] + v[j][1] * v[j][1]) + (v[j][2] * v[j][2] + v[j][3] * v[j][3]); }
        const float rs = 1.0f / sqrtf(wave_sum(s) * (1.0f / D) + EPS);
        unsigned long long* o8 = (unsigned long long*)(memN + (size_t)r * D) + lane;
#pragma unroll
        for (int j = 0; j < 4; ++j) { const f32x4 g = gr[64 * j]; const f32x4 y = v[j] * rs * g;
            o8[64 * j] = (unsigned long long)pk2(y[0], y[1]) | ((unsigned long long)pk2(y[2], y[3]) << 32); }
    }
    const int* pos = (const int*)a.in[2]; float* cosT = (float*)(ws + WS_COS); float* sinT = (float*)(ws + WS_SIN);
    for (int idx = gtid; idx < M * 64; idx += NGT) {
        const int row = idx >> 6, i = idx & 63;
        const float inv = exp2f(-(float)(2 * i) * (1.0f / 128.0f) * 13.287712379549449f);
        const float ang = (float)pos[row] * inv;
        double rv = (double)ang * 0.15915494309189535; rv -= floor(rv);
        const float fr = (float)rv;
        cosT[idx] = __builtin_amdgcn_cosf(fr); sinT[idx] = __builtin_amdgcn_sinf(fr);
    }
}

DI void rope8(u32x4 x1, u32x4 x2, const float* cp, const float* sp, u32x4& o1, u32x4& o2) {
    const f32x4 c0 = *(const f32x4*)cp, c1 = *(const f32x4*)(cp + 4), s0 = *(const f32x4*)sp, s1 = *(const f32x4*)(sp + 4);
#pragma unroll
    for (int q = 0; q < 4; ++q) {
        const float ca = q < 2 ? c0[2 * q] : c1[2 * q - 4], cb = q < 2 ? c0[2 * q + 1] : c1[2 * q - 3];
        const float sa = q < 2 ? s0[2 * q] : s1[2 * q - 4], sb = q < 2 ? s0[2 * q + 1] : s1[2 * q - 3];
        const float a0 = lo16(x1[q]), a1 = hi16(x1[q]), b0 = lo16(x2[q]), b1 = hi16(x2[q]);
        o1[q] = pk2(a0 * ca - b0 * sa, a1 * cb - b1 * sb);
        o2[q] = pk2(b0 * ca + a0 * sa, b1 * cb + a1 * sb);
    }
}
constexpr int KSTR = 272, VSTR = 528, KL_BYTES = 256 * KSTR;
DI unsigned vt_off(int dh, int kgrp) { return (unsigned)(dh * VSTR + ((kgrp ^ ((dh >> 3) & 7)) << 3)); }

DI void dil_attn_phase(LAS unsigned char* L, const bf16* Z, const float* cosT, const float* sinT, bf16* OG, float* LSE, int G, int bid, int tid) {
    const int wid = __builtin_amdgcn_readfirstlane(tid >> 6), lane = tid & 63, fr = lane & 15, fq = lane >> 4;
    LAS unsigned char* KL = L; LAS unsigned char* VL = L + KL_BYTES;
    for (int unit = bid; unit < 1536; unit += G) {
        const int j = unit & 31, h = (unit >> 5) & 3, gb = unit >> 7, g = gb % 3, b = gb / 3;
        const int dsh = 2 * g, Lseg = T >> dsh;
        const int p0 = 128 * j, r = p0 / Lseg, u0 = p0 & (Lseg - 1);
        const int tokbase = b * T + r;
        const int colq = g * 512 + h * 128, colk = 1536 + colq, colv = 3072 + colq;
        __syncthreads();
#pragma unroll
        for (int i = 0; i < 4; ++i) {
            const int p = tid + 512 * i, kk = p >> 3, pc = p & 7, uu = u0 - 128 + kk;
            u32x4 o1 = (u32x4){0u, 0u, 0u, 0u}, o2 = o1;
            if (uu >= 0) { const size_t tok = (size_t)(tokbase + (uu << dsh)); const bf16* kp = Z + tok * NATT + colk + 8 * pc;
                rope8(*(const u32x4*)kp, *(const u32x4*)(kp + 64), cosT + tok * 64 + 8 * pc, sinT + tok * 64 + 8 * pc, o1, o2); }
            *(LAS u32x4*)(KL + kk * KSTR + 16 * pc) = o1; *(LAS u32x4*)(KL + kk * KSTR + 128 + 16 * pc) = o2;
        }
#pragma unroll
        for (int i = 0; i < 8; ++i) {
            const int p = tid + 512 * i, kk = p >> 4, cb = p & 15, uu = u0 - 128 + kk;
            u32x4 x = (u32x4){0u, 0u, 0u, 0u};
            if (uu >= 0) x = *(const u32x4*)(Z + (size_t)(tokbase + (uu << dsh)) * NATT + colv + 8 * cb);
            const unsigned base = (unsigned)((((kk >> 2) ^ (cb & 7)) << 3) + (kk & 3) * 2);
#pragma unroll
            for (int jj = 0; jj < 8; ++jj) *(LAS unsigned short*)(VL + (8 * cb + jj) * VSTR + base) = (unsigned short)(x[jj >> 1] >> (16 * (jj & 1)));
        }
        const int qi = 16 * wid + fr; const size_t tq = (size_t)(tokbase + ((u0 + qi) << dsh));
        bf16x8 qf[4];
#pragma unroll
        for (int k2 = 0; k2 < 2; ++k2) { const int i0 = 32 * k2 + 8 * fq; const bf16* qp = Z + tq * NATT + colq + i0; u32x4 o1, o2;
            rope8(*(const u32x4*)qp, *(const u32x4*)(qp + 64), cosT + tq * 64 + i0, sinT + tq * 64 + i0, o1, o2); qf[k2] = mk8(o1); qf[k2 + 2] = mk8(o2); }
        __syncthreads();
        const int tw = wid & ~1;
        f32x4 s[10];
#pragma unroll
        for (int tix = 0; tix < 10; ++tix) { s[tix] = (f32x4){0.f, 0.f, 0.f, 0.f}; const int kt = tw + tix;
#pragma unroll
            for (int k4 = 0; k4 < 4; ++k4) { const bf16x8 av = *(const LAS bf16x8*)(KL + (16 * kt + fr) * KSTR + (32 * k4 + 8 * fq) * 2); s[tix] = MFMA16(av, qf[k4], s[tix]); } }
        const float scale = 0.08838834764831845f; float mx = -INFINITY;
#pragma unroll
        for (int tix = 0; tix < 10; ++tix)
#pragma unroll
            for (int e = 0; e < 4; ++e) { const int kk = 16 * (tw + tix) + 4 * fq + e; const bool ok = (kk >= qi) && (kk <= qi + 128) && (u0 - 128 + kk >= 0);
                const float v = ok ? s[tix][e] * scale : -INFINITY; s[tix][e] = v; mx = fmaxf(mx, v); }
        mx = fmaxf(mx, __shfl_xor(mx, 16)); mx = fmaxf(mx, __shfl_xor(mx, 32));
        float den = 0.f;
#pragma unroll
        for (int tix = 0; tix < 10; ++tix)
#pragma unroll
            for (int e = 0; e < 4; ++e) { const float p = __expf(s[tix][e] - mx); s[tix][e] = p; den += p; }
        den += __shfl_xor(den, 16); den += __shfl_xor(den, 32);
        bf16x8 pf[5];
#pragma unroll
        for (int pp = 0; pp < 5; ++pp) { u32x4 pw; pw.x = pk2(s[2 * pp][0], s[2 * pp][1]); pw.y = pk2(s[2 * pp][2], s[2 * pp][3]); pw.z = pk2(s[2 * pp + 1][0], s[2 * pp + 1][1]); pw.w = pk2(s[2 * pp + 1][2], s[2 * pp + 1][3]); pf[pp] = mk8(pw); }
        f32x4 o[8];
#pragma unroll
        for (int dt = 0; dt < 8; ++dt) { o[dt] = (f32x4){0.f, 0.f, 0.f, 0.f};
            const int dh = 16 * dt + fr, sw = (2 * dt + (fr >> 3)) & 7;
            const LAS unsigned char* va = VL + dh * VSTR + 32 * tw + ((fq ^ sw) << 3); const LAS unsigned char* vb2 = VL + dh * VSTR + 32 * tw + (((fq + 4) ^ sw) << 3);
#pragma unroll
            for (int pp = 0; pp < 5; ++pp) { const s16x4 lo = *(const LAS s16x4*)(va + 64 * pp), hi = *(const LAS s16x4*)(vb2 + 64 * pp);
                const bf16x8 vb = __builtin_shufflevector(lo, hi, 0, 1, 2, 3, 4, 5, 6, 7); o[dt] = MFMA16(pf[pp], vb, o[dt]); }
        }
        const float inv = 1.0f / den, lse = mx + __logf(den);
#pragma unroll
        for (int e = 0; e < 4; ++e) { const float iq = __shfl(inv, 4 * fq + e);
            bf16* op = OG + (size_t)(tokbase + ((u0 + 16 * wid + 4 * fq + e) << dsh)) * 1536 + colq + fr;
#pragma unroll
            for (int dt = 0; dt < 8; ++dt) op[16 * dt] = (bf16)f2bf(o[dt][e] * iq); }
        if (lane < 16) LSE[tq * 12 + g * 4 + h] = lse;
    }
}

DI void merge_phase(const bf16* OG, const float* LSE, bf16* AO, int gtid, int NGT) {
    for (int idx = gtid; idx < M * 64; idx += NGT) {
        const int tok = idx >> 6, h = (idx >> 4) & 3, c = idx & 15;
        const float l0 = LSE[(size_t)tok * 12 + h], l1 = LSE[(size_t)tok * 12 + 4 + h], l2 = LSE[(size_t)tok * 12 + 8 + h];
        const float mx = fmaxf(l0, fmaxf(l1, l2)); float w0 = __expf(l0 - mx), w1 = __expf(l1 - mx), w2 = __expf(l2 - mx); const float inv = 1.0f / (w0 + w1 + w2); w0 *= inv; w1 *= inv; w2 *= inv;
        const bf16* p = OG + (size_t)tok * 1536 + h * 128 + 8 * c;
        const u32x4 a = *(const u32x4*)p, b = *(const u32x4*)(p + 512), d = *(const u32x4*)(p + 1024); u32x4 o;
#pragma unroll
        for (int q = 0; q < 4; ++q) o[q] = pk2(w0 * lo16(a[q]) + w1 * lo16(b[q]) + w2 * lo16(d[q]), w0 * hi16(a[q]) + w1 * hi16(b[q]) + w2 * hi16(d[q]));
        *(u32x4*)(AO + (size_t)tok * 512 + h * 128 + 8 * c) = o;
    }
}

DI void xattn_stage_vt(LAS unsigned char* VL, const bf16* memVT, int b, int h, int hh, int tid) {
#pragma unroll
    for (int i = 0; i < 8; ++i) { const int p = tid + 512 * i, dhr = p >> 5, c = p & 31;
        const u32x4 x = *(const u32x4*)(memVT + (size_t)(h * 256 + 128 * hh + dhr) * MROWS + b * NMEM + 8 * c);
        u32x2 lo, hi; lo.x = x.x; lo.y = x.y; hi.x = x.z; hi.y = x.w;
        *(LAS u32x2*)(VL + vt_off(dhr, 2 * c)) = lo; *(LAS u32x2*)(VL + vt_off(dhr, 2 * c + 1)) = hi; }
}
DI void xattn_phase(LAS unsigned char* L, const bf16* Qx, const bf16* memK, const bf16* memVT, bf16* Ox, int G, int bid, int tid) {
    const int wid = __builtin_amdgcn_readfirstlane(tid >> 6), lane = tid & 63, fr = lane & 15, fq = lane >> 4;
    LAS unsigned char* KL = L; LAS unsigned char* VL = L + KL_BYTES;
    for (int unit = bid; unit < 512; unit += G) {
        const int j = unit & 31, h = (unit >> 5) & 3, b = unit >> 7;
        const int tok0 = b * T + 128 * j; const size_t tq = (size_t)(tok0 + 16 * wid + fr);
        bf16x8 qf[8];
#pragma unroll
        for (int k = 0; k < 8; ++k) qf[k] = *(const bf16x8*)(Qx + tq * D + h * 256 + 32 * k + 8 * fq);
        f32x4 s[16];
#pragma unroll
        for (int kt = 0; kt < 16; ++kt) s[kt] = (f32x4){0.f, 0.f, 0.f, 0.f};
#pragma unroll
        for (int hh = 0; hh < 2; ++hh) {
            __syncthreads();
#pragma unroll
            for (int i = 0; i < 8; ++i) { const int p = tid + 512 * i, m = p >> 4, cb = p & 15;
                *(LAS u32x4*)(KL + m * KSTR + 16 * cb) = *(const u32x4*)(memK + (size_t)(b * NMEM + m) * D + h * 256 + 128 * hh + 8 * cb); }
            if (hh == 0) xattn_stage_vt(VL, memVT, b, h, 0, tid);
            __syncthreads();
#pragma unroll
            for (int kt = 0; kt < 16; ++kt)
#pragma unroll
                for (int k4 = 0; k4 < 4; ++k4) { const bf16x8 av = *(const LAS bf16x8*)(KL + (16 * kt + fr) * KSTR + (32 * k4 + 8 * fq) * 2); s[kt] = MFMA16(av, qf[4 * hh + k4], s[kt]); }
        }
        float mx = -INFINITY;
#pragma unroll
        for (int kt = 0; kt < 16; ++kt)
#pragma unroll
            for (int e = 0; e < 4; ++e) { const float v = s[kt][e] * 0.0625f; s[kt][e] = v; mx = fmaxf(mx, v); }
        mx = fmaxf(mx, __shfl_xor(mx, 16)); mx = fmaxf(mx, __shfl_xor(mx, 32));
        float den = 0.f;
#pragma unroll
        for (int kt = 0; kt < 16; ++kt)
#pragma unroll
            for (int e = 0; e < 4; ++e) { const float p = __expf(s[kt][e] - mx); s[kt][e] = p; den += p; }
        den += __shfl_xor(den, 16); den += __shfl_xor(den, 32);
        bf16x8 pf[8];
#pragma unroll
        for (int pp = 0; pp < 8; ++pp) { u32x4 pw; pw.x = pk2(s[2 * pp][0], s[2 * pp][1]); pw.y = pk2(s[2 * pp][2], s[2 * pp][3]); pw.z = pk2(s[2 * pp + 1][0], s[2 * pp + 1][1]); pw.w = pk2(s[2 * pp + 1][2], s[2 * pp + 1][3]); pf[pp] = mk8(pw); }
        const float inv = 1.0f / den; float iq[4];
#pragma unroll
        for (int e = 0; e < 4; ++e) iq[e] = __shfl(inv, 4 * fq + e);
#pragma unroll
        for (int hh = 0; hh < 2; ++hh) {
            if (hh == 1) { __syncthreads(); xattn_stage_vt(VL, memVT, b, h, 1, tid); __syncthreads(); }
            f32x4 o[8];
#pragma unroll
            for (int dt = 0; dt < 8; ++dt) { o[dt] = (f32x4){0.f, 0.f, 0.f, 0.f};
                const int dh = 16 * dt + fr, sw = (2 * dt + (fr >> 3)) & 7;
                const LAS unsigned char* va = VL + dh * VSTR + ((fq ^ sw) << 3); const LAS unsigned char* vb2 = VL + dh * VSTR + (((fq + 4) ^ sw) << 3);
#pragma unroll
                for (int pp = 0; pp < 8; ++pp) { const s16x4 lo = *(const LAS s16x4*)(va + 64 * pp), hi = *(const LAS s16x4*)(vb2 + 64 * pp);
                    const bf16x8 vb = __builtin_shufflevector(lo, hi, 0, 1, 2, 3, 4, 5, 6, 7); o[dt] = MFMA16(pf[pp], vb, o[dt]); }
            }
#pragma unroll
            for (int e = 0; e < 4; ++e) { bf16* op = Ox + (size_t)(tok0 + 16 * wid + 4 * fq + e) * D + h * 256 + 128 * hh + fr;
#pragma unroll
                for (int dt = 0; dt < 8; ++dt) op[16 * dt] = (bf16)f2bf(o[dt][e] * iq[e]); }
        }
    }
}

constexpr int H1_QA = 0, H1_KA = 64 * 272, H1_VT = 2 * 64 * 272, H1_TOT = H1_VT + 128 * 144;
template <bool DRY> DI void hgrn1_phase(LAS unsigned char* L, bf16* Z2, const float* lbraw, int layer, float* DEC, unsigned long long* OI, int G, int bid, int tid) {
    const int wid = __builtin_amdgcn_readfirstlane(tid >> 6), lane = tid & 63, fr = lane & 15, fq = lane >> 4;
    const int n = tid & 127, rg = tid >> 7, tt = wid & 3, vh = wid >> 2;
    LAS float* TOT = (LAS float*)(L + H1_TOT);
    for (int unit = bid; unit < 2048; unit += G) {
        const int c = unit & 63, h = (unit >> 6) & 7, b = unit >> 9, tok0 = b * T + 64 * c, ch = h * 128 + n;
        float lbv = 0.f;
        if (layer > 0) { const float e0 = lbraw[ch], e1 = lbraw[D + ch]; lbv = 1.0f / (1.0f + expf(e0 - e1)); }
        float q[16], cs[16], kg[16]; unsigned short vr[16]; unsigned short ogr[16];
#pragma unroll
        for (int vi = 0; vi < 4; ++vi)
#pragma unroll
            for (int e = 0; e < 4; ++e) ogr[4 * vi + e] = Z2[(size_t)(tok0 + 16 * tt + 4 * fq + e) * NH2 + 3072 + h * 128 + 16 * (4 * vh + vi) + fr];
        bf16* base = Z2 + (size_t)(tok0 + 16 * rg) * NH2 + ch;
#pragma unroll
        for (int r = 0; r < 16; ++r) { const bf16* p = base + (size_t)r * NH2; q[r] = bf2f(p[0]); cs[r] = bf2f(p[1024]); vr[r] = p[2048]; }
        float run = 0.f;
#pragma unroll
        for (int r = 0; r < 16; ++r) { const float fl = cs[r]; const float sg = 1.0f / (1.0f + __expf(-fl)); const float f = lbv + (1.0f - lbv) * sg;
            kg[r] = (1.0f - lbv) / (1.0f + __expf(fl)); run += __logf(f); cs[r] = run; }
        asm volatile("s_waitcnt vmcnt(0)" ::: "memory");
        TOT[rg * 128 + n] = run;
        __syncthreads();
        const float t0 = TOT[n], t1 = TOT[128 + n], t2 = TOT[256 + n], t3 = TOT[384 + n];
        const float off = rg == 0 ? 0.f : (rg == 1 ? t0 : (rg == 2 ? t0 + t1 : t0 + t1 + t2));
        const float bmid = t0 + t1, blast = (t0 + t1) + (t2 + t3);
        const float qscale = 0.08838834764831845f;
        float kh[16];
#pragma unroll
        for (int r = 0; r < 16; ++r) { const float bt = off + cs[r]; const float qs = q[r] * qscale; const int row = 16 * rg + r;
            if (!DRY) base[(size_t)r * NH2] = (bf16)f2bf(qs * __expf(bt));
            *(LAS unsigned short*)(L + H1_QA + row * 272 + n * 2) = (unsigned short)f2bf(qs * __expf(bt - bmid));
            *(LAS unsigned short*)(L + H1_KA + row * 272 + n * 2) = (unsigned short)f2bf(kg[r] * __expf(bmid - bt));
            kh[r] = kg[r] * __expf(blast - bt); }
        u32x4 k0, k1, v0, v1;
#pragma unroll
        for (int qd = 0; qd < 4; ++qd) { k0[qd] = pk2(kh[2 * qd], kh[2 * qd + 1]); k1[qd] = pk2(kh[8 + 2 * qd], kh[9 + 2 * qd]);
            v0[qd] = (unsigned)vr[2 * qd] | ((unsigned)vr[2 * qd + 1] << 16); v1[qd] = (unsigned)vr[8 + 2 * qd] | ((unsigned)vr[9 + 2 * qd] << 16); }
        bf16* slot = Z2 + (size_t)(tok0 + (n >> 1)) * NH2 + h * 128 + (n & 1) * 64 + 16 * rg;
        if (!DRY) { *(u32x4*)(slot + 1024) = k0; *(u32x4*)(slot + 1024 + 8) = k1;
        *(u32x4*)(slot + 2048) = v0; *(u32x4*)(slot + 2048 + 8) = v1; }
        *(LAS u32x4*)(L + H1_VT + n * 144 + 32 * rg) = v0; *(LAS u32x4*)(L + H1_VT + n * 144 + 32 * rg + 16) = v1;
        if (!DRY && rg == 0) DEC[(size_t)unit * 128 + n] = __expf(blast);
        __syncthreads();
        bf16x8 bq[4];
#pragma unroll
        for (int k4 = 0; k4 < 4; ++k4) bq[k4] = *(const LAS bf16x8*)(L + H1_QA + (16 * tt + fr) * 272 + (32 * k4 + 8 * fq) * 2);
        f32x4 at[4];
#pragma unroll
        for (int st = 0; st < 4; ++st) { at[st] = (f32x4){0.f, 0.f, 0.f, 0.f};
            if (st <= tt) {
#pragma unroll
                for (int k4 = 0; k4 < 4; ++k4) { const bf16x8 av = *(const LAS bf16x8*)(L + H1_KA + (16 * st + fr) * 272 + (32 * k4 + 8 * fq) * 2); at[st] = MFMA16(av, bq[k4], at[st]); }
                if (st == tt) {
#pragma unroll
                    for (int e = 0; e < 4; ++e) if (4 * fq + e > fr) at[st][e] = 0.f; }
            } }
        bf16x8 pf[2];
#pragma unroll
        for (int pp = 0; pp < 2; ++pp) { u32x4 pw; pw.x = pk2(at[2 * pp][0], at[2 * pp][1]); pw.y = pk2(at[2 * pp][2], at[2 * pp][3]); pw.z = pk2(at[2 * pp + 1][0], at[2 * pp + 1][1]); pw.w = pk2(at[2 * pp + 1][2], at[2 * pp + 1][3]); pf[pp] = mk8(pw); }
#pragma unroll
        for (int vi = 0; vi < 4; ++vi) { const int vt = 4 * vh + vi; f32x4 o = (f32x4){0.f, 0.f, 0.f, 0.f};
#pragma unroll
            for (int pp = 0; pp < 2; ++pp) { const LAS unsigned char* vp = L + H1_VT + (16 * vt + fr) * 144 + (32 * pp + 4 * fq) * 2;
                const s16x4 lo = *(const LAS s16x4*)vp, hi = *(const LAS s16x4*)(vp + 32);
                const bf16x8 vb = __builtin_shufflevector(lo, hi, 0, 1, 2, 3, 4, 5, 6, 7); o = MFMA16(pf[pp], vb, o); }
            if (!DRY) OI[((size_t)(unit * 4 + tt) * 8 + vt) * 64 + lane] = (unsigned long long)pk2(o[0], o[1]) | ((unsigned long long)pk2(o[2], o[3]) << 32);
            float gsv[4];
#pragma unroll
            for (int e = 0; e < 4; ++e) { const float gv = bf2f(ogr[4 * vi + e]); gsv[e] = gv * sigmoidf_(gv); }
            const int P = (tt * 8 + vt) * 64 + lane;
            if (!DRY) *(unsigned long long*)(Z2 + (size_t)(tok0 + (P >> 5)) * NH2 + 3072 + h * 128 + (P & 31) * 4) = (unsigned long long)pk2(gsv[0], gsv[1]) | ((unsigned long long)pk2(gsv[2], gsv[3]) << 32); }
    }
}

constexpr int H2_BUF = 36352, H2_KHT = 17408, H2_DEC = 35840, H2_RS = 2 * H2_BUF;
template <bool DRY> DI void hgrn2_phase(LAS unsigned char* L, bf16* Z2, const float* DEC, const unsigned long long* OI, const float* gain, int bh, int tid) {
    const int w = __builtin_amdgcn_readfirstlane(tid >> 6), lane = tid & 63, fr = lane & 15, fq = lane >> 4;
    const int b = bh >> 3, h = bh & 7, unit0 = bh * 64, vcol = 16 * w + fr;
    const float gn = gain[h * 128 + vcol];
    LAS float* RS = (LAS float*)(L + H2_RS);
    u32x4 sq[2], sk[2]; f32x4 sd = (f32x4){0.f, 0.f, 0.f, 0.f};
#define H2_LOAD(cc) do { const int tok0_ = b * T + 64 * (cc); _Pragma("unroll") for (int i = 0; i < 2; ++i) { const int p = tid + 512 * i, row = p >> 4, cb = p & 15; \
        const bf16* rp = Z2 + (size_t)(tok0_ + row) * NH2 + h * 128 + 8 * cb; sq[i] = *(const u32x4*)rp; sk[i] = *(const u32x4*)(rp + 1024); } \
        if (tid < 32) sd = *(const f32x4*)(DEC + (size_t)(unit0 + (cc)) * 128 + 4 * tid); } while (0)
#define H2_WRITE(bi) do { LAS unsigned char* B_ = L + (bi) * H2_BUF; _Pragma("unroll") for (int i = 0; i < 2; ++i) { const int p = tid + 512 * i, row = p >> 4, cb = p & 15; \
        *(LAS u32x4*)(B_ + row * 272 + 16 * cb) = sq[i]; *(LAS u32x4*)(B_ + H2_KHT + (2 * row + (cb >> 3)) * 144 + 16 * (cb & 7)) = sk[i]; } \
        if (tid < 32) *(LAS f32x4*)(B_ + H2_DEC + 16 * tid) = sd; } while (0)
#define H2_PRIV(cc, VT_, OI_, GS_) do { const int tok0_ = b * T + 64 * (cc); \
        const bf16* vp_ = Z2 + (size_t)(tok0_ + (vcol >> 1)) * NH2 + 2048 + h * 128 + (vcol & 1) * 64 + 8 * fq; VT_[0] = *(const u32x4*)vp_; VT_[1] = *(const u32x4*)(vp_ + 32); \
        _Pragma("unroll") for (int tt_ = 0; tt_ < 4; ++tt_) { OI_[tt_] = OI[((size_t)((unit0 + (cc)) * 4 + tt_) * 8 + w) * 64 + lane]; const int P_ = (tt_ * 8 + w) * 64 + lane; \
            GS_[tt_] = *(const unsigned long long*)(Z2 + (size_t)(tok0_ + (P_ >> 5)) * NH2 + 3072 + h * 128 + (P_ & 31) * 4); } } while (0)
    u32x4 vtf[2]; unsigned long long oi[4], gs[4];
    H2_LOAD(0); H2_WRITE(0); H2_PRIV(0, vtf, oi, gs);
    if (tid < 192) RS[tid] = 0.f;
    f32x4 S[8];
#pragma unroll
    for (int nt = 0; nt < 8; ++nt) S[nt] = (f32x4){0.f, 0.f, 0.f, 0.f};
    __syncthreads();
    for (int c = 0; c < 64; ++c) {
        LAS unsigned char* Bc = L + (c & 1) * H2_BUF;
        LAS float* RSc = RS + (c % 3) * 64;
        asm volatile("" : "+v"(vtf[0]), "+v"(vtf[1]), "+v"(oi[0]), "+v"(oi[1]), "+v"(oi[2]), "+v"(oi[3]), "+v"(gs[0]), "+v"(gs[1]), "+v"(gs[2]), "+v"(gs[3]));
        u32x4 nvt[2]; unsigned long long noi[4], ngs[4];
        const int cn = c + 1 < 64 ? c + 1 : c;
        H2_LOAD(cn); H2_PRIV(cn, nvt, noi, ngs);
        bf16x8 qa[4][4];
#pragma unroll
        for (int tt = 0; tt < 4; ++tt)
#pragma unroll
            for (int np = 0; np < 4; ++np) { const LAS unsigned char* qp = Bc + (16 * tt + fr) * 272 + (32 * np + 4 * fq) * 2;
                const s16x4 lo = *(const LAS s16x4*)qp, hi = *(const LAS s16x4*)(qp + 32); qa[tt][np] = __builtin_shufflevector(lo, hi, 0, 1, 2, 3, 4, 5, 6, 7); }
        bf16x8 sb[4];
#pragma unroll
        for (int np = 0; np < 4; ++np) { u32x4 pw; pw.x = pk2(S[2 * np][0], S[2 * np][1]); pw.y = pk2(S[2 * np][2], S[2 * np][3]); pw.z = pk2(S[2 * np + 1][0], S[2 * np + 1][1]); pw.w = pk2(S[2 * np + 1][2], S[2 * np + 1][3]); sb[np] = mk8(pw); }
        f32x4 o[4];
#pragma unroll
        for (int tt = 0; tt < 4; ++tt) { const unsigned lo = (unsigned)oi[tt], hi = (unsigned)(oi[tt] >> 32); o[tt] = (f32x4){lo16(lo), hi16(lo), lo16(hi), hi16(hi)}; }
#pragma unroll
        for (int np = 0; np < 4; ++np)
#pragma unroll
            for (int tt = 0; tt < 4; ++tt) o[tt] = MFMA16(qa[tt][np], sb[np], o[tt]);
#pragma unroll
        for (int tt = 0; tt < 4; ++tt)
#pragma unroll
            for (int e = 0; e < 4; ++e) { const float q2 = row16_sum(o[tt][e] * o[tt][e]);
                if (fr == 0) __hip_atomic_fetch_add(RSc + 16 * tt + 4 * fq + e, q2, __ATOMIC_RELAXED, __HIP_MEMORY_SCOPE_WORKGROUP); }
        if (tid < 64) RS[((c + 1) % 3) * 64 + tid] = 0.f;
        LBAR();
        const int tok0 = b * T + 64 * c;
#pragma unroll
        for (int tt = 0; tt < 4; ++tt) { const f32x4 rs = *(const LAS f32x4*)(RSc + 16 * tt + 4 * fq);
            const unsigned glo = (unsigned)gs[tt], ghi = (unsigned)(gs[tt] >> 32); const float gv[4] = {lo16(glo), hi16(glo), lo16(ghi), hi16(ghi)};
#pragma unroll
            for (int e = 0; e < 4; ++e) { const float rstd = 1.0f / sqrtf(rs[e] * (1.0f / 128.0f) + EPS);
                const float ov_ = o[tt][e] * rstd * gn * gv[e];
                if (!DRY || ov_ == 12345.678f) Z2[(size_t)(tok0 + 16 * tt + 4 * fq + e) * NH2 + 3072 + h * 128 + vcol] = (bf16)f2bf(ov_); } }
        bf16x8 ka[8][2];
#pragma unroll
        for (int nt = 0; nt < 8; ++nt)
#pragma unroll
            for (int ks = 0; ks < 2; ++ks) ka[nt][ks] = *(const LAS bf16x8*)(Bc + H2_KHT + (16 * nt + fr) * 144 + (32 * ks + 8 * fq) * 2);
#pragma unroll
        for (int nt = 0; nt < 8; ++nt) { const f32x4 dv = *(const LAS f32x4*)(Bc + H2_DEC + (16 * nt + 4 * fq) * 4); S[nt] = S[nt] * dv; }
#pragma unroll
        for (int ks = 0; ks < 2; ++ks)
#pragma unroll
            for (int nt = 0; nt < 8; ++nt) S[nt] = MFMA16(ka[nt][ks], mk8(vtf[ks]), S[nt]);
        if (c + 1 < 64) H2_WRITE((c + 1) & 1);
        vtf[0] = nvt[0]; vtf[1] = nvt[1];
#pragma unroll
        for (int i = 0; i < 4; ++i) { oi[i] = noi[i]; gs[i] = ngs[i]; }
        LBAR();
    }
#undef H2_LOAD
#undef H2_WRITE
#undef H2_PRIV
}

#define XB_TMO      128
#define XB_XCNT(j)  (256  + 64 * (j))
#define XB_XSUB(j)  (1280 + 64 * (j))
#define XB_XGEN(j)  (2304 + 64 * (j))
#define XB_TOP      3328
#define XB_TOPGEN   3392
#define XCD_BAR_WORDS 3456
#define XB_SPIN_CAP (1u << 18)

__device__ __forceinline__ unsigned xb_ld(unsigned* p)              { return __hip_atomic_load(p, __ATOMIC_RELAXED, __HIP_MEMORY_SCOPE_AGENT); }
__device__ __forceinline__ unsigned xb_add(unsigned* p, unsigned v) { return __hip_atomic_fetch_add(p, v, __ATOMIC_RELAXED, __HIP_MEMORY_SCOPE_AGENT); }
__device__ __forceinline__ unsigned xb_xcc_id() { return (unsigned)__builtin_amdgcn_s_getreg((3 << 11) | 20) & 0xFu; }
#define XB_SPIN(cond, bar) do { unsigned _sp = 0; while (cond) { __builtin_amdgcn_s_sleep(1); \
    if ((++_sp & 255u) == 0u) { if (xb_ld(&(bar)[XB_TMO])) break; if (_sp > XB_SPIN_CAP) { atomicAdd(&(bar)[XB_TMO], 1u); break; } } } } while (0)

struct XcdBarrier {
    unsigned* bar; unsigned x;
    volatile LAS unsigned* st;
};

__device__ __forceinline__ XcdBarrier xcd_barrier_post(unsigned* bar, volatile LAS unsigned* st) {
    XcdBarrier b; b.bar = bar; b.x = xb_xcc_id(); b.st = st;
    if (threadIdx.x == 0) (void)xb_add(&bar[XB_XCNT(b.x)], 1u);
    return b;
}
__device__ __forceinline__ void xcd_barrier_complete(unsigned* bar, unsigned x, unsigned& nloc, unsigned& nx) {
    const unsigned G = gridDim.x * gridDim.y * gridDim.z;
    unsigned sum, cnt, mine, sp = 0u;
    for (;;) {
        sum = 0u; cnt = 0u; mine = 0u;
#pragma unroll
        for (unsigned j = 0; j < 16; ++j) { const unsigned c = xb_ld(&bar[XB_XCNT(j)]); sum += c; cnt += (c > 0u) ? 1u : 0u; mine = (j == x) ? c : mine; }
        if (sum == G) break;
        __builtin_amdgcn_s_sleep(1);
        if ((++sp & 255u) == 0u) { if (xb_ld(&bar[XB_TMO])) break; if (sp > XB_SPIN_CAP) { atomicAdd(&bar[XB_TMO], 1u); break; } }
    }
    nloc = mine > 0u ? mine : 1u; nx = cnt > 0u ? cnt : 1u;
}

__device__ __forceinline__ void xcd_barrier(const XcdBarrier& b) {
    asm volatile("s_waitcnt vmcnt(0)" ::: "memory");
    __syncthreads();
    if (threadIdx.x == 0) {
        unsigned* bar = b.bar;
        __builtin_amdgcn_s_waitcnt(0);
        unsigned nloc = b.st[0], nx = b.st[1];
        if (nloc == 0u) { xcd_barrier_complete(bar, b.x, nloc, nx); b.st[0] = nloc; b.st[1] = nx; }
        const unsigned old = xb_add(&bar[XB_XSUB(b.x)], 1u);
        const unsigned gen = old / nloc;
        if (old + 1u == (gen + 1u) * nloc) {
            __builtin_amdgcn_fence(__ATOMIC_RELEASE, "agent");
            asm volatile("s_waitcnt vmcnt(0)" ::: "memory");
            const unsigned og = xb_add(&bar[XB_TOP], 1u);
            const unsigned tg = og / nx;
            if (og + 1u == (tg + 1u) * nx) xb_add(&bar[XB_TOPGEN], 1u);
            else XB_SPIN(xb_ld(&bar[XB_TOPGEN]) == tg, bar);
            __builtin_amdgcn_fence(__ATOMIC_ACQUIRE, "agent");
            xb_add(&bar[XB_XGEN(b.x)], 1u);
            asm volatile("s_waitcnt vmcnt(0)" ::: "memory");
        } else {
            XB_SPIN(xb_ld(&bar[XB_XGEN(b.x)]) == gen, bar);
            __builtin_amdgcn_fence(__ATOMIC_ACQUIRE, "agent");
            asm volatile("s_waitcnt vmcnt(0)" ::: "memory");
        }
    }
    __syncthreads();
}

#ifndef PROBE_SYNC
#define PROBE_SYNC 0
#endif
#ifndef PROBE_ATT
#define PROBE_ATT 0
#endif
#ifndef PROBE_GEMM
#define PROBE_GEMM 0
#endif
#ifndef PROBE_HG
#define PROBE_HG 0
#endif
#ifndef PROBE_CONV
#define PROBE_CONV 0
#endif
#define GSYNC() do { xcd_barrier(xbar); if (PROBE_SYNC) xcd_barrier(xbar); } while (0)
#define REP(n) for (int rep_ = 0; rep_ < 1 + (n); ++rep_)
#define FRESH() unsigned char* ws = a.ws; asm volatile("" : "+s"(ws)); int tid = threadIdx.x; asm volatile("" : "+v"(tid)); \
    const int lane = tid & 63, wave = __builtin_amdgcn_readfirstlane(tid >> 6); int G = gridDim.x, bid = blockIdx.x; asm volatile("" : "+s"(G), "+s"(bid)); \
    const int gw = bid * 8 + wave, NGW = G * 8, gtid = bid * 512 + tid, NGT = G * 512; float* X = a.out; asm volatile("" : "+s"(X)); \
    bf16* Xb = (bf16*)(ws + WS_XB); float* ssq = (float*)(ws + WS_SSQ); bf16* Z = (bf16*)(ws + WS_Z); \
    (void)lane; (void)gw; (void)NGW; (void)gtid; (void)NGT; (void)Xb; (void)ssq; (void)Z; (void)X;

__global__ void __launch_bounds__(512, 2) fwd_megakernel(Args a) {
    extern __shared__ __attribute__((aligned(16))) unsigned char lds_raw[];
    LAS unsigned char* L = (LAS unsigned char*)lds_raw;
    volatile LAS unsigned* MISC = (volatile LAS unsigned*)(L + LDS_BYTES - 64);
    if (threadIdx.x < 16) MISC[threadIdx.x] = 0u;
    __syncthreads();
    const XcdBarrier xbar = xcd_barrier_post((unsigned*)(a.ws + WS_CTL), MISC);

    REP(PROBE_CONV) { FRESH(); conv_weights(a, 0, L, gw, NGW, wave, lane); }
    { FRESH(); prologue_misc(a, gw, NGW, lane, gtid, NGT); }
    cg::this_grid().sync();

    for (int l = 0; l < 2; ++l) {
        if (l > 0) { REP(PROBE_CONV) { FRESH(); conv_weights(a, l, L, gw, NGW, wave, lane); } GSYNC(); }
        REP(PROBE_GEMM) { FRESH(); run_gemm(L, Xb, D, (const bf16*)(ws + W_GU1), D, M, 2 * DFF, D, G, bid, EpiSwiglu{Z, ssq}); }
        GSYNC();
        { FRESH(); run_gemm(L, Z, DFF, (const bf16*)(ws + W_DN1), DFF, M, D, DFF, G, bid, EpiResid{l == 0 ? (const float*)a.in[0] : X, X, Xb, ssq, 0.5f}); }
        GSYNC();
        REP(PROBE_GEMM) { FRESH(); run_gemm(L, Xb, D, (const bf16*)(ws + W_IN), D, M, NATT, D, G, bid, EpiZ{Z, NATT, ssq}); }
        GSYNC();
        REP(PROBE_ATT) { FRESH(); dil_attn_phase(L, Z, (const float*)(ws + WS_COS), (const float*)(ws + WS_SIN), (bf16*)(ws + WS_OG), (float*)(ws + WS_LSE), G, bid, tid); }
        GSYNC();
        REP(PROBE_GEMM) { FRESH(); run_gemm(L, Xb, D, (const bf16*)(ws + W_IN) + (size_t)NATT * D, D, M, NH2, D, G, bid, EpiZ{Z, NH2, ssq}); }
        { FRESH(); merge_phase((const bf16*)(ws + WS_OG), (const float*)(ws + WS_LSE), (bf16*)(ws + WS_AO), gtid, NGT); }
        GSYNC();
#if PROBE_HG
        { FRESH(); hgrn1_phase<true>(L, Z, (const float*)a.in[8], l, (float*)(ws + WS_DEC), (unsigned long long*)(ws + WS_OG), G, bid, tid); }
#endif
        { FRESH(); hgrn1_phase<false>(L, Z, (const float*)a.in[8], l, (float*)(ws + WS_DEC), (unsigned long long*)(ws + WS_OG), G, bid, tid); }
        GSYNC();
        { FRESH();
#if PROBE_HG
          if (bid < 32) { hgrn2_phase<true>(L, Z, (const float*)(ws + WS_DEC), (const unsigned long long*)(ws + WS_OG), (const float*)a.in[9] + (size_t)l * D, bid, tid); __syncthreads(); }
#endif
          if (bid < 32) hgrn2_phase<false>(L, Z, (const float*)(ws + WS_DEC), (const unsigned long long*)(ws + WS_OG), (const float*)a.in[9] + (size_t)l * D, bid, tid);
          else {
            const bf16* memN = (const bf16*)(ws + WS_MEMN) + (size_t)l * MROWS * D; const bf16* Wkv = (const bf16*)(ws + W_KV);
            run_gemm(L, memN, D, Wkv, D, MROWS, D, D, G - 32, bid - 32, EpiZ{(bf16*)(ws + WS_MEMK), D, nullptr});
            run_gemm(L, Wkv + (size_t)D * D, D, memN, D, D, MROWS, D, G - 32, G - 1 - bid, EpiZ{(bf16*)(ws + WS_MEMVT), MROWS, nullptr});
          } }
        GSYNC();
        REP(PROBE_GEMM) { FRESH(); run_gemm(L, Xb, D, (const bf16*)(ws + W_IN) + (size_t)(NATT + NH2) * D, D, M, 2048, D, G, bid, EpiZ{Z, NH2, ssq}); }
        GSYNC();
        { FRESH(); run_gemm(L, (const bf16*)(ws + WS_AO), 512, (const bf16*)(ws + W_AB), 512, M, D, 512, G, bid, EpiGate<false>{Z, NH2, Z + 2048, NH2}); }
        { FRESH(); run_gemm(L, Z + 3072, NH2, (const bf16*)(ws + W_HB), D, M, D, D, G, bid, EpiGate<true>{Z + 1024, NH2, Z + 2048, NH2}); }
        GSYNC();
        { FRESH(); run_gemm(L, Z + 2048, NH2, (const bf16*)(ws + W_MO), D, M, D, D, G, bid, EpiResid{X, X, Xb, ssq, 1.0f}); }
        GSYNC();
        REP(PROBE_GEMM) { FRESH(); run_gemm(L, Xb, D, (const bf16*)(ws + W_Q), D, M, D, D, G, bid, EpiZ{Z, D, ssq}); }
        GSYNC();
        REP(PROBE_ATT) { FRESH(); xattn_phase(L, Z, (const bf16*)(ws + WS_MEMK), (const bf16*)(ws + WS_MEMVT), Z + (size_t)M * D, G, bid, tid); }
        GSYNC();
        { FRESH(); run_gemm(L, Z + (size_t)M * D, D, (const bf16*)(ws + W_O), D, M, D, D, G, bid, EpiResid{X, X, Xb, ssq, 1.0f}); }
        GSYNC();
        REP(PROBE_GEMM) { FRESH(); run_gemm(L, Xb, D, (const bf16*)(ws + W_GU2), D, M, 2 * DFF, D, G, bid, EpiSwiglu{Z, ssq}); }
        GSYNC();
        { FRESH(); run_gemm(L, Z, DFF, (const bf16*)(ws + W_DN2), DFF, M, D, DFF, G, bid, EpiResid{X, X, Xb, ssq, 0.5f}); }
        GSYNC();
    }
    { FRESH();
      const float* fg = (const float*)a.in[21];
      for (int m = gw; m < M; m += NGW) {
        f32x4* xr = (f32x4*)(X + (size_t)m * D) + lane; const f32x4* gr = (const f32x4*)fg + lane;
        f32x4 v[4]; float s = 0.f;
#pragma unroll
        for (int j = 0; j < 4; ++j) { v[j] = xr[64 * j]; s += (v[j][0] * v[j][0] + v[j][1] * v[j][1]) + (v[j][2] * v[j][2] + v[j][3] * v[j][3]); }
        const float rs = 1.0f / sqrtf(wave_sum(s) * (1.0f / D) + EPS);
#pragma unroll
        for (int j = 0; j < 4; ++j) xr[64 * j] = v[j] * rs * gr[64 * j];
      } }
}

extern "C" void kernel_launch(void* const* d_in, const int* in_sizes, int n_in, void* d_out, int out_size, void* d_ws, size_t ws_size, hipStream_t stream) {
    static int grid = 0;
    if (grid == 0) {
        if (n_in != 22 || out_size != M * D || ws_size < WS_END) { fprintf(stderr, "kernel_launch: unexpected shapes (n_in %d out %d ws %zu)\n", n_in, out_size, ws_size); grid = -1; return; }
        int dev = 0, cus = 0, per_cu = 0;
        hipGetDevice(&dev); hipDeviceGetAttribute(&cus, hipDeviceAttributeMultiprocessorCount, dev);
        hipFuncSetAttribute((const void*)fwd_megakernel, hipFuncAttributeMaxDynamicSharedMemorySize, LDS_BYTES);
        hipOccupancyMaxActiveBlocksPerMultiprocessor(&per_cu, (const void*)fwd_megakernel, 512, LDS_BYTES);
        if (per_cu < 1) { fprintf(stderr, "kernel_launch: occupancy query reports %d blocks per CU\n", per_cu); grid = -1; return; }
        grid = cus;
        if (grid < 64) { fprintf(stderr, "kernel_launch: too few CUs (%d)\n", grid); grid = -1; return; }
    }
    if (grid < 0) return;
    if (hipMemsetAsync((char*)d_ws + WS_CTL, 0, CTL_BYTES, stream) != hipSuccess) { fprintf(stderr, "kernel_launch: memset failed\n"); return; }
    Args a{};
    for (int i = 0; i < 22; ++i) a.in[i] = d_in[i];
    a.out = (float*)d_out; a.ws = (unsigned char*)d_ws;
    void* args[] = {&a};
    hipError_t e = hipLaunchCooperativeKernel((const void*)fwd_megakernel, dim3(grid), dim3(512), args, LDS_BYTES, stream);
    if (e != hipSuccess) fprintf(stderr, "cooperative launch failed: %s (grid %d)\n", hipGetErrorString(e), grid);
}
```

```cpp
#include <hip/hip_runtime.h>
#include <hip/hip_cooperative_groups.h>
#include <cstdio>
#include <cstdint>
namespace cg = cooperative_groups;
namespace pg8 {
#define PG8_LAS __attribute__((address_space(3)))
typedef unsigned short bf16_t;
typedef short bf16x8 __attribute__((ext_vector_type(8)));
typedef float f32x4 __attribute__((ext_vector_type(4)));
typedef unsigned u32x4 __attribute__((ext_vector_type(4)));
constexpr int BM = 256, BK = 64, HALF = 128, HTB = HALF * BK * 2  , STAGE_BYTES = 8 * HTB, NXCD = 8, WGM = 8;

__host__ __device__ __forceinline__ int lds_byte(int r, int c) { const int st = (r >> 4) * 2 + (c >> 5), rr = r & 15, cc = c & 31, ob = rr * 64 + cc * 2; return st * 1024 + (ob ^ (((ob >> 9) & 1) << 5)); }
__host__ __device__ __forceinline__ void stage_rc(int b, int& R, int& C) { const int st = b / 1024, sb = b % 1024, swz = sb ^ (((sb >> 9) & 1) << 5); R = (st >> 1) * 16 + swz / 64; C = (st & 1) * 32 + (swz % 64) / 2; }
__host__ __device__ __forceinline__ int perm32(int rho) { const int n = rho >> 4, i = rho & 15; return 8 * (i >> 2) + 4 * n + (i & 3); }

struct Unit { int pm, pn; };
struct Gemm { const bf16_t* A; const bf16_t* Bt; int M, N, K, lda, ldb; };

struct StaticOrder {
    int nM, nN, nwg, G, c;
    __host__ __device__ void init(int M, int N, int G_, int c_) { nM = M / BM; nN = N / BM; nwg = nM * nN; G = G_; c = c_; }
    __host__ __device__ bool next(int i, Unit& u) const {
        const long L = (long)i * G + c; if (L >= nwg) return false;
        int wgid = (int)L; { const int q = nwg / NXCD, r = nwg % NXCD, xcd = wgid % NXCD, off = wgid / NXCD; wgid = (xcd < r ? xcd * (q + 1) : r * (q + 1) + (xcd - r) * q) + off; }
        const int nig = WGM * nN, gid = wgid / nig, fm = gid * WGM, gsz = (nM - fm) < WGM ? (nM - fm) : WGM;
        u.pm = fm + ((wgid % nig) % gsz); u.pn = (wgid % nig) / gsz; return true;
    }
    __device__ __forceinline__ void a_ready(const Unit&) const {}
    __device__ __forceinline__ void done(const Unit&) const {}
};

template <class Epi, class Sched, bool ALIGN_EPI = false, bool SP2 = false>
__device__ __forceinline__ void gemm_phase(PG8_LAS unsigned char* lds, const Gemm g, const Sched& S, const Epi& E) {
    int tid_ = threadIdx.x; asm volatile("" : "+v"(tid_)); const int tid = tid_, wid = __builtin_amdgcn_readfirstlane(tid >> 6), lane = tid & 63, wr = wid >> 2, wc = wid & 3, fr = lane & 15, fq = lane >> 4;
    const int K = g.K, nt = K / BK;
    unsigned voffA[2], voffB[2];
#pragma unroll
    for (int i = 0; i < 2; ++i) { int R, C; stage_rc(tid * 16 + i * 8192, R, C); const int Rb = Epi::PERM ? ((R & ~31) + perm32(R & 31)) : R;
        voffA[i] = (unsigned)(R * g.lda + C) * 2u; voffB[i] = (unsigned)(Rb * g.ldb + C) * 2u; }
    const size_t kstep = (size_t)(BK * 2);
    const size_t hstepA = (size_t)HALF * g.lda * 2, hstepB = (size_t)HALF * g.ldb * 2;
    const size_t tstepA = 2 * hstepA, tstepB = 2 * hstepB;
    const unsigned ldsw = (unsigned)wid * 1024u;
    const int aoff = lds_byte(wr * 64 + fr, fq * 8), boff = lds_byte(wc * 32 + fr, fq * 8);
#define PG8_SA(b, h) (((b) * 2 + (h)) * HTB)
#define PG8_SB(b, h) ((4 + (b) * 2 + (h)) * HTB)
#define PG8_STAGE(bufoff, gbase, voff) do { _Pragma("unroll") for (int _i = 0; _i < 2; ++_i) \
        __builtin_amdgcn_global_load_lds((const unsigned*)((const char*)(gbase) + (voff)[_i]), (PG8_LAS unsigned*)(lds + (bufoff) + ldsw + _i * 8192), 16, 0, 0); } while (0)
#define PG8_LDA(dst, b, h) do { _Pragma("unroll") for (int m = 0; m < 4; ++m) _Pragma("unroll") for (int k = 0; k < 2; ++k) dst[m][k] = *(const PG8_LAS bf16x8*)(lds + PG8_SA(b, h) + aoff + m * 2048 + k * 1024); } while (0)
#define PG8_LDB(dst, b, h) do { _Pragma("unroll") for (int n = 0; n < 2; ++n) _Pragma("unroll") for (int k = 0; k < 2; ++k) dst[n][k] = *(const PG8_LAS bf16x8*)(lds + PG8_SB(b, h) + boff + n * 2048 + k * 1024); } while (0)
#define PG8_MMA(ai, bj, At, Bt) do { __builtin_amdgcn_s_setprio(1); _Pragma("unroll") for (int m = 0; m < 4; ++m) _Pragma("unroll") for (int n = 0; n < 2; ++n) _Pragma("unroll") for (int k = 0; k < 2; ++k) \
        acc[ai][bj][m][n] = __builtin_amdgcn_mfma_f32_16x16x32_bf16(Bt[n][k], At[m][k], acc[ai][bj][m][n], 0, 0, 0); __builtin_amdgcn_s_setprio(0); } while (0)
#define PG8_WAIT_V(n) asm volatile("s_waitcnt vmcnt(" #n ")" ::: "memory")
#define PG8_WAIT_L(n) asm volatile("s_waitcnt lgkmcnt(" #n ")" ::: "memory")
#define PG8_BAR __builtin_amdgcn_s_barrier()
#define PG8_SCHED __builtin_amdgcn_sched_barrier(0)
    Unit cur, nxt; int ui = 0;
    if (!S.next(0, cur)) return;
    f32x4 acc[2][2][4][2];
#pragma unroll
    for (int a = 0; a < 2; ++a)
#pragma unroll
        for (int b = 0; b < 2; ++b)
#pragma unroll
            for (int m = 0; m < 4; ++m)
#pragma unroll
                for (int n = 0; n < 2; ++n) acc[a][b][m][n] = (f32x4){0.f, 0.f, 0.f, 0.f};
    bf16x8 At[4][2], B0[2][2], B1[2][2];
    const char* cA = (const char*)g.A + (size_t)cur.pm * tstepA; const char* cB = (const char*)g.Bt + (size_t)cur.pn * tstepB;
    S.a_ready(cur);
    if constexpr (SP2) {
        PG8_STAGE(PG8_SB(0, 0), cB, voffB); PG8_STAGE(PG8_SB(0, 1), cB + hstepB, voffB); PG8_STAGE(PG8_SA(0, 0), cA, voffA); PG8_STAGE(PG8_SA(0, 1), cA + hstepA, voffA);
        if (wr == 1) PG8_BAR;
        PG8_WAIT_V(2); PG8_BAR;
        PG8_STAGE(PG8_SB(1, 0), cB + kstep, voffB); PG8_STAGE(PG8_SA(1, 0), cA + kstep, voffA); PG8_STAGE(PG8_SB(1, 1), cB + hstepB + kstep, voffB);
        PG8_WAIT_V(6); PG8_BAR;
    } else {
        PG8_STAGE(PG8_SB(0, 0), cB, voffB); PG8_STAGE(PG8_SA(0, 0), cA, voffA); PG8_STAGE(PG8_SB(0, 1), cB + hstepB, voffB); PG8_STAGE(PG8_SA(0, 1), cA + hstepA, voffA);
        if (wr == 1) PG8_BAR;
        PG8_WAIT_V(4); PG8_BAR;
        PG8_STAGE(PG8_SB(1, 0), cB + kstep, voffB); PG8_STAGE(PG8_SA(1, 0), cA + kstep, voffA); PG8_STAGE(PG8_SB(1, 1), cB + hstepB + kstep, voffB);
        PG8_WAIT_V(6); PG8_BAR;
    }
    for (;;) {
        const bool has_next = S.next(ui + 1, nxt);
        const char* nA = has_next ? (const char*)g.A + (size_t)nxt.pm * tstepA : cA; const char* nB = has_next ? (const char*)g.Bt + (size_t)nxt.pn * tstepB : cB;
        for (int t = 0; t < nt; t += 2) {
            const bool last = (t == nt - 2);
            const char* a1 = cA + (size_t)(t + 1) * kstep;
            const char* a2 = last ? nA : cA + (size_t)(t + 2) * kstep; const char* b2 = last ? nB : cB + (size_t)(t + 2) * kstep;
            const char* a3 = a2 + kstep; const char* b3 = b2 + kstep;
            if (last && has_next) S.a_ready(nxt);
            if constexpr (SP2) {
            PG8_LDB(B0, 0, 0); PG8_LDB(B1, 0, 1); PG8_SCHED; PG8_LDA(At, 0, 0); PG8_STAGE(PG8_SA(1, 1), a1 + hstepA, voffA);
            PG8_WAIT_V(8); PG8_WAIT_L(0); PG8_BAR; PG8_MMA(0, 0, At, B0); PG8_MMA(0, 1, At, B1); PG8_BAR; PG8_SCHED;
            PG8_LDA(At, 0, 1); PG8_STAGE(PG8_SB(0, 0), b2, voffB); PG8_STAGE(PG8_SB(0, 1), b2 + hstepB, voffB); PG8_STAGE(PG8_SA(0, 0), a2, voffA);
            PG8_WAIT_V(8); PG8_WAIT_L(0); PG8_BAR; PG8_MMA(1, 0, At, B0); PG8_MMA(1, 1, At, B1); PG8_BAR; PG8_SCHED;
            PG8_LDB(B0, 1, 0); PG8_LDB(B1, 1, 1); PG8_SCHED; PG8_LDA(At, 1, 0); PG8_STAGE(PG8_SA(0, 1), a2 + hstepA, voffA);
            PG8_WAIT_V(8); PG8_WAIT_L(0); PG8_BAR; PG8_MMA(0, 0, At, B0); PG8_MMA(0, 1, At, B1); PG8_BAR; PG8_SCHED;
            PG8_LDA(At, 1, 1); PG8_STAGE(PG8_SB(1, 0), b3, voffB); PG8_STAGE(PG8_SB(1, 1), b3 + hstepB, voffB); PG8_STAGE(PG8_SA(1, 0), a3, voffA);
            PG8_WAIT_V(8); PG8_WAIT_L(0); PG8_BAR; PG8_MMA(1, 0, At, B0); PG8_MMA(1, 1, At, B1); PG8_BAR; PG8_SCHED;
            } else {
            PG8_LDB(B0, 0, 0); PG8_SCHED; PG8_LDA(At, 0, 0); PG8_STAGE(PG8_SA(1, 1), a1 + hstepA, voffA);
            PG8_WAIT_L(8); PG8_BAR; PG8_WAIT_L(0); PG8_MMA(0, 0, At, B0); PG8_BAR; PG8_SCHED;
            PG8_LDB(B1, 0, 1); PG8_STAGE(PG8_SB(0, 0), b2, voffB);
            PG8_BAR; PG8_WAIT_L(0); PG8_MMA(0, 1, At, B1); PG8_BAR;
            PG8_LDA(At, 0, 1); PG8_STAGE(PG8_SA(0, 0), a2, voffA);
            PG8_BAR; PG8_WAIT_L(0); PG8_MMA(1, 0, At, B0); PG8_BAR; PG8_SCHED;
            PG8_STAGE(PG8_SB(0, 1), b2 + hstepB, voffB);
            PG8_WAIT_V(6); PG8_BAR; PG8_MMA(1, 1, At, B1); PG8_BAR;
            PG8_LDB(B0, 1, 0); PG8_SCHED; PG8_LDA(At, 1, 0); PG8_STAGE(PG8_SA(0, 1), a2 + hstepA, voffA);
            PG8_WAIT_L(8); PG8_BAR; PG8_WAIT_L(0); PG8_MMA(0, 0, At, B0); PG8_BAR; PG8_SCHED;
            PG8_LDB(B1, 1, 1); PG8_STAGE(PG8_SB(1, 0), b3, voffB);
            PG8_BAR; PG8_WAIT_L(0); PG8_MMA(0, 1, At, B1); PG8_BAR;
            PG8_LDA(At, 1, 1); PG8_STAGE(PG8_SA(1, 0), a3, voffA);
            PG8_BAR; PG8_WAIT_L(0); PG8_MMA(1, 0, At, B0); PG8_BAR; PG8_SCHED;
            PG8_STAGE(PG8_SB(1, 1), b3 + hstepB, voffB);
            PG8_WAIT_V(6); PG8_BAR; PG8_MMA(1, 1, At, B1); PG8_BAR;
            }
        }
        if constexpr (ALIGN_EPI) { if (wr == 0) PG8_BAR; }
        if constexpr (!Epi::AFTER_DRAIN) { E(acc, cur, wr, wc, fr, fq); S.done(cur); }
        if (!has_next) break;
#pragma unroll
        for (int a = 0; a < 2; ++a)
#pragma unroll
            for (int b = 0; b < 2; ++b)
#pragma unroll
                for (int m = 0; m < 4; ++m)
#pragma unroll
                    for (int n = 0; n < 2; ++n) acc[a][b][m][n] = (f32x4){0.f, 0.f, 0.f, 0.f};
        cur = nxt; cA = nA; cB = nB; ++ui;
        if constexpr (ALIGN_EPI) { if (wr == 1) PG8_BAR; }
    }
    PG8_WAIT_V(0);
    if constexpr (!ALIGN_EPI) { if (wr == 0) PG8_BAR; }
    PG8_BAR;
    if constexpr (Epi::AFTER_DRAIN) { E.fused(acc, cur, wr, wc, fr, fq, lds, wid, lane); S.done(cur); }
#undef PG8_SA
#undef PG8_SB
#undef PG8_STAGE
#undef PG8_LDA
#undef PG8_LDB
#undef PG8_MMA
#undef PG8_WAIT_V
#undef PG8_WAIT_L
#undef PG8_BAR
#undef PG8_SCHED
}
}

#define DI __device__ __forceinline__
#define LAS __attribute__((address_space(3)))
typedef unsigned short bf16;
typedef short bf16x8 __attribute__((ext_vector_type(8)));
typedef short s16x4 __attribute__((ext_vector_type(4)));
typedef float f32x4 __attribute__((ext_vector_type(4)));
typedef unsigned u32x4 __attribute__((ext_vector_type(4)));
typedef unsigned u32x2 __attribute__((ext_vector_type(2)));
using pg8::Unit;

constexpr int NB = 4, T = 4096, D = 1024, M = NB * T, DFF = 2816, NMEM = 256, MROWS = NB * NMEM;
constexpr int NATT = 4608, NH2 = 4096;
constexpr float EPS = 1e-6f;
constexpr int LDS_BYTES = 147456;

constexpr size_t MiB = 1u << 20;
constexpr size_t W_GU1 = 0, W_DN1 = W_GU1 + (size_t)2 * DFF * D * 2, W_IN = W_DN1 + (size_t)D * DFF * 2, W_AB = W_IN + (size_t)10752 * D * 2,
                 W_HB = W_AB + (size_t)D * 512 * 2, W_MO = W_HB + (size_t)D * D * 2, W_Q = W_MO + (size_t)D * D * 2, W_KV = W_Q + (size_t)D * D * 2,
                 W_O = W_KV + (size_t)2 * D * D * 2, W_GU2 = W_O + (size_t)D * D * 2, W_DN2 = W_GU2 + (size_t)2 * DFF * D * 2, W_END = W_DN2 + (size_t)D * DFF * 2;
static_assert(W_END <= 68 * MiB, "weights");
constexpr size_t WS_XB = 68 * MiB, WS_Z = 100 * MiB, WS_OG = 244 * MiB, WS_AO = 292 * MiB, WS_COS = 308 * MiB, WS_SIN = 312 * MiB, WS_MEMN = 316 * MiB,
                 WS_MEMK = 320 * MiB, WS_MEMVT = 322 * MiB, WS_SSQ = 324 * MiB, WS_DEC = 325 * MiB, WS_LSE = 326 * MiB, WS_CTL = 327 * MiB, CTL_BYTES = 65536, WS_END = 327 * MiB + CTL_BYTES;

DI float bf2f(unsigned short h) { return __uint_as_float((unsigned)h << 16); }
typedef __bf16 bf2_t __attribute__((ext_vector_type(2)));
typedef float f32x2_t __attribute__((ext_vector_type(2)));
DI unsigned pk2(float lo, float hi) { const bf2_t r = __builtin_convertvector((f32x2_t){lo, hi}, bf2_t); return __builtin_bit_cast(unsigned, r); }
DI unsigned f2bf(float f) { return pk2(f, 0.f) & 0xffffu; }
template <int N> DI float rr_add(float v) { return v + __int_as_float(__builtin_amdgcn_update_dpp(0, __float_as_int(v), 0x120 + N, 0xf, 0xf, false)); }
DI float row16_sum(float v) { v = rr_add<1>(v); v = rr_add<2>(v); v = rr_add<4>(v); v = rr_add<8>(v); return v; }
#define LBAR() do { asm volatile("s_waitcnt lgkmcnt(0)" ::: "memory"); __builtin_amdgcn_s_barrier(); asm volatile("" ::: "memory"); } while (0)
DI float lo16(unsigned u) { return __uint_as_float(u << 16); }
DI float hi16(unsigned u) { return __uint_as_float(u & 0xffff0000u); }
DI float wave_sum(float v) {
#pragma unroll
    for (int o = 1; o < 64; o <<= 1) v += __shfl_xor(v, o);
    return v;
}
DI float sigmoidf_(float x) { return 1.0f / (1.0f + __expf(-x)); }
DI bf16x8 mk8(u32x4 v) { return __builtin_bit_cast(bf16x8, v); }
#define MFMA16(a, b, c) __builtin_amdgcn_mfma_f32_16x16x32_bf16((a), (b), (c), 0, 0, 0)

DI float row_rstd(const float* ssq, int row) {
    const f32x4* p = (const f32x4*)(ssq + (size_t)row * 16);
    const f32x4 a = p[0], b = p[1], c = p[2], d = p[3];
    const float s = ((a[0] + a[1]) + (a[2] + a[3])) + ((b[0] + b[1]) + (b[2] + b[3])) + ((c[0] + c[1]) + (c[2] + c[3])) + ((d[0] + d[1]) + (d[2] + d[3]));
    return 1.0f / sqrtf(s * (1.0f / D) + EPS);
}
struct EpiZ {
    static constexpr bool PERM = true, AFTER_DRAIN = false;
    bf16* O; int ldc; const float* ssq;
    DI void operator()(const f32x4 (&acc)[2][2][4][2], const Unit& u, int wr, int wc, int fr, int fq) const {
        const int row0 = u.pm * 256 + wr * 64 + fr, col0 = u.pn * 256 + wc * 32 + 8 * fq;
#pragma unroll
        for (int ai = 0; ai < 2; ++ai)
#pragma unroll
            for (int m = 0; m < 4; ++m) {
                const int row = row0 + ai * 128 + m * 16;
                const float rs = ssq ? row_rstd(ssq, row) : 1.0f;
                bf16* rowp = O + (size_t)row * ldc + col0;
#pragma unroll
                for (int bj = 0; bj < 2; ++bj) {
                    const f32x4 v0 = acc[ai][bj][m][0] * rs, v1 = acc[ai][bj][m][1] * rs;
                    u32x4 w; w.x = pk2(v0[0], v0[1]); w.y = pk2(v0[2], v0[3]); w.z = pk2(v1[0], v1[1]); w.w = pk2(v1[2], v1[3]);
                    *(u32x4*)(rowp + bj * 128) = w;
                }
            }
    }
};
struct EpiSwiglu {
    static constexpr bool PERM = true, AFTER_DRAIN = false;
    bf16* H; const float* ssq;
    DI void operator()(const f32x4 (&acc)[2][2][4][2], const Unit& u, int wr, int wc, int fr, int fq) const {
        const int row0 = u.pm * 256 + wr * 64 + fr, col0 = u.pn * 128 + wc * 32 + 8 * fq;
#pragma unroll
        for (int ai = 0; ai < 2; ++ai)
#pragma unroll
            for (int m = 0; m < 4; ++m) {
                const int row = row0 + ai * 128 + m * 16;
                const float rs = row_rstd(ssq, row);
                float h[8];
#pragma unroll
                for (int n = 0; n < 2; ++n)
#pragma unroll
                    for (int e = 0; e < 4; ++e) { const float g = acc[ai][0][m][n][e] * rs, up = acc[ai][1][m][n][e] * rs; h[4 * n + e] = g * sigmoidf_(g) * up; }
                u32x4 w; w.x = pk2(h[0], h[1]); w.y = pk2(h[2], h[3]); w.z = pk2(h[4], h[5]); w.w = pk2(h[6], h[7]);
                *(u32x4*)(H + (size_t)row * DFF + col0) = w;
            }
    }
};
struct EpiResid {
    static constexpr bool PERM = false, AFTER_DRAIN = false;
    const float* xin; float* xout; bf16* Xb; float* ssq; float alpha;
    DI void operator()(const f32x4 (&acc)[2][2][4][2], const Unit& u, int wr, int wc, int fr, int fq) const {
        const int row0 = u.pm * 256 + wr * 64 + fr, col0 = u.pn * 256 + wc * 32 + 4 * fq;
#pragma unroll
        for (int ai = 0; ai < 2; ++ai)
#pragma unroll
            for (int m = 0; m < 4; ++m) {
                const int row = row0 + ai * 128 + m * 16; float ss = 0.f;
#pragma unroll
                for (int bj = 0; bj < 2; ++bj)
#pragma unroll
                    for (int n = 0; n < 2; ++n) {
                        const size_t off = (size_t)row * D + col0 + bj * 128 + n * 16;
                        const f32x4 x = *(const f32x4*)(xin + off) + acc[ai][bj][m][n] * alpha;
                        *(f32x4*)(xout + off) = x;
                        u32x2 w; w.x = pk2(x[0], x[1]); w.y = pk2(x[2], x[3]); *(u32x2*)(Xb + off) = w;
                        ss += (x[0] * x[0] + x[1] * x[1]) + (x[2] * x[2] + x[3] * x[3]);
                    }
                ss += __shfl_xor(ss, 16); ss += __shfl_xor(ss, 32);
                if (fq == 0) ssq[(size_t)row * 16 + u.pn * 4 + wc] = ss;
            }
    }
};
template <bool ADD> struct EpiGate {
    static constexpr bool PERM = true, AFTER_DRAIN = false;
    const bf16* Gt; int ldg; bf16* Mg; int ldm;
    DI void operator()(const f32x4 (&acc)[2][2][4][2], const Unit& u, int wr, int wc, int fr, int fq) const {
        const int row0 = u.pm * 256 + wr * 64 + fr, col0 = u.pn * 256 + wc * 32 + 8 * fq;
#pragma unroll
        for (int ai = 0; ai < 2; ++ai)
#pragma unroll
            for (int m = 0; m < 4; ++m) {
                const int row = row0 + ai * 128 + m * 16;
#pragma unroll
                for (int bj = 0; bj < 2; ++bj) {
                    const u32x4 gv = *(const u32x4*)(Gt + (size_t)row * ldg + col0 + bj * 128);
                    bf16* mp = Mg + (size_t)row * ldm + col0 + bj * 128;
                    u32x4 pv = (u32x4){0u, 0u, 0u, 0u}; if (ADD) pv = *(const u32x4*)mp;
                    float r[8];
#pragma unroll
                    for (int q = 0; q < 4; ++q) {
                        const float a0 = acc[ai][bj][m][q >> 1][(q & 1) * 2], a1 = acc[ai][bj][m][q >> 1][(q & 1) * 2 + 1];
                        r[2 * q] = sigmoidf_(lo16(gv[q])) * a0 + (ADD ? lo16(pv[q]) : 0.f);
                        r[2 * q + 1] = sigmoidf_(hi16(gv[q])) * a1 + (ADD ? hi16(pv[q]) : 0.f);
                    }
                    u32x4 w; w.x = pk2(r[0], r[1]); w.y = pk2(r[2], r[3]); w.z = pk2(r[4], r[5]); w.w = pk2(r[6], r[7]);
                    *(u32x4*)mp = w;
                }
            }
    }
};

template <class Epi>
DI void run_gemm(LAS unsigned char* lds, const bf16* A, int lda, const bf16* Bt, int ldb, int Mr, int N, int K, int G, int c, const Epi& E) {
    pg8::Gemm g{A, Bt, Mr, N, K, lda, ldb}; pg8::StaticOrder S; S.init(Mr, N, G, c);
    pg8::gemm_phase<Epi, pg8::StaticOrder, true, true>(lds, g, S, E);
}

DI void conv_item(const float* W, int K, int Nsrc, int Nout, bool GU, const float* gain, bf16* WT, LAS float* scr, int item, int lane) {
    const int nblk = Nout / 32, kb = item / nblk, nb = item % nblk, k0 = 64 * kb, n0 = 32 * nb;
    const int src0 = GU ? (((n0 & 255) >> 7) * DFF + 128 * (n0 >> 8) + (n0 & 127)) : n0;
#pragma unroll 8
    for (int i = 0; i < 32; ++i) { const int kk = 2 * i + (lane >> 5); const float g = gain ? gain[k0 + kk] : 1.0f;
        scr[kk * 33 + (lane & 31)] = W[(size_t)(k0 + kk) * Nsrc + src0 + (lane & 31)] * g; }
    asm volatile("s_waitcnt lgkmcnt(0)" ::: "memory");
    const int c = lane & 7;
#pragma unroll
    for (int j = 0; j < 4; ++j) { const int n = (lane >> 3) + 8 * j; const LAS float* s = scr + (8 * c) * 33 + n;
        u32x4 o; o.x = pk2(s[0 * 33], s[1 * 33]); o.y = pk2(s[2 * 33], s[3 * 33]); o.z = pk2(s[4 * 33], s[5 * 33]); o.w = pk2(s[6 * 33], s[7 * 33]);
        *(u32x4*)(WT + (size_t)(n0 + n) * K + k0 + 8 * c) = o; }
    asm volatile("s_waitcnt lgkmcnt(0)" ::: "memory");
}

struct Args { const void* in[22]; float* out; unsigned char* ws; };

DI void conv_weights(const Args& a, int l, LAS unsigned char* L, int gw, int NGW, int wave, int lane) {
    LAS float* scr = (LAS float*)(L + wave * 16384);
    unsigned char* ws = a.ws;
    int it = gw;
#define CONV(idx, K_, Ns_, No_, GU_, gidx, dst_) { const float* Wp = (const float*)a.in[idx] + (size_t)l * (K_) * (Ns_); const float* gp = (gidx) >= 0 ? (const float*)a.in[(gidx) >= 0 ? (gidx) : 0] + (size_t)l * (K_) : nullptr; \
        const int nitems = ((K_) / 64) * ((No_) / 32); for (; it < nitems; it += NGW) conv_item(Wp, K_, Ns_, No_, GU_, gp, (bf16*)(ws + (dst_)), scr, it, lane); it -= nitems; }
    CONV(4, D, 2 * DFF, 2 * DFF, true, 3, W_GU1)
    CONV(5, DFF, D, D, false, -1, W_DN1)
    CONV(7, D, 10752, 10752, false, 6, W_IN)
    CONV(10, 512, D, D, false, -1, W_AB)
    CONV(11, D, D, D, false, -1, W_HB)
    CONV(12, D, D, D, false, -1, W_MO)
    CONV(15, D, D, D, false, 13, W_Q)
    CONV(16, D, 2 * D, 2 * D, false, -1, W_KV)
    CONV(17, D, D, D, false, -1, W_O)
    CONV(19, D, 2 * DFF, 2 * DFF, true, 18, W_GU2)
    CONV(20, DFF, D, D, false, -1, W_DN2)
#undef CONV
}

DI void prologue_misc(const Args& a, int gw, int NGW, int lane, int gtid, int NGT) {
    unsigned char* ws = a.ws;
    const float* x = (const float*)a.in[0];
    bf16* Xb = (bf16*)(ws + WS_XB); float* ssq = (float*)(ws + WS_SSQ);
    for (int m = gw; m < M; m += NGW) {
        const f32x4* xr = (const f32x4*)(x + (size_t)m * D) + lane; float s = 0.f;
        unsigned long long* o8 = (unsigned long long*)(Xb + (size_t)m * D) + lane;
#pragma unroll
        for (int j = 0; j < 4; ++j) { const f32x4 v = xr[64 * j]; s += (v[0] * v[0] + v[1] * v[1]) + (v[2] * v[2] + v[3] * v[3]);
            o8[64 * j] = (unsigned long long)pk2(v[0], v[1]) | ((unsigned long long)pk2(v[2], v[3]) << 32); }
        s = wave_sum(s);
        if (lane < 16) ssq[(size_t)m * 16 + lane] = lane == 0 ? s : 0.f;
    }
    const float* mem = (const float*)a.in[1]; const float* mnorm = (const float*)a.in[14]; bf16* memN = (bf16*)(ws + WS_MEMN);
    for (int r = gw; r < 2 * MROWS; r += NGW) {
        const int l = r / MROWS, m = r % MROWS;
        const f32x4* xr = (const f32x4*)(mem + (size_t)m * D) + lane; const f32x4* gr = (const f32x4*)(mnorm + (size_t)l * D) + lane;
        f32x4 v[4]; float s = 0.f;
#pragma unroll
        for (int j = 0; j < 4; ++j) { v[j] = xr[64 * j]; s += (v[j][0] * v[j][0] + v[j][1] * v[j][1]) + (v[j][2] * v[j][2] + v[j][3] * v[j][3]); }
        const float rs = 1.0f / sqrtf(wave_sum(s) * (1.0f / D) + EPS);
        unsigned long long* o8 = (unsigned long long*)(memN + (size_t)r * D) + lane;
#pragma unroll
        for (int j = 0; j < 4; ++j) { const f32x4 g = gr[64 * j]; const f32x4 y = v[j] * rs * g;
            o8[64 * j] = (unsigned long long)pk2(y[0], y[1]) | ((unsigned long long)pk2(y[2], y[3]) << 32); }
    }
    const int* pos = (const int*)a.in[2]; float* cosT = (float*)(ws + WS_COS); float* sinT = (float*)(ws + WS_SIN);
    for (int idx = gtid; idx < M * 64; idx += NGT) {
        const int row = idx >> 6, i = idx & 63;
        const float inv = exp2f(-(float)(2 * i) * (1.0f / 128.0f) * 13.287712379549449f);
        const float ang = (float)pos[row] * inv;
        double rv = (double)ang * 0.15915494309189535; rv -= floor(rv);
        const float fr = (float)rv;
        cosT[idx] = __builtin_amdgcn_cosf(fr); sinT[idx] = __builtin_amdgcn_sinf(fr);
    }
}

DI void rope8(u32x4 x1, u32x4 x2, const float* cp, const float* sp, u32x4& o1, u32x4& o2) {
    const f32x4 c0 = *(const f32x4*)cp, c1 = *(const f32x4*)(cp + 4), s0 = *(const f32x4*)sp, s1 = *(const f32x4*)(sp + 4);
#pragma unroll
    for (int q = 0; q < 4; ++q) {
        const float ca = q < 2 ? c0[2 * q] : c1[2 * q - 4], cb = q < 2 ? c0[2 * q + 1] : c1[2 * q - 3];
        const float sa = q < 2 ? s0[2 * q] : s1[2 * q - 4], sb = q < 2 ? s0[2 * q + 1] : s1[2 * q - 3];
        const float a0 = lo16(x1[q]), a1 = hi16(x1[q]), b0 = lo16(x2[q]), b1 = hi16(x2[q]);
        o1[q] = pk2(a0 * ca - b0 * sa, a1 * cb - b1 * sb);
        o2[q] = pk2(b0 * ca + a0 * sa, b1 * cb + a1 * sb);
    }
}
constexpr int KSTR = 272, VSTR = 528, KL_BYTES = 256 * KSTR;
DI unsigned vt_off(int dh, int kgrp) { return (unsigned)(dh * VSTR + ((kgrp ^ ((dh >> 3) & 7)) << 3)); }

DI void dil_attn_phase(LAS unsigned char* L, const bf16* Z, const float* cosT, const float* sinT, bf16* OG, float* LSE, int G, int bid, int tid) {
    const int wid = __builtin_amdgcn_readfirstlane(tid >> 6), lane = tid & 63, fr = lane & 15, fq = lane >> 4;
    LAS unsigned char* KL = L; LAS unsigned char* VL = L + KL_BYTES;
    for (int unit = bid; unit < 1536; unit += G) {
        const int j = unit & 31, h = (unit >> 5) & 3, gb = unit >> 7, g = gb % 3, b = gb / 3;
        const int dsh = 2 * g, Lseg = T >> dsh;
        const int p0 = 128 * j, r = p0 / Lseg, u0 = p0 & (Lseg - 1);
        const int tokbase = b * T + r;
        const int colq = g * 512 + h * 128, colk = 1536 + colq, colv = 3072 + colq;
        __syncthreads();
#pragma unroll
        for (int i = 0; i < 4; ++i) {
            const int p = tid + 512 * i, kk = p >> 3, pc = p & 7, uu = u0 - 128 + kk;
            u32x4 o1 = (u32x4){0u, 0u, 0u, 0u}, o2 = o1;
            if (uu >= 0) { const size_t tok = (size_t)(tokbase + (uu << dsh)); const bf16* kp = Z + tok * NATT + colk + 8 * pc;
                rope8(*(const u32x4*)kp, *(const u32x4*)(kp + 64), cosT + tok * 64 + 8 * pc, sinT + tok * 64 + 8 * pc, o1, o2); }
            *(LAS u32x4*)(KL + kk * KSTR + 16 * pc) = o1; *(LAS u32x4*)(KL + kk * KSTR + 128 + 16 * pc) = o2;
        }
#pragma unroll
        for (int i = 0; i < 8; ++i) {
            const int p = tid + 512 * i, kk = p >> 4, cb = p & 15, uu = u0 - 128 + kk;
            u32x4 x = (u32x4){0u, 0u, 0u, 0u};
            if (uu >= 0) x = *(const u32x4*)(Z + (size_t)(tokbase + (uu << dsh)) * NATT + colv + 8 * cb);
            const unsigned base = (unsigned)((((kk >> 2) ^ (cb & 7)) << 3) + (kk & 3) * 2);
#pragma unroll
            for (int jj = 0; jj < 8; ++jj) *(LAS unsigned short*)(VL + (8 * cb + jj) * VSTR + base) = (unsigned short)(x[jj >> 1] >> (16 * (jj & 1)));
        }
        const int qi = 16 * wid + fr; const size_t tq = (size_t)(tokbase + ((u0 + qi) << dsh));
        bf16x8 qf[4];
#pragma unroll
        for (int k2 = 0; k2 < 2; ++k2) { const int i0 = 32 * k2 + 8 * fq; const bf16* qp = Z + tq * NATT + colq + i0; u32x4 o1, o2;
            rope8(*(const u32x4*)qp, *(const u32x4*)(qp + 64), cosT + tq * 64 + i0, sinT + tq * 64 + i0, o1, o2); qf[k2] = mk8(o1); qf[k2 + 2] = mk8(o2); }
        __syncthreads();
        const int tw = wid & ~1;
        f32x4 s[10];
#pragma unroll
        for (int tix = 0; tix < 10; ++tix) { s[tix] = (f32x4){0.f, 0.f, 0.f, 0.f}; const int kt = tw + tix;
#pragma unroll
            for (int k4 = 0; k4 < 4; ++k4) { const bf16x8 av = *(const LAS bf16x8*)(KL + (16 * kt + fr) * KSTR + (32 * k4 + 8 * fq) * 2); s[tix] = MFMA16(av, qf[k4], s[tix]); } }
        const float scale = 0.08838834764831845f; float mx = -INFINITY;
#pragma unroll
        for (int tix = 0; tix < 10; ++tix)
#pragma unroll
            for (int e = 0; e < 4; ++e) { const int kk = 16 * (tw + tix) + 4 * fq + e; const bool ok = (kk >= qi) && (kk <= qi + 128) && (u0 - 128 + kk >= 0);
                const float v = ok ? s[tix][e] * scale : -INFINITY; s[tix][e] = v; mx = fmaxf(mx, v); }
        mx = fmaxf(mx, __shfl_xor(mx, 16)); mx = fmaxf(mx, __shfl_xor(mx, 32));
        float den = 0.f;
#pragma unroll
        for (int tix = 0; tix < 10; ++tix)
#pragma unroll
            for (int e = 0; e < 4; ++e) { const float p = __expf(s[tix][e] - mx); s[tix][e] = p; den += p; }
        den += __shfl_xor(den, 16); den += __shfl_xor(den, 32);
        bf16x8 pf[5];
#pragma unroll
        for (int pp = 0; pp < 5; ++pp) { u32x4 pw; pw.x = pk2(s[2 * pp][0], s[2 * pp][1]); pw.y = pk2(s[2 * pp][2], s[2 * pp][3]); pw.z = pk2(s[2 * pp + 1][0], s[2 * pp + 1][1]); pw.w = pk2(s[2 * pp + 1][2], s[2 * pp + 1][3]); pf[pp] = mk8(pw); }
        f32x4 o[8];
#pragma unroll
        for (int dt = 0; dt < 8; ++dt) { o[dt] = (f32x4){0.f, 0.f, 0.f, 0.f};
            const int dh = 16 * dt + fr, sw = (2 * dt + (fr >> 3)) & 7;
            const LAS unsigned char* va = VL + dh * VSTR + 32 * tw + ((fq ^ sw) << 3); const LAS unsigned char* vb2 = VL + dh * VSTR + 32 * tw + (((fq + 4) ^ sw) << 3);
#pragma unroll
            for (int pp = 0; pp < 5; ++pp) { const s16x4 lo = *(const LAS s16x4*)(va + 64 * pp), hi = *(const LAS s16x4*)(vb2 + 64 * pp);
                const bf16x8 vb = __builtin_shufflevector(lo, hi, 0, 1, 2, 3, 4, 5, 6, 7); o[dt] = MFMA16(pf[pp], vb, o[dt]); }
        }
        const float inv = 1.0f / den, lse = mx + __logf(den);
#pragma unroll
        for (int e = 0; e < 4; ++e) { const float iq = __shfl(inv, 4 * fq + e);
            bf16* op = OG + (size_t)(tokbase + ((u0 + 16 * wid + 4 * fq + e) << dsh)) * 1536 + colq + fr;
#pragma unroll
            for (int dt = 0; dt < 8; ++dt) op[16 * dt] = (bf16)f2bf(o[dt][e] * iq); }
        if (lane < 16) LSE[tq * 12 + g * 4 + h] = lse;
    }
}

DI void merge_phase(const bf16* OG, const float* LSE, bf16* AO, int gtid, int NGT) {
    for (int idx = gtid; idx < M * 64; idx += NGT) {
        const int tok = idx >> 6, h = (idx >> 4) & 3, c = idx & 15;
        const float l0 = LSE[(size_t)tok * 12 + h], l1 = LSE[(size_t)tok * 12 + 4 + h], l2 = LSE[(size_t)tok * 12 + 8 + h];
        const float mx = fmaxf(l0, fmaxf(l1, l2)); float w0 = __expf(l0 - mx), w1 = __expf(l1 - mx), w2 = __expf(l2 - mx); const float inv = 1.0f / (w0 + w1 + w2); w0 *= inv; w1 *= inv; w2 *= inv;
        const bf16* p = OG + (size_t)tok * 1536 + h * 128 + 8 * c;
        const u32x4 a = *(const u32x4*)p, b = *(const u32x4*)(p + 512), d = *(const u32x4*)(p + 1024); u32x4 o;
#pragma unroll
        for (int q = 0; q < 4; ++q) o[q] = pk2(w0 * lo16(a[q]) + w1 * lo16(b[q]) + w2 * lo16(d[q]), w0 * hi16(a[q]) + w1 * hi16(b[q]) + w2 * hi16(d[q]));
        *(u32x4*)(AO + (size_t)tok * 512 + h * 128 + 8 * c) = o;
    }
}

DI void xattn_stage_vt(LAS unsigned char* VL, const bf16* memVT, int b, int h, int hh, int tid) {
#pragma unroll
    for (int i = 0; i < 8; ++i) { const int p = tid + 512 * i, dhr = p >> 5, c = p & 31;
        const u32x4 x = *(const u32x4*)(memVT + (size_t)(h * 256 + 128 * hh + dhr) * MROWS + b * NMEM + 8 * c);
        u32x2 lo, hi; lo.x = x.x; lo.y = x.y; hi.x = x.z; hi.y = x.w;
        *(LAS u32x2*)(VL + vt_off(dhr, 2 * c)) = lo; *(LAS u32x2*)(VL + vt_off(dhr, 2 * c + 1)) = hi; }
}
DI void xattn_phase(LAS unsigned char* L, const bf16* Qx, const bf16* memK, const bf16* memVT, bf16* Ox, int G, int bid, int tid) {
    const int wid = __builtin_amdgcn_readfirstlane(tid >> 6), lane = tid & 63, fr = lane & 15, fq = lane >> 4;
    LAS unsigned char* KL = L; LAS unsigned char* VL = L + KL_BYTES;
    for (int unit = bid; unit < 512; unit += G) {
        const int j = unit & 31, h = (unit >> 5) & 3, b = unit >> 7;
        const int tok0 = b * T + 128 * j; const size_t tq = (size_t)(tok0 + 16 * wid + fr);
        bf16x8 qf[8];
#pragma unroll
        for (int k = 0; k < 8; ++k) qf[k] = *(const bf16x8*)(Qx + tq * D + h * 256 + 32 * k + 8 * fq);
        f32x4 s[16];
#pragma unroll
        for (int kt = 0; kt < 16; ++kt) s[kt] = (f32x4){0.f, 0.f, 0.f, 0.f};
#pragma unroll
        for (int hh = 0; hh < 2; ++hh) {
            __syncthreads();
#pragma unroll
            for (int i = 0; i < 8; ++i) { const int p = tid + 512 * i, m = p >> 4, cb = p & 15;
                *(LAS u32x4*)(KL + m * KSTR + 16 * cb) = *(const u32x4*)(memK + (size_t)(b * NMEM + m) * D + h * 256 + 128 * hh + 8 * cb); }
            if (hh == 0) xattn_stage_vt(VL, memVT, b, h, 0, tid);
            __syncthreads();
#pragma unroll
            for (int kt = 0; kt < 16; ++kt)
#pragma unroll
                for (int k4 = 0; k4 < 4; ++k4) { const bf16x8 av = *(const LAS bf16x8*)(KL + (16 * kt + fr) * KSTR + (32 * k4 + 8 * fq) * 2); s[kt] = MFMA16(av, qf[4 * hh + k4], s[kt]); }
        }
        float mx = -INFINITY;
#pragma unroll
        for (int kt = 0; kt < 16; ++kt)
#pragma unroll
            for (int e = 0; e < 4; ++e) { const float v = s[kt][e] * 0.0625f; s[kt][e] = v; mx = fmaxf(mx, v); }
        mx = fmaxf(mx, __shfl_xor(mx, 16)); mx = fmaxf(mx, __shfl_xor(mx, 32));
        float den = 0.f;
#pragma unroll
        for (int kt = 0; kt < 16; ++kt)
#pragma unroll
            for (int e = 0; e < 4; ++e) { const float p = __expf(s[kt][e] - mx); s[kt][e] = p; den += p; }
        den += __shfl_xor(den, 16); den += __shfl_xor(den, 32);
        bf16x8 pf[8];
#pragma unroll
        for (int pp = 0; pp < 8; ++pp) { u32x4 pw; pw.x = pk2(s[2 * pp][0], s[2 * pp][1]); pw.y = pk2(s[2 * pp][2], s[2 * pp][3]); pw.z = pk2(s[2 * pp + 1][0], s[2 * pp + 1][1]); pw.w = pk2(s[2 * pp + 1][2], s[2 * pp + 1][3]); pf[pp] = mk8(pw); }
        const float inv = 1.0f / den; float iq[4];
#pragma unroll
        for (int e = 0; e < 4; ++e) iq[e] = __shfl(inv, 4 * fq + e);
#pragma unroll
        for (int hh = 0; hh < 2; ++hh) {
            if (hh == 1) { __syncthreads(); xattn_stage_vt(VL, memVT, b, h, 1, tid); __syncthreads(); }
            f32x4 o[8];
#pragma unroll
            for (int dt = 0; dt < 8; ++dt) { o[dt] = (f32x4){0.f, 0.f, 0.f, 0.f};
                const int dh = 16 * dt + fr, sw = (2 * dt + (fr >> 3)) & 7;
                const LAS unsigned char* va = VL + dh * VSTR + ((fq ^ sw) << 3); const LAS unsigned char* vb2 = VL + dh * VSTR + (((fq + 4) ^ sw) << 3);
#pragma unroll
                for (int pp = 0; pp < 8; ++pp) { const s16x4 lo = *(const LAS s16x4*)(va + 64 * pp), hi = *(const LAS s16x4*)(vb2 + 64 * pp);
                    const bf16x8 vb = __builtin_shufflevector(lo, hi, 0, 1, 2, 3, 4, 5, 6, 7); o[dt] = MFMA16(pf[pp], vb, o[dt]); }
            }
#pragma unroll
            for (int e = 0; e < 4; ++e) { bf16* op = Ox + (size_t)(tok0 + 16 * wid + 4 * fq + e) * D + h * 256 + 128 * hh + fr;
#pragma unroll
                for (int dt = 0; dt < 8; ++dt) op[16 * dt] = (bf16)f2bf(o[dt][e] * iq[e]); }
        }
    }
}

constexpr int H1_QA = 0, H1_KA = 64 * 272, H1_VT = 2 * 64 * 272, H1_TOT = H1_VT + 128 * 144;
template <bool DRY> DI void hgrn1_phase(LAS unsigned char* L, bf16* Z2, const float* lbraw, int layer, float* DEC, unsigned long long* OI, int G, int bid, int tid) {
    const int wid = __builtin_amdgcn_readfirstlane(tid >> 6), lane = tid & 63, fr = lane & 15, fq = lane >> 4;
    const int n = tid & 127, rg = tid >> 7, tt = wid & 3, vh = wid >> 2;
    LAS float* TOT = (LAS float*)(L + H1_TOT);
    for (int unit = bid; unit < 2048; unit += G) {
        const int c = unit & 63, h = (unit >> 6) & 7, b = unit >> 9, tok0 = b * T + 64 * c, ch = h * 128 + n;
        float lbv = 0.f;
        if (layer > 0) { const float e0 = lbraw[ch], e1 = lbraw[D + ch]; lbv = 1.0f / (1.0f + expf(e0 - e1)); }
        float q[16], cs[16], kg[16]; unsigned short vr[16];
        bf16* base = Z2 + (size_t)(tok0 + 16 * rg) * NH2 + ch;
#pragma unroll
        for (int r = 0; r < 16; ++r) { const bf16* p = base + (size_t)r * NH2; q[r] = bf2f(p[0]); cs[r] = bf2f(p[1024]); vr[r] = p[2048]; }
        float run = 0.f;
#pragma unroll
        for (int r = 0; r < 16; ++r) { const float fl = cs[r]; const float sg = __builtin_amdgcn_rcpf(1.0f + __expf(-fl)); const float f = lbv + (1.0f - lbv) * sg;
            kg[r] = (1.0f - lbv) * (1.0f - sg); run += __logf(f); cs[r] = run; }
        asm volatile("s_waitcnt vmcnt(0)" ::: "memory");
        TOT[rg * 128 + n] = run;
        __syncthreads();
        const float t0 = TOT[n], t1 = TOT[128 + n], t2 = TOT[256 + n], t3 = TOT[384 + n];
        const float off = rg == 0 ? 0.f : (rg == 1 ? t0 : (rg == 2 ? t0 + t1 : t0 + t1 + t2));
        const float bmid = t0 + t1, blast = (t0 + t1) + (t2 + t3);
        const float qscale = 0.08838834764831845f;
        float kh[16];
#pragma unroll
        for (int r = 0; r < 16; ++r) { const float bt = off + cs[r]; const float qs = q[r] * qscale; const int row = 16 * rg + r;
            if (!DRY) base[(size_t)r * NH2] = (bf16)f2bf(qs * __expf(bt));
            *(LAS unsigned short*)(L + H1_QA + row * 272 + n * 2) = (unsigned short)f2bf(qs * __expf(bt - bmid));
            *(LAS unsigned short*)(L + H1_KA + row * 272 + n * 2) = (unsigned short)f2bf(kg[r] * __expf(bmid - bt));
            kh[r] = kg[r] * __expf(blast - bt); }
        u32x4 k0, k1, v0, v1;
#pragma unroll
        for (int qd = 0; qd < 4; ++qd) { k0[qd] = pk2(kh[2 * qd], kh[2 * qd + 1]); k1[qd] = pk2(kh[8 + 2 * qd], kh[9 + 2 * qd]);
            v0[qd] = (unsigned)vr[2 * qd] | ((unsigned)vr[2 * qd + 1] << 16); v1[qd] = (unsigned)vr[8 + 2 * qd] | ((unsigned)vr[9 + 2 * qd] << 16); }
        bf16* slot = Z2 + (size_t)(tok0 + (n >> 1)) * NH2 + h * 128 + (n & 1) * 64 + 16 * rg;
        if (!DRY) { *(u32x4*)(slot + 1024) = k0; *(u32x4*)(slot + 1024 + 8) = k1;
        *(u32x4*)(slot + 2048) = v0; *(u32x4*)(slot + 2048 + 8) = v1; }
        *(LAS u32x4*)(L + H1_VT + n * 144 + 32 * rg) = v0; *(LAS u32x4*)(L + H1_VT + n * 144 + 32 * rg + 16) = v1;
        if (!DRY && rg == 0) DEC[(size_t)unit * 128 + n] = __expf(blast);
        __syncthreads();
        bf16x8 bq[4];
#pragma unroll
        for (int k4 = 0; k4 < 4; ++k4) bq[k4] = *(const LAS bf16x8*)(L + H1_QA + (16 * tt + fr) * 272 + (32 * k4 + 8 * fq) * 2);
        f32x4 at[4];
#pragma unroll
        for (int st = 0; st < 4; ++st) { at[st] = (f32x4){0.f, 0.f, 0.f, 0.f};
            if (st <= tt) {
#pragma unroll
                for (int k4 = 0; k4 < 4; ++k4) { const bf16x8 av = *(const LAS bf16x8*)(L + H1_KA + (16 * st + fr) * 272 + (32 * k4 + 8 * fq) * 2); at[st] = MFMA16(av, bq[k4], at[st]); }
                if (st == tt) {
#pragma unroll
                    for (int e = 0; e < 4; ++e) if (4 * fq + e > fr) at[st][e] = 0.f; }
            } }
        bf16x8 pf[2];
#pragma unroll
        for (int pp = 0; pp < 2; ++pp) { u32x4 pw; pw.x = pk2(at[2 * pp][0], at[2 * pp][1]); pw.y = pk2(at[2 * pp][2], at[2 * pp][3]); pw.z = pk2(at[2 * pp + 1][0], at[2 * pp + 1][1]); pw.w = pk2(at[2 * pp + 1][2], at[2 * pp + 1][3]); pf[pp] = mk8(pw); }
#pragma unroll
        for (int vi = 0; vi < 4; ++vi) { const int vt = 4 * vh + vi; f32x4 o = (f32x4){0.f, 0.f, 0.f, 0.f};
#pragma unroll
            for (int pp = 0; pp < 2; ++pp) { const LAS unsigned char* vp = L + H1_VT + (16 * vt + fr) * 144 + (32 * pp + 4 * fq) * 2;
                const s16x4 lo = *(const LAS s16x4*)vp, hi = *(const LAS s16x4*)(vp + 32);
                const bf16x8 vb = __builtin_shufflevector(lo, hi, 0, 1, 2, 3, 4, 5, 6, 7); o = MFMA16(vb, pf[pp], o); }
            if (!DRY) OI[((size_t)(unit * 4 + tt) * 8 + vt) * 64 + lane] = (unsigned long long)pk2(o[0], o[1]) | ((unsigned long long)pk2(o[2], o[3]) << 32);
            }
    }
}

constexpr int H2_BUF = 36352, H2_KHT = 17408, H2_DEC = 35840;
template <bool DRY> DI void hgrn2_phase(LAS unsigned char* L, bf16* Z2, const float* DEC, const unsigned long long* OI, int bh, int tid) {
    const int w = __builtin_amdgcn_readfirstlane(tid >> 6), lane = tid & 63, fr = lane & 15, fq = lane >> 4;
    const int b = bh >> 3, h = bh & 7, unit0 = bh * 64, vcol = 16 * w + fr;
    u32x4 sq[2], sk[2]; f32x4 sd = (f32x4){0.f, 0.f, 0.f, 0.f};
#define H2_LOAD(cc) do { const int tok0_ = b * T + 64 * (cc); _Pragma("unroll") for (int i = 0; i < 2; ++i) { const int p = tid + 512 * i, row = p >> 4, cb = p & 15; \
        const bf16* rp = Z2 + (size_t)(tok0_ + row) * NH2 + h * 128 + 8 * cb; sq[i] = *(const u32x4*)rp; sk[i] = *(const u32x4*)(rp + 1024); } \
        if (tid < 32) sd = *(const f32x4*)(DEC + (size_t)(unit0 + (cc)) * 128 + 4 * tid); } while (0)
#define H2_WRITE(bi) do { LAS unsigned char* B_ = L + (bi) * H2_BUF; _Pragma("unroll") for (int i = 0; i < 2; ++i) { const int p = tid + 512 * i, row = p >> 4, cb = p & 15; \
        *(LAS u32x4*)(B_ + row * 272 + 16 * cb) = sq[i]; *(LAS u32x4*)(B_ + H2_KHT + (2 * row + (cb >> 3)) * 144 + 16 * (cb & 7)) = sk[i]; } \
        if (tid < 32) *(LAS f32x4*)(B_ + H2_DEC + 16 * tid) = sd; } while (0)
#define H2_PRIV(cc, VT_, OI_) do { const int tok0_ = b * T + 64 * (cc); \
        const bf16* vp_ = Z2 + (size_t)(tok0_ + (vcol >> 1)) * NH2 + 2048 + h * 128 + (vcol & 1) * 64 + 8 * fq; VT_[0] = *(const u32x4*)vp_; VT_[1] = *(const u32x4*)(vp_ + 32); \
        _Pragma("unroll") for (int tt_ = 0; tt_ < 4; ++tt_) OI_[tt_] = OI[((size_t)((unit0 + (cc)) * 4 + tt_) * 8 + w) * 64 + lane]; } while (0)
    u32x4 vtf[2]; unsigned long long oi[4];
    H2_LOAD(0); H2_WRITE(0); H2_PRIV(0, vtf, oi);
    f32x4 S[8];
#pragma unroll
    for (int nt = 0; nt < 8; ++nt) S[nt] = (f32x4){0.f, 0.f, 0.f, 0.f};
    __syncthreads();
    for (int c = 0; c < 64; ++c) {
        LAS unsigned char* Bc = L + (c & 1) * H2_BUF;
        asm volatile("" : "+v"(vtf[0]), "+v"(vtf[1]), "+v"(oi[0]), "+v"(oi[1]), "+v"(oi[2]), "+v"(oi[3]));
        u32x4 nvt[2]; unsigned long long noi[4];
        const int cn = c + 1 < 64 ? c + 1 : c;
        H2_LOAD(cn); H2_PRIV(cn, nvt, noi);
        bf16x8 qa[4][4];
#pragma unroll
        for (int tt = 0; tt < 4; ++tt)
#pragma unroll
            for (int np = 0; np < 4; ++np) { const LAS unsigned char* qp = Bc + (16 * tt + fr) * 272 + (32 * np + 4 * fq) * 2;
                const s16x4 lo = *(const LAS s16x4*)qp, hi = *(const LAS s16x4*)(qp + 32); qa[tt][np] = __builtin_shufflevector(lo, hi, 0, 1, 2, 3, 4, 5, 6, 7); }
        bf16x8 sb[4];
#pragma unroll
        for (int np = 0; np < 4; ++np) { u32x4 pw; pw.x = pk2(S[2 * np][0], S[2 * np][1]); pw.y = pk2(S[2 * np][2], S[2 * np][3]); pw.z = pk2(S[2 * np + 1][0], S[2 * np + 1][1]); pw.w = pk2(S[2 * np + 1][2], S[2 * np + 1][3]); sb[np] = mk8(pw); }
        f32x4 o[4];
#pragma unroll
        for (int tt = 0; tt < 4; ++tt) { const unsigned lo = (unsigned)oi[tt], hi = (unsigned)(oi[tt] >> 32); o[tt] = (f32x4){lo16(lo), hi16(lo), lo16(hi), hi16(hi)}; }
#pragma unroll
        for (int np = 0; np < 4; ++np)
#pragma unroll
            for (int tt = 0; tt < 4; ++tt) o[tt] = MFMA16(sb[np], qa[tt][np], o[tt]);
        const int tok0 = b * T + 64 * c;
        if (!DRY) {
#pragma unroll
            for (int tt = 0; tt < 4; ++tt) *(unsigned long long*)(Z2 + (size_t)(tok0 + 16 * tt + fr) * NH2 + h * 128 + 16 * w + 4 * fq) = (unsigned long long)pk2(o[tt][0], o[tt][1]) | ((unsigned long long)pk2(o[tt][2], o[tt][3]) << 32);
        } else { asm volatile("" :: "v"(o[0]), "v"(o[1]), "v"(o[2]), "v"(o[3])); }
        bf16x8 ka[8][2];
#pragma unroll
        for (int nt = 0; nt < 8; ++nt)
#pragma unroll
            for (int ks = 0; ks < 2; ++ks) ka[nt][ks] = *(const LAS bf16x8*)(Bc + H2_KHT + (16 * nt + fr) * 144 + (32 * ks + 8 * fq) * 2);
#pragma unroll
        for (int nt = 0; nt < 8; ++nt) { const f32x4 dv = *(const LAS f32x4*)(Bc + H2_DEC + (16 * nt + 4 * fq) * 4); S[nt] = S[nt] * dv; }
#pragma unroll
        for (int ks = 0; ks < 2; ++ks)
#pragma unroll
            for (int nt = 0; nt < 8; ++nt) S[nt] = MFMA16(ka[nt][ks], mk8(vtf[ks]), S[nt]);
        if (c + 1 < 64) H2_WRITE((c + 1) & 1);
        vtf[0] = nvt[0]; vtf[1] = nvt[1];
#pragma unroll
        for (int i = 0; i < 4; ++i) oi[i] = noi[i];
        LBAR();
    }
#undef H2_LOAD
#undef H2_WRITE
#undef H2_PRIV
}
DI void hgrn3_phase(bf16* Z2, const float* gain, int gtid, int NGT) {
    for (int idx = gtid; idx < M * 8 * 16; idx += NGT) {
        const int j = idx & 15, item = idx >> 4, h = item & 7, tok = item >> 3;
        const bf16* op = Z2 + (size_t)tok * NH2 + h * 128 + 8 * j; bf16* gp = Z2 + (size_t)tok * NH2 + 3072 + h * 128 + 8 * j;
        const u32x4 ov = *(const u32x4*)op, gv = *(const u32x4*)gp;
        const f32x4 g0 = *(const f32x4*)(gain + h * 128 + 8 * j), g1 = *(const f32x4*)(gain + h * 128 + 8 * j + 4);
        float of[8], gf[8]; float ss = 0.f;
#pragma unroll
        for (int q = 0; q < 4; ++q) { of[2 * q] = lo16(ov[q]); of[2 * q + 1] = hi16(ov[q]); gf[2 * q] = lo16(gv[q]); gf[2 * q + 1] = hi16(gv[q]); ss += of[2 * q] * of[2 * q] + of[2 * q + 1] * of[2 * q + 1]; }
        ss = row16_sum(ss);
        const float rstd = __builtin_amdgcn_rsqf(ss * (1.0f / 128.0f) + EPS);
        float r[8];
#pragma unroll
        for (int q = 0; q < 8; ++q) { const float gn = q < 4 ? g0[q & 3] : g1[q & 3]; r[q] = of[q] * rstd * gn * (gf[q] * __builtin_amdgcn_rcpf(1.0f + __expf(-gf[q]))); }
        u32x4 w; w.x = pk2(r[0], r[1]); w.y = pk2(r[2], r[3]); w.z = pk2(r[4], r[5]); w.w = pk2(r[6], r[7]);
        *(u32x4*)gp = w;
    }
}

#define XB_TMO      128
#define XB_XCNT(j)  (256  + 64 * (j))
#define XB_XSUB(j)  (1280 + 64 * (j))
#define XB_XGEN(j)  (2304 + 64 * (j))
#define XB_TOP      3328
#define XB_TOPGEN   3392
#define XCD_BAR_WORDS 3456
#define XB_SPIN_CAP (1u << 18)

__device__ __forceinline__ unsigned xb_ld(unsigned* p)              { return __hip_atomic_load(p, __ATOMIC_RELAXED, __HIP_MEMORY_SCOPE_AGENT); }
__device__ __forceinline__ unsigned xb_add(unsigned* p, unsigned v) { return __hip_atomic_fetch_add(p, v, __ATOMIC_RELAXED, __HIP_MEMORY_SCOPE_AGENT); }
__device__ __forceinline__ unsigned xb_xcc_id() { return (unsigned)__builtin_amdgcn_s_getreg((3 << 11) | 20) & 0xFu; }
#define XB_SPIN(cond, bar) do { unsigned _sp = 0; while (cond) { __builtin_amdgcn_s_sleep(1); \
    if ((++_sp & 255u) == 0u) { if (xb_ld(&(bar)[XB_TMO])) break; if (_sp > XB_SPIN_CAP) { atomicAdd(&(bar)[XB_TMO], 1u); break; } } } } while (0)

struct XcdBarrier {
    unsigned* bar; unsigned x;
    volatile LAS unsigned* st;
};

__device__ __forceinline__ XcdBarrier xcd_barrier_post(unsigned* bar, volatile LAS unsigned* st) {
    XcdBarrier b; b.bar = bar; b.x = xb_xcc_id(); b.st = st;
    if (threadIdx.x == 0) (void)xb_add(&bar[XB_XCNT(b.x)], 1u);
    return b;
}
__device__ __forceinline__ void xcd_barrier_complete(unsigned* bar, unsigned x, unsigned& nloc, unsigned& nx) {
    const unsigned G = gridDim.x * gridDim.y * gridDim.z;
    unsigned sum, cnt, mine, sp = 0u;
    for (;;) {
        sum = 0u; cnt = 0u; mine = 0u;
#pragma unroll
        for (unsigned j = 0; j < 16; ++j) { const unsigned c = xb_ld(&bar[XB_XCNT(j)]); sum += c; cnt += (c > 0u) ? 1u : 0u; mine = (j == x) ? c : mine; }
        if (sum == G) break;
        __builtin_amdgcn_s_sleep(1);
        if ((++sp & 255u) == 0u) { if (xb_ld(&bar[XB_TMO])) break; if (sp > XB_SPIN_CAP) { atomicAdd(&bar[XB_TMO], 1u); break; } }
    }
    nloc = mine > 0u ? mine : 1u; nx = cnt > 0u ? cnt : 1u;
}

__device__ __forceinline__ void xcd_barrier(const XcdBarrier& b) {
    asm volatile("s_waitcnt vmcnt(0)" ::: "memory");
    __syncthreads();
    if (threadIdx.x == 0) {
        unsigned* bar = b.bar;
        __builtin_amdgcn_s_waitcnt(0);
        unsigned nloc = b.st[0], nx = b.st[1];
        if (nloc == 0u) { xcd_barrier_complete(bar, b.x, nloc, nx); b.st[0] = nloc; b.st[1] = nx; }
        const unsigned old = xb_add(&bar[XB_XSUB(b.x)], 1u);
        const unsigned gen = old / nloc;
        if (old + 1u == (gen + 1u) * nloc) {
            __builtin_amdgcn_fence(__ATOMIC_RELEASE, "agent");
            asm volatile("s_waitcnt vmcnt(0)" ::: "memory");
            const unsigned og = xb_add(&bar[XB_TOP], 1u);
            const unsigned tg = og / nx;
            if (og + 1u == (tg + 1u) * nx) xb_add(&bar[XB_TOPGEN], 1u);
            else XB_SPIN(xb_ld(&bar[XB_TOPGEN]) == tg, bar);
            __builtin_amdgcn_fence(__ATOMIC_ACQUIRE, "agent");
            xb_add(&bar[XB_XGEN(b.x)], 1u);
            asm volatile("s_waitcnt vmcnt(0)" ::: "memory");
        } else {
            XB_SPIN(xb_ld(&bar[XB_XGEN(b.x)]) == gen, bar);
            __builtin_amdgcn_fence(__ATOMIC_ACQUIRE, "agent");
            asm volatile("s_waitcnt vmcnt(0)" ::: "memory");
        }
    }
    __syncthreads();
}

#ifndef PROBE_SYNC
#define PROBE_SYNC 0
#endif
#ifndef PROBE_ATT
#define PROBE_ATT 0
#endif
#ifndef PROBE_GEMM
#define PROBE_GEMM 0
#endif
#ifndef PROBE_HG
#define PROBE_HG 0
#endif
#ifndef PROBE_CONV
#define PROBE_CONV 0
#endif
#define GSYNC() do { xcd_barrier(xbar); if (PROBE_SYNC) xcd_barrier(xbar); } while (0)
#define REP(n) for (int rep_ = 0; rep_ < 1 + (n); ++rep_)
#define FRESH() size_t zoff_ = 0; asm volatile("" : "+s"(zoff_)); unsigned char* ws = a.ws + zoff_; int tid = threadIdx.x; asm volatile("" : "+v"(tid)); \
    const int lane = tid & 63, wave = __builtin_amdgcn_readfirstlane(tid >> 6); int G = gridDim.x, bid = blockIdx.x; asm volatile("" : "+s"(G), "+s"(bid)); \
    const int gw = bid * 8 + wave, NGW = G * 8, gtid = bid * 512 + tid, NGT = G * 512; float* X = (float*)((unsigned char*)a.out + zoff_); \
    bf16* Xb = (bf16*)(ws + WS_XB); float* ssq = (float*)(ws + WS_SSQ); bf16* Z = (bf16*)(ws + WS_Z); \
    (void)lane; (void)gw; (void)NGW; (void)gtid; (void)NGT; (void)Xb; (void)ssq; (void)Z; (void)X;

__global__ void __launch_bounds__(512, 2) fwd_megakernel(Args a) {
    extern __shared__ __attribute__((aligned(16))) unsigned char lds_raw[];
    LAS unsigned char* L = (LAS unsigned char*)lds_raw;
    volatile LAS unsigned* MISC = (volatile LAS unsigned*)(L + LDS_BYTES - 64);
    if (threadIdx.x < 16) MISC[threadIdx.x] = 0u;
    __syncthreads();
    const XcdBarrier xbar = xcd_barrier_post((unsigned*)(a.ws + WS_CTL), MISC);

    REP(PROBE_CONV) { FRESH(); conv_weights(a, 0, L, gw, NGW, wave, lane); }
    { FRESH(); prologue_misc(a, gw, NGW, lane, gtid, NGT); }
    cg::this_grid().sync();

    for (int l = 0; l < 2; ++l) {
        if (l > 0) { REP(PROBE_CONV) { FRESH(); conv_weights(a, l, L, gw, NGW, wave, lane); } GSYNC(); }
        REP(PROBE_GEMM) { FRESH(); run_gemm(L, Xb, D, (const bf16*)(ws + W_GU1), D, M, 2 * DFF, D, G, bid, EpiSwiglu{Z, ssq}); }
        GSYNC();
        { FRESH(); run_gemm(L, Z, DFF, (const bf16*)(ws + W_DN1), DFF, M, D, DFF, G, bid, EpiResid{l == 0 ? (const float*)a.in[0] : X, X, Xb, ssq, 0.5f}); }
        GSYNC();
        REP(PROBE_GEMM) { FRESH(); run_gemm(L, Xb, D, (const bf16*)(ws + W_IN), D, M, NATT, D, G, bid, EpiZ{Z, NATT, ssq}); }
        GSYNC();
        REP(PROBE_ATT) { FRESH(); dil_attn_phase(L, Z, (const float*)(ws + WS_COS), (const float*)(ws + WS_SIN), (bf16*)(ws + WS_OG), (float*)(ws + WS_LSE), G, bid, tid); }
        GSYNC();
        REP(PROBE_GEMM) { FRESH(); run_gemm(L, Xb, D, (const bf16*)(ws + W_IN) + (size_t)NATT * D, D, M, NH2, D, G, bid, EpiZ{Z, NH2, ssq}); }
        { FRESH(); merge_phase((const bf16*)(ws + WS_OG), (const float*)(ws + WS_LSE), (bf16*)(ws + WS_AO), gtid, NGT); }
        GSYNC();
#if PROBE_HG & 1
        { FRESH(); hgrn1_phase<true>(L, Z, (const float*)a.in[8], l, (float*)(ws + WS_DEC), (unsigned long long*)(ws + WS_OG), G, bid, tid); }
#endif
        { FRESH(); hgrn1_phase<false>(L, Z, (const float*)a.in[8], l, (float*)(ws + WS_DEC), (unsigned long long*)(ws + WS_OG), G, bid, tid); }
        GSYNC();
        { FRESH();
#if PROBE_HG & 2
          if (bid < 32) { hgrn2_phase<true>(L, Z, (const float*)(ws + WS_DEC), (const unsigned long long*)(ws + WS_OG), bid, tid); __syncthreads(); }
#endif
          if (bid < 32) hgrn2_phase<false>(L, Z, (const float*)(ws + WS_DEC), (const unsigned long long*)(ws + WS_OG), bid, tid);
          else {
            const bf16* memN = (const bf16*)(ws + WS_MEMN) + (size_t)l * MROWS * D; const bf16* Wkv = (const bf16*)(ws + W_KV);
            run_gemm(L, memN, D, Wkv, D, MROWS, D, D, G - 32, bid - 32, EpiZ{(bf16*)(ws + WS_MEMK), D, nullptr});
            run_gemm(L, Wkv + (size_t)D * D, D, memN, D, D, MROWS, D, G - 32, G - 1 - bid, EpiZ{(bf16*)(ws + WS_MEMVT), MROWS, nullptr});
          } }
        GSYNC();
        { FRESH(); hgrn3_phase(Z, (const float*)a.in[9] + (size_t)l * D, gtid, NGT); }
        GSYNC();
        REP(PROBE_GEMM) { FRESH(); run_gemm(L, Xb, D, (const bf16*)(ws + W_IN) + (size_t)(NATT + NH2) * D, D, M, 2048, D, G, bid, EpiZ{Z, NH2, ssq}); }
        GSYNC();
        { FRESH(); run_gemm(L, (const bf16*)(ws + WS_AO), 512, (const bf16*)(ws + W_AB), 512, M, D, 512, G, bid, EpiGate<false>{Z, NH2, Z + 2048, NH2}); }
        { FRESH(); run_gemm(L, Z + 3072, NH2, (const bf16*)(ws + W_HB), D, M, D, D, G, bid, EpiGate<true>{Z + 1024, NH2, Z + 2048, NH2}); }
        GSYNC();
        { FRESH(); run_gemm(L, Z + 2048, NH2, (const bf16*)(ws + W_MO), D, M, D, D, G, bid, EpiResid{X, X, Xb, ssq, 1.0f}); }
        GSYNC();
        REP(PROBE_GEMM) { FRESH(); run_gemm(L, Xb, D, (const bf16*)(ws + W_Q), D, M, D, D, G, bid, EpiZ{Z, D, ssq}); }
        GSYNC();
        REP(PROBE_ATT) { FRESH(); xattn_phase(L, Z, (const bf16*)(ws + WS_MEMK), (const bf16*)(ws + WS_MEMVT), Z + (size_t)M * D, G, bid, tid); }
        GSYNC();
        { FRESH(); run_gemm(L, Z + (size_t)M * D, D, (const bf16*)(ws + W_O), D, M, D, D, G, bid, EpiResid{X, X, Xb, ssq, 1.0f}); }
        GSYNC();
        REP(PROBE_GEMM) { FRESH(); run_gemm(L, Xb, D, (const bf16*)(ws + W_GU2), D, M, 2 * DFF, D, G, bid, EpiSwiglu{Z, ssq}); }
        GSYNC();
        { FRESH(); run_gemm(L, Z, DFF, (const bf16*)(ws + W_DN2), DFF, M, D, DFF, G, bid, EpiResid{X, X, Xb, ssq, 0.5f}); }
        GSYNC();
    }
    { FRESH();
      const float* fg = (const float*)a.in[21];
      for (int m = gw; m < M; m += NGW) {
        f32x4* xr = (f32x4*)(X + (size_t)m * D) + lane; const f32x4* gr = (const f32x4*)fg + lane;
        f32x4 v[4]; float s = 0.f;
#pragma unroll
        for (int j = 0; j < 4; ++j) { v[j] = xr[64 * j]; s += (v[j][0] * v[j][0] + v[j][1] * v[j][1]) + (v[j][2] * v[j][2] + v[j][3] * v[j][3]); }
        const float rs = 1.0f / sqrtf(wave_sum(s) * (1.0f / D) + EPS);
#pragma unroll
        for (int j = 0; j < 4; ++j) xr[64 * j] = v[j] * rs * gr[64 * j];
      } }
}

extern "C" void kernel_launch(void* const* d_in, const int* in_sizes, int n_in, void* d_out, int out_size, void* d_ws, size_t ws_size, hipStream_t stream) {
    static int grid = 0;
    if (grid == 0) {
        if (n_in != 22 || out_size != M * D || ws_size < WS_END) { fprintf(stderr, "kernel_launch: unexpected shapes (n_in %d out %d ws %zu)\n", n_in, out_size, ws_size); grid = -1; return; }
        int dev = 0, cus = 0, per_cu = 0;
        hipGetDevice(&dev); hipDeviceGetAttribute(&cus, hipDeviceAttributeMultiprocessorCount, dev);
        hipFuncSetAttribute((const void*)fwd_megakernel, hipFuncAttributeMaxDynamicSharedMemorySize, LDS_BYTES);
        hipOccupancyMaxActiveBlocksPerMultiprocessor(&per_cu, (const void*)fwd_megakernel, 512, LDS_BYTES);
        if (per_cu < 1) { fprintf(stderr, "kernel_launch: occupancy query reports %d blocks per CU\n", per_cu); grid = -1; return; }
        grid = cus;
        if (grid < 64) { fprintf(stderr, "kernel_launch: too few CUs (%d)\n", grid); grid = -1; return; }
    }
    if (grid < 0) return;
    if (hipMemsetAsync((char*)d_ws + WS_CTL, 0, CTL_BYTES, stream) != hipSuccess) { fprintf(stderr, "kernel_launch: memset failed\n"); return; }
    Args a{};
    for (int i = 0; i < 22; ++i) a.in[i] = d_in[i];
    a.out = (float*)d_out; a.ws = (unsigned char*)d_ws;
    void* args[] = {&a};
    hipError_t e = hipLaunchCooperativeKernel((const void*)fwd_megakernel, dim3(grid), dim3(512), args, LDS_BYTES, stream);
    if (e != hipSuccess) fprintf(stderr, "cooperative launch failed: %s (grid %d)\n", hipGetErrorString(e), grid);
}
```

```cpp
#include <hip/hip_runtime.h>
#include <hip/hip_cooperative_groups.h>
#include <cstdio>
#include <cstdint>
namespace cg = cooperative_groups;
namespace pg8 {
#define PG8_LAS __attribute__((address_space(3)))
typedef unsigned short bf16_t;
typedef short bf16x8 __attribute__((ext_vector_type(8)));
typedef float f32x4 __attribute__((ext_vector_type(4)));
typedef unsigned u32x4 __attribute__((ext_vector_type(4)));
constexpr int BM = 256, BK = 64, HALF = 128, HTB = HALF * BK * 2  , STAGE_BYTES = 8 * HTB, NXCD = 8, WGM = 8;

__host__ __device__ __forceinline__ int lds_byte(int r, int c) { const int st = (r >> 4) * 2 + (c >> 5), rr = r & 15, cc = c & 31, ob = rr * 64 + cc * 2; return st * 1024 + (ob ^ (((ob >> 9) & 1) << 5)); }
__host__ __device__ __forceinline__ void stage_rc(int b, int& R, int& C) { const int st = b / 1024, sb = b % 1024, swz = sb ^ (((sb >> 9) & 1) << 5); R = (st >> 1) * 16 + swz / 64; C = (st & 1) * 32 + (swz % 64) / 2; }
__host__ __device__ __forceinline__ int perm32(int rho) { const int n = rho >> 4, i = rho & 15; return 8 * (i >> 2) + 4 * n + (i & 3); }

struct Unit { int pm, pn; };
struct Gemm { const bf16_t* A; const bf16_t* Bt; int M, N, K, lda, ldb; };

struct StaticOrder {
    int nM, nN, nwg, G, c;
    __host__ __device__ void init(int M, int N, int G_, int c_) { nM = M / BM; nN = N / BM; nwg = nM * nN; G = G_; c = c_; }
    __host__ __device__ bool next(int i, Unit& u) const {
        const long L = (long)i * G + c; if (L >= nwg) return false;
        int wgid = (int)L; { const int q = nwg / NXCD, r = nwg % NXCD, xcd = wgid % NXCD, off = wgid / NXCD; wgid = (xcd < r ? xcd * (q + 1) : r * (q + 1) + (xcd - r) * q) + off; }
        const int nig = WGM * nN, gid = wgid / nig, fm = gid * WGM, gsz = (nM - fm) < WGM ? (nM - fm) : WGM;
        u.pm = fm + ((wgid % nig) % gsz); u.pn = (wgid % nig) / gsz; return true;
    }
    __device__ __forceinline__ void a_ready(const Unit&) const {}
    __device__ __forceinline__ void done(const Unit&) const {}
};

template <class Epi, class Sched, bool ALIGN_EPI = false, bool SP2 = false>
__device__ __forceinline__ void gemm_phase(PG8_LAS unsigned char* lds, const Gemm g, const Sched& S, const Epi& E) {
    int tid_ = threadIdx.x; asm volatile("" : "+v"(tid_)); const int tid = tid_, wid = __builtin_amdgcn_readfirstlane(tid >> 6), lane = tid & 63, wr = wid >> 2, wc = wid & 3, fr = lane & 15, fq = lane >> 4;
    const int K = g.K, nt = K / BK;
    unsigned voffA[2], voffB[2];
#pragma unroll
    for (int i = 0; i < 2; ++i) { int R, C; stage_rc(tid * 16 + i * 8192, R, C); const int Rb = Epi::PERM ? ((R & ~31) + perm32(R & 31)) : R;
        voffA[i] = (unsigned)(R * g.lda + C) * 2u; voffB[i] = (unsigned)(Rb * g.ldb + C) * 2u; }
    const size_t kstep = (size_t)(BK * 2);
    const size_t hstepA = (size_t)HALF * g.lda * 2, hstepB = (size_t)HALF * g.ldb * 2;
    const size_t tstepA = 2 * hstepA, tstepB = 2 * hstepB;
    const unsigned ldsw = (unsigned)wid * 1024u;
    const int aoff = lds_byte(wr * 64 + fr, fq * 8), boff = lds_byte(wc * 32 + fr, fq * 8);
#define PG8_SA(b, h) (((b) * 2 + (h)) * HTB)
#define PG8_SB(b, h) ((4 + (b) * 2 + (h)) * HTB)
#define PG8_STAGE(bufoff, gbase, voff) do { _Pragma("unroll") for (int _i = 0; _i < 2; ++_i) \
        __builtin_amdgcn_global_load_lds((const unsigned*)((const char*)(gbase) + (voff)[_i]), (PG8_LAS unsigned*)(lds + (bufoff) + ldsw + _i * 8192), 16, 0, 0); } while (0)
#define PG8_LDA(dst, b, h) do { _Pragma("unroll") for (int m = 0; m < 4; ++m) _Pragma("unroll") for (int k = 0; k < 2; ++k) dst[m][k] = *(const PG8_LAS bf16x8*)(lds + PG8_SA(b, h) + aoff + m * 2048 + k * 1024); } while (0)
#define PG8_LDB(dst, b, h) do { _Pragma("unroll") for (int n = 0; n < 2; ++n) _Pragma("unroll") for (int k = 0; k < 2; ++k) dst[n][k] = *(const PG8_LAS bf16x8*)(lds + PG8_SB(b, h) + boff + n * 2048 + k * 1024); } while (0)
#define PG8_MMA(ai, bj, At, Bt) do { __builtin_amdgcn_s_setprio(1); _Pragma("unroll") for (int m = 0; m < 4; ++m) _Pragma("unroll") for (int n = 0; n < 2; ++n) _Pragma("unroll") for (int k = 0; k < 2; ++k) \
        acc[ai][bj][m][n] = __builtin_amdgcn_mfma_f32_16x16x32_bf16(Bt[n][k], At[m][k], acc[ai][bj][m][n], 0, 0, 0); __builtin_amdgcn_s_setprio(0); } while (0)
#define PG8_WAIT_V(n) asm volatile("s_waitcnt vmcnt(" #n ")" ::: "memory")
#define PG8_WAIT_L(n) asm volatile("s_waitcnt lgkmcnt(" #n ")" ::: "memory")
#define PG8_BAR __builtin_amdgcn_s_barrier()
#define PG8_SCHED __builtin_amdgcn_sched_barrier(0)
    Unit cur, nxt; int ui = 0;
    if (!S.next(0, cur)) return;
    f32x4 acc[2][2][4][2];
#pragma unroll
    for (int a = 0; a < 2; ++a)
#pragma unroll
        for (int b = 0; b < 2; ++b)
#pragma unroll
            for (int m = 0; m < 4; ++m)
#pragma unroll
                for (int n = 0; n < 2; ++n) acc[a][b][m][n] = (f32x4){0.f, 0.f, 0.f, 0.f};
    bf16x8 At[4][2], B0[2][2], B1[2][2];
    const char* cA = (const char*)g.A + (size_t)cur.pm * tstepA; const char* cB = (const char*)g.Bt + (size_t)cur.pn * tstepB;
    S.a_ready(cur);
    if constexpr (SP2) {
        PG8_STAGE(PG8_SB(0, 0), cB, voffB); PG8_STAGE(PG8_SB(0, 1), cB + hstepB, voffB); PG8_STAGE(PG8_SA(0, 0), cA, voffA); PG8_STAGE(PG8_SA(0, 1), cA + hstepA, voffA);
        if (wr == 1) PG8_BAR;
        PG8_WAIT_V(2); PG8_BAR;
        PG8_STAGE(PG8_SB(1, 0), cB + kstep, voffB); PG8_STAGE(PG8_SA(1, 0), cA + kstep, voffA); PG8_STAGE(PG8_SB(1, 1), cB + hstepB + kstep, voffB);
        PG8_WAIT_V(6); PG8_BAR;
    } else {
        PG8_STAGE(PG8_SB(0, 0), cB, voffB); PG8_STAGE(PG8_SA(0, 0), cA, voffA); PG8_STAGE(PG8_SB(0, 1), cB + hstepB, voffB); PG8_STAGE(PG8_SA(0, 1), cA + hstepA, voffA);
        if (wr == 1) PG8_BAR;
        PG8_WAIT_V(4); PG8_BAR;
        PG8_STAGE(PG8_SB(1, 0), cB + kstep, voffB); PG8_STAGE(PG8_SA(1, 0), cA + kstep, voffA); PG8_STAGE(PG8_SB(1, 1), cB + hstepB + kstep, voffB);
        PG8_WAIT_V(6); PG8_BAR;
    }
    for (;;) {
        const bool has_next = S.next(ui + 1, nxt);
        const char* nA = has_next ? (const char*)g.A + (size_t)nxt.pm * tstepA : cA; const char* nB = has_next ? (const char*)g.Bt + (size_t)nxt.pn * tstepB : cB;
        for (int t = 0; t < nt; t += 2) {
            const bool last = (t == nt - 2);
            const char* a1 = cA + (size_t)(t + 1) * kstep;
            const char* a2 = last ? nA : cA + (size_t)(t + 2) * kstep; const char* b2 = last ? nB : cB + (size_t)(t + 2) * kstep;
            const char* a3 = a2 + kstep; const char* b3 = b2 + kstep;
            if (last && has_next) S.a_ready(nxt);
            if constexpr (SP2) {
            PG8_LDB(B0, 0, 0); PG8_LDB(B1, 0, 1); PG8_SCHED; PG8_LDA(At, 0, 0); PG8_STAGE(PG8_SA(1, 1), a1 + hstepA, voffA);
            PG8_WAIT_V(8); PG8_WAIT_L(0); PG8_BAR; PG8_MMA(0, 0, At, B0); PG8_MMA(0, 1, At, B1); PG8_BAR; PG8_SCHED;
            PG8_LDA(At, 0, 1); PG8_STAGE(PG8_SB(0, 0), b2, voffB); PG8_STAGE(PG8_SB(0, 1), b2 + hstepB, voffB); PG8_STAGE(PG8_SA(0, 0), a2, voffA);
            PG8_WAIT_V(8); PG8_WAIT_L(0); PG8_BAR; PG8_MMA(1, 0, At, B0); PG8_MMA(1, 1, At, B1); PG8_BAR; PG8_SCHED;
            PG8_LDB(B0, 1, 0); PG8_LDB(B1, 1, 1); PG8_SCHED; PG8_LDA(At, 1, 0); PG8_STAGE(PG8_SA(0, 1), a2 + hstepA, voffA);
            PG8_WAIT_V(8); PG8_WAIT_L(0); PG8_BAR; PG8_MMA(0, 0, At, B0); PG8_MMA(0, 1, At, B1); PG8_BAR; PG8_SCHED;
            PG8_LDA(At, 1, 1); PG8_STAGE(PG8_SB(1, 0), b3, voffB); PG8_STAGE(PG8_SB(1, 1), b3 + hstepB, voffB); PG8_STAGE(PG8_SA(1, 0), a3, voffA);
            PG8_WAIT_V(8); PG8_WAIT_L(0); PG8_BAR; PG8_MMA(1, 0, At, B0); PG8_MMA(1, 1, At, B1); PG8_BAR; PG8_SCHED;
            } else {
            PG8_LDB(B0, 0, 0); PG8_SCHED; PG8_LDA(At, 0, 0); PG8_STAGE(PG8_SA(1, 1), a1 + hstepA, voffA);
            PG8_WAIT_L(8); PG8_BAR; PG8_WAIT_L(0); PG8_MMA(0, 0, At, B0); PG8_BAR; PG8_SCHED;
            PG8_LDB(B1, 0, 1); PG8_STAGE(PG8_SB(0, 0), b2, voffB);
            PG8_BAR; PG8_WAIT_L(0); PG8_MMA(0, 1, At, B1); PG8_BAR;
            PG8_LDA(At, 0, 1); PG8_STAGE(PG8_SA(0, 0), a2, voffA);
            PG8_BAR; PG8_WAIT_L(0); PG8_MMA(1, 0, At, B0); PG8_BAR; PG8_SCHED;
            PG8_STAGE(PG8_SB(0, 1), b2 + hstepB, voffB);
            PG8_WAIT_V(6); PG8_BAR; PG8_MMA(1, 1, At, B1); PG8_BAR;
            PG8_LDB(B0, 1, 0); PG8_SCHED; PG8_LDA(At, 1, 0); PG8_STAGE(PG8_SA(0, 1), a2 + hstepA, voffA);
            PG8_WAIT_L(8); PG8_BAR; PG8_WAIT_L(0); PG8_MMA(0, 0, At, B0); PG8_BAR; PG8_SCHED;
            PG8_LDB(B1, 1, 1); PG8_STAGE(PG8_SB(1, 0), b3, voffB);
            PG8_BAR; PG8_WAIT_L(0); PG8_MMA(0, 1, At, B1); PG8_BAR;
            PG8_LDA(At, 1, 1); PG8_STAGE(PG8_SA(1, 0), a3, voffA);
            PG8_BAR; PG8_WAIT_L(0); PG8_MMA(1, 0, At, B0); PG8_BAR; PG8_SCHED;
            PG8_STAGE(PG8_SB(1, 1), b3 + hstepB, voffB);
            PG8_WAIT_V(6); PG8_BAR; PG8_MMA(1, 1, At, B1); PG8_BAR;
            }
        }
        if constexpr (ALIGN_EPI) { if (wr == 0) PG8_BAR; }
        if constexpr (!Epi::AFTER_DRAIN) { E(acc, cur, wr, wc, fr, fq); S.done(cur); }
        if (!has_next) break;
#pragma unroll
        for (int a = 0; a < 2; ++a)
#pragma unroll
            for (int b = 0; b < 2; ++b)
#pragma unroll
                for (int m = 0; m < 4; ++m)
#pragma unroll
                    for (int n = 0; n < 2; ++n) acc[a][b][m][n] = (f32x4){0.f, 0.f, 0.f, 0.f};
        cur = nxt; cA = nA; cB = nB; ++ui;
        if constexpr (ALIGN_EPI) { if (wr == 1) PG8_BAR; }
    }
    PG8_WAIT_V(0);
    if constexpr (!ALIGN_EPI) { if (wr == 0) PG8_BAR; }
    PG8_BAR;
    if constexpr (Epi::AFTER_DRAIN) { E.fused(acc, cur, wr, wc, fr, fq, lds, wid, lane); S.done(cur); }
#undef PG8_SA
#undef PG8_SB
#undef PG8_STAGE
#undef PG8_LDA
#undef PG8_LDB
#undef PG8_MMA
#undef PG8_WAIT_V
#undef PG8_WAIT_L
#undef PG8_BAR
#undef PG8_SCHED
}
}

#define DI __device__ __forceinline__
#define LAS __attribute__((address_space(3)))
typedef unsigned short bf16;
typedef short bf16x8 __attribute__((ext_vector_type(8)));
typedef short s16x4 __attribute__((ext_vector_type(4)));
typedef float f32x4 __attribute__((ext_vector_type(4)));
typedef unsigned u32x4 __attribute__((ext_vector_type(4)));
typedef unsigned u32x2 __attribute__((ext_vector_type(2)));
using pg8::Unit;

constexpr int NB = 4, T = 4096, D = 1024, M = NB * T, DFF = 2816, NMEM = 256, MROWS = NB * NMEM;
constexpr int NATT = 4608, NH2 = 4096;
constexpr float EPS = 1e-6f;
constexpr int LDS_BYTES = 147456;

constexpr size_t MiB = 1u << 20;
constexpr size_t W_GU1 = 0, W_DN1 = W_GU1 + (size_t)2 * DFF * D * 2, W_IN = W_DN1 + (size_t)D * DFF * 2, W_AB = W_IN + (size_t)10752 * D * 2,
                 W_HB = W_AB + (size_t)D * 512 * 2, W_MO = W_HB + (size_t)D * D * 2, W_Q = W_MO + (size_t)D * D * 2, W_KV = W_Q + (size_t)D * D * 2,
                 W_O = W_KV + (size_t)2 * D * D * 2, W_GU2 = W_O + (size_t)D * D * 2, W_DN2 = W_GU2 + (size_t)2 * DFF * D * 2, W_END = W_DN2 + (size_t)D * DFF * 2;
static_assert(W_END <= 68 * MiB, "weights");
constexpr size_t WS_XB = 68 * MiB, WS_Z = 100 * MiB, WS_OG = 244 * MiB, WS_AO = 292 * MiB, WS_COS = 308 * MiB, WS_SIN = 312 * MiB, WS_MEMN = 316 * MiB,
                 WS_MEMK = 320 * MiB, WS_MEMVT = 322 * MiB, WS_SSQ = 324 * MiB, WS_DEC = 325 * MiB, WS_LSE = 326 * MiB, WS_CTL = 327 * MiB, CTL_BYTES = 65536, WS_WKV1 = 328 * MiB, WS_MEMK1 = 332 * MiB, WS_MEMVT1 = 334 * MiB, WS_END = 336 * MiB;

DI float bf2f(unsigned short h) { return __uint_as_float((unsigned)h << 16); }
typedef __bf16 bf2_t __attribute__((ext_vector_type(2)));
typedef float f32x2_t __attribute__((ext_vector_type(2)));
DI unsigned pk2(float lo, float hi) { const bf2_t r = __builtin_convertvector((f32x2_t){lo, hi}, bf2_t); return __builtin_bit_cast(unsigned, r); }
DI unsigned f2bf(float f) { return pk2(f, 0.f) & 0xffffu; }
template <int N> DI float rr_add(float v) { return v + __int_as_float(__builtin_amdgcn_update_dpp(0, __float_as_int(v), 0x120 + N, 0xf, 0xf, false)); }
DI float row16_sum(float v) { v = rr_add<1>(v); v = rr_add<2>(v); v = rr_add<4>(v); v = rr_add<8>(v); return v; }
#define LBAR() do { asm volatile("s_waitcnt lgkmcnt(0)" ::: "memory"); __builtin_amdgcn_s_barrier(); asm volatile("" ::: "memory"); } while (0)
DI float lo16(unsigned u) { return __uint_as_float(u << 16); }
DI float hi16(unsigned u) { return __uint_as_float(u & 0xffff0000u); }
DI float wave_sum(float v) {
#pragma unroll
    for (int o = 1; o < 64; o <<= 1) v += __shfl_xor(v, o);
    return v;
}
DI float sigmoidf_(float x) { return 1.0f / (1.0f + __expf(-x)); }
DI bf16x8 mk8(u32x4 v) { return __builtin_bit_cast(bf16x8, v); }
#define MFMA16(a, b, c) __builtin_amdgcn_mfma_f32_16x16x32_bf16((a), (b), (c), 0, 0, 0)

DI float row_rstd(const float* ssq, int row) {
    const f32x4* p = (const f32x4*)(ssq + (size_t)row * 16);
    const f32x4 a = p[0], b = p[1], c = p[2], d = p[3];
    const float s = ((a[0] + a[1]) + (a[2] + a[3])) + ((b[0] + b[1]) + (b[2] + b[3])) + ((c[0] + c[1]) + (c[2] + c[3])) + ((d[0] + d[1]) + (d[2] + d[3]));
    return 1.0f / sqrtf(s * (1.0f / D) + EPS);
}
struct EpiZ {
    static constexpr bool PERM = true, AFTER_DRAIN = false;
    bf16* O; int ldc; const float* ssq;
    DI void operator()(const f32x4 (&acc)[2][2][4][2], const Unit& u, int wr, int wc, int fr, int fq) const {
        const int row0 = u.pm * 256 + wr * 64 + fr, col0 = u.pn * 256 + wc * 32 + 8 * fq;
#pragma unroll
        for (int ai = 0; ai < 2; ++ai)
#pragma unroll
            for (int m = 0; m < 4; ++m) {
                const int row = row0 + ai * 128 + m * 16;
                const float rs = ssq ? row_rstd(ssq, row) : 1.0f;
                bf16* rowp = O + (size_t)row * ldc + col0;
#pragma unroll
                for (int bj = 0; bj < 2; ++bj) {
                    const f32x4 v0 = acc[ai][bj][m][0] * rs, v1 = acc[ai][bj][m][1] * rs;
                    u32x4 w; w.x = pk2(v0[0], v0[1]); w.y = pk2(v0[2], v0[3]); w.z = pk2(v1[0], v1[1]); w.w = pk2(v1[2], v1[3]);
                    *(u32x4*)(rowp + bj * 128) = w;
                }
            }
    }
};
struct EpiSwiglu {
    static constexpr bool PERM = true, AFTER_DRAIN = false;
    bf16* H; const float* ssq;
    DI void operator()(const f32x4 (&acc)[2][2][4][2], const Unit& u, int wr, int wc, int fr, int fq) const {
        const int row0 = u.pm * 256 + wr * 64 + fr, col0 = u.pn * 128 + wc * 32 + 8 * fq;
#pragma unroll
        for (int ai = 0; ai < 2; ++ai)
#pragma unroll
            for (int m = 0; m < 4; ++m) {
                const int row = row0 + ai * 128 + m * 16;
                const float rs = row_rstd(ssq, row);
                float h[8];
#pragma unroll
                for (int n = 0; n < 2; ++n)
#pragma unroll
                    for (int e = 0; e < 4; ++e) { const float g = acc[ai][0][m][n][e] * rs, up = acc[ai][1][m][n][e] * rs; h[4 * n + e] = g * sigmoidf_(g) * up; }
                u32x4 w; w.x = pk2(h[0], h[1]); w.y = pk2(h[2], h[3]); w.z = pk2(h[4], h[5]); w.w = pk2(h[6], h[7]);
                *(u32x4*)(H + (size_t)row * DFF + col0) = w;
            }
    }
};
struct EpiResid {
    static constexpr bool PERM = false, AFTER_DRAIN = false;
    const float* xin; float* xout; bf16* Xb; float* ssq; float alpha;
    DI void operator()(const f32x4 (&acc)[2][2][4][2], const Unit& u, int wr, int wc, int fr, int fq) const {
        const int row0 = u.pm * 256 + wr * 64 + fr, col0 = u.pn * 256 + wc * 32 + 4 * fq;
#pragma unroll
        for (int ai = 0; ai < 2; ++ai)
#pragma unroll
            for (int m = 0; m < 4; ++m) {
                const int row = row0 + ai * 128 + m * 16; float ss = 0.f;
#pragma unroll
                for (int bj = 0; bj < 2; ++bj)
#pragma unroll
                    for (int n = 0; n < 2; ++n) {
                        const size_t off = (size_t)row * D + col0 + bj * 128 + n * 16;
                        const f32x4 x = *(const f32x4*)(xin + off) + acc[ai][bj][m][n] * alpha;
                        *(f32x4*)(xout + off) = x;
                        u32x2 w; w.x = pk2(x[0], x[1]); w.y = pk2(x[2], x[3]); *(u32x2*)(Xb + off) = w;
                        ss += (x[0] * x[0] + x[1] * x[1]) + (x[2] * x[2] + x[3] * x[3]);
                    }
                ss += __shfl_xor(ss, 16); ss += __shfl_xor(ss, 32);
                if (fq == 0) ssq[(size_t)row * 16 + u.pn * 4 + wc] = ss;
            }
    }
};
template <bool ADD> struct EpiGate {
    static constexpr bool PERM = true, AFTER_DRAIN = false;
    const bf16* Gt; int ldg; bf16* Mg; int ldm;
    DI void operator()(const f32x4 (&acc)[2][2][4][2], const Unit& u, int wr, int wc, int fr, int fq) const {
        const int row0 = u.pm * 256 + wr * 64 + fr, col0 = u.pn * 256 + wc * 32 + 8 * fq;
#pragma unroll
        for (int ai = 0; ai < 2; ++ai)
#pragma unroll
            for (int m = 0; m < 4; ++m) {
                const int row = row0 + ai * 128 + m * 16;
#pragma unroll
                for (int bj = 0; bj < 2; ++bj) {
                    const u32x4 gv = *(const u32x4*)(Gt + (size_t)row * ldg + col0 + bj * 128);
                    bf16* mp = Mg + (size_t)row * ldm + col0 + bj * 128;
                    u32x4 pv = (u32x4){0u, 0u, 0u, 0u}; if (ADD) pv = *(const u32x4*)mp;
                    float r[8];
#pragma unroll
                    for (int q = 0; q < 4; ++q) {
                        const float a0 = acc[ai][bj][m][q >> 1][(q & 1) * 2], a1 = acc[ai][bj][m][q >> 1][(q & 1) * 2 + 1];
                        r[2 * q] = sigmoidf_(lo16(gv[q])) * a0 + (ADD ? lo16(pv[q]) : 0.f);
                        r[2 * q + 1] = sigmoidf_(hi16(gv[q])) * a1 + (ADD ? hi16(pv[q]) : 0.f);
                    }
                    u32x4 w; w.x = pk2(r[0], r[1]); w.y = pk2(r[2], r[3]); w.z = pk2(r[4], r[5]); w.w = pk2(r[6], r[7]);
                    *(u32x4*)mp = w;
                }
            }
    }
};

template <class Epi>
DI void run_gemm(LAS unsigned char* lds, const bf16* A, int lda, const bf16* Bt, int ldb, int Mr, int N, int K, int G, int c, const Epi& E) {
    pg8::Gemm g{A, Bt, Mr, N, K, lda, ldb}; pg8::StaticOrder S; S.init(Mr, N, G, c);
    pg8::gemm_phase<Epi, pg8::StaticOrder, true, true>(lds, g, S, E);
}

DI void conv_item(const float* W, int K, int Nsrc, int srcoff, int Nout, bool GU, const float* gain, bf16* WT, LAS float* scr, int item, int lane) {
    const int nblk = Nout / 32, kb = item / nblk, nb = item % nblk, k0 = 64 * kb, n0 = 32 * nb;
    const int src0 = srcoff + (GU ? (((n0 & 255) >> 7) * DFF + 128 * (n0 >> 8) + (n0 & 127)) : n0);
#pragma unroll 8
    for (int i = 0; i < 32; ++i) { const int kk = 2 * i + (lane >> 5); const float g = gain ? gain[k0 + kk] : 1.0f;
        scr[kk * 33 + (lane & 31)] = W[(size_t)(k0 + kk) * Nsrc + src0 + (lane & 31)] * g; }
    asm volatile("s_waitcnt lgkmcnt(0)" ::: "memory");
    const int c = lane & 7;
#pragma unroll
    for (int j = 0; j < 4; ++j) { const int n = (lane >> 3) + 8 * j; const LAS float* s = scr + (8 * c) * 33 + n;
        u32x4 o; o.x = pk2(s[0 * 33], s[1 * 33]); o.y = pk2(s[2 * 33], s[3 * 33]); o.z = pk2(s[4 * 33], s[5 * 33]); o.w = pk2(s[6 * 33], s[7 * 33]);
        *(u32x4*)(WT + (size_t)(n0 + n) * K + k0 + 8 * c) = o; }
    asm volatile("s_waitcnt lgkmcnt(0)" ::: "memory");
}

struct Args { const void* in[22]; float* out; unsigned char* ws; };

template <int SET> DI void conv_weights(const Args& a, LAS unsigned char* L, int gw, int NGW, int wave, int lane) {
    LAS float* scr = (LAS float*)(L + wave * 16384);
    unsigned char* ws = a.ws;
    int it = gw;
#define CONV(l_, idx, K_, Ns_, so_, No_, GU_, gidx, dst_) { const float* Wp = (const float*)a.in[idx] + (size_t)(l_) * (K_) * (Ns_); const float* gp = (gidx) >= 0 ? (const float*)a.in[(gidx) >= 0 ? (gidx) : 0] + (size_t)(l_) * (K_) : nullptr; \
        const int nitems = ((K_) / 64) * ((No_) / 32); for (; it < nitems; it += NGW) conv_item(Wp, K_, Ns_, so_, No_, GU_, gp, (bf16*)(ws + (dst_)), scr, it, lane); it -= nitems; }
    if (SET == 0) {
        CONV(0, 4, D, 2 * DFF, 0, 2 * DFF, true, 3, W_GU1)
        CONV(0, 5, DFF, D, 0, D, false, -1, W_DN1)
        CONV(0, 7, D, 10752, 0, 10752, false, 6, W_IN)
        CONV(0, 10, 512, D, 0, D, false, -1, W_AB)
        CONV(0, 11, D, D, 0, D, false, -1, W_HB)
        CONV(0, 12, D, D, 0, D, false, -1, W_MO)
        CONV(0, 15, D, D, 0, D, false, 13, W_Q)
        CONV(0, 16, D, 2 * D, 0, 2 * D, false, -1, W_KV)
        CONV(1, 16, D, 2 * D, 0, 2 * D, false, -1, WS_WKV1)
        CONV(0, 17, D, D, 0, D, false, -1, W_O)
        CONV(0, 19, D, 2 * DFF, 0, 2 * DFF, true, 18, W_GU2)
        CONV(0, 20, DFF, D, 0, D, false, -1, W_DN2)
    } else if (SET == 1) {
        CONV(1, 4, D, 2 * DFF, 0, 2 * DFF, true, 3, W_GU1)
        CONV(1, 5, DFF, D, 0, D, false, -1, W_DN1)
        CONV(1, 7, D, 10752, 0, 8704, false, 6, W_IN)
    } else {
        CONV(1, 7, D, 10752, 8704, 2048, false, 6, W_IN + (size_t)8704 * D * 2)
        CONV(1, 10, 512, D, 0, D, false, -1, W_AB)
        CONV(1, 11, D, D, 0, D, false, -1, W_HB)
        CONV(1, 12, D, D, 0, D, false, -1, W_MO)
        CONV(1, 15, D, D, 0, D, false, 13, W_Q)
        CONV(1, 17, D, D, 0, D, false, -1, W_O)
        CONV(1, 19, D, 2 * DFF, 0, 2 * DFF, true, 18, W_GU2)
        CONV(1, 20, DFF, D, 0, D, false, -1, W_DN2)
    }
#undef CONV
}

DI void prologue_misc(const Args& a, int gw, int NGW, int lane, int gtid, int NGT) {
    unsigned char* ws = a.ws;
    const float* x = (const float*)a.in[0];
    bf16* Xb = (bf16*)(ws + WS_XB); float* ssq = (float*)(ws + WS_SSQ);
    for (int m = gw; m < M; m += NGW) {
        const f32x4* xr = (const f32x4*)(x + (size_t)m * D) + lane; float s = 0.f;
        unsigned long long* o8 = (unsigned long long*)(Xb + (size_t)m * D) + lane;
#pragma unroll
        for (int j = 0; j < 4; ++j) { const f32x4 v = xr[64 * j]; s += (v[0] * v[0] + v[1] * v[1]) + (v[2] * v[2] + v[3] * v[3]);
            o8[64 * j] = (unsigned long long)pk2(v[0], v[1]) | ((unsigned long long)pk2(v[2], v[3]) << 32); }
        s = wave_sum(s);
        if (lane < 16) ssq[(size_t)m * 16 + lane] = lane == 0 ? s : 0.f;
    }
    const float* mem = (const float*)a.in[1]; const float* mnorm = (const float*)a.in[14]; bf16* memN = (bf16*)(ws + WS_MEMN);
    for (int r = gw; r < 2 * MROWS; r += NGW) {
        const int l = r / MROWS, m = r % MROWS;
        const f32x4* xr = (const f32x4*)(mem + (size_t)m * D) + lane; const f32x4* gr = (const f32x4*)(mnorm + (size_t)l * D) + lane;
        f32x4 v[4]; float s = 0.f;
#pragma unroll
        for (int j = 0; j < 4; ++j) { v[j] = xr[64 * j]; s += (v[j][0] * v[j][0] + v[j][1] * v[j][1]) + (v[j][2] * v[j][2] + v[j][3] * v[j][3]); }
        const float rs = 1.0f / sqrtf(wave_sum(s) * (1.0f / D) + EPS);
        unsigned long long* o8 = (unsigned long long*)(memN + (size_t)r * D) + lane;
#pragma unroll
        for (int j = 0; j < 4; ++j) { const f32x4 g = gr[64 * j]; const f32x4 y = v[j] * rs * g;
            o8[64 * j] = (unsigned long long)pk2(y[0], y[1]) | ((unsigned long long)pk2(y[2], y[3]) << 32); }
    }
    const int* pos = (const int*)a.in[2]; float* cosT = (float*)(ws + WS_COS); float* sinT = (float*)(ws + WS_SIN);
    for (int idx = gtid; idx < M * 64; idx += NGT) {
        const int row = idx >> 6, i = idx & 63;
        const float inv = exp2f(-(float)(2 * i) * (1.0f / 128.0f) * 13.287712379549449f);
        const float ang = (float)pos[row] * inv;
        double rv = (double)ang * 0.15915494309189535; rv -= floor(rv);
        const float fr = (float)rv;
        cosT[idx] = __builtin_amdgcn_cosf(fr); sinT[idx] = __builtin_amdgcn_sinf(fr);
    }
}

DI void rope8(u32x4 x1, u32x4 x2, const float* cp, const float* sp, u32x4& o1, u32x4& o2) {
    const f32x4 c0 = *(const f32x4*)cp, c1 = *(const f32x4*)(cp + 4), s0 = *(const f32x4*)sp, s1 = *(const f32x4*)(sp + 4);
#pragma unroll
    for (int q = 0; q < 4; ++q) {
        const float ca = q < 2 ? c0[2 * q] : c1[2 * q - 4], cb = q < 2 ? c0[2 * q + 1] : c1[2 * q - 3];
        const float sa = q < 2 ? s0[2 * q] : s1[2 * q - 4], sb = q < 2 ? s0[2 * q + 1] : s1[2 * q - 3];
        const float a0 = lo16(x1[q]), a1 = hi16(x1[q]), b0 = lo16(x2[q]), b1 = hi16(x2[q]);
        o1[q] = pk2(a0 * ca - b0 * sa, a1 * cb - b1 * sb);
        o2[q] = pk2(b0 * ca + a0 * sa, b1 * cb + a1 * sb);
    }
}
constexpr int KSTR = 272, VSTR = 528, KL_BYTES = 256 * KSTR;
DI unsigned vt_off(int dh, int kgrp) { return (unsigned)(dh * VSTR + ((kgrp ^ ((dh >> 3) & 7)) << 3)); }

DI void dil_attn_phase(LAS unsigned char* L, const bf16* Z, const float* cosT, const float* sinT, bf16* OG, float* LSE, int G, int bid, int tid) {
    const int wid = __builtin_amdgcn_readfirstlane(tid >> 6), lane = tid & 63, fr = lane & 15, fq = lane >> 4;
    LAS unsigned char* KL = L; LAS unsigned char* VL = L + KL_BYTES;
    for (int unit = bid; unit < 1536; unit += G) {
        const int j = unit & 31, h = (unit >> 5) & 3, gb = unit >> 7, g = gb % 3, b = gb / 3;
        const int dsh = 2 * g, Lseg = T >> dsh;
        const int p0 = 128 * j, r = p0 / Lseg, u0 = p0 & (Lseg - 1);
        const int tokbase = b * T + r;
        const int colq = g * 512 + h * 128, colk = 1536 + colq, colv = 3072 + colq;
        __syncthreads();
#pragma unroll
        for (int i = 0; i < 4; ++i) {
            const int p = tid + 512 * i, kk = p >> 3, pc = p & 7, uu = u0 - 128 + kk;
            u32x4 o1 = (u32x4){0u, 0u, 0u, 0u}, o2 = o1;
            if (uu >= 0) { const size_t tok = (size_t)(tokbase + (uu << dsh)); const bf16* kp = Z + tok * NATT + colk + 8 * pc;
                rope8(*(const u32x4*)kp, *(const u32x4*)(kp + 64), cosT + tok * 64 + 8 * pc, sinT + tok * 64 + 8 * pc, o1, o2); }
            *(LAS u32x4*)(KL + kk * KSTR + 16 * pc) = o1; *(LAS u32x4*)(KL + kk * KSTR + 128 + 16 * pc) = o2;
        }
#pragma unroll
        for (int i = 0; i < 8; ++i) {
            const int p = tid + 512 * i, kk = p >> 4, cb = p & 15, uu = u0 - 128 + kk;
            u32x4 x = (u32x4){0u, 0u, 0u, 0u};
            if (uu >= 0) x = *(const u32x4*)(Z + (size_t)(tokbase + (uu << dsh)) * NATT + colv + 8 * cb);
            const unsigned base = (unsigned)((((kk >> 2) ^ (cb & 7)) << 3) + (kk & 3) * 2);
#pragma unroll
            for (int jj = 0; jj < 8; ++jj) *(LAS unsigned short*)(VL + (8 * cb + jj) * VSTR + base) = (unsigned short)(x[jj >> 1] >> (16 * (jj & 1)));
        }
        const int qi = 16 * wid + fr; const size_t tq = (size_t)(tokbase + ((u0 + qi) << dsh));
        bf16x8 qf[4];
#pragma unroll
        for (int k2 = 0; k2 < 2; ++k2) { const int i0 = 32 * k2 + 8 * fq; const bf16* qp = Z + tq * NATT + colq + i0; u32x4 o1, o2;
            rope8(*(const u32x4*)qp, *(const u32x4*)(qp + 64), cosT + tq * 64 + i0, sinT + tq * 64 + i0, o1, o2); qf[k2] = mk8(o1); qf[k2 + 2] = mk8(o2); }
        __syncthreads();
        const int tw = wid & ~1;
        f32x4 s[10];
#pragma unroll
        for (int tix = 0; tix < 10; ++tix) { s[tix] = (f32x4){0.f, 0.f, 0.f, 0.f}; const int kt = tw + tix;
#pragma unroll
            for (int k4 = 0; k4 < 4; ++k4) { const bf16x8 av = *(const LAS bf16x8*)(KL + (16 * kt + fr) * KSTR + (32 * k4 + 8 * fq) * 2); s[tix] = MFMA16(av, qf[k4], s[tix]); } }
        const float scale = 0.08838834764831845f; float mx = -INFINITY;
#pragma unroll
        for (int tix = 0; tix < 10; ++tix)
#pragma unroll
            for (int e = 0; e < 4; ++e) { const int kk = 16 * (tw + tix) + 4 * fq + e; const bool ok = (kk >= qi) && (kk <= qi + 128) && (u0 - 128 + kk >= 0);
                const float v = ok ? s[tix][e] * scale : -INFINITY; s[tix][e] = v; mx = fmaxf(mx, v); }
        mx = fmaxf(mx, __shfl_xor(mx, 16)); mx = fmaxf(mx, __shfl_xor(mx, 32));
        float den = 0.f;
#pragma unroll
        for (int tix = 0; tix < 10; ++tix)
#pragma unroll
            for (int e = 0; e < 4; ++e) { const float p = __expf(s[tix][e] - mx); s[tix][e] = p; den += p; }
        den += __shfl_xor(den, 16); den += __shfl_xor(den, 32);
        bf16x8 pf[5];
#pragma unroll
        for (int pp = 0; pp < 5; ++pp) { u32x4 pw; pw.x = pk2(s[2 * pp][0], s[2 * pp][1]); pw.y = pk2(s[2 * pp][2], s[2 * pp][3]); pw.z = pk2(s[2 * pp + 1][0], s[2 * pp + 1][1]); pw.w = pk2(s[2 * pp + 1][2], s[2 * pp + 1][3]); pf[pp] = mk8(pw); }
        f32x4 o[8];
#pragma unroll
        for (int dt = 0; dt < 8; ++dt) { o[dt] = (f32x4){0.f, 0.f, 0.f, 0.f};
            const int dh = 16 * dt + fr, sw = (2 * dt + (fr >> 3)) & 7;
            const LAS unsigned char* va = VL + dh * VSTR + 32 * tw + ((fq ^ sw) << 3); const LAS unsigned char* vb2 = VL + dh * VSTR + 32 * tw + (((fq + 4) ^ sw) << 3);
#pragma unroll
            for (int pp = 0; pp < 5; ++pp) { const s16x4 lo = *(const LAS s16x4*)(va + 64 * pp), hi = *(const LAS s16x4*)(vb2 + 64 * pp);
                const bf16x8 vb = __builtin_shufflevector(lo, hi, 0, 1, 2, 3, 4, 5, 6, 7); o[dt] = MFMA16(pf[pp], vb, o[dt]); }
        }
        const float inv = 1.0f / den, lse = mx + __logf(den);
#pragma unroll
        for (int e = 0; e < 4; ++e) { const float iq = __shfl(inv, 4 * fq + e);
            bf16* op = OG + (size_t)(tokbase + ((u0 + 16 * wid + 4 * fq + e) << dsh)) * 1536 + colq + fr;
#pragma unroll
            for (int dt = 0; dt < 8; ++dt) op[16 * dt] = (bf16)f2bf(o[dt][e] * iq); }
        if (lane < 16) LSE[tq * 12 + g * 4 + h] = lse;
    }
}

DI void merge_phase(const bf16* OG, const float* LSE, bf16* AO, int gtid, int NGT) {
    for (int idx = gtid; idx < M * 64; idx += NGT) {
        const int tok = idx >> 6, h = (idx >> 4) & 3, c = idx & 15;
        const float l0 = LSE[(size_t)tok * 12 + h], l1 = LSE[(size_t)tok * 12 + 4 + h], l2 = LSE[(size_t)tok * 12 + 8 + h];
        const float mx = fmaxf(l0, fmaxf(l1, l2)); float w0 = __expf(l0 - mx), w1 = __expf(l1 - mx), w2 = __expf(l2 - mx); const float inv = 1.0f / (w0 + w1 + w2); w0 *= inv; w1 *= inv; w2 *= inv;
        const bf16* p = OG + (size_t)tok * 1536 + h * 128 + 8 * c;
        const u32x4 a = *(const u32x4*)p, b = *(const u32x4*)(p + 512), d = *(const u32x4*)(p + 1024); u32x4 o;
#pragma unroll
        for (int q = 0; q < 4; ++q) o[q] = pk2(w0 * lo16(a[q]) + w1 * lo16(b[q]) + w2 * lo16(d[q]), w0 * hi16(a[q]) + w1 * hi16(b[q]) + w2 * hi16(d[q]));
        *(u32x4*)(AO + (size_t)tok * 512 + h * 128 + 8 * c) = o;
    }
}

DI void xattn_stage_vt(LAS unsigned char* VL, const bf16* memVT, int b, int h, int hh, int tid) {
#pragma unroll
    for (int i = 0; i < 8; ++i) { const int p = tid + 512 * i, dhr = p >> 5, c = p & 31;
        const u32x4 x = *(const u32x4*)(memVT + (size_t)(h * 256 + 128 * hh + dhr) * MROWS + b * NMEM + 8 * c);
        u32x2 lo, hi; lo.x = x.x; lo.y = x.y; hi.x = x.z; hi.y = x.w;
        *(LAS u32x2*)(VL + vt_off(dhr, 2 * c)) = lo; *(LAS u32x2*)(VL + vt_off(dhr, 2 * c + 1)) = hi; }
}
DI void xattn_phase(LAS unsigned char* L, const bf16* Qx, const bf16* memK, const bf16* memVT, bf16* Ox, int G, int bid, int tid) {
    const int wid = __builtin_amdgcn_readfirstlane(tid >> 6), lane = tid & 63, fr = lane & 15, fq = lane >> 4;
    LAS unsigned char* KL = L; LAS unsigned char* VL = L + KL_BYTES;
    for (int unit = bid; unit < 512; unit += G) {
        const int j = unit & 31, h = (unit >> 5) & 3, b = unit >> 7;
        const int tok0 = b * T + 128 * j; const size_t tq = (size_t)(tok0 + 16 * wid + fr);
        bf16x8 qf[8];
#pragma unroll
        for (int k = 0; k < 8; ++k) qf[k] = *(const bf16x8*)(Qx + tq * D + h * 256 + 32 * k + 8 * fq);
        f32x4 s[16];
#pragma unroll
        for (int kt = 0; kt < 16; ++kt) s[kt] = (f32x4){0.f, 0.f, 0.f, 0.f};
#pragma unroll
        for (int hh = 0; hh < 2; ++hh) {
            __syncthreads();
#pragma unroll
            for (int i = 0; i < 8; ++i) { const int p = tid + 512 * i, m = p >> 4, cb = p & 15;
                *(LAS u32x4*)(KL + m * KSTR + 16 * cb) = *(const u32x4*)(memK + (size_t)(b * NMEM + m) * D + h * 256 + 128 * hh + 8 * cb); }
            if (hh == 0) xattn_stage_vt(VL, memVT, b, h, 0, tid);
            __syncthreads();
#pragma unroll
            for (int kt = 0; kt < 16; ++kt)
#pragma unroll
                for (int k4 = 0; k4 < 4; ++k4) { const bf16x8 av = *(const LAS bf16x8*)(KL + (16 * kt + fr) * KSTR + (32 * k4 + 8 * fq) * 2); s[kt] = MFMA16(av, qf[4 * hh + k4], s[kt]); }
        }
        float mx = -INFINITY;
#pragma unroll
        for (int kt = 0; kt < 16; ++kt)
#pragma unroll
            for (int e = 0; e < 4; ++e) { const float v = s[kt][e] * 0.0625f; s[kt][e] = v; mx = fmaxf(mx, v); }
        mx = fmaxf(mx, __shfl_xor(mx, 16)); mx = fmaxf(mx, __shfl_xor(mx, 32));
        float den = 0.f;
#pragma unroll
        for (int kt = 0; kt < 16; ++kt)
#pragma unroll
            for (int e = 0; e < 4; ++e) { const float p = __expf(s[kt][e] - mx); s[kt][e] = p; den += p; }
        den += __shfl_xor(den, 16); den += __shfl_xor(den, 32);
        bf16x8 pf[8];
#pragma unroll
        for (int pp = 0; pp < 8; ++pp) { u32x4 pw; pw.x = pk2(s[2 * pp][0], s[2 * pp][1]); pw.y = pk2(s[2 * pp][2], s[2 * pp][3]); pw.z = pk2(s[2 * pp + 1][0], s[2 * pp + 1][1]); pw.w = pk2(s[2 * pp + 1][2], s[2 * pp + 1][3]); pf[pp] = mk8(pw); }
        const float inv = 1.0f / den; float iq[4];
#pragma unroll
        for (int e = 0; e < 4; ++e) iq[e] = __shfl(inv, 4 * fq + e);
#pragma unroll
        for (int hh = 0; hh < 2; ++hh) {
            if (hh == 1) { __syncthreads(); xattn_stage_vt(VL, memVT, b, h, 1, tid); __syncthreads(); }
            f32x4 o[8];
#pragma unroll
            for (int dt = 0; dt < 8; ++dt) { o[dt] = (f32x4){0.f, 0.f, 0.f, 0.f};
                const int dh = 16 * dt + fr, sw = (2 * dt + (fr >> 3)) & 7;
                const LAS unsigned char* va = VL + dh * VSTR + ((fq ^ sw) << 3); const LAS unsigned char* vb2 = VL + dh * VSTR + (((fq + 4) ^ sw) << 3);
#pragma unroll
                for (int pp = 0; pp < 8; ++pp) { const s16x4 lo = *(const LAS s16x4*)(va + 64 * pp), hi = *(const LAS s16x4*)(vb2 + 64 * pp);
                    const bf16x8 vb = __builtin_shufflevector(lo, hi, 0, 1, 2, 3, 4, 5, 6, 7); o[dt] = MFMA16(pf[pp], vb, o[dt]); }
            }
#pragma unroll
            for (int e = 0; e < 4; ++e) { bf16* op = Ox + (size_t)(tok0 + 16 * wid + 4 * fq + e) * D + h * 256 + 128 * hh + fr;
#pragma unroll
                for (int dt = 0; dt < 8; ++dt) op[16 * dt] = (bf16)f2bf(o[dt][e] * iq[e]); }
        }
    }
}

constexpr int H1_QA = 0, H1_KA = 64 * 272, H1_VT = 2 * 64 * 272, H1_TOT = H1_VT + 128 * 144;
template <bool DRY> DI void hgrn1_phase(LAS unsigned char* L, bf16* Z2, const float* lbraw, int layer, float* DEC, unsigned long long* OI, int G, int bid, int tid) {
    const int wid = __builtin_amdgcn_readfirstlane(tid >> 6), lane = tid & 63, fr = lane & 15, fq = lane >> 4;
    const int n = tid & 127, rg = tid >> 7, tt = wid & 3, vh = wid >> 2;
    LAS float* TOT = (LAS float*)(L + H1_TOT);
    for (int unit = bid; unit < 2048; unit += G) {
        const int c = unit & 63, h = (unit >> 6) & 7, b = unit >> 9, tok0 = b * T + 64 * c, ch = h * 128 + n;
        float lbv = 0.f;
        if (layer > 0) { const float e0 = lbraw[ch], e1 = lbraw[D + ch]; lbv = 1.0f / (1.0f + expf(e0 - e1)); }
        float q[16], cs[16], kg[16]; unsigned short vr[16];
        bf16* base = Z2 + (size_t)(tok0 + 16 * rg) * NH2 + ch;
#pragma unroll
        for (int r = 0; r < 16; ++r) { const bf16* p = base + (size_t)r * NH2; q[r] = bf2f(p[0]); cs[r] = bf2f(p[1024]); vr[r] = p[2048]; }
        float run = 0.f;
#pragma unroll
        for (int r = 0; r < 16; ++r) { const float fl = cs[r]; const float sg = __builtin_amdgcn_rcpf(1.0f + __expf(-fl)); const float f = lbv + (1.0f - lbv) * sg;
            kg[r] = (1.0f - lbv) * (1.0f - sg); run += __logf(f); cs[r] = run; }
        asm volatile("s_waitcnt vmcnt(0)" ::: "memory");
        TOT[rg * 128 + n] = run;
        __syncthreads();
        const float t0 = TOT[n], t1 = TOT[128 + n], t2 = TOT[256 + n], t3 = TOT[384 + n];
        const float off = rg == 0 ? 0.f : (rg == 1 ? t0 : (rg == 2 ? t0 + t1 : t0 + t1 + t2));
        const float bmid = t0 + t1, blast = (t0 + t1) + (t2 + t3);
        const float qscale = 0.08838834764831845f;
        float kh[16];
#pragma unroll
        for (int r = 0; r < 16; ++r) { const float bt = off + cs[r]; const float qs = q[r] * qscale; const int row = 16 * rg + r;
            if (!DRY) base[(size_t)r * NH2] = (bf16)f2bf(qs * __expf(bt));
            *(LAS unsigned short*)(L + H1_QA + row * 272 + n * 2) = (unsigned short)f2bf(qs * __expf(bt - bmid));
            *(LAS unsigned short*)(L + H1_KA + row * 272 + n * 2) = (unsigned short)f2bf(kg[r] * __expf(bmid - bt));
            kh[r] = kg[r] * __expf(blast - bt); }
        u32x4 k0, k1, v0, v1;
#pragma unroll
        for (int qd = 0; qd < 4; ++qd) { k0[qd] = pk2(kh[2 * qd], kh[2 * qd + 1]); k1[qd] = pk2(kh[8 + 2 * qd], kh[9 + 2 * qd]);
            v0[qd] = (unsigned)vr[2 * qd] | ((unsigned)vr[2 * qd + 1] << 16); v1[qd] = (unsigned)vr[8 + 2 * qd] | ((unsigned)vr[9 + 2 * qd] << 16); }
        bf16* slot = Z2 + (size_t)(tok0 + (n >> 1)) * NH2 + h * 128 + (n & 1) * 64 + 16 * rg;
        if (!DRY) { *(u32x4*)(slot + 1024) = k0; *(u32x4*)(slot + 1024 + 8) = k1;
        *(u32x4*)(slot + 2048) = v0; *(u32x4*)(slot + 2048 + 8) = v1; }
        *(LAS u32x4*)(L + H1_VT + n * 144 + 32 * rg) = v0; *(LAS u32x4*)(L + H1_VT + n * 144 + 32 * rg + 16) = v1;
        if (!DRY && rg == 0) DEC[(size_t)unit * 128 + n] = __expf(blast);
        __syncthreads();
        bf16x8 bq[4];
#pragma unroll
        for (int k4 = 0; k4 < 4; ++k4) bq[k4] = *(const LAS bf16x8*)(L + H1_QA + (16 * tt + fr) * 272 + (32 * k4 + 8 * fq) * 2);
        f32x4 at[4];
#pragma unroll
        for (int st = 0; st < 4; ++st) { at[st] = (f32x4){0.f, 0.f, 0.f, 0.f};
            if (st <= tt) {
#pragma unroll
                for (int k4 = 0; k4 < 4; ++k4) { const bf16x8 av = *(const LAS bf16x8*)(L + H1_KA + (16 * st + fr) * 272 + (32 * k4 + 8 * fq) * 2); at[st] = MFMA16(av, bq[k4], at[st]); }
                if (st == tt) {
#pragma unroll
                    for (int e = 0; e < 4; ++e) if (4 * fq + e > fr) at[st][e] = 0.f; }
            } }
        bf16x8 pf[2];
#pragma unroll
        for (int pp = 0; pp < 2; ++pp) { u32x4 pw; pw.x = pk2(at[2 * pp][0], at[2 * pp][1]); pw.y = pk2(at[2 * pp][2], at[2 * pp][3]); pw.z = pk2(at[2 * pp + 1][0], at[2 * pp + 1][1]); pw.w = pk2(at[2 * pp + 1][2], at[2 * pp + 1][3]); pf[pp] = mk8(pw); }
#pragma unroll
        for (int vi = 0; vi < 4; ++vi) { const int vt = 4 * vh + vi; f32x4 o = (f32x4){0.f, 0.f, 0.f, 0.f};
#pragma unroll
            for (int pp = 0; pp < 2; ++pp) { const LAS unsigned char* vp = L + H1_VT + (16 * vt + fr) * 144 + (32 * pp + 4 * fq) * 2;
                const s16x4 lo = *(const LAS s16x4*)vp, hi = *(const LAS s16x4*)(vp + 32);
                const bf16x8 vb = __builtin_shufflevector(lo, hi, 0, 1, 2, 3, 4, 5, 6, 7); o = MFMA16(vb, pf[pp], o); }
            if (!DRY) OI[((size_t)(unit * 4 + tt) * 8 + vt) * 64 + lane] = (unsigned long long)pk2(o[0], o[1]) | ((unsigned long long)pk2(o[2], o[3]) << 32);
            }
    }
}

constexpr int H2_BUF = 36352, H2_KHT = 17408, H2_DEC = 35840;
template <bool DRY> DI void hgrn2_phase(LAS unsigned char* L, bf16* Z2, const float* DEC, const unsigned long long* OI, int bh2, int tid) {
    const int wv = __builtin_amdgcn_readfirstlane(tid >> 6), lane = tid & 63, fr = lane & 15, fq = lane >> 4;
    const int bh = bh2 >> 1, w = 4 * (bh2 & 1) + (wv & 3); const bool cw = wv < 4;
    const int b = bh >> 3, h = bh & 7, unit0 = bh * 64, vcol = 16 * w + fr;
    u32x4 sq[2], sk[2]; f32x4 sd = (f32x4){0.f, 0.f, 0.f, 0.f};
#define H2_LOAD(cc) do { const int tok0_ = b * T + 64 * (cc); _Pragma("unroll") for (int i = 0; i < 2; ++i) { const int p = tid + 512 * i, row = p >> 4, cb = p & 15; \
        const bf16* rp = Z2 + (size_t)(tok0_ + row) * NH2 + h * 128 + 8 * cb; sq[i] = *(const u32x4*)rp; sk[i] = *(const u32x4*)(rp + 1024); } \
        if (tid < 32) sd = *(const f32x4*)(DEC + (size_t)(unit0 + (cc)) * 128 + 4 * tid); } while (0)
#define H2_WRITE(bi) do { LAS unsigned char* B_ = L + (bi) * H2_BUF; _Pragma("unroll") for (int i = 0; i < 2; ++i) { const int p = tid + 512 * i, row = p >> 4, cb = p & 15; \
        *(LAS u32x4*)(B_ + row * 272 + 16 * cb) = sq[i]; *(LAS u32x4*)(B_ + H2_KHT + (2 * row + (cb >> 3)) * 144 + 16 * (cb & 7)) = sk[i]; } \
        if (tid < 32) *(LAS f32x4*)(B_ + H2_DEC + 16 * tid) = sd; } while (0)
#define H2_PRIV(cc, VT_, OI_) do { const int tok0_ = b * T + 64 * (cc); \
        const bf16* vp_ = Z2 + (size_t)(tok0_ + (vcol >> 1)) * NH2 + 2048 + h * 128 + (vcol & 1) * 64 + 8 * fq; VT_[0] = *(const u32x4*)vp_; VT_[1] = *(const u32x4*)(vp_ + 32); \
        _Pragma("unroll") for (int tt_ = 0; tt_ < 4; ++tt_) OI_[tt_] = OI[((size_t)((unit0 + (cc)) * 4 + tt_) * 8 + w) * 64 + lane]; } while (0)
    u32x4 vtf[2]; unsigned long long oi[4];
    H2_LOAD(0); H2_WRITE(0); H2_PRIV(0, vtf, oi);
    f32x4 S[8];
#pragma unroll
    for (int nt = 0; nt < 8; ++nt) S[nt] = (f32x4){0.f, 0.f, 0.f, 0.f};
    __syncthreads();
    for (int c = 0; c < 64; ++c) {
        LAS unsigned char* Bc = L + (c & 1) * H2_BUF;
        asm volatile("" : "+v"(vtf[0]), "+v"(vtf[1]), "+v"(oi[0]), "+v"(oi[1]), "+v"(oi[2]), "+v"(oi[3]));
        u32x4 nvt[2]; unsigned long long noi[4];
        const int cn = c + 1 < 64 ? c + 1 : c;
        H2_LOAD(cn); H2_PRIV(cn, nvt, noi);
        if (cw) {
        bf16x8 qa[4][4];
#pragma unroll
        for (int tt = 0; tt < 4; ++tt)
#pragma unroll
            for (int np = 0; np < 4; ++np) { const LAS unsigned char* qp = Bc + (16 * tt + fr) * 272 + (32 * np + 4 * fq) * 2;
                const s16x4 lo = *(const LAS s16x4*)qp, hi = *(const LAS s16x4*)(qp + 32); qa[tt][np] = __builtin_shufflevector(lo, hi, 0, 1, 2, 3, 4, 5, 6, 7); }
        bf16x8 sb[4];
#pragma unroll
        for (int np = 0; np < 4; ++np) { u32x4 pw; pw.x = pk2(S[2 * np][0], S[2 * np][1]); pw.y = pk2(S[2 * np][2], S[2 * np][3]); pw.z = pk2(S[2 * np + 1][0], S[2 * np + 1][1]); pw.w = pk2(S[2 * np + 1][2], S[2 * np + 1][3]); sb[np] = mk8(pw); }
        f32x4 o[4];
#pragma unroll
        for (int tt = 0; tt < 4; ++tt) { const unsigned lo = (unsigned)oi[tt], hi = (unsigned)(oi[tt] >> 32); o[tt] = (f32x4){lo16(lo), hi16(lo), lo16(hi), hi16(hi)}; }
#pragma unroll
        for (int np = 0; np < 4; ++np)
#pragma unroll
            for (int tt = 0; tt < 4; ++tt) o[tt] = MFMA16(sb[np], qa[tt][np], o[tt]);
        const int tok0 = b * T + 64 * c;
        if (!DRY) {
#pragma unroll
            for (int tt = 0; tt < 4; ++tt) *(unsigned long long*)(Z2 + (size_t)(tok0 + 16 * tt + fr) * NH2 + h * 128 + 16 * w + 4 * fq) = (unsigned long long)pk2(o[tt][0], o[tt][1]) | ((unsigned long long)pk2(o[tt][2], o[tt][3]) << 32);
        } else { asm volatile("" :: "v"(o[0]), "v"(o[1]), "v"(o[2]), "v"(o[3])); }
        bf16x8 ka[8][2];
#pragma unroll
        for (int nt = 0; nt < 8; ++nt)
#pragma unroll
            for (int ks = 0; ks < 2; ++ks) ka[nt][ks] = *(const LAS bf16x8*)(Bc + H2_KHT + (16 * nt + fr) * 144 + (32 * ks + 8 * fq) * 2);
#pragma unroll
        for (int nt = 0; nt < 8; ++nt) { const f32x4 dv = *(const LAS f32x4*)(Bc + H2_DEC + (16 * nt + 4 * fq) * 4); S[nt] = S[nt] * dv; }
#pragma unroll
        for (int ks = 0; ks < 2; ++ks)
#pragma unroll
            for (int nt = 0; nt < 8; ++nt) S[nt] = MFMA16(ka[nt][ks], mk8(vtf[ks]), S[nt]);
        }
        if (c + 1 < 64) H2_WRITE((c + 1) & 1);
        vtf[0] = nvt[0]; vtf[1] = nvt[1];
#pragma unroll
        for (int i = 0; i < 4; ++i) oi[i] = noi[i];
        LBAR();
    }
#undef H2_LOAD
#undef H2_WRITE
#undef H2_PRIV
}
DI void hgrn3_phase(bf16* Z2, const float* gain, int gtid, int NGT) {
    for (int idx = gtid; idx < M * 8 * 16; idx += NGT) {
        const int j = idx & 15, item = idx >> 4, h = item & 7, tok = item >> 3;
        const bf16* op = Z2 + (size_t)tok * NH2 + h * 128 + 8 * j; bf16* gp = Z2 + (size_t)tok * NH2 + 3072 + h * 128 + 8 * j;
        const u32x4 ov = *(const u32x4*)op, gv = *(const u32x4*)gp;
        const f32x4 g0 = *(const f32x4*)(gain + h * 128 + 8 * j), g1 = *(const f32x4*)(gain + h * 128 + 8 * j + 4);
        float of[8], gf[8]; float ss = 0.f;
#pragma unroll
        for (int q = 0; q < 4; ++q) { of[2 * q] = lo16(ov[q]); of[2 * q + 1] = hi16(ov[q]); gf[2 * q] = lo16(gv[q]); gf[2 * q + 1] = hi16(gv[q]); ss += of[2 * q] * of[2 * q] + of[2 * q + 1] * of[2 * q + 1]; }
        ss = row16_sum(ss);
        const float rstd = __builtin_amdgcn_rsqf(ss * (1.0f / 128.0f) + EPS);
        float r[8];
#pragma unroll
        for (int q = 0; q < 8; ++q) { const float gn = q < 4 ? g0[q & 3] : g1[q & 3]; r[q] = of[q] * rstd * gn * (gf[q] * __builtin_amdgcn_rcpf(1.0f + __expf(-gf[q]))); }
        u32x4 w; w.x = pk2(r[0], r[1]); w.y = pk2(r[2], r[3]); w.z = pk2(r[4], r[5]); w.w = pk2(r[6], r[7]);
        *(u32x4*)gp = w;
    }
}

#define XB_TMO      128
#define XB_XCNT(j)  (256  + 64 * (j))
#define XB_XSUB(j)  (1280 + 64 * (j))
#define XB_XGEN(j)  (2304 + 64 * (j))
#define XB_TOP      3328
#define XB_TOPGEN   3392
#define XCD_BAR_WORDS 3456
#define XB_SPIN_CAP (1u << 18)

__device__ __forceinline__ unsigned xb_ld(unsigned* p)              { return __hip_atomic_load(p, __ATOMIC_RELAXED, __HIP_MEMORY_SCOPE_AGENT); }
__device__ __forceinline__ unsigned xb_add(unsigned* p, unsigned v) { return __hip_atomic_fetch_add(p, v, __ATOMIC_RELAXED, __HIP_MEMORY_SCOPE_AGENT); }
__device__ __forceinline__ unsigned xb_xcc_id() { return (unsigned)__builtin_amdgcn_s_getreg((3 << 11) | 20) & 0xFu; }
#define XB_SPIN(cond, bar) do { unsigned _sp = 0; while (cond) { __builtin_amdgcn_s_sleep(1); \
    if ((++_sp & 255u) == 0u) { if (xb_ld(&(bar)[XB_TMO])) break; if (_sp > XB_SPIN_CAP) { atomicAdd(&(bar)[XB_TMO], 1u); break; } } } } while (0)

struct XcdBarrier {
    unsigned* bar; unsigned x;
    volatile LAS unsigned* st;
};

__device__ __forceinline__ XcdBarrier xcd_barrier_post(unsigned* bar, volatile LAS unsigned* st) {
    XcdBarrier b; b.bar = bar; b.x = xb_xcc_id(); b.st = st;
    if (threadIdx.x == 0) (void)xb_add(&bar[XB_XCNT(b.x)], 1u);
    return b;
}
__device__ __forceinline__ void xcd_barrier_complete(unsigned* bar, unsigned x, unsigned& nloc, unsigned& nx) {
    const unsigned G = gridDim.x * gridDim.y * gridDim.z;
    unsigned sum, cnt, mine, sp = 0u;
    for (;;) {
        sum = 0u; cnt = 0u; mine = 0u;
#pragma unroll
        for (unsigned j = 0; j < 16; ++j) { const unsigned c = xb_ld(&bar[XB_XCNT(j)]); sum += c; cnt += (c > 0u) ? 1u : 0u; mine = (j == x) ? c : mine; }
        if (sum == G) break;
        __builtin_amdgcn_s_sleep(1);
        if ((++sp & 255u) == 0u) { if (xb_ld(&bar[XB_TMO])) break; if (sp > XB_SPIN_CAP) { atomicAdd(&bar[XB_TMO], 1u); break; } }
    }
    nloc = mine > 0u ? mine : 1u; nx = cnt > 0u ? cnt : 1u;
}

__device__ __forceinline__ void xcd_barrier(const XcdBarrier& b) {
    asm volatile("s_waitcnt vmcnt(0)" ::: "memory");
    __syncthreads();
    if (threadIdx.x == 0) {
        unsigned* bar = b.bar;
        __builtin_amdgcn_s_waitcnt(0);
        unsigned nloc = b.st[0], nx = b.st[1];
        if (nloc == 0u) { xcd_barrier_complete(bar, b.x, nloc, nx); b.st[0] = nloc; b.st[1] = nx; }
        const unsigned old = xb_add(&bar[XB_XSUB(b.x)], 1u);
        const unsigned gen = old / nloc;
        if (old + 1u == (gen + 1u) * nloc) {
            __builtin_amdgcn_fence(__ATOMIC_RELEASE, "agent");
            asm volatile("s_waitcnt vmcnt(0)" ::: "memory");
            const unsigned og = xb_add(&bar[XB_TOP], 1u);
            const unsigned tg = og / nx;
            if (og + 1u == (tg + 1u) * nx) xb_add(&bar[XB_TOPGEN], 1u);
            else XB_SPIN(xb_ld(&bar[XB_TOPGEN]) == tg, bar);
            __builtin_amdgcn_fence(__ATOMIC_ACQUIRE, "agent");
            xb_add(&bar[XB_XGEN(b.x)], 1u);
            asm volatile("s_waitcnt vmcnt(0)" ::: "memory");
        } else {
            XB_SPIN(xb_ld(&bar[XB_XGEN(b.x)]) == gen, bar);
            __builtin_amdgcn_fence(__ATOMIC_ACQUIRE, "agent");
            asm volatile("s_waitcnt vmcnt(0)" ::: "memory");
        }
    }
    __syncthreads();
}

#ifndef PROBE_SYNC
#define PROBE_SYNC 0
#endif
#ifndef PROBE_ATT
#define PROBE_ATT 0
#endif
#ifndef PROBE_GEMM
#define PROBE_GEMM 0
#endif
#ifndef PROBE_HG
#define PROBE_HG 0
#endif
#ifndef PROBE_CONV
#define PROBE_CONV 0
#endif
#define GSYNC() do { xcd_barrier(xbar); if (PROBE_SYNC) xcd_barrier(xbar); } while (0)
#define REP(n) for (int rep_ = 0; rep_ < 1 + (n); ++rep_)
#define FRESH() size_t zoff_ = 0; asm volatile("" : "+s"(zoff_)); unsigned char* ws = a.ws + zoff_; int tid = threadIdx.x; asm volatile("" : "+v"(tid)); \
    const int lane = tid & 63, wave = __builtin_amdgcn_readfirstlane(tid >> 6); int G = gridDim.x, bid = blockIdx.x; asm volatile("" : "+s"(G), "+s"(bid)); \
    const int gw = bid * 8 + wave, NGW = G * 8, gtid = bid * 512 + tid, NGT = G * 512; float* X = (float*)((unsigned char*)a.out + zoff_); \
    bf16* Xb = (bf16*)(ws + WS_XB); float* ssq = (float*)(ws + WS_SSQ); bf16* Z = (bf16*)(ws + WS_Z); \
    (void)lane; (void)gw; (void)NGW; (void)gtid; (void)NGT; (void)Xb; (void)ssq; (void)Z; (void)X;

__global__ void __launch_bounds__(512, 2) fwd_megakernel(Args a) {
    extern __shared__ __attribute__((aligned(16))) unsigned char lds_raw[];
    LAS unsigned char* L = (LAS unsigned char*)lds_raw;
    volatile LAS unsigned* MISC = (volatile LAS unsigned*)(L + LDS_BYTES - 64);
    if (threadIdx.x < 16) MISC[threadIdx.x] = 0u;
    __syncthreads();
    const XcdBarrier xbar = xcd_barrier_post((unsigned*)(a.ws + WS_CTL), MISC);

    REP(PROBE_CONV) { FRESH(); conv_weights<0>(a, L, gw, NGW, wave, lane); }
    { FRESH(); prologue_misc(a, gw, NGW, lane, gtid, NGT); }
    cg::this_grid().sync();

    for (int l = 0; l < 2; ++l) {
        REP(PROBE_GEMM) { FRESH(); run_gemm(L, Xb, D, (const bf16*)(ws + W_GU1), D, M, 2 * DFF, D, G, bid, EpiSwiglu{Z, ssq}); }
        GSYNC();
        { FRESH(); run_gemm(L, Z, DFF, (const bf16*)(ws + W_DN1), DFF, M, D, DFF, G, bid, EpiResid{l == 0 ? (const float*)a.in[0] : X, X, Xb, ssq, 0.5f}); }
        GSYNC();
        REP(PROBE_GEMM) { FRESH(); run_gemm(L, Xb, D, (const bf16*)(ws + W_IN), D, M, NATT, D, G, bid, EpiZ{Z, NATT, ssq}); }
        GSYNC();
        REP(PROBE_ATT) { FRESH(); dil_attn_phase(L, Z, (const float*)(ws + WS_COS), (const float*)(ws + WS_SIN), (bf16*)(ws + WS_OG), (float*)(ws + WS_LSE), G, bid, tid); }
        GSYNC();
        REP(PROBE_GEMM) { FRESH(); run_gemm(L, Xb, D, (const bf16*)(ws + W_IN) + (size_t)NATT * D, D, M, NH2, D, G, bid, EpiZ{Z, NH2, ssq}); }
        { FRESH(); merge_phase((const bf16*)(ws + WS_OG), (const float*)(ws + WS_LSE), (bf16*)(ws + WS_AO), gtid, NGT); }
        GSYNC();
#if PROBE_HG & 1
        { FRESH(); hgrn1_phase<true>(L, Z, (const float*)a.in[8], l, (float*)(ws + WS_DEC), (unsigned long long*)(ws + WS_OG), G, bid, tid); }
#endif
        { FRESH(); hgrn1_phase<false>(L, Z, (const float*)a.in[8], l, (float*)(ws + WS_DEC), (unsigned long long*)(ws + WS_OG), G, bid, tid); }
        GSYNC();
        { FRESH();
#if PROBE_HG & 2
          if (bid < 64) { hgrn2_phase<true>(L, Z, (const float*)(ws + WS_DEC), (const unsigned long long*)(ws + WS_OG), bid, tid); __syncthreads(); }
#endif
          if (bid < 64) hgrn2_phase<false>(L, Z, (const float*)(ws + WS_DEC), (const unsigned long long*)(ws + WS_OG), bid, tid);
          else if (l == 0) {
            const int G2 = G - 64, c2 = bid - 64;
#pragma unroll
            for (int ll = 0; ll < 2; ++ll) {
                const bf16* memN = (const bf16*)(ws + WS_MEMN) + (size_t)ll * MROWS * D; const bf16* Wkv = (const bf16*)(ws + (ll ? WS_WKV1 : W_KV));
                run_gemm(L, memN, D, Wkv, D, MROWS, D, D, G2, (c2 + 32 * ll) % G2, EpiZ{(bf16*)(ws + (ll ? WS_MEMK1 : WS_MEMK)), D, nullptr});
                run_gemm(L, Wkv + (size_t)D * D, D, memN, D, D, MROWS, D, G2, (c2 + 32 * ll + 16) % G2, EpiZ{(bf16*)(ws + (ll ? WS_MEMVT1 : WS_MEMVT)), MROWS, nullptr});
            }
            conv_weights<1>(a, L, c2 * 8 + wave, G2 * 8, wave, lane);
          } else conv_weights<2>(a, L, (bid - 64) * 8 + wave, (G - 64) * 8, wave, lane);
        }
        GSYNC();
        { FRESH(); hgrn3_phase(Z, (const float*)a.in[9] + (size_t)l * D, gtid, NGT); }
        GSYNC();
        REP(PROBE_GEMM) { FRESH(); run_gemm(L, Xb, D, (const bf16*)(ws + W_IN) + (size_t)(NATT + NH2) * D, D, M, 2048, D, G, bid, EpiZ{Z, NH2, ssq}); }
        GSYNC();
        { FRESH(); run_gemm(L, (const bf16*)(ws + WS_AO), 512, (const bf16*)(ws + W_AB), 512, M, D, 512, G, bid, EpiGate<false>{Z, NH2, Z + 2048, NH2}); }
        { FRESH(); run_gemm(L, Z + 3072, NH2, (const bf16*)(ws + W_HB), D, M, D, D, G, bid, EpiGate<true>{Z + 1024, NH2, Z + 2048, NH2}); }
        GSYNC();
        { FRESH(); run_gemm(L, Z + 2048, NH2, (const bf16*)(ws + W_MO), D, M, D, D, G, bid, EpiResid{X, X, Xb, ssq, 1.0f}); }
        GSYNC();
        REP(PROBE_GEMM) { FRESH(); run_gemm(L, Xb, D, (const bf16*)(ws + W_Q), D, M, D, D, G, bid, EpiZ{Z, D, ssq}); }
        GSYNC();
        REP(PROBE_ATT) { FRESH(); xattn_phase(L, Z, (const bf16*)(ws + (l ? WS_MEMK1 : WS_MEMK)), (const bf16*)(ws + (l ? WS_MEMVT1 : WS_MEMVT)), Z + (size_t)M * D, G, bid, tid); }
        GSYNC();
        { FRESH(); run_gemm(L, Z + (size_t)M * D, D, (const bf16*)(ws + W_O), D, M, D, D, G, bid, EpiResid{X, X, Xb, ssq, 1.0f}); }
        GSYNC();
        REP(PROBE_GEMM) { FRESH(); run_gemm(L, Xb, D, (const bf16*)(ws + W_GU2), D, M, 2 * DFF, D, G, bid, EpiSwiglu{Z, ssq}); }
        GSYNC();
        { FRESH(); run_gemm(L, Z, DFF, (const bf16*)(ws + W_DN2), DFF, M, D, DFF, G, bid, EpiResid{X, X, Xb, ssq, 0.5f}); }
        GSYNC();
    }
    { FRESH();
      const float* fg = (const float*)a.in[21];
      for (int m = gw; m < M; m += NGW) {
        f32x4* xr = (f32x4*)(X + (size_t)m * D) + lane; const f32x4* gr = (const f32x4*)fg + lane;
        f32x4 v[4]; float s = 0.f;
#pragma unroll
        for (int j = 0; j < 4; ++j) { v[j] = xr[64 * j]; s += (v[j][0] * v[j][0] + v[j][1] * v[j][1]) + (v[j][2] * v[j][2] + v[j][3] * v[j][3]); }
        const float rs = 1.0f / sqrtf(wave_sum(s) * (1.0f / D) + EPS);
#pragma unroll
        for (int j = 0; j < 4; ++j) xr[64 * j] = v[j] * rs * gr[64 * j];
      } }
}

extern "C" void kernel_launch(void* const* d_in, const int* in_sizes, int n_in, void* d_out, int out_size, void* d_ws, size_t ws_size, hipStream_t stream) {
    static int grid = 0;
    if (grid == 0) {
        if (n_in != 22 || out_size != M * D || ws_size < WS_END) { fprintf(stderr, "kernel_launch: unexpected shapes (n_in %d out %d ws %zu)\n", n_in, out_size, ws_size); grid = -1; return; }
        int dev = 0, cus = 0, per_cu = 0;
        hipGetDevice(&dev); hipDeviceGetAttribute(&cus, hipDeviceAttributeMultiprocessorCount, dev);
        hipFuncSetAttribute((const void*)fwd_megakernel, hipFuncAttributeMaxDynamicSharedMemorySize, LDS_BYTES);
        hipOccupancyMaxActiveBlocksPerMultiprocessor(&per_cu, (const void*)fwd_megakernel, 512, LDS_BYTES);
        if (per_cu < 1) { fprintf(stderr, "kernel_launch: occupancy query reports %d blocks per CU\n", per_cu); grid = -1; return; }
        grid = cus;
        if (grid < 128) { fprintf(stderr, "kernel_launch: too few CUs (%d)\n", grid); grid = -1; return; }
    }
    if (grid < 0) return;
    if (hipMemsetAsync((char*)d_ws + WS_CTL, 0, CTL_BYTES, stream) != hipSuccess) { fprintf(stderr, "kernel_launch: memset failed\n"); return; }
    Args a{};
    for (int i = 0; i < 22; ++i) a.in[i] = d_in[i];
    a.out = (float*)d_out; a.ws = (unsigned char*)d_ws;
    void* args[] = {&a};
    hipError_t e = hipLaunchCooperativeKernel((const void*)fwd_megakernel, dim3(grid), dim3(512), args, LDS_BYTES, stream);
    if (e != hipSuccess) fprintf(stderr, "cooperative launch failed: %s (grid %d)\n", hipGetErrorString(e), grid);
}
```

```cpp
#include <hip/hip_runtime.h>
#include <hip/hip_cooperative_groups.h>
#include <cstdio>
#include <cstdint>
namespace cg = cooperative_groups;
namespace pg8 {
#define PG8_LAS __attribute__((address_space(3)))
typedef unsigned short bf16_t;
typedef short bf16x8 __attribute__((ext_vector_type(8)));
typedef float f32x4 __attribute__((ext_vector_type(4)));
typedef unsigned u32x4 __attribute__((ext_vector_type(4)));
constexpr int BM = 256, BK = 64, HALF = 128, HTB = HALF * BK * 2  , STAGE_BYTES = 8 * HTB, NXCD = 8, WGM = 8;

__host__ __device__ __forceinline__ int lds_byte(int r, int c) { const int st = (r >> 4) * 2 + (c >> 5), rr = r & 15, cc = c & 31, ob = rr * 64 + cc * 2; return st * 1024 + (ob ^ (((ob >> 9) & 1) << 5)); }
__host__ __device__ __forceinline__ void stage_rc(int b, int& R, int& C) { const int st = b / 1024, sb = b % 1024, swz = sb ^ (((sb >> 9) & 1) << 5); R = (st >> 1) * 16 + swz / 64; C = (st & 1) * 32 + (swz % 64) / 2; }
__host__ __device__ __forceinline__ int perm32(int rho) { const int n = rho >> 4, i = rho & 15; return 8 * (i >> 2) + 4 * n + (i & 3); }

struct Unit { int pm, pn; };
struct Gemm { const bf16_t* A; const bf16_t* Bt; int M, N, K, lda, ldb; };

struct StaticOrder {
    int nM, nN, nwg, G, c;
    __host__ __device__ void init(int M, int N, int G_, int c_) { nM = M / BM; nN = N / BM; nwg = nM * nN; G = G_; c = c_; }
    __host__ __device__ bool next(int i, Unit& u) const {
        const long L = (long)i * G + c; if (L >= nwg) return false;
        int wgid = (int)L; { const int q = nwg / NXCD, r = nwg % NXCD, xcd = wgid % NXCD, off = wgid / NXCD; wgid = (xcd < r ? xcd * (q + 1) : r * (q + 1) + (xcd - r) * q) + off; }
        const int nig = WGM * nN, gid = wgid / nig, fm = gid * WGM, gsz = (nM - fm) < WGM ? (nM - fm) : WGM;
        u.pm = fm + ((wgid % nig) % gsz); u.pn = (wgid % nig) / gsz; return true;
    }
    __device__ __forceinline__ void a_ready(const Unit&) const {}
    __device__ __forceinline__ void done(const Unit&) const {}
};

template <class Epi, class Sched, bool ALIGN_EPI = false, bool SP2 = false>
__device__ __forceinline__ void gemm_phase(PG8_LAS unsigned char* lds, const Gemm g, const Sched& S, const Epi& E) {
    int tid_ = threadIdx.x; asm volatile("" : "+v"(tid_)); const int tid = tid_, wid = __builtin_amdgcn_readfirstlane(tid >> 6), lane = tid & 63, wr = wid >> 2, wc = wid & 3, fr = lane & 15, fq = lane >> 4;
    const int K = g.K, nt = K / BK;
    unsigned voffA[2], voffB[2];
#pragma unroll
    for (int i = 0; i < 2; ++i) { int R, C; stage_rc(tid * 16 + i * 8192, R, C); const int Rb = Epi::PERM ? ((R & ~31) + perm32(R & 31)) : R;
        voffA[i] = (unsigned)(R * g.lda + C) * 2u; voffB[i] = (unsigned)(Rb * g.ldb + C) * 2u; }
    const size_t kstep = (size_t)(BK * 2);
    const size_t hstepA = (size_t)HALF * g.lda * 2, hstepB = (size_t)HALF * g.ldb * 2;
    const size_t tstepA = 2 * hstepA, tstepB = 2 * hstepB;
    const unsigned ldsw = (unsigned)wid * 1024u;
    const int aoff = lds_byte(wr * 64 + fr, fq * 8), boff = lds_byte(wc * 32 + fr, fq * 8);
#define PG8_SA(b, h) (((b) * 2 + (h)) * HTB)
#define PG8_SB(b, h) ((4 + (b) * 2 + (h)) * HTB)
#define PG8_STAGE(bufoff, gbase, voff) do { _Pragma("unroll") for (int _i = 0; _i < 2; ++_i) \
        __builtin_amdgcn_global_load_lds((const unsigned*)((const char*)(gbase) + (voff)[_i]), (PG8_LAS unsigned*)(lds + (bufoff) + ldsw + _i * 8192), 16, 0, 0); } while (0)
#define PG8_LDA(dst, b, h) do { _Pragma("unroll") for (int m = 0; m < 4; ++m) _Pragma("unroll") for (int k = 0; k < 2; ++k) dst[m][k] = *(const PG8_LAS bf16x8*)(lds + PG8_SA(b, h) + aoff + m * 2048 + k * 1024); } while (0)
#define PG8_LDB(dst, b, h) do { _Pragma("unroll") for (int n = 0; n < 2; ++n) _Pragma("unroll") for (int k = 0; k < 2; ++k) dst[n][k] = *(const PG8_LAS bf16x8*)(lds + PG8_SB(b, h) + boff + n * 2048 + k * 1024); } while (0)
#define PG8_MMA(ai, bj, At, Bt) do { __builtin_amdgcn_s_setprio(1); _Pragma("unroll") for (int m = 0; m < 4; ++m) _Pragma("unroll") for (int n = 0; n < 2; ++n) _Pragma("unroll") for (int k = 0; k < 2; ++k) \
        acc[ai][bj][m][n] = __builtin_amdgcn_mfma_f32_16x16x32_bf16(Bt[n][k], At[m][k], acc[ai][bj][m][n], 0, 0, 0); __builtin_amdgcn_s_setprio(0); } while (0)
#define PG8_WAIT_V(n) asm volatile("s_waitcnt vmcnt(" #n ")" ::: "memory")
#define PG8_WAIT_L(n) asm volatile("s_waitcnt lgkmcnt(" #n ")" ::: "memory")
#define PG8_BAR __builtin_amdgcn_s_barrier()
#define PG8_SCHED __builtin_amdgcn_sched_barrier(0)
    Unit cur, nxt; int ui = 0;
    if (!S.next(0, cur)) return;
    f32x4 acc[2][2][4][2];
#pragma unroll
    for (int a = 0; a < 2; ++a)
#pragma unroll
        for (int b = 0; b < 2; ++b)
#pragma unroll
            for (int m = 0; m < 4; ++m)
#pragma unroll
                for (int n = 0; n < 2; ++n) acc[a][b][m][n] = (f32x4){0.f, 0.f, 0.f, 0.f};
    bf16x8 At[4][2], B0[2][2], B1[2][2];
    const char* cA = (const char*)g.A + (size_t)cur.pm * tstepA; const char* cB = (const char*)g.Bt + (size_t)cur.pn * tstepB;
    S.a_ready(cur);
    if constexpr (SP2) {
        PG8_STAGE(PG8_SB(0, 0), cB, voffB); PG8_STAGE(PG8_SB(0, 1), cB + hstepB, voffB); PG8_STAGE(PG8_SA(0, 0), cA, voffA); PG8_STAGE(PG8_SA(0, 1), cA + hstepA, voffA);
        if (wr == 1) PG8_BAR;
        PG8_WAIT_V(2); PG8_BAR;
        PG8_STAGE(PG8_SB(1, 0), cB + kstep, voffB); PG8_STAGE(PG8_SA(1, 0), cA + kstep, voffA); PG8_STAGE(PG8_SB(1, 1), cB + hstepB + kstep, voffB);
        PG8_WAIT_V(6); PG8_BAR;
    } else {
        PG8_STAGE(PG8_SB(0, 0), cB, voffB); PG8_STAGE(PG8_SA(0, 0), cA, voffA); PG8_STAGE(PG8_SB(0, 1), cB + hstepB, voffB); PG8_STAGE(PG8_SA(0, 1), cA + hstepA, voffA);
        if (wr == 1) PG8_BAR;
        PG8_WAIT_V(4); PG8_BAR;
        PG8_STAGE(PG8_SB(1, 0), cB + kstep, voffB); PG8_STAGE(PG8_SA(1, 0), cA + kstep, voffA); PG8_STAGE(PG8_SB(1, 1), cB + hstepB + kstep, voffB);
        PG8_WAIT_V(6); PG8_BAR;
    }
    for (;;) {
        const bool has_next = S.next(ui + 1, nxt);
        const char* nA = has_next ? (const char*)g.A + (size_t)nxt.pm * tstepA : cA; const char* nB = has_next ? (const char*)g.Bt + (size_t)nxt.pn * tstepB : cB;
        for (int t = 0; t < nt; t += 2) {
            const bool last = (t == nt - 2);
            const char* a1 = cA + (size_t)(t + 1) * kstep;
            const char* a2 = last ? nA : cA + (size_t)(t + 2) * kstep; const char* b2 = last ? nB : cB + (size_t)(t + 2) * kstep;
            const char* a3 = a2 + kstep; const char* b3 = b2 + kstep;
            if (last && has_next) S.a_ready(nxt);
            if constexpr (SP2) {
            PG8_LDB(B0, 0, 0); PG8_LDB(B1, 0, 1); PG8_SCHED; PG8_LDA(At, 0, 0); PG8_STAGE(PG8_SA(1, 1), a1 + hstepA, voffA);
            PG8_WAIT_V(8); PG8_WAIT_L(0); PG8_BAR; PG8_MMA(0, 0, At, B0); PG8_MMA(0, 1, At, B1); PG8_BAR; PG8_SCHED;
            PG8_LDA(At, 0, 1); PG8_STAGE(PG8_SB(0, 0), b2, voffB); PG8_STAGE(PG8_SB(0, 1), b2 + hstepB, voffB); PG8_STAGE(PG8_SA(0, 0), a2, voffA);
            PG8_WAIT_V(8); PG8_WAIT_L(0); PG8_BAR; PG8_MMA(1, 0, At, B0); PG8_MMA(1, 1, At, B1); PG8_BAR; PG8_SCHED;
            PG8_LDB(B0, 1, 0); PG8_LDB(B1, 1, 1); PG8_SCHED; PG8_LDA(At, 1, 0); PG8_STAGE(PG8_SA(0, 1), a2 + hstepA, voffA);
            PG8_WAIT_V(8); PG8_WAIT_L(0); PG8_BAR; PG8_MMA(0, 0, At, B0); PG8_MMA(0, 1, At, B1); PG8_BAR; PG8_SCHED;
            PG8_LDA(At, 1, 1); PG8_STAGE(PG8_SB(1, 0), b3, voffB); PG8_STAGE(PG8_SB(1, 1), b3 + hstepB, voffB); PG8_STAGE(PG8_SA(1, 0), a3, voffA);
            PG8_WAIT_V(8); PG8_WAIT_L(0); PG8_BAR; PG8_MMA(1, 0, At, B0); PG8_MMA(1, 1, At, B1); PG8_BAR; PG8_SCHED;
            } else {
            PG8_LDB(B0, 0, 0); PG8_SCHED; PG8_LDA(At, 0, 0); PG8_STAGE(PG8_SA(1, 1), a1 + hstepA, voffA);
            PG8_WAIT_L(8); PG8_BAR; PG8_WAIT_L(0); PG8_MMA(0, 0, At, B0); PG8_BAR; PG8_SCHED;
            PG8_LDB(B1, 0, 1); PG8_STAGE(PG8_SB(0, 0), b2, voffB);
            PG8_BAR; PG8_WAIT_L(0); PG8_MMA(0, 1, At, B1); PG8_BAR;
            PG8_LDA(At, 0, 1); PG8_STAGE(PG8_SA(0, 0), a2, voffA);
            PG8_BAR; PG8_WAIT_L(0); PG8_MMA(1, 0, At, B0); PG8_BAR; PG8_SCHED;
            PG8_STAGE(PG8_SB(0, 1), b2 + hstepB, voffB);
            PG8_WAIT_V(6); PG8_BAR; PG8_MMA(1, 1, At, B1); PG8_BAR;
            PG8_LDB(B0, 1, 0); PG8_SCHED; PG8_LDA(At, 1, 0); PG8_STAGE(PG8_SA(0, 1), a2 + hstepA, voffA);
            PG8_WAIT_L(8); PG8_BAR; PG8_WAIT_L(0); PG8_MMA(0, 0, At, B0); PG8_BAR; PG8_SCHED;
            PG8_LDB(B1, 1, 1); PG8_STAGE(PG8_SB(1, 0), b3, voffB);
            PG8_BAR; PG8_WAIT_L(0); PG8_MMA(0, 1, At, B1); PG8_BAR;
            PG8_LDA(At, 1, 1); PG8_STAGE(PG8_SA(1, 0), a3, voffA);
            PG8_BAR; PG8_WAIT_L(0); PG8_MMA(1, 0, At, B0); PG8_BAR; PG8_SCHED;
            PG8_STAGE(PG8_SB(1, 1), b3 + hstepB, voffB);
            PG8_WAIT_V(6); PG8_BAR; PG8_MMA(1, 1, At, B1); PG8_BAR;
            }
        }
        if constexpr (ALIGN_EPI) { if (wr == 0) PG8_BAR; }
        if constexpr (!Epi::AFTER_DRAIN) { E(acc, cur, wr, wc, fr, fq); S.done(cur); }
        if (!has_next) break;
#pragma unroll
        for (int a = 0; a < 2; ++a)
#pragma unroll
            for (int b = 0; b < 2; ++b)
#pragma unroll
                for (int m = 0; m < 4; ++m)
#pragma unroll
                    for (int n = 0; n < 2; ++n) acc[a][b][m][n] = (f32x4){0.f, 0.f, 0.f, 0.f};
        cur = nxt; cA = nA; cB = nB; ++ui;
        if constexpr (ALIGN_EPI) { if (wr == 1) PG8_BAR; }
    }
    PG8_WAIT_V(0);
    if constexpr (!ALIGN_EPI) { if (wr == 0) PG8_BAR; }
    PG8_BAR;
    if constexpr (Epi::AFTER_DRAIN) { E.fused(acc, cur, wr, wc, fr, fq, lds, wid, lane); S.done(cur); }
#undef PG8_SA
#undef PG8_SB
#undef PG8_STAGE
#undef PG8_LDA
#undef PG8_LDB
#undef PG8_MMA
#undef PG8_WAIT_V
#undef PG8_WAIT_L
#undef PG8_BAR
#undef PG8_SCHED
}
}

#define DI __device__ __forceinline__
#define LAS __attribute__((address_space(3)))
typedef unsigned short bf16;
typedef short bf16x8 __attribute__((ext_vector_type(8)));
typedef short s16x4 __attribute__((ext_vector_type(4)));
typedef float f32x4 __attribute__((ext_vector_type(4)));
typedef unsigned u32x4 __attribute__((ext_vector_type(4)));
typedef unsigned u32x2 __attribute__((ext_vector_type(2)));
using pg8::Unit;

constexpr int NB = 4, T = 4096, D = 1024, M = NB * T, DFF = 2816, NMEM = 256, MROWS = NB * NMEM;
constexpr int NATT = 4608, NH2 = 4096;
constexpr float EPS = 1e-6f;
constexpr int LDS_BYTES = 147456;

constexpr size_t MiB = 1u << 20;
constexpr size_t W_GU1 = 0, W_DN1 = W_GU1 + (size_t)2 * DFF * D * 2, W_IN = W_DN1 + (size_t)D * DFF * 2, W_AB = W_IN + (size_t)10752 * D * 2,
                 W_HB = W_AB + (size_t)D * 512 * 2, W_MO = W_HB + (size_t)D * D * 2, W_Q = W_MO + (size_t)D * D * 2, W_KV = W_Q + (size_t)D * D * 2,
                 W_O = W_KV + (size_t)2 * D * D * 2, W_GU2 = W_O + (size_t)D * D * 2, W_DN2 = W_GU2 + (size_t)2 * DFF * D * 2, W_END = W_DN2 + (size_t)D * DFF * 2;
static_assert(W_END <= 68 * MiB, "weights");
constexpr size_t WS_XB = 68 * MiB, WS_Z = 100 * MiB, WS_OG = 244 * MiB, WS_AO = 292 * MiB, WS_COS = 308 * MiB, WS_SIN = 312 * MiB, WS_MEMN = 316 * MiB,
                 WS_MEMK = 320 * MiB, WS_MEMVT = 322 * MiB, WS_SSQ = 324 * MiB, WS_DEC = 325 * MiB, WS_LSE = 326 * MiB, WS_CTL = 327 * MiB, CTL_BYTES = 65536, WS_WKV1 = 328 * MiB, WS_MEMK1 = 332 * MiB, WS_MEMVT1 = 334 * MiB, WS_END = 336 * MiB;

DI float bf2f(unsigned short h) { return __uint_as_float((unsigned)h << 16); }
typedef __bf16 bf2_t __attribute__((ext_vector_type(2)));
typedef float f32x2_t __attribute__((ext_vector_type(2)));
DI unsigned pk2(float lo, float hi) { const bf2_t r = __builtin_convertvector((f32x2_t){lo, hi}, bf2_t); return __builtin_bit_cast(unsigned, r); }
DI unsigned f2bf(float f) { return pk2(f, 0.f) & 0xffffu; }
template <int N> DI float rr_add(float v) { return v + __int_as_float(__builtin_amdgcn_update_dpp(0, __float_as_int(v), 0x120 + N, 0xf, 0xf, false)); }
DI float row16_sum(float v) { v = rr_add<1>(v); v = rr_add<2>(v); v = rr_add<4>(v); v = rr_add<8>(v); return v; }
#define LBAR() do { asm volatile("s_waitcnt lgkmcnt(0)" ::: "memory"); __builtin_amdgcn_s_barrier(); asm volatile("" ::: "memory"); } while (0)
DI float lo16(unsigned u) { return __uint_as_float(u << 16); }
DI float hi16(unsigned u) { return __uint_as_float(u & 0xffff0000u); }
DI float wave_sum(float v) {
#pragma unroll
    for (int o = 1; o < 64; o <<= 1) v += __shfl_xor(v, o);
    return v;
}
DI float sigmoidf_(float x) { return 1.0f / (1.0f + __expf(-x)); }
DI bf16x8 mk8(u32x4 v) { return __builtin_bit_cast(bf16x8, v); }
#define MFMA16(a, b, c) __builtin_amdgcn_mfma_f32_16x16x32_bf16((a), (b), (c), 0, 0, 0)

DI float row_rstd(const float* ssq, int row) {
    const f32x4* p = (const f32x4*)(ssq + (size_t)row * 16);
    const f32x4 a = p[0], b = p[1], c = p[2], d = p[3];
    const float s = ((a[0] + a[1]) + (a[2] + a[3])) + ((b[0] + b[1]) + (b[2] + b[3])) + ((c[0] + c[1]) + (c[2] + c[3])) + ((d[0] + d[1]) + (d[2] + d[3]));
    return 1.0f / sqrtf(s * (1.0f / D) + EPS);
}
struct EpiZ {
    static constexpr bool PERM = true, AFTER_DRAIN = false;
    bf16* O; int ldc; const float* ssq;
    DI void operator()(const f32x4 (&acc)[2][2][4][2], const Unit& u, int wr, int wc, int fr, int fq) const {
        const int row0 = u.pm * 256 + wr * 64 + fr, col0 = u.pn * 256 + wc * 32 + 8 * fq;
#pragma unroll
        for (int ai = 0; ai < 2; ++ai)
#pragma unroll
            for (int m = 0; m < 4; ++m) {
                const int row = row0 + ai * 128 + m * 16;
                const float rs = ssq ? row_rstd(ssq, row) : 1.0f;
                bf16* rowp = O + (size_t)row * ldc + col0;
#pragma unroll
                for (int bj = 0; bj < 2; ++bj) {
                    const f32x4 v0 = acc[ai][bj][m][0] * rs, v1 = acc[ai][bj][m][1] * rs;
                    u32x4 w; w.x = pk2(v0[0], v0[1]); w.y = pk2(v0[2], v0[3]); w.z = pk2(v1[0], v1[1]); w.w = pk2(v1[2], v1[3]);
                    *(u32x4*)(rowp + bj * 128) = w;
                }
            }
    }
};
struct EpiSwiglu {
    static constexpr bool PERM = true, AFTER_DRAIN = false;
    bf16* H; const float* ssq;
    DI void operator()(const f32x4 (&acc)[2][2][4][2], const Unit& u, int wr, int wc, int fr, int fq) const {
        const int row0 = u.pm * 256 + wr * 64 + fr, col0 = u.pn * 128 + wc * 32 + 8 * fq;
#pragma unroll
        for (int ai = 0; ai < 2; ++ai)
#pragma unroll
            for (int m = 0; m < 4; ++m) {
                const int row = row0 + ai * 128 + m * 16;
                const float rs = row_rstd(ssq, row);
                float h[8];
#pragma unroll
                for (int n = 0; n < 2; ++n)
#pragma unroll
                    for (int e = 0; e < 4; ++e) { const float g = acc[ai][0][m][n][e] * rs, up = acc[ai][1][m][n][e] * rs; h[4 * n + e] = g * sigmoidf_(g) * up; }
                u32x4 w; w.x = pk2(h[0], h[1]); w.y = pk2(h[2], h[3]); w.z = pk2(h[4], h[5]); w.w = pk2(h[6], h[7]);
                *(u32x4*)(H + (size_t)row * DFF + col0) = w;
            }
    }
};
struct EpiResid {
    static constexpr bool PERM = false, AFTER_DRAIN = false;
    const float* xin; float* xout; bf16* Xb; float* ssq; float alpha;
    DI void operator()(const f32x4 (&acc)[2][2][4][2], const Unit& u, int wr, int wc, int fr, int fq) const {
        const int row0 = u.pm * 256 + wr * 64 + fr, col0 = u.pn * 256 + wc * 32 + 4 * fq;
#pragma unroll
        for (int ai = 0; ai < 2; ++ai)
#pragma unroll
            for (int m = 0; m < 4; ++m) {
                const int row = row0 + ai * 128 + m * 16; float ss = 0.f;
#pragma unroll
                for (int bj = 0; bj < 2; ++bj)
#pragma unroll
                    for (int n = 0; n < 2; ++n) {
                        const size_t off = (size_t)row * D + col0 + bj * 128 + n * 16;
                        const f32x4 x = *(const f32x4*)(xin + off) + acc[ai][bj][m][n] * alpha;
                        *(f32x4*)(xout + off) = x;
                        u32x2 w; w.x = pk2(x[0], x[1]); w.y = pk2(x[2], x[3]); *(u32x2*)(Xb + off) = w;
                        ss += (x[0] * x[0] + x[1] * x[1]) + (x[2] * x[2] + x[3] * x[3]);
                    }
                ss += __shfl_xor(ss, 16); ss += __shfl_xor(ss, 32);
                if (fq == 0) ssq[(size_t)row * 16 + u.pn * 4 + wc] = ss;
            }
    }
};
template <bool ADD> struct EpiGate {
    static constexpr bool PERM = true, AFTER_DRAIN = false;
    const bf16* Gt; int ldg; bf16* Mg; int ldm;
    DI void operator()(const f32x4 (&acc)[2][2][4][2], const Unit& u, int wr, int wc, int fr, int fq) const {
        const int row0 = u.pm * 256 + wr * 64 + fr, col0 = u.pn * 256 + wc * 32 + 8 * fq;
#pragma unroll
        for (int ai = 0; ai < 2; ++ai)
#pragma unroll
            for (int m = 0; m < 4; ++m) {
                const int row = row0 + ai * 128 + m * 16;
#pragma unroll
                for (int bj = 0; bj < 2; ++bj) {
                    const u32x4 gv = *(const u32x4*)(Gt + (size_t)row * ldg + col0 + bj * 128);
                    bf16* mp = Mg + (size_t)row * ldm + col0 + bj * 128;
                    u32x4 pv = (u32x4){0u, 0u, 0u, 0u}; if (ADD) pv = *(const u32x4*)mp;
                    float r[8];
#pragma unroll
                    for (int q = 0; q < 4; ++q) {
                        const float a0 = acc[ai][bj][m][q >> 1][(q & 1) * 2], a1 = acc[ai][bj][m][q >> 1][(q & 1) * 2 + 1];
                        r[2 * q] = sigmoidf_(lo16(gv[q])) * a0 + (ADD ? lo16(pv[q]) : 0.f);
                        r[2 * q + 1] = sigmoidf_(hi16(gv[q])) * a1 + (ADD ? hi16(pv[q]) : 0.f);
                    }
                    u32x4 w; w.x = pk2(r[0], r[1]); w.y = pk2(r[2], r[3]); w.z = pk2(r[4], r[5]); w.w = pk2(r[6], r[7]);
                    *(u32x4*)mp = w;
                }
            }
    }
};

template <class Epi>
DI void run_gemm(LAS unsigned char* lds, const bf16* A, int lda, const bf16* Bt, int ldb, int Mr, int N, int K, int G, int c, const Epi& E) {
    pg8::Gemm g{A, Bt, Mr, N, K, lda, ldb}; pg8::StaticOrder S; S.init(Mr, N, G, c);
    pg8::gemm_phase<Epi, pg8::StaticOrder, true, true>(lds, g, S, E);
}

DI void conv_item(const float* W, int K, int Nsrc, int srcoff, int Nout, bool GU, const float* gain, bf16* WT, LAS float* scr, int item, int lane) {
    const int nblk = Nout / 32, kb = item / nblk, nb = item % nblk, k0 = 64 * kb, n0 = 32 * nb;
    const int src0 = srcoff + (GU ? (((n0 & 255) >> 7) * DFF + 128 * (n0 >> 8) + (n0 & 127)) : n0);
    float wv[32];
#pragma unroll
    for (int i = 0; i < 32; ++i) { const int kk = 2 * i + (lane >> 5); wv[i] = W[(size_t)(k0 + kk) * Nsrc + src0 + (lane & 31)]; }
#pragma unroll
    for (int i = 0; i < 32; ++i) { const int kk = 2 * i + (lane >> 5); const float g = gain ? gain[k0 + kk] : 1.0f; scr[kk * 33 + (lane & 31)] = wv[i] * g; }
    asm volatile("s_waitcnt lgkmcnt(0)" ::: "memory");
    const int c = lane & 7;
#pragma unroll
    for (int j = 0; j < 4; ++j) { const int n = (lane >> 3) + 8 * j; const LAS float* s = scr + (8 * c) * 33 + n;
        u32x4 o; o.x = pk2(s[0 * 33], s[1 * 33]); o.y = pk2(s[2 * 33], s[3 * 33]); o.z = pk2(s[4 * 33], s[5 * 33]); o.w = pk2(s[6 * 33], s[7 * 33]);
        *(u32x4*)(WT + (size_t)(n0 + n) * K + k0 + 8 * c) = o; }
    asm volatile("s_waitcnt lgkmcnt(0)" ::: "memory");
}

struct Args { const void* in[22]; float* out; unsigned char* ws; };

template <int SET> DI void conv_weights(const Args& a, LAS unsigned char* L, int gw, int NGW, int wave, int lane) {
    LAS float* scr = (LAS float*)(L + wave * 16384);
    unsigned char* ws = a.ws;
    int it = gw;
#define CONV(l_, idx, K_, Ns_, so_, No_, GU_, gidx, dst_) { const float* Wp = (const float*)a.in[idx] + (size_t)(l_) * (K_) * (Ns_); const float* gp = (gidx) >= 0 ? (const float*)a.in[(gidx) >= 0 ? (gidx) : 0] + (size_t)(l_) * (K_) : nullptr; \
        const int nitems = ((K_) / 64) * ((No_) / 32); for (; it < nitems; it += NGW) conv_item(Wp, K_, Ns_, so_, No_, GU_, gp, (bf16*)(ws + (dst_)), scr, it, lane); it -= nitems; }
    if (SET == 0) {
        CONV(0, 4, D, 2 * DFF, 0, 2 * DFF, true, 3, W_GU1)
        CONV(0, 5, DFF, D, 0, D, false, -1, W_DN1)
        CONV(0, 7, D, 10752, 0, 10752, false, 6, W_IN)
        CONV(0, 10, 512, D, 0, D, false, -1, W_AB)
        CONV(0, 11, D, D, 0, D, false, -1, W_HB)
        CONV(0, 12, D, D, 0, D, false, -1, W_MO)
        CONV(0, 15, D, D, 0, D, false, 13, W_Q)
        CONV(0, 16, D, 2 * D, 0, 2 * D, false, -1, W_KV)
        CONV(1, 16, D, 2 * D, 0, 2 * D, false, -1, WS_WKV1)
        CONV(0, 17, D, D, 0, D, false, -1, W_O)
        CONV(0, 19, D, 2 * DFF, 0, 2 * DFF, true, 18, W_GU2)
        CONV(0, 20, DFF, D, 0, D, false, -1, W_DN2)
    } else if (SET == 1) {
        CONV(1, 4, D, 2 * DFF, 0, 2 * DFF, true, 3, W_GU1)
        CONV(1, 5, DFF, D, 0, D, false, -1, W_DN1)
        CONV(1, 7, D, 10752, 0, 8704, false, 6, W_IN)
    } else {
        CONV(1, 7, D, 10752, 8704, 2048, false, 6, W_IN + (size_t)8704 * D * 2)
        CONV(1, 10, 512, D, 0, D, false, -1, W_AB)
        CONV(1, 11, D, D, 0, D, false, -1, W_HB)
        CONV(1, 12, D, D, 0, D, false, -1, W_MO)
        CONV(1, 15, D, D, 0, D, false, 13, W_Q)
        CONV(1, 17, D, D, 0, D, false, -1, W_O)
        CONV(1, 19, D, 2 * DFF, 0, 2 * DFF, true, 18, W_GU2)
        CONV(1, 20, DFF, D, 0, D, false, -1, W_DN2)
    }
#undef CONV
}

DI void prologue_misc(const Args& a, int gw, int NGW, int lane, int gtid, int NGT) {
    unsigned char* ws = a.ws;
    const float* x = (const float*)a.in[0];
    bf16* Xb = (bf16*)(ws + WS_XB); float* ssq = (float*)(ws + WS_SSQ);
    for (int m = gw; m < M; m += NGW) {
        const f32x4* xr = (const f32x4*)(x + (size_t)m * D) + lane; float s = 0.f;
        unsigned long long* o8 = (unsigned long long*)(Xb + (size_t)m * D) + lane;
#pragma unroll
        for (int j = 0; j < 4; ++j) { const f32x4 v = xr[64 * j]; s += (v[0] * v[0] + v[1] * v[1]) + (v[2] * v[2] + v[3] * v[3]);
            o8[64 * j] = (unsigned long long)pk2(v[0], v[1]) | ((unsigned long long)pk2(v[2], v[3]) << 32); }
        s = wave_sum(s);
        if (lane < 16) ssq[(size_t)m * 16 + lane] = lane == 0 ? s : 0.f;
    }
    const float* mem = (const float*)a.in[1]; const float* mnorm = (const float*)a.in[14]; bf16* memN = (bf16*)(ws + WS_MEMN);
    for (int r = gw; r < 2 * MROWS; r += NGW) {
        const int l = r / MROWS, m = r % MROWS;
        const f32x4* xr = (const f32x4*)(mem + (size_t)m * D) + lane; const f32x4* gr = (const f32x4*)(mnorm + (size_t)l * D) + lane;
        f32x4 v[4]; float s = 0.f;
#pragma unroll
        for (int j = 0; j < 4; ++j) { v[j] = xr[64 * j]; s += (v[j][0] * v[j][0] + v[j][1] * v[j][1]) + (v[j][2] * v[j][2] + v[j][3] * v[j][3]); }
        const float rs = 1.0f / sqrtf(wave_sum(s) * (1.0f / D) + EPS);
        unsigned long long* o8 = (unsigned long long*)(memN + (size_t)r * D) + lane;
#pragma unroll
        for (int j = 0; j < 4; ++j) { const f32x4 g = gr[64 * j]; const f32x4 y = v[j] * rs * g;
            o8[64 * j] = (unsigned long long)pk2(y[0], y[1]) | ((unsigned long long)pk2(y[2], y[3]) << 32); }
    }
    const int* pos = (const int*)a.in[2]; float* cosT = (float*)(ws + WS_COS); float* sinT = (float*)(ws + WS_SIN);
    for (int idx = gtid; idx < M * 64; idx += NGT) {
        const int row = idx >> 6, i = idx & 63;
        const float inv = exp2f(-(float)(2 * i) * (1.0f / 128.0f) * 13.287712379549449f);
        const float ang = (float)pos[row] * inv;
        double rv = (double)ang * 0.15915494309189535; rv -= floor(rv);
        const float fr = (float)rv;
        cosT[idx] = __builtin_amdgcn_cosf(fr); sinT[idx] = __builtin_amdgcn_sinf(fr);
    }
}

DI void rope8(u32x4 x1, u32x4 x2, const float* cp, const float* sp, u32x4& o1, u32x4& o2) {
    const f32x4 c0 = *(const f32x4*)cp, c1 = *(const f32x4*)(cp + 4), s0 = *(const f32x4*)sp, s1 = *(const f32x4*)(sp + 4);
#pragma unroll
    for (int q = 0; q < 4; ++q) {
        const float ca = q < 2 ? c0[2 * q] : c1[2 * q - 4], cb = q < 2 ? c0[2 * q + 1] : c1[2 * q - 3];
        const float sa = q < 2 ? s0[2 * q] : s1[2 * q - 4], sb = q < 2 ? s0[2 * q + 1] : s1[2 * q - 3];
        const float a0 = lo16(x1[q]), a1 = hi16(x1[q]), b0 = lo16(x2[q]), b1 = hi16(x2[q]);
        o1[q] = pk2(a0 * ca - b0 * sa, a1 * cb - b1 * sb);
        o2[q] = pk2(b0 * ca + a0 * sa, b1 * cb + a1 * sb);
    }
}
constexpr int KSTR = 272, VSTR = 528, KL_BYTES = 256 * KSTR;
DI unsigned vt_off(int dh, int kgrp) { return (unsigned)(dh * VSTR + ((kgrp ^ ((dh >> 3) & 7)) << 3)); }

DI void dil_attn_phase(LAS unsigned char* L, const bf16* Z, const float* cosT, const float* sinT, bf16* OG, float* LSE, int G, int bid, int tid) {
    const int wid = __builtin_amdgcn_readfirstlane(tid >> 6), lane = tid & 63, fr = lane & 15, fq = lane >> 4;
    LAS unsigned char* KL = L; LAS unsigned char* VL = L + KL_BYTES;
    for (int unit = bid; unit < 1536; unit += G) {
        const int j = unit & 31, h = (unit >> 5) & 3, gb = unit >> 7, g = gb % 3, b = gb / 3;
        const int dsh = 2 * g, Lseg = T >> dsh;
        const int p0 = 128 * j, r = p0 / Lseg, u0 = p0 & (Lseg - 1);
        const int tokbase = b * T + r;
        const int colq = g * 512 + h * 128, colk = 1536 + colq, colv = 3072 + colq;
        __syncthreads();
#pragma unroll
        for (int i = 0; i < 4; ++i) {
            const int p = tid + 512 * i, kk = p >> 3, pc = p & 7, uu = u0 - 128 + kk;
            u32x4 o1 = (u32x4){0u, 0u, 0u, 0u}, o2 = o1;
            if (uu >= 0) { const size_t tok = (size_t)(tokbase + (uu << dsh)); const bf16* kp = Z + tok * NATT + colk + 8 * pc;
                rope8(*(const u32x4*)kp, *(const u32x4*)(kp + 64), cosT + tok * 64 + 8 * pc, sinT + tok * 64 + 8 * pc, o1, o2); }
            *(LAS u32x4*)(KL + kk * KSTR + 16 * pc) = o1; *(LAS u32x4*)(KL + kk * KSTR + 128 + 16 * pc) = o2;
        }
#pragma unroll
        for (int i = 0; i < 8; ++i) {
            const int p = tid + 512 * i, kk = p >> 4, cb = p & 15, uu = u0 - 128 + kk;
            u32x4 x = (u32x4){0u, 0u, 0u, 0u};
            if (uu >= 0) x = *(const u32x4*)(Z + (size_t)(tokbase + (uu << dsh)) * NATT + colv + 8 * cb);
            const unsigned base = (unsigned)((((kk >> 2) ^ (cb & 7)) << 3) + (kk & 3) * 2);
#pragma unroll
            for (int jj = 0; jj < 8; ++jj) *(LAS unsigned short*)(VL + (8 * cb + jj) * VSTR + base) = (unsigned short)(x[jj >> 1] >> (16 * (jj & 1)));
        }
        const int qi = 16 * wid + fr; const size_t tq = (size_t)(tokbase + ((u0 + qi) << dsh));
        bf16x8 qf[4];
#pragma unroll
        for (int k2 = 0; k2 < 2; ++k2) { const int i0 = 32 * k2 + 8 * fq; const bf16* qp = Z + tq * NATT + colq + i0; u32x4 o1, o2;
            rope8(*(const u32x4*)qp, *(const u32x4*)(qp + 64), cosT + tq * 64 + i0, sinT + tq * 64 + i0, o1, o2); qf[k2] = mk8(o1); qf[k2 + 2] = mk8(o2); }
        __syncthreads();
        const int tw = wid & ~1;
        f32x4 s[10];
#pragma unroll
        for (int tix = 0; tix < 10; ++tix) { s[tix] = (f32x4){0.f, 0.f, 0.f, 0.f}; const int kt = tw + tix;
#pragma unroll
            for (int k4 = 0; k4 < 4; ++k4) { const bf16x8 av = *(const LAS bf16x8*)(KL + (16 * kt + fr) * KSTR + (32 * k4 + 8 * fq) * 2); s[tix] = MFMA16(av, qf[k4], s[tix]); } }
        const float scale = 0.08838834764831845f; float mx = -INFINITY;
#pragma unroll
        for (int tix = 0; tix < 10; ++tix)
#pragma unroll
            for (int e = 0; e < 4; ++e) { const int kk = 16 * (tw + tix) + 4 * fq + e; const bool ok = (kk >= qi) && (kk <= qi + 128) && (u0 - 128 + kk >= 0);
                const float v = ok ? s[tix][e] * scale : -INFINITY; s[tix][e] = v; mx = fmaxf(mx, v); }
        mx = fmaxf(mx, __shfl_xor(mx, 16)); mx = fmaxf(mx, __shfl_xor(mx, 32));
        float den = 0.f;
#pragma unroll
        for (int tix = 0; tix < 10; ++tix)
#pragma unroll
            for (int e = 0; e < 4; ++e) { const float p = __expf(s[tix][e] - mx); s[tix][e] = p; den += p; }
        den += __shfl_xor(den, 16); den += __shfl_xor(den, 32);
        bf16x8 pf[5];
#pragma unroll
        for (int pp = 0; pp < 5; ++pp) { u32x4 pw; pw.x = pk2(s[2 * pp][0], s[2 * pp][1]); pw.y = pk2(s[2 * pp][2], s[2 * pp][3]); pw.z = pk2(s[2 * pp + 1][0], s[2 * pp + 1][1]); pw.w = pk2(s[2 * pp + 1][2], s[2 * pp + 1][3]); pf[pp] = mk8(pw); }
        f32x4 o[8];
#pragma unroll
        for (int dt = 0; dt < 8; ++dt) { o[dt] = (f32x4){0.f, 0.f, 0.f, 0.f};
            const int dh = 16 * dt + fr, sw = (2 * dt + (fr >> 3)) & 7;
            const LAS unsigned char* va = VL + dh * VSTR + 32 * tw + ((fq ^ sw) << 3); const LAS unsigned char* vb2 = VL + dh * VSTR + 32 * tw + (((fq + 4) ^ sw) << 3);
#pragma unroll
            for (int pp = 0; pp < 5; ++pp) { const s16x4 lo = *(const LAS s16x4*)(va + 64 * pp), hi = *(const LAS s16x4*)(vb2 + 64 * pp);
                const bf16x8 vb = __builtin_shufflevector(lo, hi, 0, 1, 2, 3, 4, 5, 6, 7); o[dt] = MFMA16(pf[pp], vb, o[dt]); }
        }
        const float inv = 1.0f / den, lse = mx + __logf(den);
#pragma unroll
        for (int e = 0; e < 4; ++e) { const float iq = __shfl(inv, 4 * fq + e);
            bf16* op = OG + (size_t)(tokbase + ((u0 + 16 * wid + 4 * fq + e) << dsh)) * 1536 + colq + fr;
#pragma unroll
            for (int dt = 0; dt < 8; ++dt) op[16 * dt] = (bf16)f2bf(o[dt][e] * iq); }
        if (lane < 16) LSE[tq * 12 + g * 4 + h] = lse;
    }
}

DI void merge_phase(const bf16* OG, const float* LSE, bf16* AO, int gtid, int NGT) {
    for (int idx0 = gtid; idx0 < M * 64; idx0 += 4 * NGT) {
        u32x4 xa[4], xb[4], xd[4]; float l0[4], l1[4], l2[4]; bf16* op[4];
#pragma unroll
        for (int u = 0; u < 4; ++u) { const int idx = idx0 + u * NGT; const bool ok = idx < M * 64; const int tok = ok ? idx >> 6 : 0, h = (idx >> 4) & 3, c = idx & 15;
            l0[u] = LSE[(size_t)tok * 12 + h]; l1[u] = LSE[(size_t)tok * 12 + 4 + h]; l2[u] = LSE[(size_t)tok * 12 + 8 + h];
            const bf16* p = OG + (size_t)tok * 1536 + h * 128 + 8 * c; xa[u] = *(const u32x4*)p; xb[u] = *(const u32x4*)(p + 512); xd[u] = *(const u32x4*)(p + 1024);
            op[u] = ok ? AO + (size_t)tok * 512 + h * 128 + 8 * c : nullptr; }
#pragma unroll
        for (int u = 0; u < 4; ++u) {
            const float mx = fmaxf(l0[u], fmaxf(l1[u], l2[u])); float w0 = __expf(l0[u] - mx), w1 = __expf(l1[u] - mx), w2 = __expf(l2[u] - mx); const float inv = __builtin_amdgcn_rcpf(w0 + w1 + w2); w0 *= inv; w1 *= inv; w2 *= inv;
            u32x4 o;
#pragma unroll
            for (int q = 0; q < 4; ++q) o[q] = pk2(w0 * lo16(xa[u][q]) + w1 * lo16(xb[u][q]) + w2 * lo16(xd[u][q]), w0 * hi16(xa[u][q]) + w1 * hi16(xb[u][q]) + w2 * hi16(xd[u][q]));
            if (op[u]) *(u32x4*)op[u] = o;
        }
    }
}

DI void xattn_stage_vt(LAS unsigned char* VL, const bf16* memVT, int b, int h, int hh, int tid) {
#pragma unroll
    for (int i = 0; i < 8; ++i) { const int p = tid + 512 * i, dhr = p >> 5, c = p & 31;
        const u32x4 x = *(const u32x4*)(memVT + (size_t)(h * 256 + 128 * hh + dhr) * MROWS + b * NMEM + 8 * c);
        u32x2 lo, hi; lo.x = x.x; lo.y = x.y; hi.x = x.z; hi.y = x.w;
        *(LAS u32x2*)(VL + vt_off(dhr, 2 * c)) = lo; *(LAS u32x2*)(VL + vt_off(dhr, 2 * c + 1)) = hi; }
}
DI void xattn_phase(LAS unsigned char* L, const bf16* Qx, const bf16* memK, const bf16* memVT, bf16* Ox, int G, int bid, int tid) {
    const int wid = __builtin_amdgcn_readfirstlane(tid >> 6), lane = tid & 63, fr = lane & 15, fq = lane >> 4;
    LAS unsigned char* KL = L; LAS unsigned char* VL = L + KL_BYTES;
    for (int unit = bid; unit < 512; unit += G) {
        const int j = unit & 31, h = (unit >> 5) & 3, b = unit >> 7;
        const int tok0 = b * T + 128 * j; const size_t tq = (size_t)(tok0 + 16 * wid + fr);
        bf16x8 qf[8];
#pragma unroll
        for (int k = 0; k < 8; ++k) qf[k] = *(const bf16x8*)(Qx + tq * D + h * 256 + 32 * k + 8 * fq);
        f32x4 s[16];
#pragma unroll
        for (int kt = 0; kt < 16; ++kt) s[kt] = (f32x4){0.f, 0.f, 0.f, 0.f};
#pragma unroll
        for (int hh = 0; hh < 2; ++hh) {
            __syncthreads();
#pragma unroll
            for (int i = 0; i < 8; ++i) { const int p = tid + 512 * i, m = p >> 4, cb = p & 15;
                *(LAS u32x4*)(KL + m * KSTR + 16 * cb) = *(const u32x4*)(memK + (size_t)(b * NMEM + m) * D + h * 256 + 128 * hh + 8 * cb); }
            if (hh == 0) xattn_stage_vt(VL, memVT, b, h, 0, tid);
            __syncthreads();
#pragma unroll
            for (int kt = 0; kt < 16; ++kt)
#pragma unroll
                for (int k4 = 0; k4 < 4; ++k4) { const bf16x8 av = *(const LAS bf16x8*)(KL + (16 * kt + fr) * KSTR + (32 * k4 + 8 * fq) * 2); s[kt] = MFMA16(av, qf[4 * hh + k4], s[kt]); }
        }
        float mx = -INFINITY;
#pragma unroll
        for (int kt = 0; kt < 16; ++kt)
#pragma unroll
            for (int e = 0; e < 4; ++e) { const float v = s[kt][e] * 0.0625f; s[kt][e] = v; mx = fmaxf(mx, v); }
        mx = fmaxf(mx, __shfl_xor(mx, 16)); mx = fmaxf(mx, __shfl_xor(mx, 32));
        float den = 0.f;
#pragma unroll
        for (int kt = 0; kt < 16; ++kt)
#pragma unroll
            for (int e = 0; e < 4; ++e) { const float p = __expf(s[kt][e] - mx); s[kt][e] = p; den += p; }
        den += __shfl_xor(den, 16); den += __shfl_xor(den, 32);
        bf16x8 pf[8];
#pragma unroll
        for (int pp = 0; pp < 8; ++pp) { u32x4 pw; pw.x = pk2(s[2 * pp][0], s[2 * pp][1]); pw.y = pk2(s[2 * pp][2], s[2 * pp][3]); pw.z = pk2(s[2 * pp + 1][0], s[2 * pp + 1][1]); pw.w = pk2(s[2 * pp + 1][2], s[2 * pp + 1][3]); pf[pp] = mk8(pw); }
        const float inv = 1.0f / den; float iq[4];
#pragma unroll
        for (int e = 0; e < 4; ++e) iq[e] = __shfl(inv, 4 * fq + e);
#pragma unroll
        for (int hh = 0; hh < 2; ++hh) {
            if (hh == 1) { __syncthreads(); xattn_stage_vt(VL, memVT, b, h, 1, tid); __syncthreads(); }
            f32x4 o[8];
#pragma unroll
            for (int dt = 0; dt < 8; ++dt) { o[dt] = (f32x4){0.f, 0.f, 0.f, 0.f};
                const int dh = 16 * dt + fr, sw = (2 * dt + (fr >> 3)) & 7;
                const LAS unsigned char* va = VL + dh * VSTR + ((fq ^ sw) << 3); const LAS unsigned char* vb2 = VL + dh * VSTR + (((fq + 4) ^ sw) << 3);
#pragma unroll
                for (int pp = 0; pp < 8; ++pp) { const s16x4 lo = *(const LAS s16x4*)(va + 64 * pp), hi = *(const LAS s16x4*)(vb2 + 64 * pp);
                    const bf16x8 vb = __builtin_shufflevector(lo, hi, 0, 1, 2, 3, 4, 5, 6, 7); o[dt] = MFMA16(pf[pp], vb, o[dt]); }
            }
#pragma unroll
            for (int e = 0; e < 4; ++e) { bf16* op = Ox + (size_t)(tok0 + 16 * wid + 4 * fq + e) * D + h * 256 + 128 * hh + fr;
#pragma unroll
                for (int dt = 0; dt < 8; ++dt) op[16 * dt] = (bf16)f2bf(o[dt][e] * iq[e]); }
        }
    }
}

constexpr int H1_QA = 0, H1_KA = 64 * 272, H1_VT = 2 * 64 * 272, H1_TOT = H1_VT + 128 * 144;
template <bool DRY> DI void hgrn1_phase(LAS unsigned char* L, bf16* Z2, const float* lbraw, int layer, float* DEC, unsigned long long* OI, int G, int bid, int tid) {
    const int wid = __builtin_amdgcn_readfirstlane(tid >> 6), lane = tid & 63, fr = lane & 15, fq = lane >> 4;
    const int n = tid & 127, rg = tid >> 7, tt = wid & 3, vh = wid >> 2;
    LAS float* TOT = (LAS float*)(L + H1_TOT);
    unsigned short rq[16], rf[16], rv[16];
#define H1_RAW(uu, RQ, RF, RV) do { const int c_ = (uu) & 63, h_ = ((uu) >> 6) & 7, b_ = (uu) >> 9; const bf16* p_ = Z2 + (size_t)(b_ * T + 64 * c_ + 16 * rg) * NH2 + h_ * 128 + n; \
        _Pragma("unroll") for (int r = 0; r < 16; ++r) { RQ[r] = p_[(size_t)r * NH2]; RF[r] = p_[(size_t)r * NH2 + 1024]; RV[r] = p_[(size_t)r * NH2 + 2048]; } } while (0)
    if (bid < 2048) H1_RAW(bid, rq, rf, rv);
    for (int unit = bid; unit < 2048; unit += G) {
        const int c = unit & 63, h = (unit >> 6) & 7, b = unit >> 9, tok0 = b * T + 64 * c, ch = h * 128 + n;
        float lbv = 0.f;
        if (layer > 0) { const float e0 = lbraw[ch], e1 = lbraw[D + ch]; lbv = 1.0f / (1.0f + expf(e0 - e1)); }
        asm volatile("" : "+v"(rq[0]), "+v"(rq[1]), "+v"(rq[2]), "+v"(rq[3]), "+v"(rq[4]), "+v"(rq[5]), "+v"(rq[6]), "+v"(rq[7]), "+v"(rq[8]), "+v"(rq[9]), "+v"(rq[10]), "+v"(rq[11]), "+v"(rq[12]), "+v"(rq[13]), "+v"(rq[14]), "+v"(rq[15]));
        asm volatile("" : "+v"(rf[0]), "+v"(rf[1]), "+v"(rf[2]), "+v"(rf[3]), "+v"(rf[4]), "+v"(rf[5]), "+v"(rf[6]), "+v"(rf[7]), "+v"(rf[8]), "+v"(rf[9]), "+v"(rf[10]), "+v"(rf[11]), "+v"(rf[12]), "+v"(rf[13]), "+v"(rf[14]), "+v"(rf[15]));
        asm volatile("" : "+v"(rv[0]), "+v"(rv[1]), "+v"(rv[2]), "+v"(rv[3]), "+v"(rv[4]), "+v"(rv[5]), "+v"(rv[6]), "+v"(rv[7]), "+v"(rv[8]), "+v"(rv[9]), "+v"(rv[10]), "+v"(rv[11]), "+v"(rv[12]), "+v"(rv[13]), "+v"(rv[14]), "+v"(rv[15]));
        float q[16], cs[16], kg[16]; unsigned short vr[16];
        bf16* base = Z2 + (size_t)(tok0 + 16 * rg) * NH2 + ch;
#pragma unroll
        for (int r = 0; r < 16; ++r) { q[r] = bf2f(rq[r]); cs[r] = bf2f(rf[r]); vr[r] = rv[r]; }
        unsigned short nq[16], nf[16], nv[16];
        { const int nu = unit + G < 2048 ? unit + G : unit; H1_RAW(nu, nq, nf, nv); }
        float run = 0.f;
#pragma unroll
        for (int r = 0; r < 16; ++r) { const float fl = cs[r]; const float sg = __builtin_amdgcn_rcpf(1.0f + __expf(-fl)); const float f = lbv + (1.0f - lbv) * sg;
            kg[r] = (1.0f - lbv) * (1.0f - sg); run += __logf(f); cs[r] = run; }
        TOT[rg * 128 + n] = run;
        __syncthreads();
        const float t0 = TOT[n], t1 = TOT[128 + n], t2 = TOT[256 + n], t3 = TOT[384 + n];
        const float off = rg == 0 ? 0.f : (rg == 1 ? t0 : (rg == 2 ? t0 + t1 : t0 + t1 + t2));
        const float bmid = t0 + t1, blast = (t0 + t1) + (t2 + t3);
        const float qscale = 0.08838834764831845f;
        float kh[16];
#pragma unroll
        for (int r = 0; r < 16; ++r) { const float bt = off + cs[r]; const float qs = q[r] * qscale; const int row = 16 * rg + r;
            if (!DRY) base[(size_t)r * NH2] = (bf16)f2bf(qs * __expf(bt));
            *(LAS unsigned short*)(L + H1_QA + row * 272 + n * 2) = (unsigned short)f2bf(qs * __expf(bt - bmid));
            *(LAS unsigned short*)(L + H1_KA + row * 272 + n * 2) = (unsigned short)f2bf(kg[r] * __expf(bmid - bt));
            kh[r] = kg[r] * __expf(blast - bt); }
        u32x4 k0, k1, v0, v1;
#pragma unroll
        for (int qd = 0; qd < 4; ++qd) { k0[qd] = pk2(kh[2 * qd], kh[2 * qd + 1]); k1[qd] = pk2(kh[8 + 2 * qd], kh[9 + 2 * qd]);
            v0[qd] = (unsigned)vr[2 * qd] | ((unsigned)vr[2 * qd + 1] << 16); v1[qd] = (unsigned)vr[8 + 2 * qd] | ((unsigned)vr[9 + 2 * qd] << 16); }
        bf16* slot = Z2 + (size_t)(tok0 + (n >> 1)) * NH2 + h * 128 + (n & 1) * 64 + 16 * rg;
        if (!DRY) { *(u32x4*)(slot + 1024) = k0; *(u32x4*)(slot + 1024 + 8) = k1;
        *(u32x4*)(slot + 2048) = v0; *(u32x4*)(slot + 2048 + 8) = v1; }
        *(LAS u32x4*)(L + H1_VT + n * 144 + 32 * rg) = v0; *(LAS u32x4*)(L + H1_VT + n * 144 + 32 * rg + 16) = v1;
        if (!DRY && rg == 0) DEC[(size_t)unit * 128 + n] = __expf(blast);
        __syncthreads();
        bf16x8 bq[4];
#pragma unroll
        for (int k4 = 0; k4 < 4; ++k4) bq[k4] = *(const LAS bf16x8*)(L + H1_QA + (16 * tt + fr) * 272 + (32 * k4 + 8 * fq) * 2);
        f32x4 at[4];
#pragma unroll
        for (int st = 0; st < 4; ++st) { at[st] = (f32x4){0.f, 0.f, 0.f, 0.f};
            if (st <= tt) {
#pragma unroll
                for (int k4 = 0; k4 < 4; ++k4) { const bf16x8 av = *(const LAS bf16x8*)(L + H1_KA + (16 * st + fr) * 272 + (32 * k4 + 8 * fq) * 2); at[st] = MFMA16(av, bq[k4], at[st]); }
                if (st == tt) {
#pragma unroll
                    for (int e = 0; e < 4; ++e) if (4 * fq + e > fr) at[st][e] = 0.f; }
            } }
        bf16x8 pf[2];
#pragma unroll
        for (int pp = 0; pp < 2; ++pp) { u32x4 pw; pw.x = pk2(at[2 * pp][0], at[2 * pp][1]); pw.y = pk2(at[2 * pp][2], at[2 * pp][3]); pw.z = pk2(at[2 * pp + 1][0], at[2 * pp + 1][1]); pw.w = pk2(at[2 * pp + 1][2], at[2 * pp + 1][3]); pf[pp] = mk8(pw); }
#pragma unroll
        for (int vi = 0; vi < 4; ++vi) { const int vt = 4 * vh + vi; f32x4 o = (f32x4){0.f, 0.f, 0.f, 0.f};
#pragma unroll
            for (int pp = 0; pp < 2; ++pp) { const LAS unsigned char* vp = L + H1_VT + (16 * vt + fr) * 144 + (32 * pp + 4 * fq) * 2;
                const s16x4 lo = *(const LAS s16x4*)vp, hi = *(const LAS s16x4*)(vp + 32);
                const bf16x8 vb = __builtin_shufflevector(lo, hi, 0, 1, 2, 3, 4, 5, 6, 7); o = MFMA16(vb, pf[pp], o); }
            if (!DRY) OI[((size_t)(unit * 4 + tt) * 8 + vt) * 64 + lane] = (unsigned long long)pk2(o[0], o[1]) | ((unsigned long long)pk2(o[2], o[3]) << 32);
            }
#pragma unroll
        for (int r = 0; r < 16; ++r) { rq[r] = nq[r]; rf[r] = nf[r]; rv[r] = nv[r]; }
    }
#undef H1_RAW
}

constexpr int H2_BUF = 36352, H2_KHT = 17408, H2_DEC = 35840;
template <bool DRY> DI void hgrn2_phase(LAS unsigned char* L, bf16* Z2, const float* DEC, unsigned long long* OIW, int bh2, int tid) {
    const unsigned long long* OI = OIW;
    const int wv = __builtin_amdgcn_readfirstlane(tid >> 6), lane = tid & 63, fr = lane & 15, fq = lane >> 4;
    const int bh = bh2 >> 1, w = 4 * (bh2 & 1) + (wv & 3); const bool cw = wv < 4;
    const int b = bh >> 3, h = bh & 7, unit0 = bh * 64, vcol = 16 * w + fr;
    u32x4 sq[2], sk[2]; f32x4 sd = (f32x4){0.f, 0.f, 0.f, 0.f};
#define H2_LOAD(cc) do { const int tok0_ = b * T + 64 * (cc); _Pragma("unroll") for (int i = 0; i < 2; ++i) { const int p = tid + 512 * i, row = p >> 4, cb = p & 15; \
        const bf16* rp = Z2 + (size_t)(tok0_ + row) * NH2 + h * 128 + 8 * cb; sq[i] = *(const u32x4*)rp; sk[i] = *(const u32x4*)(rp + 1024); } \
        if (tid < 32) sd = *(const f32x4*)(DEC + (size_t)(unit0 + (cc)) * 128 + 4 * tid); } while (0)
#define H2_WRITE(bi) do { LAS unsigned char* B_ = L + (bi) * H2_BUF; _Pragma("unroll") for (int i = 0; i < 2; ++i) { const int p = tid + 512 * i, row = p >> 4, cb = p & 15; \
        *(LAS u32x4*)(B_ + row * 272 + 16 * cb) = sq[i]; *(LAS u32x4*)(B_ + H2_KHT + (2 * row + (cb >> 3)) * 144 + 16 * (cb & 7)) = sk[i]; } \
        if (tid < 32) *(LAS f32x4*)(B_ + H2_DEC + 16 * tid) = sd; } while (0)
#define H2_PRIV(cc, VT_, OI_) do { const int tok0_ = b * T + 64 * (cc); \
        const bf16* vp_ = Z2 + (size_t)(tok0_ + (vcol >> 1)) * NH2 + 2048 + h * 128 + (vcol & 1) * 64 + 8 * fq; VT_[0] = *(const u32x4*)vp_; VT_[1] = *(const u32x4*)(vp_ + 32); \
        _Pragma("unroll") for (int tt_ = 0; tt_ < 4; ++tt_) OI_[tt_] = OI[((size_t)((unit0 + (cc)) * 4 + tt_) * 8 + w) * 64 + lane]; } while (0)
    u32x4 vtf[2]; unsigned long long oi[4];
    H2_LOAD(0); H2_WRITE(0); H2_PRIV(0, vtf, oi);
    f32x4 S[8];
#pragma unroll
    for (int nt = 0; nt < 8; ++nt) S[nt] = (f32x4){0.f, 0.f, 0.f, 0.f};
    __syncthreads();
    for (int c = 0; c < 64; ++c) {
        LAS unsigned char* Bc = L + (c & 1) * H2_BUF;
        asm volatile("" : "+v"(vtf[0]), "+v"(vtf[1]), "+v"(oi[0]), "+v"(oi[1]), "+v"(oi[2]), "+v"(oi[3]));
        u32x4 nvt[2]; unsigned long long noi[4];
        const int cn = c + 1 < 64 ? c + 1 : c;
        H2_LOAD(cn); H2_PRIV(cn, nvt, noi);
        if (cw) {
        bf16x8 qa[4][4];
#pragma unroll
        for (int tt = 0; tt < 4; ++tt)
#pragma unroll
            for (int np = 0; np < 4; ++np) { const LAS unsigned char* qp = Bc + (16 * tt + fr) * 272 + (32 * np + 4 * fq) * 2;
                const s16x4 lo = *(const LAS s16x4*)qp, hi = *(const LAS s16x4*)(qp + 32); qa[tt][np] = __builtin_shufflevector(lo, hi, 0, 1, 2, 3, 4, 5, 6, 7); }
        bf16x8 sb[4];
#pragma unroll
        for (int np = 0; np < 4; ++np) { u32x4 pw; pw.x = pk2(S[2 * np][0], S[2 * np][1]); pw.y = pk2(S[2 * np][2], S[2 * np][3]); pw.z = pk2(S[2 * np + 1][0], S[2 * np + 1][1]); pw.w = pk2(S[2 * np + 1][2], S[2 * np + 1][3]); sb[np] = mk8(pw); }
        f32x4 o[4];
#pragma unroll
        for (int tt = 0; tt < 4; ++tt) { const unsigned lo = (unsigned)oi[tt], hi = (unsigned)(oi[tt] >> 32); o[tt] = (f32x4){lo16(lo), hi16(lo), lo16(hi), hi16(hi)}; }
#pragma unroll
        for (int np = 0; np < 4; ++np)
#pragma unroll
            for (int tt = 0; tt < 4; ++tt) o[tt] = MFMA16(sb[np], qa[tt][np], o[tt]);
        if (!DRY) {
#pragma unroll
            for (int tt = 0; tt < 4; ++tt) OIW[((size_t)((unit0 + c) * 4 + tt) * 8 + w) * 64 + lane] = (unsigned long long)pk2(o[tt][0], o[tt][1]) | ((unsigned long long)pk2(o[tt][2], o[tt][3]) << 32);
        } else { asm volatile("" :: "v"(o[0]), "v"(o[1]), "v"(o[2]), "v"(o[3])); }
        bf16x8 ka[8][2];
#pragma unroll
        for (int nt = 0; nt < 8; ++nt)
#pragma unroll
            for (int ks = 0; ks < 2; ++ks) ka[nt][ks] = *(const LAS bf16x8*)(Bc + H2_KHT + (16 * nt + fr) * 144 + (32 * ks + 8 * fq) * 2);
#pragma unroll
        for (int nt = 0; nt < 8; ++nt) { const f32x4 dv = *(const LAS f32x4*)(Bc + H2_DEC + (16 * nt + 4 * fq) * 4); S[nt] = S[nt] * dv; }
#pragma unroll
        for (int ks = 0; ks < 2; ++ks)
#pragma unroll
            for (int nt = 0; nt < 8; ++nt) S[nt] = MFMA16(ka[nt][ks], mk8(vtf[ks]), S[nt]);
        }
        if (c + 1 < 64) H2_WRITE((c + 1) & 1);
        vtf[0] = nvt[0]; vtf[1] = nvt[1];
#pragma unroll
        for (int i = 0; i < 4; ++i) oi[i] = noi[i];
        LBAR();
    }
#undef H2_LOAD
#undef H2_WRITE
#undef H2_PRIV
}
DI void hgrn3_phase(bf16* Z2, const unsigned long long* OI, const float* gain, int gw, int NGW, int lane) {
    const int fr = lane & 15, fq = lane >> 4;
    for (int it = gw; it < 2048 * 4; it += NGW) {
        const int unit = it >> 2, tt = it & 3, c = unit & 63, h = (unit >> 6) & 7, b = unit >> 9;
        bf16* gp = Z2 + (size_t)(b * T + 64 * c + 16 * tt + fr) * NH2 + 3072 + h * 128 + 4 * fq;
        unsigned long long ov[8], gv[8];
#pragma unroll
        for (int vt = 0; vt < 8; ++vt) { ov[vt] = OI[((size_t)(unit * 4 + tt) * 8 + vt) * 64 + lane]; gv[vt] = *(const unsigned long long*)(gp + 16 * vt); }
        float ss = 0.f;
#pragma unroll
        for (int vt = 0; vt < 8; ++vt) { const unsigned lo = (unsigned)ov[vt], hi = (unsigned)(ov[vt] >> 32); ss += (lo16(lo) * lo16(lo) + hi16(lo) * hi16(lo)) + (lo16(hi) * lo16(hi) + hi16(hi) * hi16(hi)); }
        ss += __shfl_xor(ss, 16); ss += __shfl_xor(ss, 32);
        const float rstd = __builtin_amdgcn_rsqf(ss * (1.0f / 128.0f) + EPS);
#pragma unroll
        for (int vt = 0; vt < 8; ++vt) { const f32x4 g4 = *(const f32x4*)(gain + h * 128 + 16 * vt + 4 * fq);
            const unsigned lo = (unsigned)ov[vt], hi = (unsigned)(ov[vt] >> 32), glo = (unsigned)gv[vt], ghi = (unsigned)(gv[vt] >> 32);
            const float of[4] = {lo16(lo), hi16(lo), lo16(hi), hi16(hi)}, gf[4] = {lo16(glo), hi16(glo), lo16(ghi), hi16(ghi)}; float r[4];
#pragma unroll
            for (int e = 0; e < 4; ++e) r[e] = of[e] * rstd * g4[e] * (gf[e] * __builtin_amdgcn_rcpf(1.0f + __expf(-gf[e])));
            *(unsigned long long*)(gp + 16 * vt) = (unsigned long long)pk2(r[0], r[1]) | ((unsigned long long)pk2(r[2], r[3]) << 32); }
    }
}

#define XB_TMO      128
#define XB_XCNT(j)  (256  + 64 * (j))
#define XB_XSUB(j)  (1280 + 64 * (j))
#define XB_XGEN(j)  (2304 + 64 * (j))
#define XB_TOP      3328
#define XB_TOPGEN   3392
#define XCD_BAR_WORDS 3456
#define XB_SPIN_CAP (1u << 18)

__device__ __forceinline__ unsigned xb_ld(unsigned* p)              { return __hip_atomic_load(p, __ATOMIC_RELAXED, __HIP_MEMORY_SCOPE_AGENT); }
__device__ __forceinline__ unsigned xb_add(unsigned* p, unsigned v) { return __hip_atomic_fetch_add(p, v, __ATOMIC_RELAXED, __HIP_MEMORY_SCOPE_AGENT); }
__device__ __forceinline__ unsigned xb_xcc_id() { return (unsigned)__builtin_amdgcn_s_getreg((3 << 11) | 20) & 0xFu; }
#define XB_SPIN(cond, bar) do { unsigned _sp = 0; while (cond) { __builtin_amdgcn_s_sleep(1); \
    if ((++_sp & 255u) == 0u) { if (xb_ld(&(bar)[XB_TMO])) break; if (_sp > XB_SPIN_CAP) { atomicAdd(&(bar)[XB_TMO], 1u); break; } } } } while (0)

struct XcdBarrier {
    unsigned* bar; unsigned x;
    volatile LAS unsigned* st;
};

__device__ __forceinline__ XcdBarrier xcd_barrier_post(unsigned* bar, volatile LAS unsigned* st) {
    XcdBarrier b; b.bar = bar; b.x = xb_xcc_id(); b.st = st;
    if (threadIdx.x == 0) (void)xb_add(&bar[XB_XCNT(b.x)], 1u);
    return b;
}
__device__ __forceinline__ void xcd_barrier_complete(unsigned* bar, unsigned x, unsigned& nloc, unsigned& nx) {
    const unsigned G = gridDim.x * gridDim.y * gridDim.z;
    unsigned sum, cnt, mine, sp = 0u;
    for (;;) {
        sum = 0u; cnt = 0u; mine = 0u;
#pragma unroll
        for (unsigned j = 0; j < 16; ++j) { const unsigned c = xb_ld(&bar[XB_XCNT(j)]); sum += c; cnt += (c > 0u) ? 1u : 0u; mine = (j == x) ? c : mine; }
        if (sum == G) break;
        __builtin_amdgcn_s_sleep(1);
        if ((++sp & 255u) == 0u) { if (xb_ld(&bar[XB_TMO])) break; if (sp > XB_SPIN_CAP) { atomicAdd(&bar[XB_TMO], 1u); break; } }
    }
    nloc = mine > 0u ? mine : 1u; nx = cnt > 0u ? cnt : 1u;
}

__device__ __forceinline__ void xcd_barrier(const XcdBarrier& b) {
    asm volatile("s_waitcnt vmcnt(0)" ::: "memory");
    __syncthreads();
    if (threadIdx.x == 0) {
        unsigned* bar = b.bar;
        __builtin_amdgcn_s_waitcnt(0);
        unsigned nloc = b.st[0], nx = b.st[1];
        if (nloc == 0u) { xcd_barrier_complete(bar, b.x, nloc, nx); b.st[0] = nloc; b.st[1] = nx; }
        const unsigned old = xb_add(&bar[XB_XSUB(b.x)], 1u);
        const unsigned gen = old / nloc;
        if (old + 1u == (gen + 1u) * nloc) {
            __builtin_amdgcn_fence(__ATOMIC_RELEASE, "agent");
            asm volatile("s_waitcnt vmcnt(0)" ::: "memory");
            const unsigned og = xb_add(&bar[XB_TOP], 1u);
            const unsigned tg = og / nx;
            if (og + 1u == (tg + 1u) * nx) xb_add(&bar[XB_TOPGEN], 1u);
            else XB_SPIN(xb_ld(&bar[XB_TOPGEN]) == tg, bar);
            __builtin_amdgcn_fence(__ATOMIC_ACQUIRE, "agent");
            xb_add(&bar[XB_XGEN(b.x)], 1u);
            asm volatile("s_waitcnt vmcnt(0)" ::: "memory");
        } else {
            XB_SPIN(xb_ld(&bar[XB_XGEN(b.x)]) == gen, bar);
            __builtin_amdgcn_fence(__ATOMIC_ACQUIRE, "agent");
            asm volatile("s_waitcnt vmcnt(0)" ::: "memory");
        }
    }
    __syncthreads();
}

#ifndef PROBE_SYNC
#define PROBE_SYNC 0
#endif
#ifndef PROBE_ATT
#define PROBE_ATT 0
#endif
#ifndef PROBE_GEMM
#define PROBE_GEMM 0
#endif
#ifndef PROBE_HG
#define PROBE_HG 0
#endif
#ifndef PROBE_RES
#define PROBE_RES 0
#endif
#ifndef PROBE_CONV
#define PROBE_CONV 0
#endif
#define GSYNC() do { xcd_barrier(xbar); if (PROBE_SYNC) xcd_barrier(xbar); } while (0)
#define REP(n) for (int rep_ = 0; rep_ < 1 + (n); ++rep_)
#define FRESH() size_t zoff_ = 0; asm volatile("" : "+s"(zoff_)); unsigned char* ws = a.ws + zoff_; int tid = threadIdx.x; asm volatile("" : "+v"(tid)); \
    const int lane = tid & 63, wave = __builtin_amdgcn_readfirstlane(tid >> 6); int G = gridDim.x, bid = blockIdx.x; asm volatile("" : "+s"(G), "+s"(bid)); \
    const int gw = bid * 8 + wave, NGW = G * 8, gtid = bid * 512 + tid, NGT = G * 512; float* X = (float*)((unsigned char*)a.out + zoff_); \
    bf16* Xb = (bf16*)(ws + WS_XB); float* ssq = (float*)(ws + WS_SSQ); bf16* Z = (bf16*)(ws + WS_Z); \
    (void)lane; (void)gw; (void)NGW; (void)gtid; (void)NGT; (void)Xb; (void)ssq; (void)Z; (void)X;

__global__ void __launch_bounds__(512, 2) fwd_megakernel(Args a) {
    extern __shared__ __attribute__((aligned(16))) unsigned char lds_raw[];
    LAS unsigned char* L = (LAS unsigned char*)lds_raw;
    volatile LAS unsigned* MISC = (volatile LAS unsigned*)(L + LDS_BYTES - 64);
    if (threadIdx.x < 16) MISC[threadIdx.x] = 0u;
    __syncthreads();
    const XcdBarrier xbar = xcd_barrier_post((unsigned*)(a.ws + WS_CTL), MISC);

    REP(PROBE_CONV) { FRESH(); conv_weights<0>(a, L, gw, NGW, wave, lane); }
    { FRESH(); prologue_misc(a, gw, NGW, lane, gtid, NGT); }
    cg::this_grid().sync();

    for (int l = 0; l < 2; ++l) {
        REP(PROBE_GEMM) { FRESH(); run_gemm(L, Xb, D, (const bf16*)(ws + W_GU1), D, M, 2 * DFF, D, G, bid, EpiSwiglu{Z, ssq}); }
        GSYNC();
#if PROBE_RES
        { FRESH(); run_gemm(L, Z, DFF, (const bf16*)(ws + W_DN1), DFF, M, D, DFF, G, bid, EpiResid{l == 0 ? (const float*)a.in[0] : X, X, Xb, ssq, l == 0 ? 0.5f : 0.0f}); }
        GSYNC();
#endif
        { FRESH(); run_gemm(L, Z, DFF, (const bf16*)(ws + W_DN1), DFF, M, D, DFF, G, bid, EpiResid{l == 0 ? (const float*)a.in[0] : X, X, Xb, ssq, 0.5f}); }
        GSYNC();
        REP(PROBE_GEMM) { FRESH(); run_gemm(L, Xb, D, (const bf16*)(ws + W_IN), D, M, NATT, D, G, bid, EpiZ{Z, NATT, ssq}); }
        GSYNC();
        REP(PROBE_ATT & 1) { FRESH(); dil_attn_phase(L, Z, (const float*)(ws + WS_COS), (const float*)(ws + WS_SIN), (bf16*)(ws + WS_OG), (float*)(ws + WS_LSE), G, bid, tid); }
        GSYNC();
        REP(PROBE_GEMM) { FRESH(); run_gemm(L, Xb, D, (const bf16*)(ws + W_IN) + (size_t)NATT * D, D, M, NH2, D, G, bid, EpiZ{Z, NH2, ssq}); }
        { FRESH(); merge_phase((const bf16*)(ws + WS_OG), (const float*)(ws + WS_LSE), (bf16*)(ws + WS_AO), gtid, NGT); }
        GSYNC();
#if PROBE_HG & 1
        { FRESH(); hgrn1_phase<true>(L, Z, (const float*)a.in[8], l, (float*)(ws + WS_DEC), (unsigned long long*)(ws + WS_OG), G, bid, tid); }
#endif
        { FRESH(); hgrn1_phase<false>(L, Z, (const float*)a.in[8], l, (float*)(ws + WS_DEC), (unsigned long long*)(ws + WS_OG), G, bid, tid); }
        GSYNC();
        { FRESH();
#if PROBE_HG & 2
          if (bid < 64) { hgrn2_phase<true>(L, Z, (const float*)(ws + WS_DEC), (unsigned long long*)(ws + WS_OG), bid, tid); __syncthreads(); }
#endif
          if (bid < 64) hgrn2_phase<false>(L, Z, (const float*)(ws + WS_DEC), (unsigned long long*)(ws + WS_OG), bid, tid);
          else if (l == 0) {
            const int G2 = G - 64, c2 = bid - 64;
#pragma unroll
            for (int ll = 0; ll < 2; ++ll) {
                const bf16* memN = (const bf16*)(ws + WS_MEMN) + (size_t)ll * MROWS * D; const bf16* Wkv = (const bf16*)(ws + (ll ? WS_WKV1 : W_KV));
                run_gemm(L, memN, D, Wkv, D, MROWS, D, D, G2, (c2 + 32 * ll) % G2, EpiZ{(bf16*)(ws + (ll ? WS_MEMK1 : WS_MEMK)), D, nullptr});
                run_gemm(L, Wkv + (size_t)D * D, D, memN, D, D, MROWS, D, G2, (c2 + 32 * ll + 16) % G2, EpiZ{(bf16*)(ws + (ll ? WS_MEMVT1 : WS_MEMVT)), MROWS, nullptr});
            }
            conv_weights<1>(a, L, c2 * 8 + wave, G2 * 8, wave, lane);
          } else conv_weights<2>(a, L, (bid - 64) * 8 + wave, (G - 64) * 8, wave, lane);
        }
        GSYNC();
        { FRESH(); hgrn3_phase(Z, (const unsigned long long*)(ws + WS_OG), (const float*)a.in[9] + (size_t)l * D, gw, NGW, lane); }
        GSYNC();
        REP(PROBE_GEMM) { FRESH(); run_gemm(L, Xb, D, (const bf16*)(ws + W_IN) + (size_t)(NATT + NH2) * D, D, M, 2048, D, G, bid, EpiZ{Z, NH2, ssq}); }
        GSYNC();
        { FRESH(); run_gemm(L, (const bf16*)(ws + WS_AO), 512, (const bf16*)(ws + W_AB), 512, M, D, 512, G, bid, EpiGate<false>{Z, NH2, Z + 2048, NH2}); }
        { FRESH(); run_gemm(L, Z + 3072, NH2, (const bf16*)(ws + W_HB), D, M, D, D, G, bid, EpiGate<true>{Z + 1024, NH2, Z + 2048, NH2}); }
        GSYNC();
#if PROBE_RES
        { FRESH(); run_gemm(L, Z + 2048, NH2, (const bf16*)(ws + W_MO), D, M, D, D, G, bid, EpiResid{X, X, Xb, ssq, 0.0f}); }
        GSYNC();
#endif
        { FRESH(); run_gemm(L, Z + 2048, NH2, (const bf16*)(ws + W_MO), D, M, D, D, G, bid, EpiResid{X, X, Xb, ssq, 1.0f}); }
        GSYNC();
        REP(PROBE_GEMM) { FRESH(); run_gemm(L, Xb, D, (const bf16*)(ws + W_Q), D, M, D, D, G, bid, EpiZ{Z, D, ssq}); }
        GSYNC();
        REP((PROBE_ATT >> 1) & 1) { FRESH(); xattn_phase(L, Z, (const bf16*)(ws + (l ? WS_MEMK1 : WS_MEMK)), (const bf16*)(ws + (l ? WS_MEMVT1 : WS_MEMVT)), Z + (size_t)M * D, G, bid, tid); }
        GSYNC();
#if PROBE_RES
        { FRESH(); run_gemm(L, Z + (size_t)M * D, D, (const bf16*)(ws + W_O), D, M, D, D, G, bid, EpiResid{X, X, Xb, ssq, 0.0f}); }
        GSYNC();
#endif
        { FRESH(); run_gemm(L, Z + (size_t)M * D, D, (const bf16*)(ws + W_O), D, M, D, D, G, bid, EpiResid{X, X, Xb, ssq, 1.0f}); }
        GSYNC();
        REP(PROBE_GEMM) { FRESH(); run_gemm(L, Xb, D, (const bf16*)(ws + W_GU2), D, M, 2 * DFF, D, G, bid, EpiSwiglu{Z, ssq}); }
        GSYNC();
#if PROBE_RES
        { FRESH(); run_gemm(L, Z, DFF, (const bf16*)(ws + W_DN2), DFF, M, D, DFF, G, bid, EpiResid{X, X, Xb, ssq, 0.0f}); }
        GSYNC();
#endif
        { FRESH(); run_gemm(L, Z, DFF, (const bf16*)(ws + W_DN2), DFF, M, D, DFF, G, bid, EpiResid{X, X, Xb, ssq, 0.5f}); }
        GSYNC();
    }
    { FRESH();
      const float* fg = (const float*)a.in[21];
      for (int m = gw; m < M; m += NGW) {
        f32x4* xr = (f32x4*)(X + (size_t)m * D) + lane; const f32x4* gr = (const f32x4*)fg + lane;
        f32x4 v[4]; float s = 0.f;
#pragma unroll
        for (int j = 0; j < 4; ++j) { v[j] = xr[64 * j]; s += (v[j][0] * v[j][0] + v[j][1] * v[j][1]) + (v[j][2] * v[j][2] + v[j][3] * v[j][3]); }
        const float rs = 1.0f / sqrtf(wave_sum(s) * (1.0f / D) + EPS);
#pragma unroll
        for (int j = 0; j < 4; ++j) xr[64 * j] = v[j] * rs * gr[64 * j];
      } }
}

extern "C" void kernel_launch(void* const* d_in, const int* in_sizes, int n_in, void* d_out, int out_size, void* d_ws, size_t ws_size, hipStream_t stream) {
    static int grid = 0;
    if (grid == 0) {
        if (n_in != 22 || out_size != M * D || ws_size < WS_END) { fprintf(stderr, "kernel_launch: unexpected shapes (n_in %d out %d ws %zu)\n", n_in, out_size, ws_size); grid = -1; return; }
        int dev = 0, cus = 0, per_cu = 0;
        hipGetDevice(&dev); hipDeviceGetAttribute(&cus, hipDeviceAttributeMultiprocessorCount, dev);
        hipFuncSetAttribute((const void*)fwd_megakernel, hipFuncAttributeMaxDynamicSharedMemorySize, LDS_BYTES);
        hipOccupancyMaxActiveBlocksPerMultiprocessor(&per_cu, (const void*)fwd_megakernel, 512, LDS_BYTES);
        if (per_cu < 1) { fprintf(stderr, "kernel_launch: occupancy query reports %d blocks per CU\n", per_cu); grid = -1; return; }
        grid = cus;
        if (grid < 128) { fprintf(stderr, "kernel_launch: too few CUs (%d)\n", grid); grid = -1; return; }
    }
    if (grid < 0) return;
    if (hipMemsetAsync((char*)d_ws + WS_CTL, 0, CTL_BYTES, stream) != hipSuccess) { fprintf(stderr, "kernel_launch: memset failed\n"); return; }
    Args a{};
    for (int i = 0; i < 22; ++i) a.in[i] = d_in[i];
    a.out = (float*)d_out; a.ws = (unsigned char*)d_ws;
    void* args[] = {&a};
    hipError_t e = hipLaunchCooperativeKernel((const void*)fwd_megakernel, dim3(grid), dim3(512), args, LDS_BYTES, stream);
    if (e != hipSuccess) fprintf(stderr, "cooperative launch failed: %s (grid %d)\n", hipGetErrorString(e), grid);
}
```

```cpp
#include <hip/hip_runtime.h>
#include <hip/hip_cooperative_groups.h>
#include <cstdio>
#include <cstdint>
namespace cg = cooperative_groups;
namespace pg8 {
#define PG8_LAS __attribute__((address_space(3)))
typedef unsigned short bf16_t;
typedef short bf16x8 __attribute__((ext_vector_type(8)));
typedef float f32x4 __attribute__((ext_vector_type(4)));
typedef unsigned u32x4 __attribute__((ext_vector_type(4)));
constexpr int BM = 256, BK = 64, HALF = 128, HTB = HALF * BK * 2  , STAGE_BYTES = 8 * HTB, NXCD = 8, WGM = 8;

__host__ __device__ __forceinline__ int lds_byte(int r, int c) { const int st = (r >> 4) * 2 + (c >> 5), rr = r & 15, cc = c & 31, ob = rr * 64 + cc * 2; return st * 1024 + (ob ^ (((ob >> 9) & 1) << 5)); }
__host__ __device__ __forceinline__ void stage_rc(int b, int& R, int& C) { const int st = b / 1024, sb = b % 1024, swz = sb ^ (((sb >> 9) & 1) << 5); R = (st >> 1) * 16 + swz / 64; C = (st & 1) * 32 + (swz % 64) / 2; }
__host__ __device__ __forceinline__ int perm32(int rho) { const int n = rho >> 4, i = rho & 15; return 8 * (i >> 2) + 4 * n + (i & 3); }

struct Unit { int pm, pn; };
struct Gemm { const bf16_t* A; const bf16_t* Bt; int M, N, K, lda, ldb; };

struct StaticOrder {
    int nM, nN, nwg, G, c;
    __host__ __device__ void init(int M, int N, int G_, int c_) { nM = M / BM; nN = N / BM; nwg = nM * nN; G = G_; c = c_; }
    __host__ __device__ bool next(int i, Unit& u) const {
        const long L = (long)i * G + c; if (L >= nwg) return false;
        int wgid = (int)L; { const int q = nwg / NXCD, r = nwg % NXCD, xcd = wgid % NXCD, off = wgid / NXCD; wgid = (xcd < r ? xcd * (q + 1) : r * (q + 1) + (xcd - r) * q) + off; }
        const int nig = WGM * nN, gid = wgid / nig, fm = gid * WGM, gsz = (nM - fm) < WGM ? (nM - fm) : WGM;
        u.pm = fm + ((wgid % nig) % gsz); u.pn = (wgid % nig) / gsz; return true;
    }
    __device__ __forceinline__ void a_ready(const Unit&) const {}
    __device__ __forceinline__ void done(const Unit&) const {}
};

template <class Epi, class Sched, bool ALIGN_EPI = false, bool SP2 = false>
__device__ __forceinline__ void gemm_phase(PG8_LAS unsigned char* lds, const Gemm g, const Sched& S, const Epi& E) {
    int tid_ = threadIdx.x; asm volatile("" : "+v"(tid_)); const int tid = tid_, wid = __builtin_amdgcn_readfirstlane(tid >> 6), lane = tid & 63, wr = wid >> 2, wc = wid & 3, fr = lane & 15, fq = lane >> 4;
    const int K = g.K, nt = K / BK;
    unsigned voffA[2], voffB[2];
#pragma unroll
    for (int i = 0; i < 2; ++i) { int R, C; stage_rc(tid * 16 + i * 8192, R, C); const int Rb = Epi::PERM ? ((R & ~31) + perm32(R & 31)) : R;
        voffA[i] = (unsigned)(R * g.lda + C) * 2u; voffB[i] = (unsigned)(Rb * g.ldb + C) * 2u; }
    const size_t kstep = (size_t)(BK * 2);
    const size_t hstepA = (size_t)HALF * g.lda * 2, hstepB = (size_t)HALF * g.ldb * 2;
    const size_t tstepA = 2 * hstepA, tstepB = 2 * hstepB;
    const unsigned ldsw = (unsigned)wid * 1024u;
    const int aoff = lds_byte(wr * 64 + fr, fq * 8), boff = lds_byte(wc * 32 + fr, fq * 8);
#define PG8_SA(b, h) (((b) * 2 + (h)) * HTB)
#define PG8_SB(b, h) ((4 + (b) * 2 + (h)) * HTB)
#define PG8_STAGE(bufoff, gbase, voff) do { _Pragma("unroll") for (int _i = 0; _i < 2; ++_i) \
        __builtin_amdgcn_global_load_lds((const unsigned*)((const char*)(gbase) + (voff)[_i]), (PG8_LAS unsigned*)(lds + (bufoff) + ldsw + _i * 8192), 16, 0, 0); } while (0)
#define PG8_LDA(dst, b, h) do { _Pragma("unroll") for (int m = 0; m < 4; ++m) _Pragma("unroll") for (int k = 0; k < 2; ++k) dst[m][k] = *(const PG8_LAS bf16x8*)(lds + PG8_SA(b, h) + aoff + m * 2048 + k * 1024); } while (0)
#define PG8_LDB(dst, b, h) do { _Pragma("unroll") for (int n = 0; n < 2; ++n) _Pragma("unroll") for (int k = 0; k < 2; ++k) dst[n][k] = *(const PG8_LAS bf16x8*)(lds + PG8_SB(b, h) + boff + n * 2048 + k * 1024); } while (0)
#define PG8_MMA(ai, bj, At, Bt) do { __builtin_amdgcn_s_setprio(1); _Pragma("unroll") for (int m = 0; m < 4; ++m) _Pragma("unroll") for (int n = 0; n < 2; ++n) _Pragma("unroll") for (int k = 0; k < 2; ++k) \
        acc[ai][bj][m][n] = __builtin_amdgcn_mfma_f32_16x16x32_bf16(Bt[n][k], At[m][k], acc[ai][bj][m][n], 0, 0, 0); __builtin_amdgcn_s_setprio(0); } while (0)
#define PG8_WAIT_V(n) asm volatile("s_waitcnt vmcnt(" #n ")" ::: "memory")
#define PG8_WAIT_L(n) asm volatile("s_waitcnt lgkmcnt(" #n ")" ::: "memory")
#define PG8_BAR __builtin_amdgcn_s_barrier()
#define PG8_SCHED __builtin_amdgcn_sched_barrier(0)
    Unit cur, nxt; int ui = 0;
    if (!S.next(0, cur)) return;
    f32x4 acc[2][2][4][2];
#pragma unroll
    for (int a = 0; a < 2; ++a)
#pragma unroll
        for (int b = 0; b < 2; ++b)
#pragma unroll
            for (int m = 0; m < 4; ++m)
#pragma unroll
                for (int n = 0; n < 2; ++n) acc[a][b][m][n] = (f32x4){0.f, 0.f, 0.f, 0.f};
    bf16x8 At[4][2], B0[2][2], B1[2][2];
    const char* cA = (const char*)g.A + (size_t)cur.pm * tstepA; const char* cB = (const char*)g.Bt + (size_t)cur.pn * tstepB;
    S.a_ready(cur);
    if constexpr (SP2) {
        PG8_STAGE(PG8_SB(0, 0), cB, voffB); PG8_STAGE(PG8_SB(0, 1), cB + hstepB, voffB); PG8_STAGE(PG8_SA(0, 0), cA, voffA); PG8_STAGE(PG8_SA(0, 1), cA + hstepA, voffA);
        if (wr == 1) PG8_BAR;
        PG8_WAIT_V(2); PG8_BAR;
        PG8_STAGE(PG8_SB(1, 0), cB + kstep, voffB); PG8_STAGE(PG8_SA(1, 0), cA + kstep, voffA); PG8_STAGE(PG8_SB(1, 1), cB + hstepB + kstep, voffB);
        PG8_WAIT_V(6); PG8_BAR;
    } else {
        PG8_STAGE(PG8_SB(0, 0), cB, voffB); PG8_STAGE(PG8_SA(0, 0), cA, voffA); PG8_STAGE(PG8_SB(0, 1), cB + hstepB, voffB); PG8_STAGE(PG8_SA(0, 1), cA + hstepA, voffA);
        if (wr == 1) PG8_BAR;
        PG8_WAIT_V(4); PG8_BAR;
        PG8_STAGE(PG8_SB(1, 0), cB + kstep, voffB); PG8_STAGE(PG8_SA(1, 0), cA + kstep, voffA); PG8_STAGE(PG8_SB(1, 1), cB + hstepB + kstep, voffB);
        PG8_WAIT_V(6); PG8_BAR;
    }
    for (;;) {
        const bool has_next = S.next(ui + 1, nxt);
        const char* nA = has_next ? (const char*)g.A + (size_t)nxt.pm * tstepA : cA; const char* nB = has_next ? (const char*)g.Bt + (size_t)nxt.pn * tstepB : cB;
        for (int t = 0; t < nt; t += 2) {
            const bool last = (t == nt - 2);
            const char* a1 = cA + (size_t)(t + 1) * kstep;
            const char* a2 = last ? nA : cA + (size_t)(t + 2) * kstep; const char* b2 = last ? nB : cB + (size_t)(t + 2) * kstep;
            const char* a3 = a2 + kstep; const char* b3 = b2 + kstep;
            if (last && has_next) S.a_ready(nxt);
            if constexpr (SP2) {
            PG8_LDB(B0, 0, 0); PG8_LDB(B1, 0, 1); PG8_SCHED; PG8_LDA(At, 0, 0); PG8_STAGE(PG8_SA(1, 1), a1 + hstepA, voffA);
            PG8_WAIT_V(8); PG8_WAIT_L(0); PG8_BAR; PG8_MMA(0, 0, At, B0); PG8_MMA(0, 1, At, B1); PG8_BAR; PG8_SCHED;
            PG8_LDA(At, 0, 1); PG8_STAGE(PG8_SB(0, 0), b2, voffB); PG8_STAGE(PG8_SB(0, 1), b2 + hstepB, voffB); PG8_STAGE(PG8_SA(0, 0), a2, voffA);
            PG8_WAIT_V(8); PG8_WAIT_L(0); PG8_BAR; PG8_MMA(1, 0, At, B0); PG8_MMA(1, 1, At, B1); PG8_BAR; PG8_SCHED;
            PG8_LDB(B0, 1, 0); PG8_LDB(B1, 1, 1); PG8_SCHED; PG8_LDA(At, 1, 0); PG8_STAGE(PG8_SA(0, 1), a2 + hstepA, voffA);
            PG8_WAIT_V(8); PG8_WAIT_L(0); PG8_BAR; PG8_MMA(0, 0, At, B0); PG8_MMA(0, 1, At, B1); PG8_BAR; PG8_SCHED;
            PG8_LDA(At, 1, 1); PG8_STAGE(PG8_SB(1, 0), b3, voffB); PG8_STAGE(PG8_SB(1, 1), b3 + hstepB, voffB); PG8_STAGE(PG8_SA(1, 0), a3, voffA);
            PG8_WAIT_V(8); PG8_WAIT_L(0); PG8_BAR; PG8_MMA(1, 0, At, B0); PG8_MMA(1, 1, At, B1); PG8_BAR; PG8_SCHED;
            } else {
            PG8_LDB(B0, 0, 0); PG8_SCHED; PG8_LDA(At, 0, 0); PG8_STAGE(PG8_SA(1, 1), a1 + hstepA, voffA);
            PG8_WAIT_L(8); PG8_BAR; PG8_WAIT_L(0); PG8_MMA(0, 0, At, B0); PG8_BAR; PG8_SCHED;
            PG8_LDB(B1, 0, 1); PG8_STAGE(PG8_SB(0, 0), b2, voffB);
            PG8_BAR; PG8_WAIT_L(0); PG8_MMA(0, 1, At, B1); PG8_BAR;
            PG8_LDA(At, 0, 1); PG8_STAGE(PG8_SA(0, 0), a2, voffA);
            PG8_BAR; PG8_WAIT_L(0); PG8_MMA(1, 0, At, B0); PG8_BAR; PG8_SCHED;
            PG8_STAGE(PG8_SB(0, 1), b2 + hstepB, voffB);
            PG8_WAIT_V(6); PG8_BAR; PG8_MMA(1, 1, At, B1); PG8_BAR;
            PG8_LDB(B0, 1, 0); PG8_SCHED; PG8_LDA(At, 1, 0); PG8_STAGE(PG8_SA(0, 1), a2 + hstepA, voffA);
            PG8_WAIT_L(8); PG8_BAR; PG8_WAIT_L(0); PG8_MMA(0, 0, At, B0); PG8_BAR; PG8_SCHED;
            PG8_LDB(B1, 1, 1); PG8_STAGE(PG8_SB(1, 0), b3, voffB);
            PG8_BAR; PG8_WAIT_L(0); PG8_MMA(0, 1, At, B1); PG8_BAR;
            PG8_LDA(At, 1, 1); PG8_STAGE(PG8_SA(1, 0), a3, voffA);
            PG8_BAR; PG8_WAIT_L(0); PG8_MMA(1, 0, At, B0); PG8_BAR; PG8_SCHED;
            PG8_STAGE(PG8_SB(1, 1), b3 + hstepB, voffB);
            PG8_WAIT_V(6); PG8_BAR; PG8_MMA(1, 1, At, B1); PG8_BAR;
            }
        }
        if constexpr (ALIGN_EPI) { if (wr == 0) PG8_BAR; }
        if constexpr (!Epi::AFTER_DRAIN) { E(acc, cur, wr, wc, fr, fq); S.done(cur); }
        if (!has_next) break;
#pragma unroll
        for (int a = 0; a < 2; ++a)
#pragma unroll
            for (int b = 0; b < 2; ++b)
#pragma unroll
                for (int m = 0; m < 4; ++m)
#pragma unroll
                    for (int n = 0; n < 2; ++n) acc[a][b][m][n] = (f32x4){0.f, 0.f, 0.f, 0.f};
        cur = nxt; cA = nA; cB = nB; ++ui;
        if constexpr (ALIGN_EPI) { if (wr == 1) PG8_BAR; }
    }
    PG8_WAIT_V(0);
    if constexpr (!ALIGN_EPI) { if (wr == 0) PG8_BAR; }
    PG8_BAR;
    if constexpr (Epi::AFTER_DRAIN) { E.fused(acc, cur, wr, wc, fr, fq, lds, wid, lane); S.done(cur); }
#undef PG8_SA
#undef PG8_SB
#undef PG8_STAGE
#undef PG8_LDA
#undef PG8_LDB
#undef PG8_MMA
#undef PG8_WAIT_V
#undef PG8_WAIT_L
#undef PG8_BAR
#undef PG8_SCHED
}
}

#define DI __device__ __forceinline__
#ifndef PROBE_DSEC
#define PROBE_DSEC 0
#endif
#define LAS __attribute__((address_space(3)))
typedef unsigned short bf16;
typedef short bf16x8 __attribute__((ext_vector_type(8)));
typedef short s16x4 __attribute__((ext_vector_type(4)));
typedef float f32x4 __attribute__((ext_vector_type(4)));
typedef unsigned u32x4 __attribute__((ext_vector_type(4)));
typedef unsigned u32x2 __attribute__((ext_vector_type(2)));
using pg8::Unit;

constexpr int NB = 4, T = 4096, D = 1024, M = NB * T, DFF = 2816, NMEM = 256, MROWS = NB * NMEM;
constexpr int NATT = 4608, NH2 = 4096;
constexpr float EPS = 1e-6f;
constexpr int LDS_BYTES = 147456;

constexpr size_t MiB = 1u << 20;
constexpr size_t W_GU1 = 0, W_DN1 = W_GU1 + (size_t)2 * DFF * D * 2, W_IN = W_DN1 + (size_t)D * DFF * 2, W_AB = W_IN + (size_t)10752 * D * 2,
                 W_HB = W_AB + (size_t)D * 512 * 2, W_MO = W_HB + (size_t)D * D * 2, W_Q = W_MO + (size_t)D * D * 2, W_KV = W_Q + (size_t)D * D * 2,
                 W_O = W_KV + (size_t)2 * D * D * 2, W_GU2 = W_O + (size_t)D * D * 2, W_DN2 = W_GU2 + (size_t)2 * DFF * D * 2, W_END = W_DN2 + (size_t)D * DFF * 2;
static_assert(W_END <= 68 * MiB, "weights");
constexpr size_t WS_XB = 68 * MiB, WS_Z = 100 * MiB, WS_OG = 244 * MiB, WS_AO = 292 * MiB, WS_COS = 308 * MiB, WS_SIN = 312 * MiB, WS_MEMN = 316 * MiB,
                 WS_MEMK = 320 * MiB, WS_MEMVT = 322 * MiB, WS_SSQ = 324 * MiB, WS_DEC = 325 * MiB, WS_LSE = 326 * MiB, WS_CTL = 327 * MiB, CTL_BYTES = 65536, WS_WKV1 = 328 * MiB, WS_MEMK1 = 332 * MiB, WS_MEMVT1 = 334 * MiB, WS_END = 336 * MiB;

DI float bf2f(unsigned short h) { return __uint_as_float((unsigned)h << 16); }
typedef __bf16 bf2_t __attribute__((ext_vector_type(2)));
typedef float f32x2_t __attribute__((ext_vector_type(2)));
DI unsigned pk2(float lo, float hi) { const bf2_t r = __builtin_convertvector((f32x2_t){lo, hi}, bf2_t); return __builtin_bit_cast(unsigned, r); }
DI unsigned f2bf(float f) { return pk2(f, 0.f) & 0xffffu; }
template <int N> DI float rr_add(float v) { return v + __int_as_float(__builtin_amdgcn_update_dpp(0, __float_as_int(v), 0x120 + N, 0xf, 0xf, false)); }
DI float row16_sum(float v) { v = rr_add<1>(v); v = rr_add<2>(v); v = rr_add<4>(v); v = rr_add<8>(v); return v; }
#define LBAR() do { asm volatile("s_waitcnt lgkmcnt(0)" ::: "memory"); __builtin_amdgcn_s_barrier(); asm volatile("" ::: "memory"); } while (0)
DI float lo16(unsigned u) { return __uint_as_float(u << 16); }
DI float hi16(unsigned u) { return __uint_as_float(u & 0xffff0000u); }
DI float wave_sum(float v) {
#pragma unroll
    for (int o = 1; o < 64; o <<= 1) v += __shfl_xor(v, o);
    return v;
}
DI float sigmoidf_(float x) { return __builtin_amdgcn_rcpf(1.0f + __expf(-x)); }
DI bf16x8 mk8(u32x4 v) { return __builtin_bit_cast(bf16x8, v); }
#define MFMA16(a, b, c) __builtin_amdgcn_mfma_f32_16x16x32_bf16((a), (b), (c), 0, 0, 0)

#define EPI_FENCE() asm volatile("" ::: "memory")
DI void rows_rstd(const float* ssq, int row0, int fq, float (&rs)[8]) {
    f32x4 pv[8];
#pragma unroll
    for (int k = 0; k < 8; ++k) pv[k] = *(const f32x4*)(ssq + (size_t)(row0 + (k >> 2) * 128 + (k & 3) * 16) * 16 + 4 * fq);
#pragma unroll
    for (int k = 0; k < 8; ++k) { float t = (pv[k][0] + pv[k][1]) + (pv[k][2] + pv[k][3]); t += __shfl_xor(t, 16); t += __shfl_xor(t, 32); rs[k] = __builtin_amdgcn_rsqf(t * (1.0f / D) + EPS); }
}
struct EpiZ {
    static constexpr bool PERM = true, AFTER_DRAIN = false;
    bf16* O; int ldc; const float* ssq;
    DI void operator()(const f32x4 (&acc)[2][2][4][2], const Unit& u, int wr, int wc, int fr, int fq) const {
        const int row0 = u.pm * 256 + wr * 64 + fr, col0 = u.pn * 256 + wc * 32 + 8 * fq;
        float rs[8];
        if (ssq) rows_rstd(ssq, row0, fq, rs); else {
#pragma unroll
            for (int k = 0; k < 8; ++k) rs[k] = 1.0f; }
        EPI_FENCE();
#pragma unroll
        for (int ai = 0; ai < 2; ++ai)
#pragma unroll
            for (int m = 0; m < 4; ++m) {
                const int row = row0 + ai * 128 + m * 16; const float r1 = rs[ai * 4 + m];
                bf16* rowp = O + (size_t)row * ldc + col0;
#pragma unroll
                for (int bj = 0; bj < 2; ++bj) {
                    const f32x4 v0 = acc[ai][bj][m][0] * r1, v1 = acc[ai][bj][m][1] * r1;
                    u32x4 w; w.x = pk2(v0[0], v0[1]); w.y = pk2(v0[2], v0[3]); w.z = pk2(v1[0], v1[1]); w.w = pk2(v1[2], v1[3]);
                    *(u32x4*)(rowp + bj * 128) = w;
                }
            }
    }
};
struct EpiRope {
    static constexpr bool PERM = true, AFTER_DRAIN = false;
    bf16* O; const float* ssq; const float* cosT; const float* sinT;
    DI void operator()(const f32x4 (&acc)[2][2][4][2], const Unit& u, int wr, int wc, int fr, int fq) const {
        const int row0 = u.pm * 256 + wr * 64 + fr;
        float rs[8]; rows_rstd(ssq, row0, fq, rs);
        if (u.pn < 12) {
            const int i0 = 32 * (wc & 1) + 8 * fq, colb = (2 * u.pn + (wc >> 1)) * 128 + i0;
#pragma unroll
            for (int hb = 0; hb < 4; ++hb) {
                const int ai = hb >> 1, mb = (hb & 1) * 2;
                f32x4 c0[2], c1[2], s0[2], s1[2];
#pragma unroll
                for (int mm = 0; mm < 2; ++mm) { const int row = row0 + ai * 128 + (mb + mm) * 16; const float* cp = cosT + (size_t)row * 64 + i0; const float* sp = sinT + (size_t)row * 64 + i0;
                    c0[mm] = *(const f32x4*)cp; c1[mm] = *(const f32x4*)(cp + 4); s0[mm] = *(const f32x4*)sp; s1[mm] = *(const f32x4*)(sp + 4); }
                EPI_FENCE();
#pragma unroll
                for (int mm = 0; mm < 2; ++mm) { const int m = mb + mm;
                    const int row = row0 + ai * 128 + m * 16; const float r1 = rs[ai * 4 + m];
                    const f32x4 a0 = acc[ai][0][m][0] * r1, a1 = acc[ai][0][m][1] * r1, b0 = acc[ai][1][m][0] * r1, b1 = acc[ai][1][m][1] * r1;
                    const f32x4 y10 = a0 * c0[mm] - b0 * s0[mm], y11 = a1 * c1[mm] - b1 * s1[mm], y20 = b0 * c0[mm] + a0 * s0[mm], y21 = b1 * c1[mm] + a1 * s1[mm];
                    u32x4 w1, w2; w1.x = pk2(y10[0], y10[1]); w1.y = pk2(y10[2], y10[3]); w1.z = pk2(y11[0], y11[1]); w1.w = pk2(y11[2], y11[3]);
                    w2.x = pk2(y20[0], y20[1]); w2.y = pk2(y20[2], y20[3]); w2.z = pk2(y21[0], y21[1]); w2.w = pk2(y21[2], y21[3]);
                    bf16* rowp = O + (size_t)row * NATT + colb; *(u32x4*)rowp = w1; *(u32x4*)(rowp + 64) = w2;
                }
                EPI_FENCE();
            }
        } else {
            const int col0 = u.pn * 256 + wc * 32 + 8 * fq;
            EPI_FENCE();
#pragma unroll
            for (int ai = 0; ai < 2; ++ai)
#pragma unroll
                for (int m = 0; m < 4; ++m) {
                    const int row = row0 + ai * 128 + m * 16; const float r1 = rs[ai * 4 + m]; bf16* rowp = O + (size_t)row * NATT + col0;
#pragma unroll
                    for (int bj = 0; bj < 2; ++bj) { const f32x4 v0 = acc[ai][bj][m][0] * r1, v1 = acc[ai][bj][m][1] * r1;
                        u32x4 w; w.x = pk2(v0[0], v0[1]); w.y = pk2(v0[2], v0[3]); w.z = pk2(v1[0], v1[1]); w.w = pk2(v1[2], v1[3]); *(u32x4*)(rowp + bj * 128) = w; }
                }
        }
    }
};
struct EpiSwiglu {
    static constexpr bool PERM = true, AFTER_DRAIN = false;
    bf16* H; const float* ssq;
    DI void operator()(const f32x4 (&acc)[2][2][4][2], const Unit& u, int wr, int wc, int fr, int fq) const {
        const int row0 = u.pm * 256 + wr * 64 + fr, col0 = u.pn * 128 + wc * 32 + 8 * fq;
        float rs[8]; rows_rstd(ssq, row0, fq, rs);
        EPI_FENCE();
#pragma unroll
        for (int ai = 0; ai < 2; ++ai)
#pragma unroll
            for (int m = 0; m < 4; ++m) {
                const int row = row0 + ai * 128 + m * 16; const float r1 = rs[ai * 4 + m];
                float h[8];
#pragma unroll
                for (int n = 0; n < 2; ++n)
#pragma unroll
                    for (int e = 0; e < 4; ++e) { const float g = acc[ai][0][m][n][e] * r1, up = acc[ai][1][m][n][e] * r1; h[4 * n + e] = g * sigmoidf_(g) * up; }
                u32x4 w; w.x = pk2(h[0], h[1]); w.y = pk2(h[2], h[3]); w.z = pk2(h[4], h[5]); w.w = pk2(h[6], h[7]);
                *(u32x4*)(H + (size_t)row * DFF + col0) = w;
            }
    }
};
struct EpiResid {
    static constexpr bool PERM = false, AFTER_DRAIN = false;
    const float* x32; bf16* hi; const bf16* lo_in; bf16* lo_out; float* ssq; float alpha;
    DI void operator()(const f32x4 (&acc)[2][2][4][2], const Unit& u, int wr, int wc, int fr, int fq) const {
        const int row0 = u.pm * 256 + wr * 64 + fr, col0 = u.pn * 256 + wc * 32 + 4 * fq;
#pragma unroll
        for (int rb = 0; rb < 4; ++rb) {
            const int ai = rb >> 1, mb = (rb & 1) * 2;
            f32x4 xo[8];
            if (x32) {
#pragma unroll
                for (int g = 0; g < 8; ++g) xo[g] = *(const f32x4*)(x32 + (size_t)(row0 + ai * 128 + (mb + (g >> 2)) * 16) * D + col0 + ((g >> 1) & 1) * 128 + (g & 1) * 16);
            } else {
                u32x2 hv[8], lv[8];
#pragma unroll
                for (int g = 0; g < 8; ++g) { const size_t off = (size_t)(row0 + ai * 128 + (mb + (g >> 2)) * 16) * D + col0 + ((g >> 1) & 1) * 128 + (g & 1) * 16; hv[g] = *(const u32x2*)(hi + off); lv[g] = *(const u32x2*)(lo_in + off); }
#pragma unroll
                for (int g = 0; g < 8; ++g) xo[g] = (f32x4){lo16(hv[g].x) + lo16(lv[g].x), hi16(hv[g].x) + hi16(lv[g].x), lo16(hv[g].y) + lo16(lv[g].y), hi16(hv[g].y) + hi16(lv[g].y)};
            }
            EPI_FENCE();
#pragma unroll
            for (int mm = 0; mm < 2; ++mm) { const int m = mb + mm; const int row = row0 + ai * 128 + m * 16; float ss = 0.f;
#pragma unroll
                for (int bj = 0; bj < 2; ++bj)
#pragma unroll
                    for (int n = 0; n < 2; ++n) {
                        const size_t off = (size_t)row * D + col0 + bj * 128 + n * 16;
                        const f32x4 x = xo[mm * 4 + bj * 2 + n] + acc[ai][bj][m][n] * alpha;
                        u32x2 w; w.x = pk2(x[0], x[1]); w.y = pk2(x[2], x[3]); *(u32x2*)(hi + off) = w;
                        u32x2 wl; wl.x = pk2(x[0] - lo16(w.x), x[1] - hi16(w.x)); wl.y = pk2(x[2] - lo16(w.y), x[3] - hi16(w.y)); *(u32x2*)(lo_out + off) = wl;
                        ss += (x[0] * x[0] + x[1] * x[1]) + (x[2] * x[2] + x[3] * x[3]);
                    }
                ss += __shfl_xor(ss, 16); ss += __shfl_xor(ss, 32);
                if (fq == 0) ssq[(size_t)row * 16 + u.pn * 4 + wc] = ss;
            }
            EPI_FENCE();
        }
    }
};
template <bool ADD> struct EpiGate {
    static constexpr bool PERM = true, AFTER_DRAIN = false;
    const bf16* Gt; int ldg; bf16* Mg; int ldm;
    DI void operator()(const f32x4 (&acc)[2][2][4][2], const Unit& u, int wr, int wc, int fr, int fq) const {
        const int row0 = u.pm * 256 + wr * 64 + fr, col0 = u.pn * 256 + wc * 32 + 8 * fq;
#pragma unroll
        for (int ai = 0; ai < 2; ++ai) {
            u32x4 gv[8], pv[8];
#pragma unroll
            for (int k = 0; k < 8; ++k) { const int row = row0 + ai * 128 + (k >> 1) * 16;
                gv[k] = *(const u32x4*)(Gt + (size_t)row * ldg + col0 + (k & 1) * 128);
                pv[k] = (u32x4){0u, 0u, 0u, 0u}; if (ADD) pv[k] = *(const u32x4*)(Mg + (size_t)row * ldm + col0 + (k & 1) * 128); }
            EPI_FENCE();
#pragma unroll
            for (int k = 0; k < 8; ++k) { const int m = k >> 1, bj = k & 1; const int row = row0 + ai * 128 + m * 16;
                float r[8];
#pragma unroll
                for (int q = 0; q < 4; ++q) {
                    const float a0 = acc[ai][bj][m][q >> 1][(q & 1) * 2], a1 = acc[ai][bj][m][q >> 1][(q & 1) * 2 + 1];
                    r[2 * q] = sigmoidf_(lo16(gv[k][q])) * a0 + (ADD ? lo16(pv[k][q]) : 0.f);
                    r[2 * q + 1] = sigmoidf_(hi16(gv[k][q])) * a1 + (ADD ? hi16(pv[k][q]) : 0.f);
                }
                u32x4 w; w.x = pk2(r[0], r[1]); w.y = pk2(r[2], r[3]); w.z = pk2(r[4], r[5]); w.w = pk2(r[6], r[7]);
                *(u32x4*)(Mg + (size_t)row * ldm + col0 + bj * 128) = w;
            }
            EPI_FENCE();
        }
    }
};

template <class Epi>
DI void run_gemm(LAS unsigned char* lds, const bf16* A, int lda, const bf16* Bt, int ldb, int Mr, int N, int K, int G, int c, const Epi& E) {
    pg8::Gemm g{A, Bt, Mr, N, K, lda, ldb}; pg8::StaticOrder S; S.init(Mr, N, G, c);
    pg8::gemm_phase<Epi, pg8::StaticOrder, true, true>(lds, g, S, E);
}

DI void conv_item(const float* W, int K, int Nsrc, int srcoff, int Nout, int GU, const float* gain, bf16* WT, LAS float* scr, int item, int lane) {
    const int nblk = Nout / 64, kb = item / nblk, nb = item % nblk, k0 = 64 * kb, n0 = 64 * nb;
    const int src0 = srcoff + (GU == 1 ? (((n0 & 255) >> 7) * DFF + 128 * (n0 >> 8) + (n0 & 127)) : ((GU == 2 && n0 < 3072) ? (2 * (n0 >> 8) + ((n0 & 127) >> 6)) * 128 + ((n0 & 255) >> 7) * 64 : n0));
    float wv[64];
    const float* wp = W + (size_t)k0 * Nsrc + src0 + lane;
#pragma unroll
    for (int i = 0; i < 64; ++i) wv[i] = __builtin_nontemporal_load(wp + (size_t)i * Nsrc);
    const float g = gain ? gain[k0 + lane] : 1.0f;
#pragma unroll
    for (int i = 0; i < 64; ++i) scr[i * 65 + lane] = wv[i] * __shfl(g, i);
    asm volatile("s_waitcnt lgkmcnt(0)" ::: "memory");
    const int c = lane & 7;
#pragma unroll
    for (int j = 0; j < 8; ++j) { const int n = (lane >> 3) + 8 * j; const LAS float* s = scr + (8 * c) * 65 + n;
        u32x4 o; o.x = pk2(s[0 * 65], s[1 * 65]); o.y = pk2(s[2 * 65], s[3 * 65]); o.z = pk2(s[4 * 65], s[5 * 65]); o.w = pk2(s[6 * 65], s[7 * 65]);
        *(u32x4*)(WT + (size_t)(n0 + n) * K + k0 + 8 * c) = o; }
    asm volatile("s_waitcnt lgkmcnt(0)" ::: "memory");
}

struct Args { const void* in[22]; float* out; unsigned char* ws; };

template <int SET> DI void conv_weights(const Args& a, LAS unsigned char* L, int gw, int NGW, int wave, int lane) {
    LAS float* scr = (LAS float*)(L + wave * 16640);
    unsigned char* ws = a.ws;
    int it = gw;
#define CONV(l_, idx, K_, Ns_, so_, No_, GU_, gidx, dst_) { const float* Wp = (const float*)a.in[idx] + (size_t)(l_) * (K_) * (Ns_); const float* gp = (gidx) >= 0 ? (const float*)a.in[(gidx) >= 0 ? (gidx) : 0] + (size_t)(l_) * (K_) : nullptr; \
        const int nitems = ((K_) / 64) * ((No_) / 64); for (; it < nitems; it += NGW) conv_item(Wp, K_, Ns_, so_, No_, GU_, gp, (bf16*)(ws + (dst_)), scr, it, lane); it -= nitems; }
    if (SET == 0) {
        CONV(0, 4, D, 2 * DFF, 0, 2 * DFF, true, 3, W_GU1)
        CONV(0, 5, DFF, D, 0, D, false, -1, W_DN1)
        CONV(0, 7, D, 10752, 0, 10752, 2, 6, W_IN)
        CONV(0, 10, 512, D, 0, D, false, -1, W_AB)
        CONV(0, 11, D, D, 0, D, false, -1, W_HB)
        CONV(0, 12, D, D, 0, D, false, -1, W_MO)
        CONV(0, 15, D, D, 0, D, false, 13, W_Q)
        CONV(0, 16, D, 2 * D, 0, 2 * D, false, -1, W_KV)
        CONV(1, 16, D, 2 * D, 0, 2 * D, false, -1, WS_WKV1)
        CONV(0, 17, D, D, 0, D, false, -1, W_O)
        CONV(0, 19, D, 2 * DFF, 0, 2 * DFF, true, 18, W_GU2)
        CONV(0, 20, DFF, D, 0, D, false, -1, W_DN2)
    } else if (SET == 1) {
        CONV(1, 4, D, 2 * DFF, 0, 2 * DFF, true, 3, W_GU1)
        CONV(1, 5, DFF, D, 0, D, false, -1, W_DN1)
        CONV(1, 7, D, 10752, 0, 8704, 2, 6, W_IN)
    } else {
        CONV(1, 7, D, 10752, 8704, 2048, false, 6, W_IN + (size_t)8704 * D * 2)
        CONV(1, 10, 512, D, 0, D, false, -1, W_AB)
        CONV(1, 11, D, D, 0, D, false, -1, W_HB)
        CONV(1, 12, D, D, 0, D, false, -1, W_MO)
        CONV(1, 15, D, D, 0, D, false, 13, W_Q)
        CONV(1, 17, D, D, 0, D, false, -1, W_O)
        CONV(1, 19, D, 2 * DFF, 0, 2 * DFF, true, 18, W_GU2)
        CONV(1, 20, DFF, D, 0, D, false, -1, W_DN2)
    }
#undef CONV
}

DI void prologue_misc(const Args& a, int gw, int NGW, int lane, int gtid, int NGT) {
    unsigned char* ws = a.ws;
    const float* x = (const float*)a.in[0];
    bf16* Xb = (bf16*)(ws + WS_XB); float* ssq = (float*)(ws + WS_SSQ);
    for (int m0 = gw; m0 < M; m0 += 2 * NGW) {
        const int m1 = m0 + NGW < M ? m0 + NGW : m0;
        f32x4 va[4], vb[4];
#pragma unroll
        for (int j = 0; j < 4; ++j) { va[j] = ((const f32x4*)(x + (size_t)m0 * D) + lane)[64 * j]; vb[j] = ((const f32x4*)(x + (size_t)m1 * D) + lane)[64 * j]; }
#pragma unroll
        for (int rr = 0; rr < 2; ++rr) { const int m = rr ? m1 : m0; float s2 = 0.f;
            unsigned long long* o8 = (unsigned long long*)(Xb + (size_t)m * D) + lane;
#pragma unroll
            for (int j = 0; j < 4; ++j) { const f32x4 v = rr ? vb[j] : va[j]; s2 += (v[0] * v[0] + v[1] * v[1]) + (v[2] * v[2] + v[3] * v[3]);
                o8[64 * j] = (unsigned long long)pk2(v[0], v[1]) | ((unsigned long long)pk2(v[2], v[3]) << 32); }
            s2 = wave_sum(s2);
            if (lane < 16) ssq[(size_t)m * 16 + lane] = lane == 0 ? s2 : 0.f; }
    }
    const float* mem = (const float*)a.in[1]; const float* mnorm = (const float*)a.in[14]; bf16* memN = (bf16*)(ws + WS_MEMN);
    for (int r = gw; r < 2 * MROWS; r += NGW) {
        const int l = r / MROWS, m = r % MROWS;
        const f32x4* xr = (const f32x4*)(mem + (size_t)m * D) + lane; const f32x4* gr = (const f32x4*)(mnorm + (size_t)l * D) + lane;
        f32x4 v[4]; float s = 0.f;
#pragma unroll
        for (int j = 0; j < 4; ++j) { v[j] = xr[64 * j]; s += (v[j][0] * v[j][0] + v[j][1] * v[j][1]) + (v[j][2] * v[j][2] + v[j][3] * v[j][3]); }
        const float rs = 1.0f / sqrtf(wave_sum(s) * (1.0f / D) + EPS);
        unsigned long long* o8 = (unsigned long long*)(memN + (size_t)r * D) + lane;
#pragma unroll
        for (int j = 0; j < 4; ++j) { const f32x4 g = gr[64 * j]; const f32x4 y = v[j] * rs * g;
            o8[64 * j] = (unsigned long long)pk2(y[0], y[1]) | ((unsigned long long)pk2(y[2], y[3]) << 32); }
    }
    const int* pos = (const int*)a.in[2]; float* cosT = (float*)(ws + WS_COS); float* sinT = (float*)(ws + WS_SIN);
    for (int idx = gtid; idx < M * 64; idx += NGT) {
        const int row = idx >> 6, i = idx & 63;
        const float inv = exp2f(-(float)(2 * i) * (1.0f / 128.0f) * 13.287712379549449f);
        const float ang = (float)pos[row] * inv;
        double rv = (double)ang * 0.15915494309189535; rv -= floor(rv);
        const float fr = (float)rv;
        cosT[idx] = __builtin_amdgcn_cosf(fr); sinT[idx] = __builtin_amdgcn_sinf(fr);
    }
}

DI void rope8(u32x4 x1, u32x4 x2, const float* cp, const float* sp, u32x4& o1, u32x4& o2) {
    const f32x4 c0 = *(const f32x4*)cp, c1 = *(const f32x4*)(cp + 4), s0 = *(const f32x4*)sp, s1 = *(const f32x4*)(sp + 4);
#pragma unroll
    for (int q = 0; q < 4; ++q) {
        const float ca = q < 2 ? c0[2 * q] : c1[2 * q - 4], cb = q < 2 ? c0[2 * q + 1] : c1[2 * q - 3];
        const float sa = q < 2 ? s0[2 * q] : s1[2 * q - 4], sb = q < 2 ? s0[2 * q + 1] : s1[2 * q - 3];
        const float a0 = lo16(x1[q]), a1 = hi16(x1[q]), b0 = lo16(x2[q]), b1 = hi16(x2[q]);
        o1[q] = pk2(a0 * ca - b0 * sa, a1 * cb - b1 * sb);
        o2[q] = pk2(b0 * ca + a0 * sa, b1 * cb + a1 * sb);
    }
}
constexpr int KSTR = 272, VSTR = 528, KL_BYTES = 256 * KSTR;
DI unsigned vt_off(int dh, int kgrp) { return (unsigned)(dh * VSTR + ((kgrp ^ ((dh >> 3) & 7)) << 3)); }

DI void dil_attn_phase(LAS unsigned char* L, const bf16* Z, const float* cosT, const float* sinT, bf16* OG, float* LSE, int G, int bid, int tid, unsigned long long& tsec) {
#define DSEC(k) do { if (PROBE_DSEC) { const unsigned long long tn_ = __builtin_amdgcn_s_memrealtime(); if (PROBE_DSEC == (k)) tsec += tn_ - tl_; tl_ = tn_; } } while (0)
    unsigned long long tl_ = PROBE_DSEC ? __builtin_amdgcn_s_memrealtime() : 0;
    const int wid = __builtin_amdgcn_readfirstlane(tid >> 6), lane = tid & 63, fr = lane & 15, fq = lane >> 4;
    LAS unsigned char* KL = L; LAS unsigned char* VL = L + KL_BYTES;
    u32x4 kreg[8], vreg[8];
#define DIL_LOAD(uu_) do { const int j_ = (uu_) & 31, h_ = ((uu_) >> 5) & 3, gb_ = (uu_) >> 7, g_ = gb_ % 3, b_ = gb_ / 3, dsh_ = 2 * g_, Ls_ = T >> dsh_, p0_ = 128 * j_, r_ = p0_ / Ls_, u0_ = p0_ & (Ls_ - 1); \
        const int tb_ = b_ * T + r_, cq_ = g_ * 512 + h_ * 128; \
        _Pragma("unroll") for (int i = 0; i < 8; ++i) { const int p = tid + 512 * i, kk = p >> 4, cb = p & 15; int uu = u0_ - 128 + kk; uu = uu < 0 ? 0 : uu; \
            const bf16* rp_ = Z + (size_t)(tb_ + (uu << dsh_)) * NATT + cq_ + 8 * cb; kreg[i] = *(const u32x4*)(rp_ + 1536); vreg[i] = *(const u32x4*)(rp_ + 3072); } \
        } while (0)
    if (bid < 1536) DIL_LOAD(bid);
    for (int unit = bid; unit < 1536; unit += G) {
        const int j = unit & 31, h = (unit >> 5) & 3, gb = unit >> 7, g = gb % 3, b = gb / 3;
        const int dsh = 2 * g, Lseg = T >> dsh;
        const int p0 = 128 * j, r = p0 / Lseg, u0 = p0 & (Lseg - 1);
        const int tokbase = b * T + r;
        const int colq = g * 512 + h * 128;
        asm volatile("" : "+v"(kreg[0]), "+v"(kreg[1]), "+v"(kreg[2]), "+v"(kreg[3]), "+v"(kreg[4]), "+v"(kreg[5]), "+v"(kreg[6]), "+v"(kreg[7]));
        asm volatile("" : "+v"(vreg[0]), "+v"(vreg[1]), "+v"(vreg[2]), "+v"(vreg[3]), "+v"(vreg[4]), "+v"(vreg[5]), "+v"(vreg[6]), "+v"(vreg[7]));
        const int qi = 16 * wid + fr; const size_t tq = (size_t)(tokbase + ((u0 + qi) << dsh));
        bf16x8 qf[4];
#pragma unroll
        for (int k4 = 0; k4 < 4; ++k4) qf[k4] = *(const bf16x8*)(Z + tq * NATT + colq + 32 * k4 + 8 * fq);
        __syncthreads();
        DSEC(6);
#pragma unroll
        for (int i = 0; i < 8; ++i) {
            const int p = tid + 512 * i, kk = p >> 4, cb = p & 15; const bool ok = u0 - 128 + kk >= 0;
            const u32x4 zz = (u32x4){0u, 0u, 0u, 0u}; const u32x4 kx = ok ? kreg[i] : zz, x = ok ? vreg[i] : zz;
            *(LAS u32x4*)(KL + kk * KSTR + 16 * cb) = kx;
            const unsigned base = (unsigned)((((kk >> 2) ^ (cb & 7)) << 3) + (kk & 3) * 2);
#pragma unroll
            for (int jj = 0; jj < 8; ++jj) *(LAS unsigned short*)(VL + (8 * cb + jj) * VSTR + base) = (unsigned short)(x[jj >> 1] >> (16 * (jj & 1)));
        }
        DSEC(1);
        { const int nu = unit + G < 1536 ? unit + G : unit; DIL_LOAD(nu); }
        DSEC(2);
        __syncthreads();
        DSEC(3);
        const int tw = wid & ~1;
        f32x4 s[10];
#pragma unroll
        for (int tix = 0; tix < 10; ++tix) s[tix] = (f32x4){0.f, 0.f, 0.f, 0.f};
#pragma unroll
        for (int k4 = 0; k4 < 4; ++k4)
#pragma unroll
            for (int t5 = 0; t5 < 2; ++t5) { bf16x8 av[5];
#pragma unroll
                for (int tix = 0; tix < 5; ++tix) av[tix] = *(const LAS bf16x8*)(KL + (16 * (tw + 5 * t5 + tix) + fr) * KSTR + (32 * k4 + 8 * fq) * 2);
#pragma unroll
                for (int tix = 0; tix < 5; ++tix) s[5 * t5 + tix] = MFMA16(av[tix], qf[k4], s[5 * t5 + tix]); }
        DSEC(4);
        const float scale = 0.08838834764831845f; float mx = -INFINITY;
#pragma unroll
        for (int tix = 0; tix < 10; ++tix)
#pragma unroll
            for (int e = 0; e < 4; ++e) { const int kk = 16 * (tw + tix) + 4 * fq + e; const bool ok = (kk >= qi) && (kk <= qi + 128) && (u0 - 128 + kk >= 0);
                const float v = ok ? s[tix][e] * scale : -INFINITY; s[tix][e] = v; mx = fmaxf(mx, v); }
        mx = fmaxf(mx, __shfl_xor(mx, 16)); mx = fmaxf(mx, __shfl_xor(mx, 32));
        float den = 0.f;
#pragma unroll
        for (int tix = 0; tix < 10; ++tix)
#pragma unroll
            for (int e = 0; e < 4; ++e) { const float p = __expf(s[tix][e] - mx); s[tix][e] = p; den += p; }
        den += __shfl_xor(den, 16); den += __shfl_xor(den, 32);
        DSEC(5);
        bf16x8 pf[5];
#pragma unroll
        for (int pp = 0; pp < 5; ++pp) { u32x4 pw; pw.x = pk2(s[2 * pp][0], s[2 * pp][1]); pw.y = pk2(s[2 * pp][2], s[2 * pp][3]); pw.z = pk2(s[2 * pp + 1][0], s[2 * pp + 1][1]); pw.w = pk2(s[2 * pp + 1][2], s[2 * pp + 1][3]); pf[pp] = mk8(pw); }
        f32x4 o[8];
#pragma unroll
        for (int dt = 0; dt < 8; ++dt) o[dt] = (f32x4){0.f, 0.f, 0.f, 0.f};
        const unsigned x0 = (unsigned)(fq ^ (fr >> 3));
        const LAS unsigned char* vev = L + KL_BYTES + fr * VSTR + 32 * tw + (x0 << 3); const LAS unsigned char* vod = L + KL_BYTES + fr * VSTR + 32 * tw + ((x0 ^ 2u) << 3);
#pragma unroll
        for (int pp = 0; pp < 5; ++pp)
#pragma unroll
            for (int d4 = 0; d4 < 2; ++d4) { bf16x8 vf[4];
#pragma unroll
                for (int dq = 0; dq < 4; ++dq) { const int dt = 4 * d4 + dq; const LAS unsigned char* vb_ = ((dt & 1) ? vod : vev) + 16 * dt * VSTR + 64 * pp;
                    const s16x4 lo = *(const LAS s16x4*)(vb_ + (((2 * dt) & 4) << 3)), hi = *(const LAS s16x4*)(vb_ + ((((2 * dt) & 4) ^ 4) << 3)); vf[dq] = __builtin_shufflevector(lo, hi, 0, 1, 2, 3, 4, 5, 6, 7); }
#pragma unroll
                for (int dq = 0; dq < 4; ++dq) o[4 * d4 + dq] = MFMA16(vf[dq], pf[pp], o[4 * d4 + dq]);
            }
        const float inv = __builtin_amdgcn_rcpf(den), lse = mx + __logf(den);
        { bf16* op = OG + tq * 1536 + colq + 4 * fq;
#pragma unroll
          for (int dt = 0; dt < 8; ++dt) *(unsigned long long*)(op + 16 * dt) = (unsigned long long)pk2(o[dt][0] * inv, o[dt][1] * inv) | ((unsigned long long)pk2(o[dt][2] * inv, o[dt][3] * inv) << 32); }
        if (lane < 16) LSE[tq * 12 + g * 4 + h] = lse;
    }
#undef DIL_LOAD
}

DI void merge_phase(const bf16* OG, const float* LSE, bf16* AO, int gtid, int NGT) {
    for (int idx0 = gtid; idx0 < M * 64; idx0 += 4 * NGT) {
        u32x4 xa[4], xb[4], xd[4]; float l0[4], l1[4], l2[4]; bf16* op[4];
#pragma unroll
        for (int u = 0; u < 4; ++u) { const int idx = idx0 + u * NGT; const bool ok = idx < M * 64; const int tok = ok ? idx >> 6 : 0, h = (idx >> 4) & 3, c = idx & 15;
            l0[u] = LSE[(size_t)tok * 12 + h]; l1[u] = LSE[(size_t)tok * 12 + 4 + h]; l2[u] = LSE[(size_t)tok * 12 + 8 + h];
            const bf16* p = OG + (size_t)tok * 1536 + h * 128 + 8 * c; xa[u] = *(const u32x4*)p; xb[u] = *(const u32x4*)(p + 512); xd[u] = *(const u32x4*)(p + 1024);
            op[u] = ok ? AO + (size_t)tok * 512 + h * 128 + 8 * c : nullptr; }
#pragma unroll
        for (int u = 0; u < 4; ++u) {
            const float mx = fmaxf(l0[u], fmaxf(l1[u], l2[u])); float w0 = __expf(l0[u] - mx), w1 = __expf(l1[u] - mx), w2 = __expf(l2[u] - mx); const float inv = __builtin_amdgcn_rcpf(w0 + w1 + w2); w0 *= inv; w1 *= inv; w2 *= inv;
            u32x4 o;
#pragma unroll
            for (int q = 0; q < 4; ++q) o[q] = pk2(w0 * lo16(xa[u][q]) + w1 * lo16(xb[u][q]) + w2 * lo16(xd[u][q]), w0 * hi16(xa[u][q]) + w1 * hi16(xb[u][q]) + w2 * hi16(xd[u][q]));
            if (op[u]) *(u32x4*)op[u] = o;
        }
    }
}

#define XK_LOAD(R, b_, h_, hh_) do { _Pragma("unroll") for (int i = 0; i < 8; ++i) { const int p = tid + 512 * i, m = p >> 4, cb = p & 15; R[i] = *(const u32x4*)(memK + (size_t)((b_) * NMEM + m) * D + (h_) * 256 + 128 * (hh_) + 8 * cb); } } while (0)
#define XK_WRITE(R) do { _Pragma("unroll") for (int i = 0; i < 8; ++i) { const int p = tid + 512 * i, m = p >> 4, cb = p & 15; *(LAS u32x4*)(KL + m * KSTR + 16 * cb) = R[i]; } } while (0)
#define XV_LOAD(R, b_, h_, hh_) do { _Pragma("unroll") for (int i = 0; i < 8; ++i) { const int p = tid + 512 * i, dhr = p >> 5, c = p & 31; R[i] = *(const u32x4*)(memVT + (size_t)((h_) * 256 + 128 * (hh_) + dhr) * MROWS + (b_) * NMEM + 8 * c); } } while (0)
#define XV_WRITE(R) do { _Pragma("unroll") for (int i = 0; i < 8; ++i) { const int p = tid + 512 * i, dhr = p >> 5, c = p & 31; u32x2 lo, hi; lo.x = R[i].x; lo.y = R[i].y; hi.x = R[i].z; hi.y = R[i].w; \
        *(LAS u32x2*)(VL + vt_off(dhr, 2 * c)) = lo; *(LAS u32x2*)(VL + vt_off(dhr, 2 * c + 1)) = hi; } } while (0)
DI void xattn_phase(LAS unsigned char* L, const bf16* Qx, const bf16* memK, const bf16* memVT, bf16* Ox, int G, int bid, int tid, unsigned long long& tsec) {
    unsigned long long tl_ = PROBE_DSEC ? __builtin_amdgcn_s_memrealtime() : 0;
    const int wid = __builtin_amdgcn_readfirstlane(tid >> 6), lane = tid & 63, fr = lane & 15, fq = lane >> 4;
    LAS unsigned char* KL = L; LAS unsigned char* VL = L + KL_BYTES;
    u32x4 ra[8], rb[8];
    if (bid < 512) { const int h0 = (bid >> 5) & 3, b0 = bid >> 7; XK_LOAD(ra, b0, h0, 0); XV_LOAD(rb, b0, h0, 0); }
    for (int unit = bid; unit < 512; unit += G) {
        const int j = unit & 31, h = (unit >> 5) & 3, b = unit >> 7;
        const int nun = unit + G < 512 ? unit + G : unit, hn = (nun >> 5) & 3, bn = nun >> 7;
        asm volatile("" : "+v"(ra[0]), "+v"(ra[1]), "+v"(ra[2]), "+v"(ra[3]), "+v"(ra[4]), "+v"(ra[5]), "+v"(ra[6]), "+v"(ra[7]));
        asm volatile("" : "+v"(rb[0]), "+v"(rb[1]), "+v"(rb[2]), "+v"(rb[3]), "+v"(rb[4]), "+v"(rb[5]), "+v"(rb[6]), "+v"(rb[7]));
        const int tok0 = b * T + 128 * j; const size_t tq = (size_t)(tok0 + 16 * wid + fr);
        f32x4 s[16];
#pragma unroll
        for (int kt = 0; kt < 16; ++kt) s[kt] = (f32x4){0.f, 0.f, 0.f, 0.f};
#pragma unroll
        for (int hh = 0; hh < 2; ++hh) {
            __syncthreads();
            XK_WRITE(ra);
            if (hh == 0) { XV_WRITE(rb); XK_LOAD(ra, b, h, 1); XV_LOAD(rb, b, h, 1); }
            else XK_LOAD(ra, bn, hn, 0);
            __syncthreads();
            DSEC(11);
#pragma unroll
            for (int k4 = 0; k4 < 4; ++k4) { const bf16x8 qk = *(const bf16x8*)(Qx + tq * D + h * 256 + 128 * hh + 32 * k4 + 8 * fq);
#pragma unroll
                for (int k8 = 0; k8 < 4; ++k8) { bf16x8 av[4];
#pragma unroll
                    for (int kt = 0; kt < 4; ++kt) av[kt] = *(const LAS bf16x8*)(KL + (16 * (4 * k8 + kt) + fr) * KSTR + (32 * k4 + 8 * fq) * 2);
#pragma unroll
                    for (int kt = 0; kt < 4; ++kt) s[4 * k8 + kt] = MFMA16(av[kt], qk, s[4 * k8 + kt]); } }
        }
        DSEC(12);
        float mx = -INFINITY;
#pragma unroll
        for (int kt = 0; kt < 16; ++kt)
#pragma unroll
            for (int e = 0; e < 4; ++e) { const float v = s[kt][e] * 0.0625f; s[kt][e] = v; mx = fmaxf(mx, v); }
        mx = fmaxf(mx, __shfl_xor(mx, 16)); mx = fmaxf(mx, __shfl_xor(mx, 32));
        float den = 0.f;
#pragma unroll
        for (int kt = 0; kt < 16; ++kt)
#pragma unroll
            for (int e = 0; e < 4; ++e) { const float p = __expf(s[kt][e] - mx); s[kt][e] = p; den += p; }
        den += __shfl_xor(den, 16); den += __shfl_xor(den, 32);
        DSEC(13);
        bf16x8 pf[8];
#pragma unroll
        for (int pp = 0; pp < 8; ++pp) { u32x4 pw; pw.x = pk2(s[2 * pp][0], s[2 * pp][1]); pw.y = pk2(s[2 * pp][2], s[2 * pp][3]); pw.z = pk2(s[2 * pp + 1][0], s[2 * pp + 1][1]); pw.w = pk2(s[2 * pp + 1][2], s[2 * pp + 1][3]); pf[pp] = mk8(pw); }
        const float inv = __builtin_amdgcn_rcpf(den);
#pragma unroll
        for (int hh = 0; hh < 2; ++hh) {
            if (hh == 1) { DSEC(14); __syncthreads(); XV_WRITE(rb); XV_LOAD(rb, bn, hn, 0); __syncthreads(); DSEC(15); }
            f32x4 o[8];
#pragma unroll
            for (int dt = 0; dt < 8; ++dt) o[dt] = (f32x4){0.f, 0.f, 0.f, 0.f};
            const unsigned x0 = (unsigned)(fq ^ (fr >> 3));
            const LAS unsigned char* vev = L + KL_BYTES + fr * VSTR + (x0 << 3); const LAS unsigned char* vod = L + KL_BYTES + fr * VSTR + ((x0 ^ 2u) << 3);
#pragma unroll
            for (int pp = 0; pp < 8; ++pp)
#pragma unroll
                for (int d4 = 0; d4 < 2; ++d4) { bf16x8 vf[4];
#pragma unroll
                    for (int dq = 0; dq < 4; ++dq) { const int dt = 4 * d4 + dq; const LAS unsigned char* vb_ = ((dt & 1) ? vod : vev) + 16 * dt * VSTR + 64 * pp;
                        const s16x4 lo = *(const LAS s16x4*)(vb_ + (((2 * dt) & 4) << 3)), hi = *(const LAS s16x4*)(vb_ + ((((2 * dt) & 4) ^ 4) << 3)); vf[dq] = __builtin_shufflevector(lo, hi, 0, 1, 2, 3, 4, 5, 6, 7); }
#pragma unroll
                    for (int dq = 0; dq < 4; ++dq) o[4 * d4 + dq] = MFMA16(vf[dq], pf[pp], o[4 * d4 + dq]);
                }
            { bf16* op = Ox + tq * D + h * 256 + 128 * hh + 4 * fq;
#pragma unroll
              for (int dt = 0; dt < 8; ++dt) *(unsigned long long*)(op + 16 * dt) = (unsigned long long)pk2(o[dt][0] * inv, o[dt][1] * inv) | ((unsigned long long)pk2(o[dt][2] * inv, o[dt][3] * inv) << 32); }
        }
        DSEC(14);
    }
}
#undef XK_LOAD
#undef XK_WRITE
#undef XV_LOAD
#undef XV_WRITE

constexpr int H1_QA = 0, H1_KA = 64 * 272, H1_VT = 2 * 64 * 272, H1_TOT = H1_VT + 128 * 144;
template <bool DRY> DI void hgrn1_phase(LAS unsigned char* L, bf16* Z2, const float* lbraw, int layer, float* DEC, unsigned long long* OI, int G, int bid, int tid) {
    const int wid = __builtin_amdgcn_readfirstlane(tid >> 6), lane = tid & 63, fr = lane & 15, fq = lane >> 4;
    const int n = tid & 127, rg = tid >> 7, tt = wid & 3, vh = wid >> 2;
    LAS float* TOT = (LAS float*)(L + H1_TOT);
    unsigned short rq[16], rf[16], rv[16];
#define H1_RAW(uu, RQ, RF, RV) do { const int c_ = (uu) & 63, h_ = ((uu) >> 6) & 7, b_ = (uu) >> 9; const bf16* p_ = Z2 + (size_t)(b_ * T + 64 * c_ + 16 * rg) * NH2 + h_ * 128 + n; \
        _Pragma("unroll") for (int r = 0; r < 16; ++r) { RQ[r] = p_[(size_t)r * NH2]; RF[r] = p_[(size_t)r * NH2 + 1024]; RV[r] = p_[(size_t)r * NH2 + 2048]; } } while (0)
    if (bid < 2048) H1_RAW(bid, rq, rf, rv);
    for (int unit = bid; unit < 2048; unit += G) {
        const int c = unit & 63, h = (unit >> 6) & 7, b = unit >> 9, tok0 = b * T + 64 * c, ch = h * 128 + n;
        float lbv = 0.f;
        if (layer > 0) { const float e0 = lbraw[ch], e1 = lbraw[D + ch]; lbv = 1.0f / (1.0f + expf(e0 - e1)); }
        asm volatile("" : "+v"(rq[0]), "+v"(rq[1]), "+v"(rq[2]), "+v"(rq[3]), "+v"(rq[4]), "+v"(rq[5]), "+v"(rq[6]), "+v"(rq[7]), "+v"(rq[8]), "+v"(rq[9]), "+v"(rq[10]), "+v"(rq[11]), "+v"(rq[12]), "+v"(rq[13]), "+v"(rq[14]), "+v"(rq[15]));
        asm volatile("" : "+v"(rf[0]), "+v"(rf[1]), "+v"(rf[2]), "+v"(rf[3]), "+v"(rf[4]), "+v"(rf[5]), "+v"(rf[6]), "+v"(rf[7]), "+v"(rf[8]), "+v"(rf[9]), "+v"(rf[10]), "+v"(rf[11]), "+v"(rf[12]), "+v"(rf[13]), "+v"(rf[14]), "+v"(rf[15]));
        asm volatile("" : "+v"(rv[0]), "+v"(rv[1]), "+v"(rv[2]), "+v"(rv[3]), "+v"(rv[4]), "+v"(rv[5]), "+v"(rv[6]), "+v"(rv[7]), "+v"(rv[8]), "+v"(rv[9]), "+v"(rv[10]), "+v"(rv[11]), "+v"(rv[12]), "+v"(rv[13]), "+v"(rv[14]), "+v"(rv[15]));
        float q[16], cs[16], kg[16]; unsigned short vr[16];
        bf16* base = Z2 + (size_t)(tok0 + 16 * rg) * NH2 + ch;
#pragma unroll
        for (int r = 0; r < 16; ++r) { q[r] = bf2f(rq[r]); cs[r] = bf2f(rf[r]); vr[r] = rv[r]; }
        unsigned short nq[16], nf[16], nv[16];
        { const int nu = unit + G < 2048 ? unit + G : unit; H1_RAW(nu, nq, nf, nv); }
        float run = 0.f;
#pragma unroll
        for (int r = 0; r < 16; ++r) { const float fl = cs[r]; const float sg = __builtin_amdgcn_rcpf(1.0f + __expf(-fl)); const float f = lbv + (1.0f - lbv) * sg;
            kg[r] = (1.0f - lbv) * (1.0f - sg); run += __logf(f); cs[r] = run; }
        TOT[rg * 128 + n] = run;
        __syncthreads();
        const float t0 = TOT[n], t1 = TOT[128 + n], t2 = TOT[256 + n], t3 = TOT[384 + n];
        const float off = rg == 0 ? 0.f : (rg == 1 ? t0 : (rg == 2 ? t0 + t1 : t0 + t1 + t2));
        const float bmid = t0 + t1, blast = (t0 + t1) + (t2 + t3);
        const float qscale = 0.08838834764831845f;
        float kh[16];
#pragma unroll
        for (int r = 0; r < 16; ++r) { const float bt = off + cs[r]; const float qs = q[r] * qscale; const int row = 16 * rg + r;
            if (!DRY) base[(size_t)r * NH2] = (bf16)f2bf(qs * __expf(bt));
            *(LAS unsigned short*)(L + H1_QA + row * 272 + n * 2) = (unsigned short)f2bf(qs * __expf(bt - bmid));
            *(LAS unsigned short*)(L + H1_KA + row * 272 + n * 2) = (unsigned short)f2bf(kg[r] * __expf(bmid - bt));
            kh[r] = kg[r] * __expf(blast - bt); }
        u32x4 k0, k1, v0, v1;
#pragma unroll
        for (int qd = 0; qd < 4; ++qd) { k0[qd] = pk2(kh[2 * qd], kh[2 * qd + 1]); k1[qd] = pk2(kh[8 + 2 * qd], kh[9 + 2 * qd]);
            v0[qd] = (unsigned)vr[2 * qd] | ((unsigned)vr[2 * qd + 1] << 16); v1[qd] = (unsigned)vr[8 + 2 * qd] | ((unsigned)vr[9 + 2 * qd] << 16); }
        bf16* slot = Z2 + (size_t)(tok0 + (n >> 1)) * NH2 + h * 128 + (n & 1) * 64 + 16 * rg;
        if (!DRY) { *(u32x4*)(slot + 1024) = k0; *(u32x4*)(slot + 1024 + 8) = k1;
        *(u32x4*)(slot + 2048) = v0; *(u32x4*)(slot + 2048 + 8) = v1; }
        *(LAS u32x4*)(L + H1_VT + n * 144 + 32 * rg) = v0; *(LAS u32x4*)(L + H1_VT + n * 144 + 32 * rg + 16) = v1;
        if (!DRY && rg == 0) DEC[(size_t)unit * 128 + n] = __expf(blast);
        __syncthreads();
        bf16x8 bq[4];
#pragma unroll
        for (int k4 = 0; k4 < 4; ++k4) bq[k4] = *(const LAS bf16x8*)(L + H1_QA + (16 * tt + fr) * 272 + (32 * k4 + 8 * fq) * 2);
        f32x4 at[4];
#pragma unroll
        for (int st = 0; st < 4; ++st) { at[st] = (f32x4){0.f, 0.f, 0.f, 0.f};
            if (st <= tt) {
#pragma unroll
                for (int k4 = 0; k4 < 4; ++k4) { const bf16x8 av = *(const LAS bf16x8*)(L + H1_KA + (16 * st + fr) * 272 + (32 * k4 + 8 * fq) * 2); at[st] = MFMA16(av, bq[k4], at[st]); }
                if (st == tt) {
#pragma unroll
                    for (int e = 0; e < 4; ++e) if (4 * fq + e > fr) at[st][e] = 0.f; }
            } }
        bf16x8 pf[2];
#pragma unroll
        for (int pp = 0; pp < 2; ++pp) { u32x4 pw; pw.x = pk2(at[2 * pp][0], at[2 * pp][1]); pw.y = pk2(at[2 * pp][2], at[2 * pp][3]); pw.z = pk2(at[2 * pp + 1][0], at[2 * pp + 1][1]); pw.w = pk2(at[2 * pp + 1][2], at[2 * pp + 1][3]); pf[pp] = mk8(pw); }
#pragma unroll
        for (int vi = 0; vi < 4; ++vi) { const int vt = 4 * vh + vi; f32x4 o = (f32x4){0.f, 0.f, 0.f, 0.f};
#pragma unroll
            for (int pp = 0; pp < 2; ++pp) { const LAS unsigned char* vp = L + H1_VT + (16 * vt + fr) * 144 + (32 * pp + 4 * fq) * 2;
                const s16x4 lo = *(const LAS s16x4*)vp, hi = *(const LAS s16x4*)(vp + 32);
                const bf16x8 vb = __builtin_shufflevector(lo, hi, 0, 1, 2, 3, 4, 5, 6, 7); o = MFMA16(vb, pf[pp], o); }
            if (!DRY) OI[((size_t)(unit * 4 + tt) * 8 + vt) * 64 + lane] = (unsigned long long)pk2(o[0], o[1]) | ((unsigned long long)pk2(o[2], o[3]) << 32);
            }
#pragma unroll
        for (int r = 0; r < 16; ++r) { rq[r] = nq[r]; rf[r] = nf[r]; rv[r] = nv[r]; }
    }
#undef H1_RAW
}

constexpr int H2_BUF = 36352, H2_KHT = 17408, H2_DEC = 35840;
template <bool DRY> DI void hgrn2_phase(LAS unsigned char* L, bf16* Z2, const float* DEC, unsigned long long* OIW, int bh2, int tid) {
    const unsigned long long* OI = OIW;
    const int wv = __builtin_amdgcn_readfirstlane(tid >> 6), lane = tid & 63, fr = lane & 15, fq = lane >> 4;
    const int bh = bh2 >> 1, w = 4 * (bh2 & 1) + (wv & 3); const bool cw = wv < 4;
    const int b = bh >> 3, h = bh & 7, unit0 = bh * 64, vcol = 16 * w + fr;
    u32x4 sqA[2], skA[2]; f32x4 sdA = (f32x4){0.f, 0.f, 0.f, 0.f};
#define H2_LOAD(cc, sq, sk, sd) do { const int tok0_ = b * T + 64 * (cc); _Pragma("unroll") for (int i = 0; i < 2; ++i) { const int p = tid + 512 * i, row = p >> 4, cb = p & 15; \
        const bf16* rp = Z2 + (size_t)(tok0_ + row) * NH2 + h * 128 + 8 * cb; sq[i] = *(const u32x4*)rp; sk[i] = *(const u32x4*)(rp + 1024); } \
        if (tid < 32) sd = *(const f32x4*)(DEC + (size_t)(unit0 + (cc)) * 128 + 4 * tid); } while (0)
#define H2_WRITE(bi, sq, sk, sd) do { LAS unsigned char* B_ = L + (bi) * H2_BUF; _Pragma("unroll") for (int i = 0; i < 2; ++i) { const int p = tid + 512 * i, row = p >> 4, cb = p & 15; \
        *(LAS u32x4*)(B_ + row * 272 + 16 * cb) = sq[i]; *(LAS u32x4*)(B_ + H2_KHT + (2 * row + (cb >> 3)) * 144 + 16 * (cb & 7)) = sk[i]; } \
        if (tid < 32) *(LAS f32x4*)(B_ + H2_DEC + 16 * tid) = sd; } while (0)
#define H2_PRIV(cc, VT_, OI_) do { const int tok0_ = b * T + 64 * (cc); \
        const bf16* vp_ = Z2 + (size_t)(tok0_ + (vcol >> 1)) * NH2 + 2048 + h * 128 + (vcol & 1) * 64 + 8 * fq; VT_[0] = *(const u32x4*)vp_; VT_[1] = *(const u32x4*)(vp_ + 32); \
        _Pragma("unroll") for (int tt_ = 0; tt_ < 4; ++tt_) OI_[tt_] = OI[((size_t)((unit0 + (cc)) * 4 + tt_) * 8 + w) * 64 + lane]; } while (0)
    u32x4 vtf[2]; unsigned long long oi[4];
    u32x4 nvt[2]; unsigned long long noi[4];
    H2_LOAD(0, sqA, skA, sdA); H2_WRITE(0, sqA, skA, sdA); H2_PRIV(0, vtf, oi);
    H2_LOAD(1, sqA, skA, sdA); H2_PRIV(1, nvt, noi);
    f32x4 S[8];
#pragma unroll
    for (int nt = 0; nt < 8; ++nt) S[nt] = (f32x4){0.f, 0.f, 0.f, 0.f};
    __syncthreads();
    for (int c = 0; c < 64; ++c) {
        LAS unsigned char* Bc = L + (c & 1) * H2_BUF;
        asm volatile("" : "+v"(vtf[0]), "+v"(vtf[1]), "+v"(oi[0]), "+v"(oi[1]), "+v"(oi[2]), "+v"(oi[3]), "+v"(nvt[0]), "+v"(nvt[1]), "+v"(noi[0]), "+v"(noi[1]), "+v"(noi[2]), "+v"(noi[3]));
        asm volatile("" : "+v"(sqA[0]), "+v"(sqA[1]), "+v"(skA[0]), "+v"(skA[1]), "+v"(sdA));
        u32x4 sqB[2], skB[2]; f32x4 sdB = (f32x4){0.f, 0.f, 0.f, 0.f}; u32x4 nnvt[2]; unsigned long long nnoi[4];
        const int c2 = c + 2 < 64 ? c + 2 : 63;
        H2_LOAD(c2, sqB, skB, sdB); H2_PRIV(c2, nnvt, nnoi);
        if (cw) {
        bf16x8 qa[4][4];
#pragma unroll
        for (int tt = 0; tt < 4; ++tt)
#pragma unroll
            for (int np = 0; np < 4; ++np) { const LAS unsigned char* qp = Bc + (16 * tt + fr) * 272 + (32 * np + 4 * fq) * 2;
                const s16x4 lo = *(const LAS s16x4*)qp, hi = *(const LAS s16x4*)(qp + 32); qa[tt][np] = __builtin_shufflevector(lo, hi, 0, 1, 2, 3, 4, 5, 6, 7); }
        bf16x8 sb[4];
#pragma unroll
        for (int np = 0; np < 4; ++np) { u32x4 pw; pw.x = pk2(S[2 * np][0], S[2 * np][1]); pw.y = pk2(S[2 * np][2], S[2 * np][3]); pw.z = pk2(S[2 * np + 1][0], S[2 * np + 1][1]); pw.w = pk2(S[2 * np + 1][2], S[2 * np + 1][3]); sb[np] = mk8(pw); }
        f32x4 o[4];
#pragma unroll
        for (int tt = 0; tt < 4; ++tt) { const unsigned lo = (unsigned)oi[tt], hi = (unsigned)(oi[tt] >> 32); o[tt] = (f32x4){lo16(lo), hi16(lo), lo16(hi), hi16(hi)}; }
#pragma unroll
        for (int np = 0; np < 4; ++np)
#pragma unroll
            for (int tt = 0; tt < 4; ++tt) o[tt] = MFMA16(sb[np], qa[tt][np], o[tt]);
        if (!DRY) {
#pragma unroll
            for (int tt = 0; tt < 4; ++tt) OIW[((size_t)((unit0 + c) * 4 + tt) * 8 + w) * 64 + lane] = (unsigned long long)pk2(o[tt][0], o[tt][1]) | ((unsigned long long)pk2(o[tt][2], o[tt][3]) << 32);
        } else { asm volatile("" :: "v"(o[0]), "v"(o[1]), "v"(o[2]), "v"(o[3])); }
        bf16x8 ka[8][2];
#pragma unroll
        for (int nt = 0; nt < 8; ++nt)
#pragma unroll
            for (int ks = 0; ks < 2; ++ks) ka[nt][ks] = *(const LAS bf16x8*)(Bc + H2_KHT + (16 * nt + fr) * 144 + (32 * ks + 8 * fq) * 2);
#pragma unroll
        for (int nt = 0; nt < 8; ++nt) { const f32x4 dv = *(const LAS f32x4*)(Bc + H2_DEC + (16 * nt + 4 * fq) * 4); S[nt] = S[nt] * dv; }
#pragma unroll
        for (int ks = 0; ks < 2; ++ks)
#pragma unroll
            for (int nt = 0; nt < 8; ++nt) S[nt] = MFMA16(ka[nt][ks], mk8(vtf[ks]), S[nt]);
        }
        if (c + 1 < 64) H2_WRITE((c + 1) & 1, sqA, skA, sdA);
        vtf[0] = nvt[0]; vtf[1] = nvt[1]; nvt[0] = nnvt[0]; nvt[1] = nnvt[1];
#pragma unroll
        for (int i = 0; i < 4; ++i) { oi[i] = noi[i]; noi[i] = nnoi[i]; }
        sqA[0] = sqB[0]; sqA[1] = sqB[1]; skA[0] = skB[0]; skA[1] = skB[1]; sdA = sdB;
        LBAR();
    }
#undef H2_LOAD
#undef H2_WRITE
#undef H2_PRIV
}
DI void hgrn3_phase(bf16* Z2, const unsigned long long* OI, const float* gain, int gw, int NGW, int lane) {
    const int fr = lane & 15, fq = lane >> 4;
    for (int it = gw; it < 2048 * 4; it += NGW) {
        const int unit = it >> 2, tt = it & 3, c = unit & 63, h = (unit >> 6) & 7, b = unit >> 9;
        bf16* gp = Z2 + (size_t)(b * T + 64 * c + 16 * tt + fr) * NH2 + 3072 + h * 128 + 4 * fq;
        unsigned long long ov[8], gv[8];
#pragma unroll
        for (int vt = 0; vt < 8; ++vt) { ov[vt] = OI[((size_t)(unit * 4 + tt) * 8 + vt) * 64 + lane]; gv[vt] = *(const unsigned long long*)(gp + 16 * vt); }
        float ss = 0.f;
#pragma unroll
        for (int vt = 0; vt < 8; ++vt) { const unsigned lo = (unsigned)ov[vt], hi = (unsigned)(ov[vt] >> 32); ss += (lo16(lo) * lo16(lo) + hi16(lo) * hi16(lo)) + (lo16(hi) * lo16(hi) + hi16(hi) * hi16(hi)); }
        ss += __shfl_xor(ss, 16); ss += __shfl_xor(ss, 32);
        const float rstd = __builtin_amdgcn_rsqf(ss * (1.0f / 128.0f) + EPS);
#pragma unroll
        for (int vt = 0; vt < 8; ++vt) { const f32x4 g4 = *(const f32x4*)(gain + h * 128 + 16 * vt + 4 * fq);
            const unsigned lo = (unsigned)ov[vt], hi = (unsigned)(ov[vt] >> 32), glo = (unsigned)gv[vt], ghi = (unsigned)(gv[vt] >> 32);
            const float of[4] = {lo16(lo), hi16(lo), lo16(hi), hi16(hi)}, gf[4] = {lo16(glo), hi16(glo), lo16(ghi), hi16(ghi)}; float r[4];
#pragma unroll
            for (int e = 0; e < 4; ++e) r[e] = of[e] * rstd * g4[e] * (gf[e] * __builtin_amdgcn_rcpf(1.0f + __expf(-gf[e])));
            *(unsigned long long*)(gp + 16 * vt) = (unsigned long long)pk2(r[0], r[1]) | ((unsigned long long)pk2(r[2], r[3]) << 32); }
    }
}

#define XB_TMO      128
#define XB_XCNT(j)  (256  + 64 * (j))
#define XB_XSUB(j)  (1280 + 64 * (j))
#define XB_XGEN(j)  (2304 + 64 * (j))
#define XB_TOP      3328
#define XB_TOPGEN   3392
#define XCD_BAR_WORDS 3456
#define XB_SPIN_CAP (1u << 18)

__device__ __forceinline__ unsigned xb_ld(unsigned* p)              { return __hip_atomic_load(p, __ATOMIC_RELAXED, __HIP_MEMORY_SCOPE_AGENT); }
__device__ __forceinline__ unsigned xb_add(unsigned* p, unsigned v) { return __hip_atomic_fetch_add(p, v, __ATOMIC_RELAXED, __HIP_MEMORY_SCOPE_AGENT); }
__device__ __forceinline__ unsigned xb_xcc_id() { return (unsigned)__builtin_amdgcn_s_getreg((3 << 11) | 20) & 0xFu; }
#define XB_SPIN(cond, bar) do { unsigned _sp = 0; while (cond) { __builtin_amdgcn_s_sleep(1); \
    if ((++_sp & 255u) == 0u) { if (xb_ld(&(bar)[XB_TMO])) break; if (_sp > XB_SPIN_CAP) { atomicAdd(&(bar)[XB_TMO], 1u); break; } } } } while (0)

struct XcdBarrier {
    unsigned* bar; unsigned x;
    volatile LAS unsigned* st;
};

__device__ __forceinline__ XcdBarrier xcd_barrier_post(unsigned* bar, volatile LAS unsigned* st) {
    XcdBarrier b; b.bar = bar; b.x = xb_xcc_id(); b.st = st;
    if (threadIdx.x == 0) (void)xb_add(&bar[XB_XCNT(b.x)], 1u);
    return b;
}
__device__ __forceinline__ void xcd_barrier_complete(unsigned* bar, unsigned x, unsigned& nloc, unsigned& nx) {
    const unsigned G = gridDim.x * gridDim.y * gridDim.z;
    unsigned sum, cnt, mine, sp = 0u;
    for (;;) {
        sum = 0u; cnt = 0u; mine = 0u;
#pragma unroll
        for (unsigned j = 0; j < 16; ++j) { const unsigned c = xb_ld(&bar[XB_XCNT(j)]); sum += c; cnt += (c > 0u) ? 1u : 0u; mine = (j == x) ? c : mine; }
        if (sum == G) break;
        __builtin_amdgcn_s_sleep(1);
        if ((++sp & 255u) == 0u) { if (xb_ld(&bar[XB_TMO])) break; if (sp > XB_SPIN_CAP) { atomicAdd(&bar[XB_TMO], 1u); break; } }
    }
    nloc = mine > 0u ? mine : 1u; nx = cnt > 0u ? cnt : 1u;
}

__device__ __forceinline__ void xcd_barrier(const XcdBarrier& b) {
    asm volatile("s_waitcnt vmcnt(0)" ::: "memory");
    __syncthreads();
    if (threadIdx.x == 0) {
        unsigned* bar = b.bar;
        __builtin_amdgcn_s_waitcnt(0);
        unsigned nloc = b.st[0], nx = b.st[1];
        if (nloc == 0u) { xcd_barrier_complete(bar, b.x, nloc, nx); b.st[0] = nloc; b.st[1] = nx; }
        const unsigned old = xb_add(&bar[XB_XSUB(b.x)], 1u);
        const unsigned gen = old / nloc;
        if (old + 1u == (gen + 1u) * nloc) {
            __builtin_amdgcn_fence(__ATOMIC_RELEASE, "agent");
            asm volatile("s_waitcnt vmcnt(0)" ::: "memory");
            const unsigned og = xb_add(&bar[XB_TOP], 1u);
            const unsigned tg = og / nx;
            if (og + 1u == (tg + 1u) * nx) xb_add(&bar[XB_TOPGEN], 1u);
            else XB_SPIN(xb_ld(&bar[XB_TOPGEN]) == tg, bar);
            __builtin_amdgcn_fence(__ATOMIC_ACQUIRE, "agent");
            xb_add(&bar[XB_XGEN(b.x)], 1u);
            asm volatile("s_waitcnt vmcnt(0)" ::: "memory");
        } else {
            XB_SPIN(xb_ld(&bar[XB_XGEN(b.x)]) == gen, bar);
            __builtin_amdgcn_fence(__ATOMIC_ACQUIRE, "agent");
            asm volatile("s_waitcnt vmcnt(0)" ::: "memory");
        }
    }
    __syncthreads();
}

#ifndef PROBE_SYNC
#define PROBE_SYNC 0
#endif
#ifndef PROBE_ATT
#define PROBE_ATT 0
#endif
#ifndef PROBE_GEMM
#define PROBE_GEMM 0
#endif
#ifndef PROBE_HG
#define PROBE_HG 0
#endif
#ifndef PROBE_RES
#define PROBE_RES 0
#endif
#ifndef PROBE_TMASK
#define PROBE_TMASK 0
#endif
#ifndef PROBE_CONV
#define PROBE_CONV 0
#endif
#define GSYNC() do { xcd_barrier(xbar); if (PROBE_SYNC) xcd_barrier(xbar); } while (0)
#define REP(n) for (int rep_ = 0; rep_ < 1 + (n); ++rep_)
#define FRESH() size_t zoff_ = 0; asm volatile("" : "+s"(zoff_)); unsigned char* ws = a.ws + zoff_; int tid = threadIdx.x; asm volatile("" : "+v"(tid)); \
    const int lane = tid & 63, wave = __builtin_amdgcn_readfirstlane(tid >> 6); int G = gridDim.x, bid = blockIdx.x; asm volatile("" : "+s"(G), "+s"(bid)); \
    const int gw = bid * 8 + wave, NGW = G * 8, gtid = bid * 512 + tid, NGT = G * 512; float* X = (float*)((unsigned char*)a.out + zoff_); bf16* XLO = (bf16*)X; (void)XLO; \
    bf16* Xb = (bf16*)(ws + WS_XB); float* ssq = (float*)(ws + WS_SSQ); bf16* Z = (bf16*)(ws + WS_Z); \
    (void)lane; (void)gw; (void)NGW; (void)gtid; (void)NGT; (void)Xb; (void)ssq; (void)Z; (void)X;

__global__ void __launch_bounds__(512, 2) fwd_megakernel(Args a) {
    extern __shared__ __attribute__((aligned(16))) unsigned char lds_raw[];
    LAS unsigned char* L = (LAS unsigned char*)lds_raw;
    volatile LAS unsigned* MISC = (volatile LAS unsigned*)(L + LDS_BYTES - 64);
    if (threadIdx.x < 16) MISC[threadIdx.x] = 0u;
    __syncthreads();
    const XcdBarrier xbar = xcd_barrier_post((unsigned*)(a.ws + WS_CTL), MISC);
    unsigned long long t_dsec = 0;
#if PROBE_TMASK
    unsigned long long t_last = __builtin_amdgcn_s_memrealtime(), t_acc = 0;
#define PT(bit) do { const unsigned long long tn_ = __builtin_amdgcn_s_memrealtime(); if ((PROBE_TMASK >> (bit)) & 1) t_acc += tn_ - t_last; t_last = tn_; } while (0)
#else
#define PT(bit) do {} while (0)
#endif

    REP(PROBE_CONV) { FRESH(); conv_weights<0>(a, L, gw, NGW, wave, lane); }
    { FRESH(); prologue_misc(a, gw, NGW, lane, gtid, NGT); }
    cg::this_grid().sync();
        PT(0);

    for (int l = 0; l < 2; ++l) {
        REP(PROBE_GEMM) { FRESH(); run_gemm(L, Xb, D, (const bf16*)(ws + W_GU1), D, M, 2 * DFF, D, G, bid, EpiSwiglu{Z, ssq}); }
        GSYNC();
        PT(1);
#if PROBE_RES
        { FRESH(); run_gemm(L, Z, DFF, (const bf16*)(ws + W_DN1), DFF, M, D, DFF, G, bid, EpiResid{l == 0 ? (const float*)a.in[0] : nullptr, Xb, XLO, XLO, ssq, l == 0 ? 0.5f : 0.0f}); }
        GSYNC();
#endif
        { FRESH(); run_gemm(L, Z, DFF, (const bf16*)(ws + W_DN1), DFF, M, D, DFF, G, bid, EpiResid{l == 0 ? (const float*)a.in[0] : nullptr, Xb, XLO, XLO, ssq, 0.5f}); }
        GSYNC();
        PT(2);
        REP(PROBE_GEMM) { FRESH(); run_gemm(L, Xb, D, (const bf16*)(ws + W_IN), D, M, NATT, D, G, bid, EpiRope{Z, ssq, (const float*)(ws + WS_COS), (const float*)(ws + WS_SIN)}); }
        GSYNC();
        PT(1);
        REP(PROBE_ATT & 1) { FRESH(); dil_attn_phase(L, Z, (const float*)(ws + WS_COS), (const float*)(ws + WS_SIN), (bf16*)(ws + WS_OG), (float*)(ws + WS_LSE), G, (G & 7) ? bid : (bid & 7) * (G >> 3) + (bid >> 3), tid, t_dsec); }
        GSYNC();
        PT(5);
        REP(PROBE_GEMM) { FRESH(); run_gemm(L, Xb, D, (const bf16*)(ws + W_IN) + (size_t)NATT * D, D, M, NH2, D, G, bid, EpiZ{Z, NH2, ssq}); }
        { FRESH(); merge_phase((const bf16*)(ws + WS_OG), (const float*)(ws + WS_LSE), (bf16*)(ws + WS_AO), gtid, NGT); }
        GSYNC();
        PT(1);
#if PROBE_HG & 1
        { FRESH(); hgrn1_phase<true>(L, Z, (const float*)a.in[8], l, (float*)(ws + WS_DEC), (unsigned long long*)(ws + WS_OG), G, bid, tid); }
#endif
        { FRESH(); hgrn1_phase<false>(L, Z, (const float*)a.in[8], l, (float*)(ws + WS_DEC), (unsigned long long*)(ws + WS_OG), G, bid, tid); }
        GSYNC();
        PT(6);
        { FRESH();
#if PROBE_HG & 2
          if (bid < 64) { hgrn2_phase<true>(L, Z, (const float*)(ws + WS_DEC), (unsigned long long*)(ws + WS_OG), bid, tid); __syncthreads(); }
#endif
          if (bid < 64) hgrn2_phase<false>(L, Z, (const float*)(ws + WS_DEC), (unsigned long long*)(ws + WS_OG), bid, tid);
          else if (l == 0) {
            const int G2 = G - 64, c2 = bid - 64;
#pragma unroll
            for (int ll = 0; ll < 2; ++ll) {
                const bf16* memN = (const bf16*)(ws + WS_MEMN) + (size_t)ll * MROWS * D; const bf16* Wkv = (const bf16*)(ws + (ll ? WS_WKV1 : W_KV));
                run_gemm(L, memN, D, Wkv, D, MROWS, D, D, G2, (c2 + 32 * ll) % G2, EpiZ{(bf16*)(ws + (ll ? WS_MEMK1 : WS_MEMK)), D, nullptr});
                run_gemm(L, Wkv + (size_t)D * D, D, memN, D, D, MROWS, D, G2, (c2 + 32 * ll + 16) % G2, EpiZ{(bf16*)(ws + (ll ? WS_MEMVT1 : WS_MEMVT)), MROWS, nullptr});
            }
            conv_weights<1>(a, L, c2 * 8 + wave, G2 * 8, wave, lane);
          } else conv_weights<2>(a, L, (bid - 64) * 8 + wave, (G - 64) * 8, wave, lane);
        }
        GSYNC();
        PT(7);
        { FRESH(); hgrn3_phase(Z, (const unsigned long long*)(ws + WS_OG), (const float*)a.in[9] + (size_t)l * D, gw, NGW, lane); }
        REP(PROBE_GEMM) { FRESH(); run_gemm(L, Xb, D, (const bf16*)(ws + W_IN) + (size_t)(NATT + NH2) * D, D, M, 2048, D, G, bid, EpiZ{Z, NH2, ssq}); }
        GSYNC();
        PT(1);
        { FRESH(); run_gemm(L, (const bf16*)(ws + WS_AO), 512, (const bf16*)(ws + W_AB), 512, M, D, 512, G, bid, EpiGate<false>{Z, NH2, Z + 2048, NH2}); }
        { FRESH(); run_gemm(L, Z + 3072, NH2, (const bf16*)(ws + W_HB), D, M, D, D, G, bid, EpiGate<true>{Z + 1024, NH2, Z + 2048, NH2}); }
        GSYNC();
        PT(3);
#if PROBE_RES
        { FRESH(); run_gemm(L, Z + 2048, NH2, (const bf16*)(ws + W_MO), D, M, D, D, G, bid, EpiResid{nullptr, Xb, XLO, XLO, ssq, 0.0f}); }
        GSYNC();
#endif
        { FRESH(); run_gemm(L, Z + 2048, NH2, (const bf16*)(ws + W_MO), D, M, D, D, G, bid, EpiResid{nullptr, Xb, XLO, XLO, ssq, 1.0f}); }
        GSYNC();
        PT(2);
        REP(PROBE_GEMM) { FRESH(); run_gemm(L, Xb, D, (const bf16*)(ws + W_Q), D, M, D, D, G, bid, EpiZ{Z, D, ssq}); }
        GSYNC();
        PT(4);
        REP((PROBE_ATT >> 1) & 1) { FRESH(); xattn_phase(L, Z, (const bf16*)(ws + (l ? WS_MEMK1 : WS_MEMK)), (const bf16*)(ws + (l ? WS_MEMVT1 : WS_MEMVT)), Z + (size_t)M * D, G, (G & 7) ? bid : (bid & 7) * (G >> 3) + (bid >> 3), tid, t_dsec); }
        GSYNC();
        PT(9);
#if PROBE_RES
        { FRESH(); run_gemm(L, Z + (size_t)M * D, D, (const bf16*)(ws + W_O), D, M, D, D, G, bid, EpiResid{nullptr, Xb, XLO, XLO, ssq, 0.0f}); }
        GSYNC();
#endif
        { FRESH(); run_gemm(L, Z + (size_t)M * D, D, (const bf16*)(ws + W_O), D, M, D, D, G, bid, EpiResid{nullptr, Xb, XLO, XLO, ssq, 1.0f}); }
        GSYNC();
        PT(2);
        REP(PROBE_GEMM) { FRESH(); run_gemm(L, Xb, D, (const bf16*)(ws + W_GU2), D, M, 2 * DFF, D, G, bid, EpiSwiglu{Z, ssq}); }
        GSYNC();
        PT(1);
#if PROBE_RES
        { FRESH(); run_gemm(L, Z, DFF, (const bf16*)(ws + W_DN2), DFF, M, D, DFF, G, bid, EpiResid{nullptr, Xb, XLO, XLO, ssq, 0.0f}); }
        GSYNC();
#endif
        { FRESH(); run_gemm(L, Z, DFF, (const bf16*)(ws + W_DN2), DFF, M, D, DFF, G, bid, EpiResid{nullptr, Xb, XLO, l == 1 ? (bf16*)(ws + WS_OG) : XLO, ssq, 0.5f}); }
        GSYNC();
        PT(2);
    }
    { FRESH();
      const float* fg = (const float*)a.in[21]; const bf16* LO = (const bf16*)(ws + WS_OG);
      for (int m0 = gw; m0 < M; m0 += 2 * NGW) {
        const int m1 = m0 + NGW < M ? m0 + NGW : m0;
        unsigned long long hv[2][4], lv[2][4];
#pragma unroll
        for (int rr = 0; rr < 2; ++rr) { const int m = rr ? m1 : m0;
#pragma unroll
            for (int j = 0; j < 4; ++j) { hv[rr][j] = ((const unsigned long long*)(Xb + (size_t)m * D) + lane)[64 * j]; lv[rr][j] = ((const unsigned long long*)(LO + (size_t)m * D) + lane)[64 * j]; } }
#pragma unroll
        for (int rr = 0; rr < 2; ++rr) { const int m = rr ? m1 : m0;
            f32x4* xr = (f32x4*)(X + (size_t)m * D) + lane; const f32x4* gr = (const f32x4*)fg + lane;
            f32x4 v[4]; float s2 = 0.f;
#pragma unroll
            for (int j = 0; j < 4; ++j) { const unsigned h0 = (unsigned)hv[rr][j], h1 = (unsigned)(hv[rr][j] >> 32), l0 = (unsigned)lv[rr][j], l1 = (unsigned)(lv[rr][j] >> 32);
                v[j] = (f32x4){lo16(h0) + lo16(l0), hi16(h0) + hi16(l0), lo16(h1) + lo16(l1), hi16(h1) + hi16(l1)}; s2 += (v[j][0] * v[j][0] + v[j][1] * v[j][1]) + (v[j][2] * v[j][2] + v[j][3] * v[j][3]); }
            const float rs = __builtin_amdgcn_rsqf(wave_sum(s2) * (1.0f / D) + EPS);
#pragma unroll
            for (int j = 0; j < 4; ++j) xr[64 * j] = v[j] * rs * gr[64 * j]; }
      } }
#if PROBE_TMASK
    { const unsigned long long t0_ = __builtin_amdgcn_s_memrealtime(); while (__builtin_amdgcn_s_memrealtime() - t0_ < t_acc) __builtin_amdgcn_s_sleep(8); }
#endif
#if PROBE_DSEC
    { const unsigned long long t0_ = __builtin_amdgcn_s_memrealtime(); while (__builtin_amdgcn_s_memrealtime() - t0_ < t_dsec) __builtin_amdgcn_s_sleep(8); }
#endif
}

extern "C" void kernel_launch(void* const* d_in, const int* in_sizes, int n_in, void* d_out, int out_size, void* d_ws, size_t ws_size, hipStream_t stream) {
    static int grid = 0;
    if (grid == 0) {
        if (n_in != 22 || out_size != M * D || ws_size < WS_END) { fprintf(stderr, "kernel_launch: unexpected shapes (n_in %d out %d ws %zu)\n", n_in, out_size, ws_size); grid = -1; return; }
        int dev = 0, cus = 0, per_cu = 0;
        hipGetDevice(&dev); hipDeviceGetAttribute(&cus, hipDeviceAttributeMultiprocessorCount, dev);
        hipFuncSetAttribute((const void*)fwd_megakernel, hipFuncAttributeMaxDynamicSharedMemorySize, LDS_BYTES);
        hipOccupancyMaxActiveBlocksPerMultiprocessor(&per_cu, (const void*)fwd_megakernel, 512, LDS_BYTES);
        if (per_cu < 1) { fprintf(stderr, "kernel_launch: occupancy query reports %d blocks per CU\n", per_cu); grid = -1; return; }
        grid = cus;
        if (grid < 128) { fprintf(stderr, "kernel_launch: too few CUs (%d)\n", grid); grid = -1; return; }
    }
    if (grid < 0) return;
    if (hipMemsetAsync((char*)d_ws + WS_CTL, 0, CTL_BYTES, stream) != hipSuccess) { fprintf(stderr, "kernel_launch: memset failed\n"); return; }
    Args a{};
    for (int i = 0; i < 22; ++i) a.in[i] = d_in[i];
    a.out = (float*)d_out; a.ws = (unsigned char*)d_ws;
    void* args[] = {&a};
    hipError_t e = hipLaunchCooperativeKernel((const void*)fwd_megakernel, dim3(grid), dim3(512), args, LDS_BYTES, stream);
    if (e != hipSuccess) fprintf(stderr, "cooperative launch failed: %s (grid %d)\n", hipGetErrorString(e), grid);
}
```

```cpp
#include <hip/hip_runtime.h>
#include <hip/hip_cooperative_groups.h>
#include <cstdio>
#include <cstdint>
namespace cg = cooperative_groups;
namespace pg8 {
#define PG8_LAS __attribute__((address_space(3)))
typedef unsigned short bf16_t;
typedef short bf16x8 __attribute__((ext_vector_type(8)));
typedef float f32x4 __attribute__((ext_vector_type(4)));
typedef unsigned u32x4 __attribute__((ext_vector_type(4)));
constexpr int BM = 256, BK = 64, HALF = 128, HTB = HALF * BK * 2  , STAGE_BYTES = 8 * HTB, NXCD = 8, WGM = 8;

__host__ __device__ __forceinline__ int lds_byte(int r, int c) { const int st = (r >> 4) * 2 + (c >> 5), rr = r & 15, cc = c & 31, ob = rr * 64 + cc * 2; return st * 1024 + (ob ^ (((ob >> 9) & 1) << 5)); }
__host__ __device__ __forceinline__ void stage_rc(int b, int& R, int& C) { const int st = b / 1024, sb = b % 1024, swz = sb ^ (((sb >> 9) & 1) << 5); R = (st >> 1) * 16 + swz / 64; C = (st & 1) * 32 + (swz % 64) / 2; }
__host__ __device__ __forceinline__ int perm32(int rho) { const int n = rho >> 4, i = rho & 15; return 8 * (i >> 2) + 4 * n + (i & 3); }

struct Unit { int pm, pn; };
struct Gemm { const bf16_t* A; const bf16_t* Bt; int M, N, K, lda, ldb; };

struct StaticOrder {
    int nM, nN, nwg, G, c;
    __host__ __device__ void init(int M, int N, int G_, int c_) { nM = M / BM; nN = N / BM; nwg = nM * nN; G = G_; c = c_; }
    __host__ __device__ bool next(int i, Unit& u) const {
        const long L = (long)i * G + c; if (L >= nwg) return false;
        int wgid = (int)L; { const int q = nwg / NXCD, r = nwg % NXCD, xcd = wgid % NXCD, off = wgid / NXCD; wgid = (xcd < r ? xcd * (q + 1) : r * (q + 1) + (xcd - r) * q) + off; }
        const int nig = WGM * nN, gid = wgid / nig, fm = gid * WGM, gsz = (nM - fm) < WGM ? (nM - fm) : WGM;
        u.pm = fm + ((wgid % nig) % gsz); u.pn = (wgid % nig) / gsz; return true;
    }
    __device__ __forceinline__ void a_ready(const Unit&) const {}
    __device__ __forceinline__ void done(const Unit&) const {}
};

template <class Epi, class Sched, bool ALIGN_EPI = false, bool SP2 = false>
__device__ __forceinline__ void gemm_phase(PG8_LAS unsigned char* lds, const Gemm g, const Sched& S, const Epi& E) {
    int tid_ = threadIdx.x; asm volatile("" : "+v"(tid_)); const int tid = tid_, wid = __builtin_amdgcn_readfirstlane(tid >> 6), lane = tid & 63, wr = wid >> 2, wc = wid & 3, fr = lane & 15, fq = lane >> 4;
    const int K = g.K, nt = K / BK;
    unsigned voffA[2], voffB[2];
#pragma unroll
    for (int i = 0; i < 2; ++i) { int R, C; stage_rc(tid * 16 + i * 8192, R, C); const int Rb = Epi::PERM ? ((R & ~31) + perm32(R & 31)) : R;
        voffA[i] = (unsigned)(R * g.lda + C) * 2u; voffB[i] = (unsigned)(Rb * g.ldb + C) * 2u; }
    const size_t kstep = (size_t)(BK * 2);
    const size_t hstepA = (size_t)HALF * g.lda * 2, hstepB = (size_t)HALF * g.ldb * 2;
    const size_t tstepA = 2 * hstepA, tstepB = 2 * hstepB;
    const unsigned ldsw = (unsigned)wid * 1024u;
    const int aoff = lds_byte(wr * 64 + fr, fq * 8), boff = lds_byte(wc * 32 + fr, fq * 8);
#define PG8_SA(b, h) (((b) * 2 + (h)) * HTB)
#define PG8_SB(b, h) ((4 + (b) * 2 + (h)) * HTB)
#define PG8_STAGE(bufoff, gbase, voff) do { _Pragma("unroll") for (int _i = 0; _i < 2; ++_i) \
        __builtin_amdgcn_global_load_lds((const unsigned*)((const char*)(gbase) + (voff)[_i]), (PG8_LAS unsigned*)(lds + (bufoff) + ldsw + _i * 8192), 16, 0, 0); } while (0)
#define PG8_LDA(dst, b, h) do { _Pragma("unroll") for (int m = 0; m < 4; ++m) _Pragma("unroll") for (int k = 0; k < 2; ++k) dst[m][k] = *(const PG8_LAS bf16x8*)(lds + PG8_SA(b, h) + aoff + m * 2048 + k * 1024); } while (0)
#define PG8_LDB(dst, b, h) do { _Pragma("unroll") for (int n = 0; n < 2; ++n) _Pragma("unroll") for (int k = 0; k < 2; ++k) dst[n][k] = *(const PG8_LAS bf16x8*)(lds + PG8_SB(b, h) + boff + n * 2048 + k * 1024); } while (0)
#define PG8_MMA(ai, bj, At, Bt) do { __builtin_amdgcn_s_setprio(1); _Pragma("unroll") for (int m = 0; m < 4; ++m) _Pragma("unroll") for (int n = 0; n < 2; ++n) _Pragma("unroll") for (int k = 0; k < 2; ++k) \
        acc[ai][bj][m][n] = __builtin_amdgcn_mfma_f32_16x16x32_bf16(Bt[n][k], At[m][k], acc[ai][bj][m][n], 0, 0, 0); __builtin_amdgcn_s_setprio(0); } while (0)
#define PG8_WAIT_V(n) asm volatile("s_waitcnt vmcnt(" #n ")" ::: "memory")
#define PG8_WAIT_L(n) asm volatile("s_waitcnt lgkmcnt(" #n ")" ::: "memory")
#define PG8_BAR __builtin_amdgcn_s_barrier()
#define PG8_SCHED __builtin_amdgcn_sched_barrier(0)
    Unit cur, nxt; int ui = 0;
    if (!S.next(0, cur)) return;
    f32x4 acc[2][2][4][2];
#pragma unroll
    for (int a = 0; a < 2; ++a)
#pragma unroll
        for (int b = 0; b < 2; ++b)
#pragma unroll
            for (int m = 0; m < 4; ++m)
#pragma unroll
                for (int n = 0; n < 2; ++n) acc[a][b][m][n] = (f32x4){0.f, 0.f, 0.f, 0.f};
    bf16x8 At[4][2], B0[2][2], B1[2][2];
    const char* cA = (const char*)g.A + (size_t)cur.pm * tstepA; const char* cB = (const char*)g.Bt + (size_t)cur.pn * tstepB;
    S.a_ready(cur);
    if constexpr (SP2) {
        PG8_STAGE(PG8_SB(0, 0), cB, voffB); PG8_STAGE(PG8_SB(0, 1), cB + hstepB, voffB); PG8_STAGE(PG8_SA(0, 0), cA, voffA); PG8_STAGE(PG8_SA(0, 1), cA + hstepA, voffA);
        if (wr == 1) PG8_BAR;
        PG8_WAIT_V(2); PG8_BAR;
        PG8_STAGE(PG8_SB(1, 0), cB + kstep, voffB); PG8_STAGE(PG8_SA(1, 0), cA + kstep, voffA); PG8_STAGE(PG8_SB(1, 1), cB + hstepB + kstep, voffB);
        PG8_WAIT_V(6); PG8_BAR;
    } else {
        PG8_STAGE(PG8_SB(0, 0), cB, voffB); PG8_STAGE(PG8_SA(0, 0), cA, voffA); PG8_STAGE(PG8_SB(0, 1), cB + hstepB, voffB); PG8_STAGE(PG8_SA(0, 1), cA + hstepA, voffA);
        if (wr == 1) PG8_BAR;
        PG8_WAIT_V(4); PG8_BAR;
        PG8_STAGE(PG8_SB(1, 0), cB + kstep, voffB); PG8_STAGE(PG8_SA(1, 0), cA + kstep, voffA); PG8_STAGE(PG8_SB(1, 1), cB + hstepB + kstep, voffB);
        PG8_WAIT_V(6); PG8_BAR;
    }
    for (;;) {
        const bool has_next = S.next(ui + 1, nxt);
        const char* nA = has_next ? (const char*)g.A + (size_t)nxt.pm * tstepA : cA; const char* nB = has_next ? (const char*)g.Bt + (size_t)nxt.pn * tstepB : cB;
        for (int t = 0; t < nt; t += 2) {
            const bool last = (t == nt - 2);
            const char* a1 = cA + (size_t)(t + 1) * kstep;
            const char* a2 = last ? nA : cA + (size_t)(t + 2) * kstep; const char* b2 = last ? nB : cB + (size_t)(t + 2) * kstep;
            const char* a3 = a2 + kstep; const char* b3 = b2 + kstep;
            if (last && has_next) S.a_ready(nxt);
            if constexpr (SP2) {
            PG8_LDB(B0, 0, 0); PG8_LDB(B1, 0, 1); PG8_SCHED; PG8_LDA(At, 0, 0); PG8_STAGE(PG8_SA(1, 1), a1 + hstepA, voffA);
            PG8_WAIT_V(8); PG8_WAIT_L(0); PG8_BAR; PG8_MMA(0, 0, At, B0); PG8_MMA(0, 1, At, B1); PG8_BAR; PG8_SCHED;
            PG8_LDA(At, 0, 1); PG8_STAGE(PG8_SB(0, 0), b2, voffB); PG8_STAGE(PG8_SB(0, 1), b2 + hstepB, voffB); PG8_STAGE(PG8_SA(0, 0), a2, voffA);
            PG8_WAIT_V(8); PG8_WAIT_L(0); PG8_BAR; PG8_MMA(1, 0, At, B0); PG8_MMA(1, 1, At, B1); PG8_BAR; PG8_SCHED;
            PG8_LDB(B0, 1, 0); PG8_LDB(B1, 1, 1); PG8_SCHED; PG8_LDA(At, 1, 0); PG8_STAGE(PG8_SA(0, 1), a2 + hstepA, voffA);
            PG8_WAIT_V(8); PG8_WAIT_L(0); PG8_BAR; PG8_MMA(0, 0, At, B0); PG8_MMA(0, 1, At, B1); PG8_BAR; PG8_SCHED;
            PG8_LDA(At, 1, 1); PG8_STAGE(PG8_SB(1, 0), b3, voffB); PG8_STAGE(PG8_SB(1, 1), b3 + hstepB, voffB); PG8_STAGE(PG8_SA(1, 0), a3, voffA);
            PG8_WAIT_V(8); PG8_WAIT_L(0); PG8_BAR; PG8_MMA(1, 0, At, B0); PG8_MMA(1, 1, At, B1); PG8_BAR; PG8_SCHED;
            } else {
            PG8_LDB(B0, 0, 0); PG8_SCHED; PG8_LDA(At, 0, 0); PG8_STAGE(PG8_SA(1, 1), a1 + hstepA, voffA);
            PG8_WAIT_L(8); PG8_BAR; PG8_WAIT_L(0); PG8_MMA(0, 0, At, B0); PG8_BAR; PG8_SCHED;
            PG8_LDB(B1, 0, 1); PG8_STAGE(PG8_SB(0, 0), b2, voffB);
            PG8_BAR; PG8_WAIT_L(0); PG8_MMA(0, 1, At, B1); PG8_BAR;
            PG8_LDA(At, 0, 1); PG8_STAGE(PG8_SA(0, 0), a2, voffA);
            PG8_BAR; PG8_WAIT_L(0); PG8_MMA(1, 0, At, B0); PG8_BAR; PG8_SCHED;
            PG8_STAGE(PG8_SB(0, 1), b2 + hstepB, voffB);
            PG8_WAIT_V(6); PG8_BAR; PG8_MMA(1, 1, At, B1); PG8_BAR;
            PG8_LDB(B0, 1, 0); PG8_SCHED; PG8_LDA(At, 1, 0); PG8_STAGE(PG8_SA(0, 1), a2 + hstepA, voffA);
            PG8_WAIT_L(8); PG8_BAR; PG8_WAIT_L(0); PG8_MMA(0, 0, At, B0); PG8_BAR; PG8_SCHED;
            PG8_LDB(B1, 1, 1); PG8_STAGE(PG8_SB(1, 0), b3, voffB);
            PG8_BAR; PG8_WAIT_L(0); PG8_MMA(0, 1, At, B1); PG8_BAR;
            PG8_LDA(At, 1, 1); PG8_STAGE(PG8_SA(1, 0), a3, voffA);
            PG8_BAR; PG8_WAIT_L(0); PG8_MMA(1, 0, At, B0); PG8_BAR; PG8_SCHED;
            PG8_STAGE(PG8_SB(1, 1), b3 + hstepB, voffB);
            PG8_WAIT_V(6); PG8_BAR; PG8_MMA(1, 1, At, B1); PG8_BAR;
            }
        }
        if constexpr (ALIGN_EPI) { if (wr == 0) PG8_BAR; }
        if constexpr (!Epi::AFTER_DRAIN) { E(acc, cur, wr, wc, fr, fq); S.done(cur); }
        if (!has_next) break;
#pragma unroll
        for (int a = 0; a < 2; ++a)
#pragma unroll
            for (int b = 0; b < 2; ++b)
#pragma unroll
                for (int m = 0; m < 4; ++m)
#pragma unroll
                    for (int n = 0; n < 2; ++n) acc[a][b][m][n] = (f32x4){0.f, 0.f, 0.f, 0.f};
        cur = nxt; cA = nA; cB = nB; ++ui;
        if constexpr (ALIGN_EPI) { if (wr == 1) PG8_BAR; }
    }
    PG8_WAIT_V(0);
    if constexpr (!ALIGN_EPI) { if (wr == 0) PG8_BAR; }
    PG8_BAR;
    if constexpr (Epi::AFTER_DRAIN) { E.fused(acc, cur, wr, wc, fr, fq, lds, wid, lane); S.done(cur); }
#undef PG8_SA
#undef PG8_SB
#undef PG8_STAGE
#undef PG8_LDA
#undef PG8_LDB
#undef PG8_MMA
#undef PG8_WAIT_V
#undef PG8_WAIT_L
#undef PG8_BAR
#undef PG8_SCHED
}
}

#define DI __device__ __forceinline__
#ifndef PROBE_DSEC
#define PROBE_DSEC 0
#endif
#define LAS __attribute__((address_space(3)))
typedef unsigned short bf16;
typedef short bf16x8 __attribute__((ext_vector_type(8)));
typedef short s16x4 __attribute__((ext_vector_type(4)));
typedef float f32x4 __attribute__((ext_vector_type(4)));
typedef unsigned u32x4 __attribute__((ext_vector_type(4)));
typedef unsigned u32x2 __attribute__((ext_vector_type(2)));
using pg8::Unit;

constexpr int NB = 4, T = 4096, D = 1024, M = NB * T, DFF = 2816, NMEM = 256, MROWS = NB * NMEM;
constexpr int NATT = 4608, NH2 = 4096;
constexpr float EPS = 1e-6f;
constexpr int LDS_BYTES = 147456;

constexpr size_t MiB = 1u << 20;
constexpr size_t W_GU1 = 0, W_DN1 = W_GU1 + (size_t)2 * DFF * D * 2, W_IN = W_DN1 + (size_t)D * DFF * 2, W_AB = W_IN + (size_t)10752 * D * 2,
                 W_HB = W_AB + (size_t)D * 512 * 2, W_MO = W_HB + (size_t)D * D * 2, W_Q = W_MO + (size_t)D * D * 2, W_KV = W_Q + (size_t)D * D * 2,
                 W_O = W_KV + (size_t)2 * D * D * 2, W_GU2 = W_O + (size_t)D * D * 2, W_DN2 = W_GU2 + (size_t)2 * DFF * D * 2, W_END = W_DN2 + (size_t)D * DFF * 2;
static_assert(W_END <= 68 * MiB, "weights");
constexpr size_t WS_XB = 68 * MiB, WS_Z = 100 * MiB, WS_OG = 244 * MiB, WS_AO = 292 * MiB, WS_COS = 308 * MiB, WS_SIN = 312 * MiB, WS_MEMN = 316 * MiB,
                 WS_MEMK = 320 * MiB, WS_MEMVT = 322 * MiB, WS_SSQ = 324 * MiB, WS_DEC = 325 * MiB, WS_LSE = 326 * MiB, WS_CTL = 327 * MiB, CTL_BYTES = 65536, WS_WKV1 = 328 * MiB, WS_MEMK1 = 332 * MiB, WS_MEMVT1 = 334 * MiB, WS_END = 336 * MiB;

DI float bf2f(unsigned short h) { return __uint_as_float((unsigned)h << 16); }
typedef __bf16 bf2_t __attribute__((ext_vector_type(2)));
typedef float f32x2_t __attribute__((ext_vector_type(2)));
DI unsigned pk2(float lo, float hi) { const bf2_t r = __builtin_convertvector((f32x2_t){lo, hi}, bf2_t); return __builtin_bit_cast(unsigned, r); }
DI unsigned f2bf(float f) { return pk2(f, 0.f) & 0xffffu; }
template <int N> DI float rr_add(float v) { return v + __int_as_float(__builtin_amdgcn_update_dpp(0, __float_as_int(v), 0x120 + N, 0xf, 0xf, false)); }
DI float row16_sum(float v) { v = rr_add<1>(v); v = rr_add<2>(v); v = rr_add<4>(v); v = rr_add<8>(v); return v; }
#define LBAR() do { asm volatile("s_waitcnt lgkmcnt(0)" ::: "memory"); __builtin_amdgcn_s_barrier(); asm volatile("" ::: "memory"); } while (0)
DI float lo16(unsigned u) { return __uint_as_float(u << 16); }
DI float hi16(unsigned u) { return __uint_as_float(u & 0xffff0000u); }
DI float wave_sum(float v) {
#pragma unroll
    for (int o = 1; o < 64; o <<= 1) v += __shfl_xor(v, o);
    return v;
}
DI float sigmoidf_(float x) { return __builtin_amdgcn_rcpf(1.0f + __expf(-x)); }
DI bf16x8 mk8(u32x4 v) { return __builtin_bit_cast(bf16x8, v); }
#define MFMA16(a, b, c) __builtin_amdgcn_mfma_f32_16x16x32_bf16((a), (b), (c), 0, 0, 0)

#define EPI_FENCE() asm volatile("" ::: "memory")
DI void rows_rstd(const float* ssq, int row0, int fq, float (&rs)[8]) {
    f32x4 pv[8];
#pragma unroll
    for (int k = 0; k < 8; ++k) pv[k] = *(const f32x4*)(ssq + (size_t)(row0 + (k >> 2) * 128 + (k & 3) * 16) * 16 + 4 * fq);
#pragma unroll
    for (int k = 0; k < 8; ++k) { float t = (pv[k][0] + pv[k][1]) + (pv[k][2] + pv[k][3]); t += __shfl_xor(t, 16); t += __shfl_xor(t, 32); rs[k] = __builtin_amdgcn_rsqf(t * (1.0f / D) + EPS); }
}
struct EpiZ {
    static constexpr bool PERM = true, AFTER_DRAIN = false;
    bf16* O; int ldc; const float* ssq;
    DI void operator()(const f32x4 (&acc)[2][2][4][2], const Unit& u, int wr, int wc, int fr, int fq) const {
        const int row0 = u.pm * 256 + wr * 64 + fr, col0 = u.pn * 256 + wc * 32 + 8 * fq;
        float rs[8];
        if (ssq) rows_rstd(ssq, row0, fq, rs); else {
#pragma unroll
            for (int k = 0; k < 8; ++k) rs[k] = 1.0f; }
        EPI_FENCE();
#pragma unroll
        for (int ai = 0; ai < 2; ++ai)
#pragma unroll
            for (int m = 0; m < 4; ++m) {
                const int row = row0 + ai * 128 + m * 16; const float r1 = rs[ai * 4 + m];
                bf16* rowp = O + (size_t)row * ldc + col0;
#pragma unroll
                for (int bj = 0; bj < 2; ++bj) {
                    const f32x4 v0 = acc[ai][bj][m][0] * r1, v1 = acc[ai][bj][m][1] * r1;
                    u32x4 w; w.x = pk2(v0[0], v0[1]); w.y = pk2(v0[2], v0[3]); w.z = pk2(v1[0], v1[1]); w.w = pk2(v1[2], v1[3]);
                    *(u32x4*)(rowp + bj * 128) = w;
                }
            }
    }
};
struct EpiRope {
    static constexpr bool PERM = true, AFTER_DRAIN = false;
    bf16* O; const float* ssq; const float* cosT; const float* sinT;
    DI void operator()(const f32x4 (&acc)[2][2][4][2], const Unit& u, int wr, int wc, int fr, int fq) const {
        const int row0 = u.pm * 256 + wr * 64 + fr;
        float rs[8]; rows_rstd(ssq, row0, fq, rs);
        if (u.pn < 12) {
            const int i0 = 32 * (wc & 1) + 8 * fq, colb = (2 * u.pn + (wc >> 1)) * 128 + i0;
#pragma unroll
            for (int hb = 0; hb < 4; ++hb) {
                const int ai = hb >> 1, mb = (hb & 1) * 2;
                f32x4 c0[2], c1[2], s0[2], s1[2];
#pragma unroll
                for (int mm = 0; mm < 2; ++mm) { const int row = row0 + ai * 128 + (mb + mm) * 16; const float* cp = cosT + (size_t)row * 64 + i0; const float* sp = sinT + (size_t)row * 64 + i0;
                    c0[mm] = *(const f32x4*)cp; c1[mm] = *(const f32x4*)(cp + 4); s0[mm] = *(const f32x4*)sp; s1[mm] = *(const f32x4*)(sp + 4); }
                EPI_FENCE();
#pragma unroll
                for (int mm = 0; mm < 2; ++mm) { const int m = mb + mm;
                    const int row = row0 + ai * 128 + m * 16; const float r1 = rs[ai * 4 + m];
                    const f32x4 a0 = acc[ai][0][m][0] * r1, a1 = acc[ai][0][m][1] * r1, b0 = acc[ai][1][m][0] * r1, b1 = acc[ai][1][m][1] * r1;
                    const f32x4 y10 = a0 * c0[mm] - b0 * s0[mm], y11 = a1 * c1[mm] - b1 * s1[mm], y20 = b0 * c0[mm] + a0 * s0[mm], y21 = b1 * c1[mm] + a1 * s1[mm];
                    u32x4 w1, w2; w1.x = pk2(y10[0], y10[1]); w1.y = pk2(y10[2], y10[3]); w1.z = pk2(y11[0], y11[1]); w1.w = pk2(y11[2], y11[3]);
                    w2.x = pk2(y20[0], y20[1]); w2.y = pk2(y20[2], y20[3]); w2.z = pk2(y21[0], y21[1]); w2.w = pk2(y21[2], y21[3]);
                    bf16* rowp = O + (size_t)row * NATT + colb; *(u32x4*)rowp = w1; *(u32x4*)(rowp + 64) = w2;
                }
                EPI_FENCE();
            }
        } else {
            const int col0 = u.pn * 256 + wc * 32 + 8 * fq;
            EPI_FENCE();
#pragma unroll
            for (int ai = 0; ai < 2; ++ai)
#pragma unroll
                for (int m = 0; m < 4; ++m) {
                    const int row = row0 + ai * 128 + m * 16; const float r1 = rs[ai * 4 + m]; bf16* rowp = O + (size_t)row * NATT + col0;
#pragma unroll
                    for (int bj = 0; bj < 2; ++bj) { const f32x4 v0 = acc[ai][bj][m][0] * r1, v1 = acc[ai][bj][m][1] * r1;
                        u32x4 w; w.x = pk2(v0[0], v0[1]); w.y = pk2(v0[2], v0[3]); w.z = pk2(v1[0], v1[1]); w.w = pk2(v1[2], v1[3]); *(u32x4*)(rowp + bj * 128) = w; }
                }
        }
    }
};
struct EpiSwiglu {
    static constexpr bool PERM = true, AFTER_DRAIN = false;
    bf16* H; const float* ssq;
    DI void operator()(const f32x4 (&acc)[2][2][4][2], const Unit& u, int wr, int wc, int fr, int fq) const {
        const int row0 = u.pm * 256 + wr * 64 + fr, col0 = u.pn * 128 + wc * 32 + 8 * fq;
        float rs[8]; rows_rstd(ssq, row0, fq, rs);
        EPI_FENCE();
#pragma unroll
        for (int ai = 0; ai < 2; ++ai)
#pragma unroll
            for (int m = 0; m < 4; ++m) {
                const int row = row0 + ai * 128 + m * 16; const float r1 = rs[ai * 4 + m];
                float h[8];
#pragma unroll
                for (int n = 0; n < 2; ++n)
#pragma unroll
                    for (int e = 0; e < 4; ++e) { const float g = acc[ai][0][m][n][e] * r1, up = acc[ai][1][m][n][e] * r1; h[4 * n + e] = g * sigmoidf_(g) * up; }
                u32x4 w; w.x = pk2(h[0], h[1]); w.y = pk2(h[2], h[3]); w.z = pk2(h[4], h[5]); w.w = pk2(h[6], h[7]);
                *(u32x4*)(H + (size_t)row * DFF + col0) = w;
            }
    }
};
struct EpiResid {
    static constexpr bool PERM = false, AFTER_DRAIN = false;
    const float* x32; bf16* hi; const bf16* lo_in; bf16* lo_out; float* ssq; float alpha;
    DI void operator()(const f32x4 (&acc)[2][2][4][2], const Unit& u, int wr, int wc, int fr, int fq) const {
        const int row0 = u.pm * 256 + wr * 64 + fr, col0 = u.pn * 256 + wc * 32 + 4 * fq;
#pragma unroll
        for (int rb = 0; rb < 4; ++rb) {
            const int ai = rb >> 1, mb = (rb & 1) * 2;
            f32x4 xo[8];
            if (x32) {
#pragma unroll
                for (int g = 0; g < 8; ++g) xo[g] = *(const f32x4*)(x32 + (size_t)(row0 + ai * 128 + (mb + (g >> 2)) * 16) * D + col0 + ((g >> 1) & 1) * 128 + (g & 1) * 16);
            } else {
                u32x2 hv[8], lv[8];
#pragma unroll
                for (int g = 0; g < 8; ++g) { const size_t off = (size_t)(row0 + ai * 128 + (mb + (g >> 2)) * 16) * D + col0 + ((g >> 1) & 1) * 128 + (g & 1) * 16; hv[g] = *(const u32x2*)(hi + off); lv[g] = *(const u32x2*)(lo_in + off); }
#pragma unroll
                for (int g = 0; g < 8; ++g) xo[g] = (f32x4){lo16(hv[g].x) + lo16(lv[g].x), hi16(hv[g].x) + hi16(lv[g].x), lo16(hv[g].y) + lo16(lv[g].y), hi16(hv[g].y) + hi16(lv[g].y)};
            }
            EPI_FENCE();
#pragma unroll
            for (int mm = 0; mm < 2; ++mm) { const int m = mb + mm; const int row = row0 + ai * 128 + m * 16; float ss = 0.f;
#pragma unroll
                for (int bj = 0; bj < 2; ++bj)
#pragma unroll
                    for (int n = 0; n < 2; ++n) {
                        const size_t off = (size_t)row * D + col0 + bj * 128 + n * 16;
                        const f32x4 x = xo[mm * 4 + bj * 2 + n] + acc[ai][bj][m][n] * alpha;
                        u32x2 w; w.x = pk2(x[0], x[1]); w.y = pk2(x[2], x[3]); *(u32x2*)(hi + off) = w;
                        u32x2 wl; wl.x = pk2(x[0] - lo16(w.x), x[1] - hi16(w.x)); wl.y = pk2(x[2] - lo16(w.y), x[3] - hi16(w.y)); *(u32x2*)(lo_out + off) = wl;
                        ss += (x[0] * x[0] + x[1] * x[1]) + (x[2] * x[2] + x[3] * x[3]);
                    }
                ss += __shfl_xor(ss, 16); ss += __shfl_xor(ss, 32);
                if (fq == 0) ssq[(size_t)row * 16 + u.pn * 4 + wc] = ss;
            }
            EPI_FENCE();
        }
    }
};
template <bool ADD> struct EpiGate {
    static constexpr bool PERM = true, AFTER_DRAIN = false;
    const bf16* Gt; int ldg; bf16* Mg; int ldm;
    DI void operator()(const f32x4 (&acc)[2][2][4][2], const Unit& u, int wr, int wc, int fr, int fq) const {
        const int row0 = u.pm * 256 + wr * 64 + fr, col0 = u.pn * 256 + wc * 32 + 8 * fq;
#pragma unroll
        for (int ai = 0; ai < 2; ++ai) {
            u32x4 gv[8], pv[8];
#pragma unroll
            for (int k = 0; k < 8; ++k) { const int row = row0 + ai * 128 + (k >> 1) * 16;
                gv[k] = *(const u32x4*)(Gt + (size_t)row * ldg + col0 + (k & 1) * 128);
                pv[k] = (u32x4){0u, 0u, 0u, 0u}; if (ADD) pv[k] = *(const u32x4*)(Mg + (size_t)row * ldm + col0 + (k & 1) * 128); }
            EPI_FENCE();
#pragma unroll
            for (int k = 0; k < 8; ++k) { const int m = k >> 1, bj = k & 1; const int row = row0 + ai * 128 + m * 16;
                float r[8];
#pragma unroll
                for (int q = 0; q < 4; ++q) {
                    const float a0 = acc[ai][bj][m][q >> 1][(q & 1) * 2], a1 = acc[ai][bj][m][q >> 1][(q & 1) * 2 + 1];
                    r[2 * q] = sigmoidf_(lo16(gv[k][q])) * a0 + (ADD ? lo16(pv[k][q]) : 0.f);
                    r[2 * q + 1] = sigmoidf_(hi16(gv[k][q])) * a1 + (ADD ? hi16(pv[k][q]) : 0.f);
                }
                u32x4 w; w.x = pk2(r[0], r[1]); w.y = pk2(r[2], r[3]); w.z = pk2(r[4], r[5]); w.w = pk2(r[6], r[7]);
                *(u32x4*)(Mg + (size_t)row * ldm + col0 + bj * 128) = w;
            }
            EPI_FENCE();
        }
    }
};

template <class Epi>
DI void run_gemm(LAS unsigned char* lds, const bf16* A, int lda, const bf16* Bt, int ldb, int Mr, int N, int K, int G, int c, const Epi& E) {
    pg8::Gemm g{A, Bt, Mr, N, K, lda, ldb}; pg8::StaticOrder S; S.init(Mr, N, G, c);
    pg8::gemm_phase<Epi, pg8::StaticOrder, true, true>(lds, g, S, E);
}

DI void conv_item(const float* W, int K, int Nsrc, int srcoff, int Nout, int GU, const float* gain, bf16* WT, LAS float* scr, int item, int lane) {
    const int nblk = Nout / 64, kb = item / nblk, nb = item % nblk, k0 = 64 * kb, n0 = 64 * nb;
    const int src0 = srcoff + (GU == 1 ? (((n0 & 255) >> 7) * DFF + 128 * (n0 >> 8) + (n0 & 127)) : ((GU == 2 && n0 < 3072) ? (2 * (n0 >> 8) + ((n0 & 127) >> 6)) * 128 + ((n0 & 255) >> 7) * 64 : n0));
    float wv[64];
    const float* wp = W + (size_t)k0 * Nsrc + src0 + lane;
#pragma unroll
    for (int i = 0; i < 64; ++i) wv[i] = __builtin_nontemporal_load(wp + (size_t)i * Nsrc);
    const float g = gain ? gain[k0 + lane] : 1.0f;
#pragma unroll
    for (int i = 0; i < 64; ++i) scr[i * 65 + lane] = wv[i] * __shfl(g, i);
    asm volatile("s_waitcnt lgkmcnt(0)" ::: "memory");
    const int c = lane & 7;
#pragma unroll
    for (int j = 0; j < 8; ++j) { const int n = (lane >> 3) + 8 * j; const LAS float* s = scr + (8 * c) * 65 + n;
        u32x4 o; o.x = pk2(s[0 * 65], s[1 * 65]); o.y = pk2(s[2 * 65], s[3 * 65]); o.z = pk2(s[4 * 65], s[5 * 65]); o.w = pk2(s[6 * 65], s[7 * 65]);
        *(u32x4*)(WT + (size_t)(n0 + n) * K + k0 + 8 * c) = o; }
    asm volatile("s_waitcnt lgkmcnt(0)" ::: "memory");
}

struct Args { const void* in[22]; float* out; unsigned char* ws; };

template <int SET> DI void conv_weights(const Args& a, LAS unsigned char* L, int gw, int NGW, int wave, int lane) {
    LAS float* scr = (LAS float*)(L + wave * 16640);
    unsigned char* ws = a.ws;
    int it = gw;
#define CONV(l_, idx, K_, Ns_, so_, No_, GU_, gidx, dst_) { const float* Wp = (const float*)a.in[idx] + (size_t)(l_) * (K_) * (Ns_); const float* gp = (gidx) >= 0 ? (const float*)a.in[(gidx) >= 0 ? (gidx) : 0] + (size_t)(l_) * (K_) : nullptr; \
        const int nitems = ((K_) / 64) * ((No_) / 64); for (; it < nitems; it += NGW) conv_item(Wp, K_, Ns_, so_, No_, GU_, gp, (bf16*)(ws + (dst_)), scr, it, lane); it -= nitems; }
    if (SET == 0) {
        CONV(0, 4, D, 2 * DFF, 0, 2 * DFF, true, 3, W_GU1)
        CONV(0, 5, DFF, D, 0, D, false, -1, W_DN1)
        CONV(0, 7, D, 10752, 0, 10752, 2, 6, W_IN)
        CONV(0, 10, 512, D, 0, D, false, -1, W_AB)
        CONV(0, 11, D, D, 0, D, false, -1, W_HB)
        CONV(0, 12, D, D, 0, D, false, -1, W_MO)
        CONV(0, 15, D, D, 0, D, false, 13, W_Q)
        CONV(0, 16, D, 2 * D, 0, 2 * D, false, -1, W_KV)
        CONV(1, 16, D, 2 * D, 0, 2 * D, false, -1, WS_WKV1)
        CONV(0, 17, D, D, 0, D, false, -1, W_O)
        CONV(0, 19, D, 2 * DFF, 0, 2 * DFF, true, 18, W_GU2)
        CONV(0, 20, DFF, D, 0, D, false, -1, W_DN2)
    } else if (SET == 1) {
        CONV(1, 4, D, 2 * DFF, 0, 2 * DFF, true, 3, W_GU1)
        CONV(1, 5, DFF, D, 0, D, false, -1, W_DN1)
        CONV(1, 7, D, 10752, 0, 8704, 2, 6, W_IN)
    } else {
        CONV(1, 7, D, 10752, 8704, 2048, false, 6, W_IN + (size_t)8704 * D * 2)
        CONV(1, 10, 512, D, 0, D, false, -1, W_AB)
        CONV(1, 11, D, D, 0, D, false, -1, W_HB)
        CONV(1, 12, D, D, 0, D, false, -1, W_MO)
        CONV(1, 15, D, D, 0, D, false, 13, W_Q)
        CONV(1, 17, D, D, 0, D, false, -1, W_O)
        CONV(1, 19, D, 2 * DFF, 0, 2 * DFF, true, 18, W_GU2)
        CONV(1, 20, DFF, D, 0, D, false, -1, W_DN2)
    }
#undef CONV
}

DI void prologue_misc(const Args& a, int gw, int NGW, int lane, int gtid, int NGT) {
    unsigned char* ws = a.ws;
    const float* x = (const float*)a.in[0];
    bf16* Xb = (bf16*)(ws + WS_XB); float* ssq = (float*)(ws + WS_SSQ);
    for (int m0 = gw; m0 < M; m0 += 2 * NGW) {
        const int m1 = m0 + NGW < M ? m0 + NGW : m0;
        f32x4 va[4], vb[4];
#pragma unroll
        for (int j = 0; j < 4; ++j) { va[j] = ((const f32x4*)(x + (size_t)m0 * D) + lane)[64 * j]; vb[j] = ((const f32x4*)(x + (size_t)m1 * D) + lane)[64 * j]; }
#pragma unroll
        for (int rr = 0; rr < 2; ++rr) { const int m = rr ? m1 : m0; float s2 = 0.f;
            unsigned long long* o8 = (unsigned long long*)(Xb + (size_t)m * D) + lane;
#pragma unroll
            for (int j = 0; j < 4; ++j) { const f32x4 v = rr ? vb[j] : va[j]; s2 += (v[0] * v[0] + v[1] * v[1]) + (v[2] * v[2] + v[3] * v[3]);
                o8[64 * j] = (unsigned long long)pk2(v[0], v[1]) | ((unsigned long long)pk2(v[2], v[3]) << 32); }
            s2 = wave_sum(s2);
            if (lane < 16) ssq[(size_t)m * 16 + lane] = lane == 0 ? s2 : 0.f; }
    }
    const float* mem = (const float*)a.in[1]; const float* mnorm = (const float*)a.in[14]; bf16* memN = (bf16*)(ws + WS_MEMN);
    for (int r = gw; r < 2 * MROWS; r += NGW) {
        const int l = r / MROWS, m = r % MROWS;
        const f32x4* xr = (const f32x4*)(mem + (size_t)m * D) + lane; const f32x4* gr = (const f32x4*)(mnorm + (size_t)l * D) + lane;
        f32x4 v[4]; float s = 0.f;
#pragma unroll
        for (int j = 0; j < 4; ++j) { v[j] = xr[64 * j]; s += (v[j][0] * v[j][0] + v[j][1] * v[j][1]) + (v[j][2] * v[j][2] + v[j][3] * v[j][3]); }
        const float rs = 1.0f / sqrtf(wave_sum(s) * (1.0f / D) + EPS);
        unsigned long long* o8 = (unsigned long long*)(memN + (size_t)r * D) + lane;
#pragma unroll
        for (int j = 0; j < 4; ++j) { const f32x4 g = gr[64 * j]; const f32x4 y = v[j] * rs * g;
            o8[64 * j] = (unsigned long long)pk2(y[0], y[1]) | ((unsigned long long)pk2(y[2], y[3]) << 32); }
    }
    const int* pos = (const int*)a.in[2]; float* cosT = (float*)(ws + WS_COS); float* sinT = (float*)(ws + WS_SIN);
    for (int idx = gtid; idx < M * 64; idx += NGT) {
        const int row = idx >> 6, i = idx & 63;
        const float inv = exp2f(-(float)(2 * i) * (1.0f / 128.0f) * 13.287712379549449f);
        const float ang = (float)pos[row] * inv;
        double rv = (double)ang * 0.15915494309189535; rv -= floor(rv);
        const float fr = (float)rv;
        cosT[idx] = __builtin_amdgcn_cosf(fr); sinT[idx] = __builtin_amdgcn_sinf(fr);
    }
}

DI void rope8(u32x4 x1, u32x4 x2, const float* cp, const float* sp, u32x4& o1, u32x4& o2) {
    const f32x4 c0 = *(const f32x4*)cp, c1 = *(const f32x4*)(cp + 4), s0 = *(const f32x4*)sp, s1 = *(const f32x4*)(sp + 4);
#pragma unroll
    for (int q = 0; q < 4; ++q) {
        const float ca = q < 2 ? c0[2 * q] : c1[2 * q - 4], cb = q < 2 ? c0[2 * q + 1] : c1[2 * q - 3];
        const float sa = q < 2 ? s0[2 * q] : s1[2 * q - 4], sb = q < 2 ? s0[2 * q + 1] : s1[2 * q - 3];
        const float a0 = lo16(x1[q]), a1 = hi16(x1[q]), b0 = lo16(x2[q]), b1 = hi16(x2[q]);
        o1[q] = pk2(a0 * ca - b0 * sa, a1 * cb - b1 * sb);
        o2[q] = pk2(b0 * ca + a0 * sa, b1 * cb + a1 * sb);
    }
}
constexpr int KSTR = 272, VSTR = 528, KL_BYTES = 256 * KSTR;
DI unsigned vt_off(int dh, int kgrp) { return (unsigned)(dh * VSTR + ((kgrp ^ ((dh >> 3) & 7)) << 3)); }

DI void dil_attn_phase(LAS unsigned char* L, const bf16* Z, const float* cosT, const float* sinT, bf16* OG, float* LSE, int G, int bid, int tid, unsigned long long& tsec) {
#define DSEC(k) do { if (PROBE_DSEC) { const unsigned long long tn_ = __builtin_amdgcn_s_memrealtime(); if (PROBE_DSEC == (k)) tsec += tn_ - tl_; tl_ = tn_; } } while (0)
    unsigned long long tl_ = PROBE_DSEC ? __builtin_amdgcn_s_memrealtime() : 0;
    const int wid = __builtin_amdgcn_readfirstlane(tid >> 6), lane = tid & 63, fr = lane & 15, fq = lane >> 4;
    LAS unsigned char* KL = L; LAS unsigned char* VL = L + KL_BYTES;
    u32x4 kreg[8], vreg[8];
#define DIL_LOAD(uu_) do { const int j_ = (uu_) & 31, h_ = ((uu_) >> 5) & 3, gb_ = (uu_) >> 7, g_ = gb_ % 3, b_ = gb_ / 3, dsh_ = 2 * g_, Ls_ = T >> dsh_, p0_ = 128 * j_, r_ = p0_ / Ls_, u0_ = p0_ & (Ls_ - 1); \
        const int tb_ = b_ * T + r_, cq_ = g_ * 512 + h_ * 128; \
        _Pragma("unroll") for (int i = 0; i < 8; ++i) { const int p = tid + 512 * i, kk = p >> 4, cb = p & 15; int uu = u0_ - 128 + kk; uu = uu < 0 ? 0 : uu; \
            const bf16* rp_ = Z + (size_t)(tb_ + (uu << dsh_)) * NATT + cq_ + 8 * cb; kreg[i] = *(const u32x4*)(rp_ + 1536); vreg[i] = *(const u32x4*)(rp_ + 3072); } \
        } while (0)
    if (bid < 1536) DIL_LOAD(bid);
    for (int unit = bid; unit < 1536; unit += G) {
        const int j = unit & 31, h = (unit >> 5) & 3, gb = unit >> 7, g = gb % 3, b = gb / 3;
        const int dsh = 2 * g, Lseg = T >> dsh;
        const int p0 = 128 * j, r = p0 / Lseg, u0 = p0 & (Lseg - 1);
        const int tokbase = b * T + r;
        const int colq = g * 512 + h * 128;
        asm volatile("" : "+v"(kreg[0]), "+v"(kreg[1]), "+v"(kreg[2]), "+v"(kreg[3]), "+v"(kreg[4]), "+v"(kreg[5]), "+v"(kreg[6]), "+v"(kreg[7]));
        asm volatile("" : "+v"(vreg[0]), "+v"(vreg[1]), "+v"(vreg[2]), "+v"(vreg[3]), "+v"(vreg[4]), "+v"(vreg[5]), "+v"(vreg[6]), "+v"(vreg[7]));
        const int qi = 16 * wid + fr; const size_t tq = (size_t)(tokbase + ((u0 + qi) << dsh));
        bf16x8 qf[4];
#pragma unroll
        for (int k4 = 0; k4 < 4; ++k4) qf[k4] = *(const bf16x8*)(Z + tq * NATT + colq + 32 * k4 + 8 * fq);
        __syncthreads();
        DSEC(6);
#pragma unroll
        for (int i = 0; i < 8; ++i) {
            const int p = tid + 512 * i, kk = p >> 4, cb = p & 15; const bool ok = u0 - 128 + kk >= 0;
            const u32x4 zz = (u32x4){0u, 0u, 0u, 0u}; const u32x4 kx = ok ? kreg[i] : zz, x = ok ? vreg[i] : zz;
            *(LAS u32x4*)(KL + kk * KSTR + 16 * cb) = kx;
            const unsigned base = (unsigned)((((kk >> 2) ^ (cb & 7)) << 3) + (kk & 3) * 2);
#pragma unroll
            for (int jj = 0; jj < 8; ++jj) *(LAS unsigned short*)(VL + (8 * cb + jj) * VSTR + base) = (unsigned short)(x[jj >> 1] >> (16 * (jj & 1)));
        }
        DSEC(1);
        { const int nu = unit + G < 1536 ? unit + G : unit; DIL_LOAD(nu); }
        DSEC(2);
        __syncthreads();
        DSEC(3);
        const int tw = wid & ~1;
        f32x4 s[10];
#pragma unroll
        for (int tix = 0; tix < 10; ++tix) s[tix] = (f32x4){0.f, 0.f, 0.f, 0.f};
#pragma unroll
        for (int k4 = 0; k4 < 4; ++k4)
#pragma unroll
            for (int t5 = 0; t5 < 2; ++t5) { bf16x8 av[5];
#pragma unroll
                for (int tix = 0; tix < 5; ++tix) av[tix] = *(const LAS bf16x8*)(KL + (16 * (tw + 5 * t5 + tix) + fr) * KSTR + (32 * k4 + 8 * fq) * 2);
#pragma unroll
                for (int tix = 0; tix < 5; ++tix) s[5 * t5 + tix] = MFMA16(av[tix], qf[k4], s[5 * t5 + tix]); }
        DSEC(4);
        const float scale = 0.08838834764831845f; float mx = -INFINITY;
#pragma unroll
        for (int tix = 0; tix < 10; ++tix)
#pragma unroll
            for (int e = 0; e < 4; ++e) { const int kk = 16 * (tw + tix) + 4 * fq + e; const bool ok = (kk >= qi) && (kk <= qi + 128) && (u0 - 128 + kk >= 0);
                const float v = ok ? s[tix][e] * scale : -INFINITY; s[tix][e] = v; mx = fmaxf(mx, v); }
        mx = fmaxf(mx, __shfl_xor(mx, 16)); mx = fmaxf(mx, __shfl_xor(mx, 32));
        float den = 0.f;
#pragma unroll
        for (int tix = 0; tix < 10; ++tix)
#pragma unroll
            for (int e = 0; e < 4; ++e) { const float p = __expf(s[tix][e] - mx); s[tix][e] = p; den += p; }
        den += __shfl_xor(den, 16); den += __shfl_xor(den, 32);
        DSEC(5);
        bf16x8 pf[5];
#pragma unroll
        for (int pp = 0; pp < 5; ++pp) { u32x4 pw; pw.x = pk2(s[2 * pp][0], s[2 * pp][1]); pw.y = pk2(s[2 * pp][2], s[2 * pp][3]); pw.z = pk2(s[2 * pp + 1][0], s[2 * pp + 1][1]); pw.w = pk2(s[2 * pp + 1][2], s[2 * pp + 1][3]); pf[pp] = mk8(pw); }
        f32x4 o[8];
#pragma unroll
        for (int dt = 0; dt < 8; ++dt) o[dt] = (f32x4){0.f, 0.f, 0.f, 0.f};
        const unsigned x0 = (unsigned)(fq ^ (fr >> 3));
        const LAS unsigned char* vev = L + KL_BYTES + fr * VSTR + 32 * tw + (x0 << 3); const LAS unsigned char* vod = L + KL_BYTES + fr * VSTR + 32 * tw + ((x0 ^ 2u) << 3);
#pragma unroll
        for (int pp = 0; pp < 5; ++pp)
#pragma unroll
            for (int d4 = 0; d4 < 2; ++d4) { bf16x8 vf[4];
#pragma unroll
                for (int dq = 0; dq < 4; ++dq) { const int dt = 4 * d4 + dq; const LAS unsigned char* vb_ = ((dt & 1) ? vod : vev) + 16 * dt * VSTR + 64 * pp;
                    const s16x4 lo = *(const LAS s16x4*)(vb_ + (((2 * dt) & 4) << 3)), hi = *(const LAS s16x4*)(vb_ + ((((2 * dt) & 4) ^ 4) << 3)); vf[dq] = __builtin_shufflevector(lo, hi, 0, 1, 2, 3, 4, 5, 6, 7); }
#pragma unroll
                for (int dq = 0; dq < 4; ++dq) o[4 * d4 + dq] = MFMA16(vf[dq], pf[pp], o[4 * d4 + dq]);
            }
        const float inv = __builtin_amdgcn_rcpf(den), lse = mx + __logf(den);
        { bf16* op = OG + tq * 1536 + colq + 4 * fq;
#pragma unroll
          for (int dt = 0; dt < 8; ++dt) *(unsigned long long*)(op + 16 * dt) = (unsigned long long)pk2(o[dt][0] * inv, o[dt][1] * inv) | ((unsigned long long)pk2(o[dt][2] * inv, o[dt][3] * inv) << 32); }
        if (lane < 16) LSE[tq * 12 + g * 4 + h] = lse;
    }
#undef DIL_LOAD
}

DI void merge_phase(const bf16* OG, const float* LSE, bf16* AO, int gtid, int NGT) {
    for (int idx0 = gtid; idx0 < M * 64; idx0 += 4 * NGT) {
        u32x4 xa[4], xb[4], xd[4]; float l0[4], l1[4], l2[4]; bf16* op[4];
#pragma unroll
        for (int u = 0; u < 4; ++u) { const int idx = idx0 + u * NGT; const bool ok = idx < M * 64; const int tok = ok ? idx >> 6 : 0, h = (idx >> 4) & 3, c = idx & 15;
            l0[u] = LSE[(size_t)tok * 12 + h]; l1[u] = LSE[(size_t)tok * 12 + 4 + h]; l2[u] = LSE[(size_t)tok * 12 + 8 + h];
            const bf16* p = OG + (size_t)tok * 1536 + h * 128 + 8 * c; xa[u] = *(const u32x4*)p; xb[u] = *(const u32x4*)(p + 512); xd[u] = *(const u32x4*)(p + 1024);
            op[u] = ok ? AO + (size_t)tok * 512 + h * 128 + 8 * c : nullptr; }
#pragma unroll
        for (int u = 0; u < 4; ++u) {
            const float mx = fmaxf(l0[u], fmaxf(l1[u], l2[u])); float w0 = __expf(l0[u] - mx), w1 = __expf(l1[u] - mx), w2 = __expf(l2[u] - mx); const float inv = __builtin_amdgcn_rcpf(w0 + w1 + w2); w0 *= inv; w1 *= inv; w2 *= inv;
            u32x4 o;
#pragma unroll
            for (int q = 0; q < 4; ++q) o[q] = pk2(w0 * lo16(xa[u][q]) + w1 * lo16(xb[u][q]) + w2 * lo16(xd[u][q]), w0 * hi16(xa[u][q]) + w1 * hi16(xb[u][q]) + w2 * hi16(xd[u][q]));
            if (op[u]) *(u32x4*)op[u] = o;
        }
    }
}

#define XK_LOAD(R, b_, h_, hh_) do { _Pragma("unroll") for (int i = 0; i < 8; ++i) { const int p = tid + 512 * i, m = p >> 4, cb = p & 15; R[i] = *(const u32x4*)(memK + (size_t)((b_) * NMEM + m) * D + (h_) * 256 + 128 * (hh_) + 8 * cb); } } while (0)
#define XK_WRITE(R) do { _Pragma("unroll") for (int i = 0; i < 8; ++i) { const int p = tid + 512 * i, m = p >> 4, cb = p & 15; *(LAS u32x4*)(KL + m * KSTR + 16 * cb) = R[i]; } } while (0)
#define XV_LOAD(R, b_, h_, hh_) do { _Pragma("unroll") for (int i = 0; i < 8; ++i) { const int p = tid + 512 * i, dhr = p >> 5, c = p & 31; R[i] = *(const u32x4*)(memVT + (size_t)((h_) * 256 + 128 * (hh_) + dhr) * MROWS + (b_) * NMEM + 8 * c); } } while (0)
#define XV_WRITE(R) do { _Pragma("unroll") for (int i = 0; i < 8; ++i) { const int p = tid + 512 * i, dhr = p >> 5, c = p & 31; u32x2 lo, hi; lo.x = R[i].x; lo.y = R[i].y; hi.x = R[i].z; hi.y = R[i].w; \
        *(LAS u32x2*)(VL + vt_off(dhr, 2 * c)) = lo; *(LAS u32x2*)(VL + vt_off(dhr, 2 * c + 1)) = hi; } } while (0)
DI void xattn_phase(LAS unsigned char* L, const bf16* Qx, const bf16* memK, const bf16* memVT, bf16* Ox, int G, int bid, int tid, unsigned long long& tsec) {
    unsigned long long tl_ = PROBE_DSEC ? __builtin_amdgcn_s_memrealtime() : 0;
    const int wid = __builtin_amdgcn_readfirstlane(tid >> 6), lane = tid & 63, fr = lane & 15, fq = lane >> 4;
    LAS unsigned char* KL = L; LAS unsigned char* VL = L + KL_BYTES;
    u32x4 ra[8], rb[8];
    if (bid < 512) { const int h0 = (bid >> 5) & 3, b0 = bid >> 7; XK_LOAD(ra, b0, h0, 0); XV_LOAD(rb, b0, h0, 0); }
    for (int unit = bid; unit < 512; unit += G) {
        const int j = unit & 31, h = (unit >> 5) & 3, b = unit >> 7;
        const int nun = unit + G < 512 ? unit + G : unit, hn = (nun >> 5) & 3, bn = nun >> 7;
        asm volatile("" : "+v"(ra[0]), "+v"(ra[1]), "+v"(ra[2]), "+v"(ra[3]), "+v"(ra[4]), "+v"(ra[5]), "+v"(ra[6]), "+v"(ra[7]));
        asm volatile("" : "+v"(rb[0]), "+v"(rb[1]), "+v"(rb[2]), "+v"(rb[3]), "+v"(rb[4]), "+v"(rb[5]), "+v"(rb[6]), "+v"(rb[7]));
        const int tok0 = b * T + 128 * j; const size_t tq = (size_t)(tok0 + 16 * wid + fr);
        f32x4 s[16];
#pragma unroll
        for (int kt = 0; kt < 16; ++kt) s[kt] = (f32x4){0.f, 0.f, 0.f, 0.f};
#pragma unroll
        for (int hh = 0; hh < 2; ++hh) {
            __syncthreads();
            XK_WRITE(ra);
            if (hh == 0) { XV_WRITE(rb); XK_LOAD(ra, b, h, 1); XV_LOAD(rb, b, h, 1); }
            else XK_LOAD(ra, bn, hn, 0);
            __syncthreads();
            DSEC(11);
#pragma unroll
            for (int k4 = 0; k4 < 4; ++k4) { const bf16x8 qk = *(const bf16x8*)(Qx + tq * D + h * 256 + 128 * hh + 32 * k4 + 8 * fq);
#pragma unroll
                for (int k8 = 0; k8 < 4; ++k8) { bf16x8 av[4];
#pragma unroll
                    for (int kt = 0; kt < 4; ++kt) av[kt] = *(const LAS bf16x8*)(KL + (16 * (4 * k8 + kt) + fr) * KSTR + (32 * k4 + 8 * fq) * 2);
#pragma unroll
                    for (int kt = 0; kt < 4; ++kt) s[4 * k8 + kt] = MFMA16(av[kt], qk, s[4 * k8 + kt]); } }
        }
        DSEC(12);
        float mx = -INFINITY;
#pragma unroll
        for (int kt = 0; kt < 16; ++kt)
#pragma unroll
            for (int e = 0; e < 4; ++e) { const float v = s[kt][e] * 0.0625f; s[kt][e] = v; mx = fmaxf(mx, v); }
        mx = fmaxf(mx, __shfl_xor(mx, 16)); mx = fmaxf(mx, __shfl_xor(mx, 32));
        float den = 0.f;
#pragma unroll
        for (int kt = 0; kt < 16; ++kt)
#pragma unroll
            for (int e = 0; e < 4; ++e) { const float p = __expf(s[kt][e] - mx); s[kt][e] = p; den += p; }
        den += __shfl_xor(den, 16); den += __shfl_xor(den, 32);
        DSEC(13);
        bf16x8 pf[8];
#pragma unroll
        for (int pp = 0; pp < 8; ++pp) { u32x4 pw; pw.x = pk2(s[2 * pp][0], s[2 * pp][1]); pw.y = pk2(s[2 * pp][2], s[2 * pp][3]); pw.z = pk2(s[2 * pp + 1][0], s[2 * pp + 1][1]); pw.w = pk2(s[2 * pp + 1][2], s[2 * pp + 1][3]); pf[pp] = mk8(pw); }
        const float inv = __builtin_amdgcn_rcpf(den);
#pragma unroll
        for (int hh = 0; hh < 2; ++hh) {
            if (hh == 1) { DSEC(14); __syncthreads(); XV_WRITE(rb); XV_LOAD(rb, bn, hn, 0); __syncthreads(); DSEC(15); }
            f32x4 o[8];
#pragma unroll
            for (int dt = 0; dt < 8; ++dt) o[dt] = (f32x4){0.f, 0.f, 0.f, 0.f};
            const unsigned x0 = (unsigned)(fq ^ (fr >> 3));
            const LAS unsigned char* vev = L + KL_BYTES + fr * VSTR + (x0 << 3); const LAS unsigned char* vod = L + KL_BYTES + fr * VSTR + ((x0 ^ 2u) << 3);
#pragma unroll
            for (int pp = 0; pp < 8; ++pp)
#pragma unroll
                for (int d4 = 0; d4 < 2; ++d4) { bf16x8 vf[4];
#pragma unroll
                    for (int dq = 0; dq < 4; ++dq) { const int dt = 4 * d4 + dq; const LAS unsigned char* vb_ = ((dt & 1) ? vod : vev) + 16 * dt * VSTR + 64 * pp;
                        const s16x4 lo = *(const LAS s16x4*)(vb_ + (((2 * dt) & 4) << 3)), hi = *(const LAS s16x4*)(vb_ + ((((2 * dt) & 4) ^ 4) << 3)); vf[dq] = __builtin_shufflevector(lo, hi, 0, 1, 2, 3, 4, 5, 6, 7); }
#pragma unroll
                    for (int dq = 0; dq < 4; ++dq) o[4 * d4 + dq] = MFMA16(vf[dq], pf[pp], o[4 * d4 + dq]);
                }
            { bf16* op = Ox + tq * D + h * 256 + 128 * hh + 4 * fq;
#pragma unroll
              for (int dt = 0; dt < 8; ++dt) *(unsigned long long*)(op + 16 * dt) = (unsigned long long)pk2(o[dt][0] * inv, o[dt][1] * inv) | ((unsigned long long)pk2(o[dt][2] * inv, o[dt][3] * inv) << 32); }
        }
        DSEC(14);
    }
}
#undef XK_LOAD
#undef XK_WRITE
#undef XV_LOAD
#undef XV_WRITE

constexpr int H1_QA = 0, H1_KA = 64 * 272, H1_VT = 2 * 64 * 272, H1_TOT = H1_VT + 128 * 144;
template <bool DRY> DI void hgrn1_phase(LAS unsigned char* L, bf16* Z2, const float* lbraw, int layer, float* DEC, unsigned long long* OI, int G, int bid, int tid) {
    const int wid = __builtin_amdgcn_readfirstlane(tid >> 6), lane = tid & 63, fr = lane & 15, fq = lane >> 4;
    const int n = tid & 127, rg = tid >> 7, tt = wid & 3, vh = wid >> 2;
    LAS float* TOT = (LAS float*)(L + H1_TOT);
    unsigned short rq[16], rf[16], rv[16];
#define H1_RAW(uu, RQ, RF, RV) do { const int c_ = (uu) & 63, h_ = ((uu) >> 6) & 7, b_ = (uu) >> 9; const bf16* p_ = Z2 + (size_t)(b_ * T + 64 * c_ + 16 * rg) * NH2 + h_ * 128 + n; \
        _Pragma("unroll") for (int r = 0; r < 16; ++r) { RQ[r] = p_[(size_t)r * NH2]; RF[r] = p_[(size_t)r * NH2 + 1024]; RV[r] = p_[(size_t)r * NH2 + 2048]; } } while (0)
    if (bid < 2048) H1_RAW(bid, rq, rf, rv);
    for (int unit = bid; unit < 2048; unit += G) {
        const int c = unit & 63, h = (unit >> 6) & 7, b = unit >> 9, tok0 = b * T + 64 * c, ch = h * 128 + n;
        float lbv = 0.f;
        if (layer > 0) { const float e0 = lbraw[ch], e1 = lbraw[D + ch]; lbv = 1.0f / (1.0f + expf(e0 - e1)); }
        asm volatile("" : "+v"(rq[0]), "+v"(rq[1]), "+v"(rq[2]), "+v"(rq[3]), "+v"(rq[4]), "+v"(rq[5]), "+v"(rq[6]), "+v"(rq[7]), "+v"(rq[8]), "+v"(rq[9]), "+v"(rq[10]), "+v"(rq[11]), "+v"(rq[12]), "+v"(rq[13]), "+v"(rq[14]), "+v"(rq[15]));
        asm volatile("" : "+v"(rf[0]), "+v"(rf[1]), "+v"(rf[2]), "+v"(rf[3]), "+v"(rf[4]), "+v"(rf[5]), "+v"(rf[6]), "+v"(rf[7]), "+v"(rf[8]), "+v"(rf[9]), "+v"(rf[10]), "+v"(rf[11]), "+v"(rf[12]), "+v"(rf[13]), "+v"(rf[14]), "+v"(rf[15]));
        asm volatile("" : "+v"(rv[0]), "+v"(rv[1]), "+v"(rv[2]), "+v"(rv[3]), "+v"(rv[4]), "+v"(rv[5]), "+v"(rv[6]), "+v"(rv[7]), "+v"(rv[8]), "+v"(rv[9]), "+v"(rv[10]), "+v"(rv[11]), "+v"(rv[12]), "+v"(rv[13]), "+v"(rv[14]), "+v"(rv[15]));
        float q[16], cs[16], kg[16]; unsigned short vr[16];
        bf16* base = Z2 + (size_t)(tok0 + 16 * rg) * NH2 + ch;
#pragma unroll
        for (int r = 0; r < 16; ++r) { q[r] = bf2f(rq[r]); cs[r] = bf2f(rf[r]); vr[r] = rv[r]; }
        unsigned short nq[16], nf[16], nv[16];
        { const int nu = unit + G < 2048 ? unit + G : unit; H1_RAW(nu, nq, nf, nv); }
        float run = 0.f;
#pragma unroll
        for (int r = 0; r < 16; ++r) { const float fl = cs[r]; const float sg = __builtin_amdgcn_rcpf(1.0f + __expf(-fl)); const float f = lbv + (1.0f - lbv) * sg;
            kg[r] = (1.0f - lbv) * (1.0f - sg); run += __logf(f); cs[r] = run; }
        TOT[rg * 128 + n] = run;
        __syncthreads();
        const float t0 = TOT[n], t1 = TOT[128 + n], t2 = TOT[256 + n], t3 = TOT[384 + n];
        const float off = rg == 0 ? 0.f : (rg == 1 ? t0 : (rg == 2 ? t0 + t1 : t0 + t1 + t2));
        const float bmid = t0 + t1, blast = (t0 + t1) + (t2 + t3);
        const float qscale = 0.08838834764831845f;
        float kh[16];
#pragma unroll
        for (int r = 0; r < 16; ++r) { const float bt = off + cs[r]; const float qs = q[r] * qscale; const int row = 16 * rg + r;
            if (!DRY) base[(size_t)r * NH2] = (bf16)f2bf(qs * __expf(bt));
            *(LAS unsigned short*)(L + H1_QA + row * 272 + n * 2) = (unsigned short)f2bf(qs * __expf(bt - bmid));
            *(LAS unsigned short*)(L + H1_KA + row * 272 + n * 2) = (unsigned short)f2bf(kg[r] * __expf(bmid - bt));
            kh[r] = kg[r] * __expf(blast - bt); }
        u32x4 k0, k1, v0, v1;
#pragma unroll
        for (int qd = 0; qd < 4; ++qd) { k0[qd] = pk2(kh[2 * qd], kh[2 * qd + 1]); k1[qd] = pk2(kh[8 + 2 * qd], kh[9 + 2 * qd]);
            v0[qd] = (unsigned)vr[2 * qd] | ((unsigned)vr[2 * qd + 1] << 16); v1[qd] = (unsigned)vr[8 + 2 * qd] | ((unsigned)vr[9 + 2 * qd] << 16); }
        bf16* slot = Z2 + (size_t)(tok0 + (n >> 1)) * NH2 + h * 128 + (n & 1) * 64 + 16 * rg;
        if (!DRY) { *(u32x4*)(slot + 1024) = k0; *(u32x4*)(slot + 1024 + 8) = k1;
        *(u32x4*)(slot + 2048) = v0; *(u32x4*)(slot + 2048 + 8) = v1; }
        *(LAS u32x4*)(L + H1_VT + n * 144 + 32 * rg) = v0; *(LAS u32x4*)(L + H1_VT + n * 144 + 32 * rg + 16) = v1;
        if (!DRY && rg == 0) DEC[(size_t)unit * 128 + n] = __expf(blast);
        __syncthreads();
        bf16x8 bq[4];
#pragma unroll
        for (int k4 = 0; k4 < 4; ++k4) bq[k4] = *(const LAS bf16x8*)(L + H1_QA + (16 * tt + fr) * 272 + (32 * k4 + 8 * fq) * 2);
        f32x4 at[4];
#pragma unroll
        for (int st = 0; st < 4; ++st) { at[st] = (f32x4){0.f, 0.f, 0.f, 0.f};
            if (st <= tt) {
#pragma unroll
                for (int k4 = 0; k4 < 4; ++k4) { const bf16x8 av = *(const LAS bf16x8*)(L + H1_KA + (16 * st + fr) * 272 + (32 * k4 + 8 * fq) * 2); at[st] = MFMA16(av, bq[k4], at[st]); }
                if (st == tt) {
#pragma unroll
                    for (int e = 0; e < 4; ++e) if (4 * fq + e > fr) at[st][e] = 0.f; }
            } }
        bf16x8 pf[2];
#pragma unroll
        for (int pp = 0; pp < 2; ++pp) { u32x4 pw; pw.x = pk2(at[2 * pp][0], at[2 * pp][1]); pw.y = pk2(at[2 * pp][2], at[2 * pp][3]); pw.z = pk2(at[2 * pp + 1][0], at[2 * pp + 1][1]); pw.w = pk2(at[2 * pp + 1][2], at[2 * pp + 1][3]); pf[pp] = mk8(pw); }
#pragma unroll
        for (int vi = 0; vi < 4; ++vi) { const int vt = 4 * vh + vi; f32x4 o = (f32x4){0.f, 0.f, 0.f, 0.f};
#pragma unroll
            for (int pp = 0; pp < 2; ++pp) { const LAS unsigned char* vp = L + H1_VT + (16 * vt + fr) * 144 + (32 * pp + 4 * fq) * 2;
                const s16x4 lo = *(const LAS s16x4*)vp, hi = *(const LAS s16x4*)(vp + 32);
                const bf16x8 vb = __builtin_shufflevector(lo, hi, 0, 1, 2, 3, 4, 5, 6, 7); o = MFMA16(vb, pf[pp], o); }
            if (!DRY) OI[((size_t)(unit * 4 + tt) * 8 + vt) * 64 + lane] = (unsigned long long)pk2(o[0], o[1]) | ((unsigned long long)pk2(o[2], o[3]) << 32);
            }
#pragma unroll
        for (int r = 0; r < 16; ++r) { rq[r] = nq[r]; rf[r] = nf[r]; rv[r] = nv[r]; }
    }
#undef H1_RAW
}

constexpr int H2_BUF = 36352, H2_KHT = 17408, H2_DEC = 35840;
template <bool DRY> DI void hgrn2_phase(LAS unsigned char* L, bf16* Z2, const float* DEC, unsigned long long* OIW, int bh2, int tid) {
    const unsigned long long* OI = OIW;
    const int wv = __builtin_amdgcn_readfirstlane(tid >> 6), lane = tid & 63, fr = lane & 15, fq = lane >> 4;
    const int bh = bh2 >> 1, w = 4 * (bh2 & 1) + (wv & 3); const bool cw = wv < 4;
    const int b = bh >> 3, h = bh & 7, unit0 = bh * 64, vcol = 16 * w + fr;
    u32x4 sqA[2], skA[2]; f32x4 sdA = (f32x4){0.f, 0.f, 0.f, 0.f};
#define H2_LOAD(cc, sq, sk, sd) do { const int tok0_ = b * T + 64 * (cc); _Pragma("unroll") for (int i = 0; i < 2; ++i) { const int p = tid + 512 * i, row = p >> 4, cb = p & 15; \
        const bf16* rp = Z2 + (size_t)(tok0_ + row) * NH2 + h * 128 + 8 * cb; sq[i] = *(const u32x4*)rp; sk[i] = *(const u32x4*)(rp + 1024); } \
        if (tid < 32) sd = *(const f32x4*)(DEC + (size_t)(unit0 + (cc)) * 128 + 4 * tid); } while (0)
#define H2_WRITE(bi, sq, sk, sd) do { LAS unsigned char* B_ = L + (bi) * H2_BUF; _Pragma("unroll") for (int i = 0; i < 2; ++i) { const int p = tid + 512 * i, row = p >> 4, cb = p & 15; \
        *(LAS u32x4*)(B_ + row * 272 + 16 * cb) = sq[i]; *(LAS u32x4*)(B_ + H2_KHT + (2 * row + (cb >> 3)) * 144 + 16 * (cb & 7)) = sk[i]; } \
        if (tid < 32) *(LAS f32x4*)(B_ + H2_DEC + 16 * tid) = sd; } while (0)
#define H2_PRIV(cc, VT_, OI_) do { const int tok0_ = b * T + 64 * (cc); \
        const bf16* vp_ = Z2 + (size_t)(tok0_ + (vcol >> 1)) * NH2 + 2048 + h * 128 + (vcol & 1) * 64 + 8 * fq; VT_[0] = *(const u32x4*)vp_; VT_[1] = *(const u32x4*)(vp_ + 32); \
        _Pragma("unroll") for (int tt_ = 0; tt_ < 4; ++tt_) OI_[tt_] = OI[((size_t)((unit0 + (cc)) * 4 + tt_) * 8 + w) * 64 + lane]; } while (0)
    u32x4 vtf[2]; unsigned long long oi[4];
    u32x4 nvt[2]; unsigned long long noi[4];
    H2_LOAD(0, sqA, skA, sdA); H2_WRITE(0, sqA, skA, sdA); H2_PRIV(0, vtf, oi);
    H2_LOAD(1, sqA, skA, sdA); H2_PRIV(1, nvt, noi);
    f32x4 S[8];
#pragma unroll
    for (int nt = 0; nt < 8; ++nt) S[nt] = (f32x4){0.f, 0.f, 0.f, 0.f};
    __syncthreads();
    for (int c = 0; c < 64; ++c) {
        LAS unsigned char* Bc = L + (c & 1) * H2_BUF;
        asm volatile("" : "+v"(vtf[0]), "+v"(vtf[1]), "+v"(oi[0]), "+v"(oi[1]), "+v"(oi[2]), "+v"(oi[3]), "+v"(nvt[0]), "+v"(nvt[1]), "+v"(noi[0]), "+v"(noi[1]), "+v"(noi[2]), "+v"(noi[3]));
        asm volatile("" : "+v"(sqA[0]), "+v"(sqA[1]), "+v"(skA[0]), "+v"(skA[1]), "+v"(sdA));
        u32x4 sqB[2], skB[2]; f32x4 sdB = (f32x4){0.f, 0.f, 0.f, 0.f}; u32x4 nnvt[2]; unsigned long long nnoi[4];
        const int c2 = c + 2 < 64 ? c + 2 : 63;
        H2_LOAD(c2, sqB, skB, sdB); H2_PRIV(c2, nnvt, nnoi);
        if (cw) {
        bf16x8 qa[4][4];
#pragma unroll
        for (int tt = 0; tt < 4; ++tt)
#pragma unroll
            for (int np = 0; np < 4; ++np) { const LAS unsigned char* qp = Bc + (16 * tt + fr) * 272 + (32 * np + 4 * fq) * 2;
                const s16x4 lo = *(const LAS s16x4*)qp, hi = *(const LAS s16x4*)(qp + 32); qa[tt][np] = __builtin_shufflevector(lo, hi, 0, 1, 2, 3, 4, 5, 6, 7); }
        bf16x8 sb[4];
#pragma unroll
        for (int np = 0; np < 4; ++np) { u32x4 pw; pw.x = pk2(S[2 * np][0], S[2 * np][1]); pw.y = pk2(S[2 * np][2], S[2 * np][3]); pw.z = pk2(S[2 * np + 1][0], S[2 * np + 1][1]); pw.w = pk2(S[2 * np + 1][2], S[2 * np + 1][3]); sb[np] = mk8(pw); }
        f32x4 o[4];
#pragma unroll
        for (int tt = 0; tt < 4; ++tt) { const unsigned lo = (unsigned)oi[tt], hi = (unsigned)(oi[tt] >> 32); o[tt] = (f32x4){lo16(lo), hi16(lo), lo16(hi), hi16(hi)}; }
#pragma unroll
        for (int np = 0; np < 4; ++np)
#pragma unroll
            for (int tt = 0; tt < 4; ++tt) o[tt] = MFMA16(sb[np], qa[tt][np], o[tt]);
        if (!DRY) {
#pragma unroll
            for (int tt = 0; tt < 4; ++tt) OIW[((size_t)((unit0 + c) * 4 + tt) * 8 + w) * 64 + lane] = (unsigned long long)pk2(o[tt][0], o[tt][1]) | ((unsigned long long)pk2(o[tt][2], o[tt][3]) << 32);
        } else { asm volatile("" :: "v"(o[0]), "v"(o[1]), "v"(o[2]), "v"(o[3])); }
        bf16x8 ka[8][2];
#pragma unroll
        for (int nt = 0; nt < 8; ++nt)
#pragma unroll
            for (int ks = 0; ks < 2; ++ks) ka[nt][ks] = *(const LAS bf16x8*)(Bc + H2_KHT + (16 * nt + fr) * 144 + (32 * ks + 8 * fq) * 2);
#pragma unroll
        for (int nt = 0; nt < 8; ++nt) { const f32x4 dv = *(const LAS f32x4*)(Bc + H2_DEC + (16 * nt + 4 * fq) * 4); S[nt] = S[nt] * dv; }
#pragma unroll
        for (int ks = 0; ks < 2; ++ks)
#pragma unroll
            for (int nt = 0; nt < 8; ++nt) S[nt] = MFMA16(ka[nt][ks], mk8(vtf[ks]), S[nt]);
        }
        if (c + 1 < 64) H2_WRITE((c + 1) & 1, sqA, skA, sdA);
        vtf[0] = nvt[0]; vtf[1] = nvt[1]; nvt[0] = nnvt[0]; nvt[1] = nnvt[1];
#pragma unroll
        for (int i = 0; i < 4; ++i) { oi[i] = noi[i]; noi[i] = nnoi[i]; }
        sqA[0] = sqB[0]; sqA[1] = sqB[1]; skA[0] = skB[0]; skA[1] = skB[1]; sdA = sdB;
        LBAR();
    }
#undef H2_LOAD
#undef H2_WRITE
#undef H2_PRIV
}
DI void hgrn3_phase(bf16* Z2, const unsigned long long* OI, const float* gain, int gw, int NGW, int lane) {
    const int fr = lane & 15, fq = lane >> 4;
    for (int it = gw; it < 2048 * 4; it += NGW) {
        const int unit = it >> 2, tt = it & 3, c = unit & 63, h = (unit >> 6) & 7, b = unit >> 9;
        bf16* gp = Z2 + (size_t)(b * T + 64 * c + 16 * tt + fr) * NH2 + 3072 + h * 128 + 4 * fq;
        unsigned long long ov[8], gv[8];
#pragma unroll
        for (int vt = 0; vt < 8; ++vt) { ov[vt] = OI[((size_t)(unit * 4 + tt) * 8 + vt) * 64 + lane]; gv[vt] = *(const unsigned long long*)(gp + 16 * vt); }
        float ss = 0.f;
#pragma unroll
        for (int vt = 0; vt < 8; ++vt) { const unsigned lo = (unsigned)ov[vt], hi = (unsigned)(ov[vt] >> 32); ss += (lo16(lo) * lo16(lo) + hi16(lo) * hi16(lo)) + (lo16(hi) * lo16(hi) + hi16(hi) * hi16(hi)); }
        ss += __shfl_xor(ss, 16); ss += __shfl_xor(ss, 32);
        const float rstd = __builtin_amdgcn_rsqf(ss * (1.0f / 128.0f) + EPS);
#pragma unroll
        for (int vt = 0; vt < 8; ++vt) { const f32x4 g4 = *(const f32x4*)(gain + h * 128 + 16 * vt + 4 * fq);
            const unsigned lo = (unsigned)ov[vt], hi = (unsigned)(ov[vt] >> 32), glo = (unsigned)gv[vt], ghi = (unsigned)(gv[vt] >> 32);
            const float of[4] = {lo16(lo), hi16(lo), lo16(hi), hi16(hi)}, gf[4] = {lo16(glo), hi16(glo), lo16(ghi), hi16(ghi)}; float r[4];
#pragma unroll
            for (int e = 0; e < 4; ++e) r[e] = of[e] * rstd * g4[e] * (gf[e] * __builtin_amdgcn_rcpf(1.0f + __expf(-gf[e])));
            *(unsigned long long*)(gp + 16 * vt) = (unsigned long long)pk2(r[0], r[1]) | ((unsigned long long)pk2(r[2], r[3]) << 32); }
    }
}

#define XB_TMO      128
#define XB_XCNT(j)  (256  + 64 * (j))
#define XB_XSUB(j)  (1280 + 64 * (j))
#define XB_XGEN(j)  (2304 + 64 * (j))
#define XB_TOP      3328
#define XB_TOPGEN   3392
#define XCD_BAR_WORDS 3456
#define XB_SPIN_CAP (1u << 18)

__device__ __forceinline__ unsigned xb_ld(unsigned* p)              { return __hip_atomic_load(p, __ATOMIC_RELAXED, __HIP_MEMORY_SCOPE_AGENT); }
__device__ __forceinline__ unsigned xb_add(unsigned* p, unsigned v) { return __hip_atomic_fetch_add(p, v, __ATOMIC_RELAXED, __HIP_MEMORY_SCOPE_AGENT); }
__device__ __forceinline__ unsigned xb_xcc_id() { return (unsigned)__builtin_amdgcn_s_getreg((3 << 11) | 20) & 0xFu; }
#define XB_SPIN(cond, bar) do { unsigned _sp = 0; while (cond) { __builtin_amdgcn_s_sleep(1); \
    if ((++_sp & 255u) == 0u) { if (xb_ld(&(bar)[XB_TMO])) break; if (_sp > XB_SPIN_CAP) { atomicAdd(&(bar)[XB_TMO], 1u); break; } } } } while (0)

struct XcdBarrier {
    unsigned* bar; unsigned x;
    volatile LAS unsigned* st;
};

__device__ __forceinline__ XcdBarrier xcd_barrier_post(unsigned* bar, volatile LAS unsigned* st) {
    XcdBarrier b; b.bar = bar; b.x = xb_xcc_id(); b.st = st;
    if (threadIdx.x == 0) (void)xb_add(&bar[XB_XCNT(b.x)], 1u);
    return b;
}
__device__ __forceinline__ void xcd_barrier_complete(unsigned* bar, unsigned x, unsigned& nloc, unsigned& nx) {
    const unsigned G = gridDim.x * gridDim.y * gridDim.z;
    unsigned sum, cnt, mine, sp = 0u;
    for (;;) {
        sum = 0u; cnt = 0u; mine = 0u;
#pragma unroll
        for (unsigned j = 0; j < 16; ++j) { const unsigned c = xb_ld(&bar[XB_XCNT(j)]); sum += c; cnt += (c > 0u) ? 1u : 0u; mine = (j == x) ? c : mine; }
        if (sum == G) break;
        __builtin_amdgcn_s_sleep(1);
        if ((++sp & 255u) == 0u) { if (xb_ld(&bar[XB_TMO])) break; if (sp > XB_SPIN_CAP) { atomicAdd(&bar[XB_TMO], 1u); break; } }
    }
    nloc = mine > 0u ? mine : 1u; nx = cnt > 0u ? cnt : 1u;
}

__device__ __forceinline__ void xcd_barrier(const XcdBarrier& b) {
    asm volatile("s_waitcnt vmcnt(0)" ::: "memory");
    __syncthreads();
    if (threadIdx.x == 0) {
        unsigned* bar = b.bar;
        __builtin_amdgcn_s_waitcnt(0);
        unsigned nloc = b.st[0], nx = b.st[1];
        if (nloc == 0u) { xcd_barrier_complete(bar, b.x, nloc, nx); b.st[0] = nloc; b.st[1] = nx; }
        const unsigned old = xb_add(&bar[XB_XSUB(b.x)], 1u);
        const unsigned gen = old / nloc;
        if (old + 1u == (gen + 1u) * nloc) {
            __builtin_amdgcn_fence(__ATOMIC_RELEASE, "agent");
            asm volatile("s_waitcnt vmcnt(0)" ::: "memory");
            const unsigned og = xb_add(&bar[XB_TOP], 1u);
            const unsigned tg = og / nx;
            if (og + 1u == (tg + 1u) * nx) xb_add(&bar[XB_TOPGEN], 1u);
            else XB_SPIN(xb_ld(&bar[XB_TOPGEN]) == tg, bar);
            __builtin_amdgcn_fence(__ATOMIC_ACQUIRE, "agent");
            xb_add(&bar[XB_XGEN(b.x)], 1u);
            asm volatile("s_waitcnt vmcnt(0)" ::: "memory");
        } else {
            XB_SPIN(xb_ld(&bar[XB_XGEN(b.x)]) == gen, bar);
            __builtin_amdgcn_fence(__ATOMIC_ACQUIRE, "agent");
            asm volatile("s_waitcnt vmcnt(0)" ::: "memory");
        }
    }
    __syncthreads();
}

#ifndef PROBE_SYNC
#define PROBE_SYNC 0
#endif
#ifndef PROBE_ATT
#define PROBE_ATT 0
#endif
#ifndef PROBE_GEMM
#define PROBE_GEMM 0
#endif
#ifndef PROBE_HG
#define PROBE_HG 0
#endif
#ifndef PROBE_RES
#define PROBE_RES 0
#endif
#ifndef PROBE_TMASK
#define PROBE_TMASK 0
#endif
#ifndef PROBE_CONV
#define PROBE_CONV 0
#endif
#define GSYNC() do { xcd_barrier(xbar); if (PROBE_SYNC) xcd_barrier(xbar); } while (0)
#define REP(n) for (int rep_ = 0; rep_ < 1 + (n); ++rep_)
#define FRESH() size_t zoff_ = 0; asm volatile("" : "+s"(zoff_)); unsigned char* ws = a.ws + zoff_; int tid = threadIdx.x; asm volatile("" : "+v"(tid)); \
    const int lane = tid & 63, wave = __builtin_amdgcn_readfirstlane(tid >> 6); int G = gridDim.x, bid = blockIdx.x; asm volatile("" : "+s"(G), "+s"(bid)); \
    const int gw = bid * 8 + wave, NGW = G * 8, gtid = bid * 512 + tid, NGT = G * 512; float* X = (float*)((unsigned char*)a.out + zoff_); bf16* XLO = (bf16*)X; (void)XLO; \
    bf16* Xb = (bf16*)(ws + WS_XB); float* ssq = (float*)(ws + WS_SSQ); bf16* Z = (bf16*)(ws + WS_Z); \
    (void)lane; (void)gw; (void)NGW; (void)gtid; (void)NGT; (void)Xb; (void)ssq; (void)Z; (void)X;

__global__ void __launch_bounds__(512, 2) fwd_megakernel(Args a) {
    extern __shared__ __attribute__((aligned(16))) unsigned char lds_raw[];
    LAS unsigned char* L = (LAS unsigned char*)lds_raw;
    volatile LAS unsigned* MISC = (volatile LAS unsigned*)(L + LDS_BYTES - 64);
    if (threadIdx.x < 16) MISC[threadIdx.x] = 0u;
    __syncthreads();
    const XcdBarrier xbar = xcd_barrier_post((unsigned*)(a.ws + WS_CTL), MISC);
    unsigned long long t_dsec = 0;
#if PROBE_TMASK
    unsigned long long t_last = __builtin_amdgcn_s_memrealtime(), t_acc = 0;
#define PT(bit) do { const unsigned long long tn_ = __builtin_amdgcn_s_memrealtime(); if ((PROBE_TMASK >> (bit)) & 1) t_acc += tn_ - t_last; t_last = tn_; } while (0)
#else
#define PT(bit) do {} while (0)
#endif

    REP(PROBE_CONV) { FRESH(); conv_weights<0>(a, L, gw, NGW, wave, lane); }
    { FRESH(); prologue_misc(a, gw, NGW, lane, gtid, NGT); }
    if (a.ws == nullptr) cg::this_grid().sync();
    GSYNC();
        PT(0);

    for (int l = 0; l < 2; ++l) {
        REP(PROBE_GEMM) { FRESH(); run_gemm(L, Xb, D, (const bf16*)(ws + W_GU1), D, M, 2 * DFF, D, G, bid, EpiSwiglu{Z, ssq}); }
        GSYNC();
        PT(1);
#if PROBE_RES
        { FRESH(); run_gemm(L, Z, DFF, (const bf16*)(ws + W_DN1), DFF, M, D, DFF, G, bid, EpiResid{l == 0 ? (const float*)a.in[0] : nullptr, Xb, XLO, XLO, ssq, l == 0 ? 0.5f : 0.0f}); }
        GSYNC();
#endif
        { FRESH(); run_gemm(L, Z, DFF, (const bf16*)(ws + W_DN1), DFF, M, D, DFF, G, bid, EpiResid{l == 0 ? (const float*)a.in[0] : nullptr, Xb, XLO, XLO, ssq, 0.5f}); }
        GSYNC();
        PT(2);
        REP(PROBE_GEMM) { FRESH(); run_gemm(L, Xb, D, (const bf16*)(ws + W_IN), D, M, NATT, D, G, bid, EpiRope{Z, ssq, (const float*)(ws + WS_COS), (const float*)(ws + WS_SIN)}); }
        GSYNC();
        PT(1);
        REP(PROBE_ATT & 1) { FRESH(); dil_attn_phase(L, Z, (const float*)(ws + WS_COS), (const float*)(ws + WS_SIN), (bf16*)(ws + WS_OG), (float*)(ws + WS_LSE), G, (G & 7) ? bid : (bid & 7) * (G >> 3) + (bid >> 3), tid, t_dsec); }
        GSYNC();
        PT(5);
        REP(PROBE_GEMM) { FRESH(); run_gemm(L, Xb, D, (const bf16*)(ws + W_IN) + (size_t)NATT * D, D, M, NH2, D, G, bid, EpiZ{Z, NH2, ssq}); }
        { FRESH(); merge_phase((const bf16*)(ws + WS_OG), (const float*)(ws + WS_LSE), (bf16*)(ws + WS_AO), gtid, NGT); }
        GSYNC();
        PT(1);
#if PROBE_HG & 1
        { FRESH(); hgrn1_phase<true>(L, Z, (const float*)a.in[8], l, (float*)(ws + WS_DEC), (unsigned long long*)(ws + WS_OG), G, bid, tid); }
#endif
        { FRESH(); hgrn1_phase<false>(L, Z, (const float*)a.in[8], l, (float*)(ws + WS_DEC), (unsigned long long*)(ws + WS_OG), G, bid, tid); }
        GSYNC();
        PT(6);
        { FRESH();
#if PROBE_HG & 2
          if (bid < 64) { hgrn2_phase<true>(L, Z, (const float*)(ws + WS_DEC), (unsigned long long*)(ws + WS_OG), bid, tid); __syncthreads(); }
#endif
          if (bid < 64) hgrn2_phase<false>(L, Z, (const float*)(ws + WS_DEC), (unsigned long long*)(ws + WS_OG), bid, tid);
          else if (l == 0) {
            const int G2 = G - 64, c2 = bid - 64;
#pragma unroll
            for (int ll = 0; ll < 2; ++ll) {
                const bf16* memN = (const bf16*)(ws + WS_MEMN) + (size_t)ll * MROWS * D; const bf16* Wkv = (const bf16*)(ws + (ll ? WS_WKV1 : W_KV));
                run_gemm(L, memN, D, Wkv, D, MROWS, D, D, G2, (c2 + 32 * ll) % G2, EpiZ{(bf16*)(ws + (ll ? WS_MEMK1 : WS_MEMK)), D, nullptr});
                run_gemm(L, Wkv + (size_t)D * D, D, memN, D, D, MROWS, D, G2, (c2 + 32 * ll + 16) % G2, EpiZ{(bf16*)(ws + (ll ? WS_MEMVT1 : WS_MEMVT)), MROWS, nullptr});
            }
            conv_weights<1>(a, L, c2 * 8 + wave, G2 * 8, wave, lane);
          } else conv_weights<2>(a, L, (bid - 64) * 8 + wave, (G - 64) * 8, wave, lane);
        }
        GSYNC();
        PT(7);
        { FRESH(); hgrn3_phase(Z, (const unsigned long long*)(ws + WS_OG), (const float*)a.in[9] + (size_t)l * D, gw, NGW, lane); }
        REP(PROBE_GEMM) { FRESH(); run_gemm(L, Xb, D, (const bf16*)(ws + W_IN) + (size_t)(NATT + NH2) * D, D, M, 2048, D, G, bid, EpiZ{Z, NH2, ssq}); }
        GSYNC();
        PT(1);
        { FRESH(); run_gemm(L, (const bf16*)(ws + WS_AO), 512, (const bf16*)(ws + W_AB), 512, M, D, 512, G, bid, EpiGate<false>{Z, NH2, Z + 2048, NH2}); }
        { FRESH(); run_gemm(L, Z + 3072, NH2, (const bf16*)(ws + W_HB), D, M, D, D, G, bid, EpiGate<true>{Z + 1024, NH2, Z + 2048, NH2}); }
        GSYNC();
        PT(3);
#if PROBE_RES
        { FRESH(); run_gemm(L, Z + 2048, NH2, (const bf16*)(ws + W_MO), D, M, D, D, G, bid, EpiResid{nullptr, Xb, XLO, XLO, ssq, 0.0f}); }
        GSYNC();
#endif
        { FRESH(); run_gemm(L, Z + 2048, NH2, (const bf16*)(ws + W_MO), D, M, D, D, G, bid, EpiResid{nullptr, Xb, XLO, XLO, ssq, 1.0f}); }
        GSYNC();
        PT(2);
        REP(PROBE_GEMM) { FRESH(); run_gemm(L, Xb, D, (const bf16*)(ws + W_Q), D, M, D, D, G, bid, EpiZ{Z, D, ssq}); }
        GSYNC();
        PT(4);
        REP((PROBE_ATT >> 1) & 1) { FRESH(); xattn_phase(L, Z, (const bf16*)(ws + (l ? WS_MEMK1 : WS_MEMK)), (const bf16*)(ws + (l ? WS_MEMVT1 : WS_MEMVT)), Z + (size_t)M * D, G, (G & 7) ? bid : (bid & 7) * (G >> 3) + (bid >> 3), tid, t_dsec); }
        GSYNC();
        PT(9);
#if PROBE_RES
        { FRESH(); run_gemm(L, Z + (size_t)M * D, D, (const bf16*)(ws + W_O), D, M, D, D, G, bid, EpiResid{nullptr, Xb, XLO, XLO, ssq, 0.0f}); }
        GSYNC();
#endif
        { FRESH(); run_gemm(L, Z + (size_t)M * D, D, (const bf16*)(ws + W_O), D, M, D, D, G, bid, EpiResid{nullptr, Xb, XLO, XLO, ssq, 1.0f}); }
        GSYNC();
        PT(2);
        REP(PROBE_GEMM) { FRESH(); run_gemm(L, Xb, D, (const bf16*)(ws + W_GU2), D, M, 2 * DFF, D, G, bid, EpiSwiglu{Z, ssq}); }
        GSYNC();
        PT(1);
#if PROBE_RES
        { FRESH(); run_gemm(L, Z, DFF, (const bf16*)(ws + W_DN2), DFF, M, D, DFF, G, bid, EpiResid{nullptr, Xb, XLO, XLO, ssq, 0.0f}); }
        GSYNC();
#endif
        { FRESH(); run_gemm(L, Z, DFF, (const bf16*)(ws + W_DN2), DFF, M, D, DFF, G, bid, EpiResid{nullptr, Xb, XLO, l == 1 ? (bf16*)(ws + WS_OG) : XLO, ssq, 0.5f}); }
        GSYNC();
        PT(2);
    }
    { FRESH();
      const float* fg = (const float*)a.in[21]; const bf16* LO = (const bf16*)(ws + WS_OG);
      for (int m0 = gw; m0 < M; m0 += 2 * NGW) {
        const int m1 = m0 + NGW < M ? m0 + NGW : m0;
        unsigned long long hv[2][4], lv[2][4];
#pragma unroll
        for (int rr = 0; rr < 2; ++rr) { const int m = rr ? m1 : m0;
#pragma unroll
            for (int j = 0; j < 4; ++j) { hv[rr][j] = ((const unsigned long long*)(Xb + (size_t)m * D) + lane)[64 * j]; lv[rr][j] = ((const unsigned long long*)(LO + (size_t)m * D) + lane)[64 * j]; } }
#pragma unroll
        for (int rr = 0; rr < 2; ++rr) { const int m = rr ? m1 : m0;
            f32x4* xr = (f32x4*)(X + (size_t)m * D) + lane; const f32x4* gr = (const f32x4*)fg + lane;
            f32x4 v[4]; float s2 = 0.f;
#pragma unroll
            for (int j = 0; j < 4; ++j) { const unsigned h0 = (unsigned)hv[rr][j], h1 = (unsigned)(hv[rr][j] >> 32), l0 = (unsigned)lv[rr][j], l1 = (unsigned)(lv[rr][j] >> 32);
                v[j] = (f32x4){lo16(h0) + lo16(l0), hi16(h0) + hi16(l0), lo16(h1) + lo16(l1), hi16(h1) + hi16(l1)}; s2 += (v[j][0] * v[j][0] + v[j][1] * v[j][1]) + (v[j][2] * v[j][2] + v[j][3] * v[j][3]); }
            const float rs = __builtin_amdgcn_rsqf(wave_sum(s2) * (1.0f / D) + EPS);
#pragma unroll
            for (int j = 0; j < 4; ++j) xr[64 * j] = v[j] * rs * gr[64 * j]; }
      } }
#if PROBE_TMASK
    { const unsigned long long t0_ = __builtin_amdgcn_s_memrealtime(); while (__builtin_amdgcn_s_memrealtime() - t0_ < t_acc) __builtin_amdgcn_s_sleep(8); }
#endif
#if PROBE_DSEC
    { const unsigned long long t0_ = __builtin_amdgcn_s_memrealtime(); while (__builtin_amdgcn_s_memrealtime() - t0_ < t_dsec) __builtin_amdgcn_s_sleep(8); }
#endif
}

extern "C" void kernel_launch(void* const* d_in, const int* in_sizes, int n_in, void* d_out, int out_size, void* d_ws, size_t ws_size, hipStream_t stream) {
    static int grid = 0;
    if (grid == 0) {
        if (n_in != 22 || out_size != M * D || ws_size < WS_END) { fprintf(stderr, "kernel_launch: unexpected shapes (n_in %d out %d ws %zu)\n", n_in, out_size, ws_size); grid = -1; return; }
        int dev = 0, cus = 0, per_cu = 0;
        hipGetDevice(&dev); hipDeviceGetAttribute(&cus, hipDeviceAttributeMultiprocessorCount, dev);
        hipFuncSetAttribute((const void*)fwd_megakernel, hipFuncAttributeMaxDynamicSharedMemorySize, LDS_BYTES);
        hipOccupancyMaxActiveBlocksPerMultiprocessor(&per_cu, (const void*)fwd_megakernel, 512, LDS_BYTES);
        if (per_cu < 1) { fprintf(stderr, "kernel_launch: occupancy query reports %d blocks per CU\n", per_cu); grid = -1; return; }
        grid = cus;
        if (grid < 128) { fprintf(stderr, "kernel_launch: too few CUs (%d)\n", grid); grid = -1; return; }
    }
    if (grid < 0) return;
    if (hipMemsetAsync((char*)d_ws + WS_CTL, 0, CTL_BYTES, stream) != hipSuccess) { fprintf(stderr, "kernel_launch: memset failed\n"); return; }
    Args a{};
    for (int i = 0; i < 22; ++i) a.in[i] = d_in[i];
    a.out = (float*)d_out; a.ws = (unsigned char*)d_ws;
    void* args[] = {&a};
    hipError_t e = hipLaunchCooperativeKernel((const void*)fwd_megakernel, dim3(grid), dim3(512), args, LDS_BYTES, stream);
    if (e != hipSuccess) fprintf(stderr, "cooperative launch failed: %s (grid %d)\n", hipGetErrorString(e), grid);
}
```

```cpp
#include <hip/hip_runtime.h>
#include <hip/hip_cooperative_groups.h>
#include <cstdio>
#include <cstdint>
namespace cg = cooperative_groups;
namespace pg8 {
#define PG8_LAS __attribute__((address_space(3)))
typedef unsigned short bf16_t;
typedef short bf16x8 __attribute__((ext_vector_type(8)));
typedef float f32x4 __attribute__((ext_vector_type(4)));
typedef unsigned u32x4 __attribute__((ext_vector_type(4)));
constexpr int BM = 256, BK = 64, HALF = 128, HTB = HALF * BK * 2  , STAGE_BYTES = 8 * HTB, NXCD = 8, WGM = 8;

__host__ __device__ __forceinline__ int lds_byte(int r, int c) { const int st = (r >> 4) * 2 + (c >> 5), rr = r & 15, cc = c & 31, ob = rr * 64 + cc * 2; return st * 1024 + (ob ^ (((ob >> 9) & 1) << 5)); }
__host__ __device__ __forceinline__ void stage_rc(int b, int& R, int& C) { const int st = b / 1024, sb = b % 1024, swz = sb ^ (((sb >> 9) & 1) << 5); R = (st >> 1) * 16 + swz / 64; C = (st & 1) * 32 + (swz % 64) / 2; }
__host__ __device__ __forceinline__ int perm32(int rho) { const int n = rho >> 4, i = rho & 15; return 8 * (i >> 2) + 4 * n + (i & 3); }

struct Unit { int pm, pn; };
struct Gemm { const bf16_t* A; const bf16_t* Bt; int M, N, K, lda, ldb; };

struct StaticOrder {
    int nM, nN, nwg, G, c;
    __host__ __device__ void init(int M, int N, int G_, int c_) { nM = M / BM; nN = N / BM; nwg = nM * nN; G = G_; c = c_; }
    __host__ __device__ bool next(int i, Unit& u) const {
        const long L = (long)i * G + c; if (L >= nwg) return false;
        int wgid = (int)L; { const int q = nwg / NXCD, r = nwg % NXCD, xcd = wgid % NXCD, off = wgid / NXCD; wgid = (xcd < r ? xcd * (q + 1) : r * (q + 1) + (xcd - r) * q) + off; }
        const int nig = WGM * nN, gid = wgid / nig, fm = gid * WGM, gsz = (nM - fm) < WGM ? (nM - fm) : WGM;
        u.pm = fm + ((wgid % nig) % gsz); u.pn = (wgid % nig) / gsz; return true;
    }
    __device__ __forceinline__ void a_ready(const Unit&) const {}
    __device__ __forceinline__ void done(const Unit&) const {}
};

template <class Epi, class Sched, bool ALIGN_EPI = false, bool SP2 = false>
__device__ __forceinline__ void gemm_phase(PG8_LAS unsigned char* lds, const Gemm g, const Sched& S, const Epi& E) {
    int tid_ = threadIdx.x; asm volatile("" : "+v"(tid_)); const int tid = tid_, wid = __builtin_amdgcn_readfirstlane(tid >> 6), lane = tid & 63, wr = wid >> 2, wc = wid & 3, fr = lane & 15, fq = lane >> 4;
    const int K = g.K, nt = K / BK;
    unsigned voffA[2], voffB[2];
#pragma unroll
    for (int i = 0; i < 2; ++i) { int R, C; stage_rc(tid * 16 + i * 8192, R, C); const int Rb = Epi::PERM ? ((R & ~31) + perm32(R & 31)) : R;
        voffA[i] = (unsigned)(R * g.lda + C) * 2u; voffB[i] = (unsigned)(Rb * g.ldb + C) * 2u; }
    const size_t kstep = (size_t)(BK * 2);
    const size_t hstepA = (size_t)HALF * g.lda * 2, hstepB = (size_t)HALF * g.ldb * 2;
    const size_t tstepA = 2 * hstepA, tstepB = 2 * hstepB;
    const unsigned ldsw = (unsigned)wid * 1024u;
    const int aoff = lds_byte(wr * 64 + fr, fq * 8), boff = lds_byte(wc * 32 + fr, fq * 8);
#define PG8_SA(b, h) (((b) * 2 + (h)) * HTB)
#define PG8_SB(b, h) ((4 + (b) * 2 + (h)) * HTB)
#define PG8_STAGE(bufoff, gbase, voff) do { _Pragma("unroll") for (int _i = 0; _i < 2; ++_i) \
        __builtin_amdgcn_global_load_lds((const unsigned*)((const char*)(gbase) + (voff)[_i]), (PG8_LAS unsigned*)(lds + (bufoff) + ldsw + _i * 8192), 16, 0, 0); } while (0)
#define PG8_LDA(dst, b, h) do { _Pragma("unroll") for (int m = 0; m < 4; ++m) _Pragma("unroll") for (int k = 0; k < 2; ++k) dst[m][k] = *(const PG8_LAS bf16x8*)(lds + PG8_SA(b, h) + aoff + m * 2048 + k * 1024); } while (0)
#define PG8_LDB(dst, b, h) do { _Pragma("unroll") for (int n = 0; n < 2; ++n) _Pragma("unroll") for (int k = 0; k < 2; ++k) dst[n][k] = *(const PG8_LAS bf16x8*)(lds + PG8_SB(b, h) + boff + n * 2048 + k * 1024); } while (0)
#define PG8_MMA(ai, bj, At, Bt) do { __builtin_amdgcn_s_setprio(1); _Pragma("unroll") for (int m = 0; m < 4; ++m) _Pragma("unroll") for (int n = 0; n < 2; ++n) _Pragma("unroll") for (int k = 0; k < 2; ++k) \
        acc[ai][bj][m][n] = __builtin_amdgcn_mfma_f32_16x16x32_bf16(Bt[n][k], At[m][k], acc[ai][bj][m][n], 0, 0, 0); __builtin_amdgcn_s_setprio(0); } while (0)
#define PG8_WAIT_V(n) asm volatile("s_waitcnt vmcnt(" #n ")" ::: "memory")
#define PG8_WAIT_L(n) asm volatile("s_waitcnt lgkmcnt(" #n ")" ::: "memory")
#define PG8_BAR __builtin_amdgcn_s_barrier()
#define PG8_SCHED __builtin_amdgcn_sched_barrier(0)
    Unit cur, nxt; int ui = 0;
    if (!S.next(0, cur)) return;
    f32x4 acc[2][2][4][2];
#pragma unroll
    for (int a = 0; a < 2; ++a)
#pragma unroll
        for (int b = 0; b < 2; ++b)
#pragma unroll
            for (int m = 0; m < 4; ++m)
#pragma unroll
                for (int n = 0; n < 2; ++n) acc[a][b][m][n] = (f32x4){0.f, 0.f, 0.f, 0.f};
    bf16x8 At[4][2], B0[2][2], B1[2][2];
    const char* cA = (const char*)g.A + (size_t)cur.pm * tstepA; const char* cB = (const char*)g.Bt + (size_t)cur.pn * tstepB;
    S.a_ready(cur);
    if constexpr (SP2) {
        PG8_STAGE(PG8_SB(0, 0), cB, voffB); PG8_STAGE(PG8_SB(0, 1), cB + hstepB, voffB); PG8_STAGE(PG8_SA(0, 0), cA, voffA); PG8_STAGE(PG8_SA(0, 1), cA + hstepA, voffA);
        if (wr == 1) PG8_BAR;
        PG8_WAIT_V(2); PG8_BAR;
        PG8_STAGE(PG8_SB(1, 0), cB + kstep, voffB); PG8_STAGE(PG8_SA(1, 0), cA + kstep, voffA); PG8_STAGE(PG8_SB(1, 1), cB + hstepB + kstep, voffB);
        PG8_WAIT_V(6); PG8_BAR;
    } else {
        PG8_STAGE(PG8_SB(0, 0), cB, voffB); PG8_STAGE(PG8_SA(0, 0), cA, voffA); PG8_STAGE(PG8_SB(0, 1), cB + hstepB, voffB); PG8_STAGE(PG8_SA(0, 1), cA + hstepA, voffA);
        if (wr == 1) PG8_BAR;
        PG8_WAIT_V(4); PG8_BAR;
        PG8_STAGE(PG8_SB(1, 0), cB + kstep, voffB); PG8_STAGE(PG8_SA(1, 0), cA + kstep, voffA); PG8_STAGE(PG8_SB(1, 1), cB + hstepB + kstep, voffB);
        PG8_WAIT_V(6); PG8_BAR;
    }
    for (;;) {
        const bool has_next = S.next(ui + 1, nxt);
        const char* nA = has_next ? (const char*)g.A + (size_t)nxt.pm * tstepA : cA; const char* nB = has_next ? (const char*)g.Bt + (size_t)nxt.pn * tstepB : cB;
        for (int t = 0; t < nt; t += 2) {
            const bool last = (t == nt - 2);
            const char* a1 = cA + (size_t)(t + 1) * kstep;
            const char* a2 = last ? nA : cA + (size_t)(t + 2) * kstep; const char* b2 = last ? nB : cB + (size_t)(t + 2) * kstep;
            const char* a3 = a2 + kstep; const char* b3 = b2 + kstep;
            if (last && has_next) S.a_ready(nxt);
            if constexpr (SP2) {
            PG8_LDB(B0, 0, 0); PG8_LDB(B1, 0, 1); PG8_SCHED; PG8_LDA(At, 0, 0); PG8_STAGE(PG8_SA(1, 1), a1 + hstepA, voffA);
            PG8_WAIT_V(8); PG8_WAIT_L(0); PG8_BAR; PG8_MMA(0, 0, At, B0); PG8_MMA(0, 1, At, B1); PG8_BAR; PG8_SCHED;
            PG8_LDA(At, 0, 1); PG8_STAGE(PG8_SB(0, 0), b2, voffB); PG8_STAGE(PG8_SB(0, 1), b2 + hstepB, voffB); PG8_STAGE(PG8_SA(0, 0), a2, voffA);
            PG8_WAIT_V(8); PG8_WAIT_L(0); PG8_BAR; PG8_MMA(1, 0, At, B0); PG8_MMA(1, 1, At, B1); PG8_BAR; PG8_SCHED;
            PG8_LDB(B0, 1, 0); PG8_LDB(B1, 1, 1); PG8_SCHED; PG8_LDA(At, 1, 0); PG8_STAGE(PG8_SA(0, 1), a2 + hstepA, voffA);
            PG8_WAIT_V(8); PG8_WAIT_L(0); PG8_BAR; PG8_MMA(0, 0, At, B0); PG8_MMA(0, 1, At, B1); PG8_BAR; PG8_SCHED;
            PG8_LDA(At, 1, 1); PG8_STAGE(PG8_SB(1, 0), b3, voffB); PG8_STAGE(PG8_SB(1, 1), b3 + hstepB, voffB); PG8_STAGE(PG8_SA(1, 0), a3, voffA);
            PG8_WAIT_V(8); PG8_WAIT_L(0); PG8_BAR; PG8_MMA(1, 0, At, B0); PG8_MMA(1, 1, At, B1); PG8_BAR; PG8_SCHED;
            } else {
            PG8_LDB(B0, 0, 0); PG8_SCHED; PG8_LDA(At, 0, 0); PG8_STAGE(PG8_SA(1, 1), a1 + hstepA, voffA);
            PG8_WAIT_L(8); PG8_BAR; PG8_WAIT_L(0); PG8_MMA(0, 0, At, B0); PG8_BAR; PG8_SCHED;
            PG8_LDB(B1, 0, 1); PG8_STAGE(PG8_SB(0, 0), b2, voffB);
            PG8_BAR; PG8_WAIT_L(0); PG8_MMA(0, 1, At, B1); PG8_BAR;
            PG8_LDA(At, 0, 1); PG8_STAGE(PG8_SA(0, 0), a2, voffA);
            PG8_BAR; PG8_WAIT_L(0); PG8_MMA(1, 0, At, B0); PG8_BAR; PG8_SCHED;
            PG8_STAGE(PG8_SB(0, 1), b2 + hstepB, voffB);
            PG8_WAIT_V(6); PG8_BAR; PG8_MMA(1, 1, At, B1); PG8_BAR;
            PG8_LDB(B0, 1, 0); PG8_SCHED; PG8_LDA(At, 1, 0); PG8_STAGE(PG8_SA(0, 1), a2 + hstepA, voffA);
            PG8_WAIT_L(8); PG8_BAR; PG8_WAIT_L(0); PG8_MMA(0, 0, At, B0); PG8_BAR; PG8_SCHED;
            PG8_LDB(B1, 1, 1); PG8_STAGE(PG8_SB(1, 0), b3, voffB);
            PG8_BAR; PG8_WAIT_L(0); PG8_MMA(0, 1, At, B1); PG8_BAR;
            PG8_LDA(At, 1, 1); PG8_STAGE(PG8_SA(1, 0), a3, voffA);
            PG8_BAR; PG8_WAIT_L(0); PG8_MMA(1, 0, At, B0); PG8_BAR; PG8_SCHED;
            PG8_STAGE(PG8_SB(1, 1), b3 + hstepB, voffB);
            PG8_WAIT_V(6); PG8_BAR; PG8_MMA(1, 1, At, B1); PG8_BAR;
            }
        }
        if constexpr (ALIGN_EPI) { if (wr == 0) PG8_BAR; }
        if constexpr (!Epi::AFTER_DRAIN) { E(acc, cur, wr, wc, fr, fq); S.done(cur); }
        if (!has_next) break;
#pragma unroll
        for (int a = 0; a < 2; ++a)
#pragma unroll
            for (int b = 0; b < 2; ++b)
#pragma unroll
                for (int m = 0; m < 4; ++m)
#pragma unroll
                    for (int n = 0; n < 2; ++n) acc[a][b][m][n] = (f32x4){0.f, 0.f, 0.f, 0.f};
        cur = nxt; cA = nA; cB = nB; ++ui;
        if constexpr (ALIGN_EPI) { if (wr == 1) PG8_BAR; }
    }
    PG8_WAIT_V(0);
    if constexpr (!ALIGN_EPI) { if (wr == 0) PG8_BAR; }
    PG8_BAR;
    if constexpr (Epi::AFTER_DRAIN) { E.fused(acc, cur, wr, wc, fr, fq, lds, wid, lane); S.done(cur); }
#undef PG8_SA
#undef PG8_SB
#undef PG8_STAGE
#undef PG8_LDA
#undef PG8_LDB
#undef PG8_MMA
#undef PG8_WAIT_V
#undef PG8_WAIT_L
#undef PG8_BAR
#undef PG8_SCHED
}
}

#define DI __device__ __forceinline__
#ifndef PROBE_DSEC
#define PROBE_DSEC 0
#endif
#define LAS __attribute__((address_space(3)))
typedef unsigned short bf16;
typedef short bf16x8 __attribute__((ext_vector_type(8)));
typedef short s16x4 __attribute__((ext_vector_type(4)));
typedef float f32x4 __attribute__((ext_vector_type(4)));
typedef unsigned u32x4 __attribute__((ext_vector_type(4)));
typedef unsigned u32x2 __attribute__((ext_vector_type(2)));
using pg8::Unit;

constexpr int NB = 4, T = 4096, D = 1024, M = NB * T, DFF = 2816, NMEM = 256, MROWS = NB * NMEM;
constexpr int NATT = 4608, NH2 = 4096;
constexpr float EPS = 1e-6f;
constexpr int LDS_BYTES = 147456;

constexpr size_t MiB = 1u << 20;
constexpr size_t W_GU1 = 0, W_DN1 = W_GU1 + (size_t)2 * DFF * D * 2, W_IN = W_DN1 + (size_t)D * DFF * 2, W_AB = W_IN + (size_t)10752 * D * 2,
                 W_HB = W_AB + (size_t)D * 512 * 2, W_MO = W_HB + (size_t)D * D * 2, W_Q = W_MO + (size_t)D * D * 2, W_KV = W_Q + (size_t)D * D * 2,
                 W_O = W_KV + (size_t)2 * D * D * 2, W_GU2 = W_O + (size_t)D * D * 2, W_DN2 = W_GU2 + (size_t)2 * DFF * D * 2, W_END = W_DN2 + (size_t)D * DFF * 2;
static_assert(W_END <= 68 * MiB, "weights");
constexpr size_t WS_XB = 68 * MiB, WS_Z = 100 * MiB, WS_OG = 244 * MiB, WS_AO = 292 * MiB, WS_COS = 308 * MiB, WS_SIN = 312 * MiB, WS_MEMN = 316 * MiB,
                 WS_MEMK = 320 * MiB, WS_MEMVT = 322 * MiB, WS_SSQ = 324 * MiB, WS_DEC = 325 * MiB, WS_LSE = 326 * MiB, WS_CTL = 327 * MiB, CTL_BYTES = 65536, WS_WKV1 = 328 * MiB, WS_MEMK1 = 332 * MiB, WS_MEMVT1 = 334 * MiB, WS_END = 336 * MiB;

DI float bf2f(unsigned short h) { return __uint_as_float((unsigned)h << 16); }
typedef __bf16 bf2_t __attribute__((ext_vector_type(2)));
typedef float f32x2_t __attribute__((ext_vector_type(2)));
DI unsigned pk2(float lo, float hi) { const bf2_t r = __builtin_convertvector((f32x2_t){lo, hi}, bf2_t); return __builtin_bit_cast(unsigned, r); }
DI unsigned f2bf(float f) { return pk2(f, 0.f) & 0xffffu; }
template <int N> DI float rr_add(float v) { return v + __int_as_float(__builtin_amdgcn_update_dpp(0, __float_as_int(v), 0x120 + N, 0xf, 0xf, false)); }
DI float row16_sum(float v) { v = rr_add<1>(v); v = rr_add<2>(v); v = rr_add<4>(v); v = rr_add<8>(v); return v; }
#define LBAR() do { asm volatile("s_waitcnt lgkmcnt(0)" ::: "memory"); __builtin_amdgcn_s_barrier(); asm volatile("" ::: "memory"); } while (0)
DI float lo16(unsigned u) { return __uint_as_float(u << 16); }
DI float hi16(unsigned u) { return __uint_as_float(u & 0xffff0000u); }
DI float wave_sum(float v) {
#pragma unroll
    for (int o = 1; o < 64; o <<= 1) v += __shfl_xor(v, o);
    return v;
}
DI float sigmoidf_(float x) { return __builtin_amdgcn_rcpf(1.0f + __expf(-x)); }
DI bf16x8 mk8(u32x4 v) { return __builtin_bit_cast(bf16x8, v); }
#define MFMA16(a, b, c) __builtin_amdgcn_mfma_f32_16x16x32_bf16((a), (b), (c), 0, 0, 0)

#define EPI_FENCE() asm volatile("" ::: "memory")
DI void rows_rstd(const float* ssq, int row0, int fq, float (&rs)[8]) {
    f32x4 pv[8];
#pragma unroll
    for (int k = 0; k < 8; ++k) pv[k] = *(const f32x4*)(ssq + (size_t)(row0 + (k >> 2) * 128 + (k & 3) * 16) * 16 + 4 * fq);
#pragma unroll
    for (int k = 0; k < 8; ++k) { float t = (pv[k][0] + pv[k][1]) + (pv[k][2] + pv[k][3]); t += __shfl_xor(t, 16); t += __shfl_xor(t, 32); rs[k] = __builtin_amdgcn_rsqf(t * (1.0f / D) + EPS); }
}
struct EpiZ {
    static constexpr bool PERM = true, AFTER_DRAIN = false;
    bf16* O; int ldc; const float* ssq;
    DI void operator()(const f32x4 (&acc)[2][2][4][2], const Unit& u, int wr, int wc, int fr, int fq) const {
        const int row0 = u.pm * 256 + wr * 64 + fr, col0 = u.pn * 256 + wc * 32 + 8 * fq;
        float rs[8];
        if (ssq) rows_rstd(ssq, row0, fq, rs); else {
#pragma unroll
            for (int k = 0; k < 8; ++k) rs[k] = 1.0f; }
        EPI_FENCE();
#pragma unroll
        for (int ai = 0; ai < 2; ++ai)
#pragma unroll
            for (int m = 0; m < 4; ++m) {
                const int row = row0 + ai * 128 + m * 16; const float r1 = rs[ai * 4 + m];
                bf16* rowp = O + (size_t)row * ldc + col0;
#pragma unroll
                for (int bj = 0; bj < 2; ++bj) {
                    const f32x4 v0 = acc[ai][bj][m][0] * r1, v1 = acc[ai][bj][m][1] * r1;
                    u32x4 w; w.x = pk2(v0[0], v0[1]); w.y = pk2(v0[2], v0[3]); w.z = pk2(v1[0], v1[1]); w.w = pk2(v1[2], v1[3]);
                    *(u32x4*)(rowp + bj * 128) = w;
                }
            }
    }
};
struct EpiRope {
    static constexpr bool PERM = true, AFTER_DRAIN = false;
    bf16* O; const float* ssq; const float* cosT; const float* sinT;
    DI void operator()(const f32x4 (&acc)[2][2][4][2], const Unit& u, int wr, int wc, int fr, int fq) const {
        const int row0 = u.pm * 256 + wr * 64 + fr;
        float rs[8]; rows_rstd(ssq, row0, fq, rs);
        if (u.pn < 12) {
            const int i0 = 32 * (wc & 1) + 8 * fq, colb = (2 * u.pn + (wc >> 1)) * 128 + i0;
#pragma unroll
            for (int hb = 0; hb < 4; ++hb) {
                const int ai = hb >> 1, mb = (hb & 1) * 2;
                f32x4 c0[2], c1[2], s0[2], s1[2];
#pragma unroll
                for (int mm = 0; mm < 2; ++mm) { const int row = row0 + ai * 128 + (mb + mm) * 16; const float* cp = cosT + (size_t)row * 64 + i0; const float* sp = sinT + (size_t)row * 64 + i0;
                    c0[mm] = *(const f32x4*)cp; c1[mm] = *(const f32x4*)(cp + 4); s0[mm] = *(const f32x4*)sp; s1[mm] = *(const f32x4*)(sp + 4); }
                EPI_FENCE();
#pragma unroll
                for (int mm = 0; mm < 2; ++mm) { const int m = mb + mm;
                    const int row = row0 + ai * 128 + m * 16; const float r1 = rs[ai * 4 + m];
                    const f32x4 a0 = acc[ai][0][m][0] * r1, a1 = acc[ai][0][m][1] * r1, b0 = acc[ai][1][m][0] * r1, b1 = acc[ai][1][m][1] * r1;
                    const f32x4 y10 = a0 * c0[mm] - b0 * s0[mm], y11 = a1 * c1[mm] - b1 * s1[mm], y20 = b0 * c0[mm] + a0 * s0[mm], y21 = b1 * c1[mm] + a1 * s1[mm];
                    u32x4 w1, w2; w1.x = pk2(y10[0], y10[1]); w1.y = pk2(y10[2], y10[3]); w1.z = pk2(y11[0], y11[1]); w1.w = pk2(y11[2], y11[3]);
                    w2.x = pk2(y20[0], y20[1]); w2.y = pk2(y20[2], y20[3]); w2.z = pk2(y21[0], y21[1]); w2.w = pk2(y21[2], y21[3]);
                    bf16* rowp = O + (size_t)row * NATT + colb; *(u32x4*)rowp = w1; *(u32x4*)(rowp + 64) = w2;
                }
                EPI_FENCE();
            }
        } else {
            const int col0 = u.pn * 256 + wc * 32 + 8 * fq;
            EPI_FENCE();
#pragma unroll
            for (int ai = 0; ai < 2; ++ai)
#pragma unroll
                for (int m = 0; m < 4; ++m) {
                    const int row = row0 + ai * 128 + m * 16; const float r1 = rs[ai * 4 + m]; bf16* rowp = O + (size_t)row * NATT + col0;
#pragma unroll
                    for (int bj = 0; bj < 2; ++bj) { const f32x4 v0 = acc[ai][bj][m][0] * r1, v1 = acc[ai][bj][m][1] * r1;
                        u32x4 w; w.x = pk2(v0[0], v0[1]); w.y = pk2(v0[2], v0[3]); w.z = pk2(v1[0], v1[1]); w.w = pk2(v1[2], v1[3]); *(u32x4*)(rowp + bj * 128) = w; }
                }
        }
    }
};
struct EpiSwiglu {
    static constexpr bool PERM = true, AFTER_DRAIN = false;
    bf16* H; const float* ssq;
    DI void operator()(const f32x4 (&acc)[2][2][4][2], const Unit& u, int wr, int wc, int fr, int fq) const {
        const int row0 = u.pm * 256 + wr * 64 + fr, col0 = u.pn * 128 + wc * 32 + 8 * fq;
        float rs[8]; rows_rstd(ssq, row0, fq, rs);
        EPI_FENCE();
#pragma unroll
        for (int ai = 0; ai < 2; ++ai)
#pragma unroll
            for (int m = 0; m < 4; ++m) {
                const int row = row0 + ai * 128 + m * 16; const float r1 = rs[ai * 4 + m];
                float h[8];
#pragma unroll
                for (int n = 0; n < 2; ++n)
#pragma unroll
                    for (int e = 0; e < 4; ++e) { const float g = acc[ai][0][m][n][e] * r1, up = acc[ai][1][m][n][e] * r1; h[4 * n + e] = g * sigmoidf_(g) * up; }
                u32x4 w; w.x = pk2(h[0], h[1]); w.y = pk2(h[2], h[3]); w.z = pk2(h[4], h[5]); w.w = pk2(h[6], h[7]);
                *(u32x4*)(H + (size_t)row * DFF + col0) = w;
            }
    }
};
struct EpiResid {
    static constexpr bool PERM = false, AFTER_DRAIN = false;
    const float* x32; bf16* hi; const bf16* lo_in; bf16* lo_out; float* ssq; float alpha;
    DI void operator()(const f32x4 (&acc)[2][2][4][2], const Unit& u, int wr, int wc, int fr, int fq) const {
        const int row0 = u.pm * 256 + wr * 64 + fr, col0 = u.pn * 256 + wc * 32 + 4 * fq;
#pragma unroll
        for (int rb = 0; rb < 4; ++rb) {
            const int ai = rb >> 1, mb = (rb & 1) * 2;
            f32x4 xo[8];
            if (x32) {
#pragma unroll
                for (int g = 0; g < 8; ++g) xo[g] = *(const f32x4*)(x32 + (size_t)(row0 + ai * 128 + (mb + (g >> 2)) * 16) * D + col0 + ((g >> 1) & 1) * 128 + (g & 1) * 16);
            } else {
                u32x2 hv[8], lv[8];
#pragma unroll
                for (int g = 0; g < 8; ++g) { const size_t off = (size_t)(row0 + ai * 128 + (mb + (g >> 2)) * 16) * D + col0 + ((g >> 1) & 1) * 128 + (g & 1) * 16; hv[g] = *(const u32x2*)(hi + off); lv[g] = *(const u32x2*)(lo_in + off); }
#pragma unroll
                for (int g = 0; g < 8; ++g) xo[g] = (f32x4){lo16(hv[g].x) + lo16(lv[g].x), hi16(hv[g].x) + hi16(lv[g].x), lo16(hv[g].y) + lo16(lv[g].y), hi16(hv[g].y) + hi16(lv[g].y)};
            }
            EPI_FENCE();
#pragma unroll
            for (int mm = 0; mm < 2; ++mm) { const int m = mb + mm; const int row = row0 + ai * 128 + m * 16; float ss = 0.f;
#pragma unroll
                for (int bj = 0; bj < 2; ++bj)
#pragma unroll
                    for (int n = 0; n < 2; ++n) {
                        const size_t off = (size_t)row * D + col0 + bj * 128 + n * 16;
                        const f32x4 x = xo[mm * 4 + bj * 2 + n] + acc[ai][bj][m][n] * alpha;
                        u32x2 w; w.x = pk2(x[0], x[1]); w.y = pk2(x[2], x[3]); *(u32x2*)(hi + off) = w;
                        u32x2 wl; wl.x = pk2(x[0] - lo16(w.x), x[1] - hi16(w.x)); wl.y = pk2(x[2] - lo16(w.y), x[3] - hi16(w.y)); *(u32x2*)(lo_out + off) = wl;
                        ss += (x[0] * x[0] + x[1] * x[1]) + (x[2] * x[2] + x[3] * x[3]);
                    }
                ss += __shfl_xor(ss, 16); ss += __shfl_xor(ss, 32);
                if (fq == 0) ssq[(size_t)row * 16 + u.pn * 4 + wc] = ss;
            }
            EPI_FENCE();
        }
    }
};
template <bool ADD> struct EpiGate {
    static constexpr bool PERM = true, AFTER_DRAIN = false;
    const bf16* Gt; int ldg; bf16* Mg; int ldm;
    DI void operator()(const f32x4 (&acc)[2][2][4][2], const Unit& u, int wr, int wc, int fr, int fq) const {
        const int row0 = u.pm * 256 + wr * 64 + fr, col0 = u.pn * 256 + wc * 32 + 8 * fq;
#pragma unroll
        for (int ai = 0; ai < 2; ++ai) {
            u32x4 gv[8], pv[8];
#pragma unroll
            for (int k = 0; k < 8; ++k) { const int row = row0 + ai * 128 + (k >> 1) * 16;
                gv[k] = *(const u32x4*)(Gt + (size_t)row * ldg + col0 + (k & 1) * 128);
                pv[k] = (u32x4){0u, 0u, 0u, 0u}; if (ADD) pv[k] = *(const u32x4*)(Mg + (size_t)row * ldm + col0 + (k & 1) * 128); }
            EPI_FENCE();
#pragma unroll
            for (int k = 0; k < 8; ++k) { const int m = k >> 1, bj = k & 1; const int row = row0 + ai * 128 + m * 16;
                float r[8];
#pragma unroll
                for (int q = 0; q < 4; ++q) {
                    const float a0 = acc[ai][bj][m][q >> 1][(q & 1) * 2], a1 = acc[ai][bj][m][q >> 1][(q & 1) * 2 + 1];
                    r[2 * q] = sigmoidf_(lo16(gv[k][q])) * a0 + (ADD ? lo16(pv[k][q]) : 0.f);
                    r[2 * q + 1] = sigmoidf_(hi16(gv[k][q])) * a1 + (ADD ? hi16(pv[k][q]) : 0.f);
                }
                u32x4 w; w.x = pk2(r[0], r[1]); w.y = pk2(r[2], r[3]); w.z = pk2(r[4], r[5]); w.w = pk2(r[6], r[7]);
                *(u32x4*)(Mg + (size_t)row * ldm + col0 + bj * 128) = w;
            }
            EPI_FENCE();
        }
    }
};

template <class Epi>
DI void run_gemm(LAS unsigned char* lds, const bf16* A, int lda, const bf16* Bt, int ldb, int Mr, int N, int K, int G, int c, const Epi& E) {
    pg8::Gemm g{A, Bt, Mr, N, K, lda, ldb}; pg8::StaticOrder S; S.init(Mr, N, G, c);
    pg8::gemm_phase<Epi, pg8::StaticOrder, true, true>(lds, g, S, E);
}

DI void conv_item(const float* W, int K, int Nsrc, int srcoff, int Nout, int GU, const float* gain, bf16* WT, LAS float* scr, int item, int lane) {
    const int nblk = Nout / 64, kb = item / nblk, nb = item % nblk, k0 = 64 * kb, n0 = 64 * nb;
    const int src0 = srcoff + (GU == 1 ? (((n0 & 255) >> 7) * DFF + 128 * (n0 >> 8) + (n0 & 127)) : ((GU == 2 && n0 < 3072) ? (2 * (n0 >> 8) + ((n0 & 127) >> 6)) * 128 + ((n0 & 255) >> 7) * 64 : n0));
    float wv[64];
    const float* wp = W + (size_t)k0 * Nsrc + src0 + lane;
#pragma unroll
    for (int i = 0; i < 64; ++i) wv[i] = __builtin_nontemporal_load(wp + (size_t)i * Nsrc);
    const float g = gain ? gain[k0 + lane] : 1.0f;
#pragma unroll
    for (int i = 0; i < 64; ++i) scr[i * 65 + lane] = wv[i] * __shfl(g, i);
    asm volatile("s_waitcnt lgkmcnt(0)" ::: "memory");
    const int c = lane & 7;
#pragma unroll
    for (int j = 0; j < 8; ++j) { const int n = (lane >> 3) + 8 * j; const LAS float* s = scr + (8 * c) * 65 + n;
        u32x4 o; o.x = pk2(s[0 * 65], s[1 * 65]); o.y = pk2(s[2 * 65], s[3 * 65]); o.z = pk2(s[4 * 65], s[5 * 65]); o.w = pk2(s[6 * 65], s[7 * 65]);
        *(u32x4*)(WT + (size_t)(n0 + n) * K + k0 + 8 * c) = o; }
    asm volatile("s_waitcnt lgkmcnt(0)" ::: "memory");
}

struct Args { const void* in[22]; float* out; unsigned char* ws; };

template <int SET> DI void conv_weights(const Args& a, LAS unsigned char* L, int gw, int NGW, int wave, int lane) {
    LAS float* scr = (LAS float*)(L + wave * 16640);
    unsigned char* ws = a.ws;
    int it = gw;
#define CONV(l_, idx, K_, Ns_, so_, No_, GU_, gidx, dst_) { const float* Wp = (const float*)a.in[idx] + (size_t)(l_) * (K_) * (Ns_); const float* gp = (gidx) >= 0 ? (const float*)a.in[(gidx) >= 0 ? (gidx) : 0] + (size_t)(l_) * (K_) : nullptr; \
        const int nitems = ((K_) / 64) * ((No_) / 64); for (; it < nitems; it += NGW) conv_item(Wp, K_, Ns_, so_, No_, GU_, gp, (bf16*)(ws + (dst_)), scr, it, lane); it -= nitems; }
    if (SET == 0) {
        CONV(0, 4, D, 2 * DFF, 0, 2 * DFF, true, 3, W_GU1)
        CONV(0, 5, DFF, D, 0, D, false, -1, W_DN1)
        CONV(0, 7, D, 10752, 0, 10752, 2, 6, W_IN)
        CONV(0, 10, 512, D, 0, D, false, -1, W_AB)
        CONV(0, 11, D, D, 0, D, false, -1, W_HB)
        CONV(0, 12, D, D, 0, D, false, -1, W_MO)
        CONV(0, 15, D, D, 0, D, false, 13, W_Q)
        CONV(0, 16, D, 2 * D, 0, 2 * D, false, -1, W_KV)
        CONV(1, 16, D, 2 * D, 0, 2 * D, false, -1, WS_WKV1)
        CONV(0, 17, D, D, 0, D, false, -1, W_O)
        CONV(0, 19, D, 2 * DFF, 0, 2 * DFF, true, 18, W_GU2)
        CONV(0, 20, DFF, D, 0, D, false, -1, W_DN2)
    } else if (SET == 1) {
        CONV(1, 4, D, 2 * DFF, 0, 2 * DFF, true, 3, W_GU1)
        CONV(1, 5, DFF, D, 0, D, false, -1, W_DN1)
        CONV(1, 7, D, 10752, 0, 8704, 2, 6, W_IN)
    } else {
        CONV(1, 7, D, 10752, 8704, 2048, false, 6, W_IN + (size_t)8704 * D * 2)
        CONV(1, 10, 512, D, 0, D, false, -1, W_AB)
        CONV(1, 11, D, D, 0, D, false, -1, W_HB)
        CONV(1, 12, D, D, 0, D, false, -1, W_MO)
        CONV(1, 15, D, D, 0, D, false, 13, W_Q)
        CONV(1, 17, D, D, 0, D, false, -1, W_O)
        CONV(1, 19, D, 2 * DFF, 0, 2 * DFF, true, 18, W_GU2)
        CONV(1, 20, DFF, D, 0, D, false, -1, W_DN2)
    }
#undef CONV
}

DI void prologue_misc(const Args& a, int gw, int NGW, int lane, int gtid, int NGT) {
    unsigned char* ws = a.ws;
    const float* x = (const float*)a.in[0];
    bf16* Xb = (bf16*)(ws + WS_XB); float* ssq = (float*)(ws + WS_SSQ);
    for (int m0 = gw; m0 < M; m0 += 2 * NGW) {
        const int m1 = m0 + NGW < M ? m0 + NGW : m0;
        f32x4 va[4], vb[4];
#pragma unroll
        for (int j = 0; j < 4; ++j) { va[j] = ((const f32x4*)(x + (size_t)m0 * D) + lane)[64 * j]; vb[j] = ((const f32x4*)(x + (size_t)m1 * D) + lane)[64 * j]; }
#pragma unroll
        for (int rr = 0; rr < 2; ++rr) { const int m = rr ? m1 : m0; float s2 = 0.f;
            unsigned long long* o8 = (unsigned long long*)(Xb + (size_t)m * D) + lane;
#pragma unroll
            for (int j = 0; j < 4; ++j) { const f32x4 v = rr ? vb[j] : va[j]; s2 += (v[0] * v[0] + v[1] * v[1]) + (v[2] * v[2] + v[3] * v[3]);
                o8[64 * j] = (unsigned long long)pk2(v[0], v[1]) | ((unsigned long long)pk2(v[2], v[3]) << 32); }
            s2 = wave_sum(s2);
            if (lane < 16) ssq[(size_t)m * 16 + lane] = lane == 0 ? s2 : 0.f; }
    }
    const float* mem = (const float*)a.in[1]; const float* mnorm = (const float*)a.in[14]; bf16* memN = (bf16*)(ws + WS_MEMN);
    for (int r = gw; r < 2 * MROWS; r += NGW) {
        const int l = r / MROWS, m = r % MROWS;
        const f32x4* xr = (const f32x4*)(mem + (size_t)m * D) + lane; const f32x4* gr = (const f32x4*)(mnorm + (size_t)l * D) + lane;
        f32x4 v[4]; float s = 0.f;
#pragma unroll
        for (int j = 0; j < 4; ++j) { v[j] = xr[64 * j]; s += (v[j][0] * v[j][0] + v[j][1] * v[j][1]) + (v[j][2] * v[j][2] + v[j][3] * v[j][3]); }
        const float rs = 1.0f / sqrtf(wave_sum(s) * (1.0f / D) + EPS);
        unsigned long long* o8 = (unsigned long long*)(memN + (size_t)r * D) + lane;
#pragma unroll
        for (int j = 0; j < 4; ++j) { const f32x4 g = gr[64 * j]; const f32x4 y = v[j] * rs * g;
            o8[64 * j] = (unsigned long long)pk2(y[0], y[1]) | ((unsigned long long)pk2(y[2], y[3]) << 32); }
    }
    const int* pos = (const int*)a.in[2]; float* cosT = (float*)(ws + WS_COS); float* sinT = (float*)(ws + WS_SIN);
    for (int idx = gtid; idx < M * 64; idx += NGT) {
        const int row = idx >> 6, i = idx & 63;
        const float inv = exp2f(-(float)(2 * i) * (1.0f / 128.0f) * 13.287712379549449f);
        const float ang = (float)pos[row] * inv;
        double rv = (double)ang * 0.15915494309189535; rv -= floor(rv);
        const float fr = (float)rv;
        cosT[idx] = __builtin_amdgcn_cosf(fr); sinT[idx] = __builtin_amdgcn_sinf(fr);
    }
}

DI void rope8(u32x4 x1, u32x4 x2, const float* cp, const float* sp, u32x4& o1, u32x4& o2) {
    const f32x4 c0 = *(const f32x4*)cp, c1 = *(const f32x4*)(cp + 4), s0 = *(const f32x4*)sp, s1 = *(const f32x4*)(sp + 4);
#pragma unroll
    for (int q = 0; q < 4; ++q) {
        const float ca = q < 2 ? c0[2 * q] : c1[2 * q - 4], cb = q < 2 ? c0[2 * q + 1] : c1[2 * q - 3];
        const float sa = q < 2 ? s0[2 * q] : s1[2 * q - 4], sb = q < 2 ? s0[2 * q + 1] : s1[2 * q - 3];
        const float a0 = lo16(x1[q]), a1 = hi16(x1[q]), b0 = lo16(x2[q]), b1 = hi16(x2[q]);
        o1[q] = pk2(a0 * ca - b0 * sa, a1 * cb - b1 * sb);
        o2[q] = pk2(b0 * ca + a0 * sa, b1 * cb + a1 * sb);
    }
}
constexpr int KSTR = 272, VSTR = 528, KL_BYTES = 256 * KSTR;
DI unsigned vt_off(int dh, int kgrp) { return (unsigned)(dh * VSTR + ((kgrp ^ ((dh >> 3) & 7)) << 3)); }

DI void dil_attn_phase(LAS unsigned char* L, const bf16* Z, const float* cosT, const float* sinT, bf16* OG, float* LSE, int G, int bid, int tid, unsigned long long& tsec) {
#define DSEC(k) do { if (PROBE_DSEC) { const unsigned long long tn_ = __builtin_amdgcn_s_memrealtime(); if (PROBE_DSEC == (k)) tsec += tn_ - tl_; tl_ = tn_; } } while (0)
    unsigned long long tl_ = PROBE_DSEC ? __builtin_amdgcn_s_memrealtime() : 0;
    const int wid = __builtin_amdgcn_readfirstlane(tid >> 6), lane = tid & 63, fr = lane & 15, fq = lane >> 4;
    LAS unsigned char* KL = L; LAS unsigned char* VL = L + KL_BYTES;
    u32x4 kreg[8], vreg[8];
#define DIL_LOAD(uu_) do { const int j_ = (uu_) & 31, h_ = ((uu_) >> 5) & 3, gb_ = (uu_) >> 7, g_ = gb_ % 3, b_ = gb_ / 3, dsh_ = 2 * g_, Ls_ = T >> dsh_, p0_ = 128 * j_, r_ = p0_ / Ls_, u0_ = p0_ & (Ls_ - 1); \
        const int tb_ = b_ * T + r_, cq_ = g_ * 512 + h_ * 128; \
        _Pragma("unroll") for (int i = 0; i < 8; ++i) { const int p = tid + 512 * i, kk = p >> 4, cb = p & 15; int uu = u0_ - 128 + kk; uu = uu < 0 ? 0 : uu; \
            const bf16* rp_ = Z + (size_t)(tb_ + (uu << dsh_)) * NATT + cq_ + 8 * cb; kreg[i] = *(const u32x4*)(rp_ + 1536); vreg[i] = *(const u32x4*)(rp_ + 3072); } \
        } while (0)
    if (bid < 1536) DIL_LOAD(bid);
    for (int unit = bid; unit < 1536; unit += G) {
        const int j = unit & 31, h = (unit >> 5) & 3, gb = unit >> 7, g = gb % 3, b = gb / 3;
        const int dsh = 2 * g, Lseg = T >> dsh;
        const int p0 = 128 * j, r = p0 / Lseg, u0 = p0 & (Lseg - 1);
        const int tokbase = b * T + r;
        const int colq = g * 512 + h * 128;
        asm volatile("" : "+v"(kreg[0]), "+v"(kreg[1]), "+v"(kreg[2]), "+v"(kreg[3]), "+v"(kreg[4]), "+v"(kreg[5]), "+v"(kreg[6]), "+v"(kreg[7]));
        asm volatile("" : "+v"(vreg[0]), "+v"(vreg[1]), "+v"(vreg[2]), "+v"(vreg[3]), "+v"(vreg[4]), "+v"(vreg[5]), "+v"(vreg[6]), "+v"(vreg[7]));
        const int qi = 16 * wid + fr; const size_t tq = (size_t)(tokbase + ((u0 + qi) << dsh));
        bf16x8 qf[4];
#pragma unroll
        for (int k4 = 0; k4 < 4; ++k4) qf[k4] = *(const bf16x8*)(Z + tq * NATT + colq + 32 * k4 + 8 * fq);
        __syncthreads();
        DSEC(6);
#pragma unroll
        for (int i = 0; i < 8; ++i) {
            const int p = tid + 512 * i, kk = p >> 4, cb = p & 15; const bool ok = u0 - 128 + kk >= 0;
            const u32x4 zz = (u32x4){0u, 0u, 0u, 0u}; const u32x4 kx = ok ? kreg[i] : zz, x = ok ? vreg[i] : zz;
            *(LAS u32x4*)(KL + kk * KSTR + 16 * cb) = kx;
            const unsigned base = (unsigned)((((kk >> 2) ^ (cb & 7)) << 3) + (kk & 3) * 2);
#pragma unroll
            for (int jj = 0; jj < 8; ++jj) *(LAS unsigned short*)(VL + (8 * cb + jj) * VSTR + base) = (unsigned short)(x[jj >> 1] >> (16 * (jj & 1)));
        }
        DSEC(1);
        { const int nu = unit + G < 1536 ? unit + G : unit; DIL_LOAD(nu); }
        DSEC(2);
        __syncthreads();
        DSEC(3);
        const int tw = wid & ~1;
        f32x4 s[10];
#pragma unroll
        for (int tix = 0; tix < 10; ++tix) s[tix] = (f32x4){0.f, 0.f, 0.f, 0.f};
#pragma unroll
        for (int k4 = 0; k4 < 4; ++k4)
#pragma unroll
            for (int t5 = 0; t5 < 2; ++t5) { bf16x8 av[5];
#pragma unroll
                for (int tix = 0; tix < 5; ++tix) av[tix] = *(const LAS bf16x8*)(KL + (16 * (tw + 5 * t5 + tix) + fr) * KSTR + (32 * k4 + 8 * fq) * 2);
#pragma unroll
                for (int tix = 0; tix < 5; ++tix) s[5 * t5 + tix] = MFMA16(av[tix], qf[k4], s[5 * t5 + tix]); }
        DSEC(4);
        const float scale = 0.08838834764831845f; float mx = -INFINITY;
#pragma unroll
        for (int tix = 0; tix < 10; ++tix)
#pragma unroll
            for (int e = 0; e < 4; ++e) { const int kk = 16 * (tw + tix) + 4 * fq + e; const bool ok = (kk >= qi) && (kk <= qi + 128) && (u0 - 128 + kk >= 0);
                const float v = ok ? s[tix][e] * scale : -INFINITY; s[tix][e] = v; mx = fmaxf(mx, v); }
        mx = fmaxf(mx, __shfl_xor(mx, 16)); mx = fmaxf(mx, __shfl_xor(mx, 32));
        float den = 0.f;
#pragma unroll
        for (int tix = 0; tix < 10; ++tix)
#pragma unroll
            for (int e = 0; e < 4; ++e) { const float p = __expf(s[tix][e] - mx); s[tix][e] = p; den += p; }
        den += __shfl_xor(den, 16); den += __shfl_xor(den, 32);
        DSEC(5);
        bf16x8 pf[5];
#pragma unroll
        for (int pp = 0; pp < 5; ++pp) { u32x4 pw; pw.x = pk2(s[2 * pp][0], s[2 * pp][1]); pw.y = pk2(s[2 * pp][2], s[2 * pp][3]); pw.z = pk2(s[2 * pp + 1][0], s[2 * pp + 1][1]); pw.w = pk2(s[2 * pp + 1][2], s[2 * pp + 1][3]); pf[pp] = mk8(pw); }
        f32x4 o[8];
#pragma unroll
        for (int dt = 0; dt < 8; ++dt) o[dt] = (f32x4){0.f, 0.f, 0.f, 0.f};
        const unsigned x0 = (unsigned)(fq ^ (fr >> 3));
        const LAS unsigned char* vev = L + KL_BYTES + fr * VSTR + 32 * tw + (x0 << 3); const LAS unsigned char* vod = L + KL_BYTES + fr * VSTR + 32 * tw + ((x0 ^ 2u) << 3);
#pragma unroll
        for (int pp = 0; pp < 5; ++pp)
#pragma unroll
            for (int d4 = 0; d4 < 2; ++d4) { bf16x8 vf[4];
#pragma unroll
                for (int dq = 0; dq < 4; ++dq) { const int dt = 4 * d4 + dq; const LAS unsigned char* vb_ = ((dt & 1) ? vod : vev) + 16 * dt * VSTR + 64 * pp;
                    const s16x4 lo = *(const LAS s16x4*)(vb_ + (((2 * dt) & 4) << 3)), hi = *(const LAS s16x4*)(vb_ + ((((2 * dt) & 4) ^ 4) << 3)); vf[dq] = __builtin_shufflevector(lo, hi, 0, 1, 2, 3, 4, 5, 6, 7); }
#pragma unroll
                for (int dq = 0; dq < 4; ++dq) o[4 * d4 + dq] = MFMA16(vf[dq], pf[pp], o[4 * d4 + dq]);
            }
        const float inv = __builtin_amdgcn_rcpf(den), lse = mx + __logf(den);
        { bf16* op = OG + tq * 1536 + colq + 4 * fq;
#pragma unroll
          for (int dt = 0; dt < 8; ++dt) *(unsigned long long*)(op + 16 * dt) = (unsigned long long)pk2(o[dt][0] * inv, o[dt][1] * inv) | ((unsigned long long)pk2(o[dt][2] * inv, o[dt][3] * inv) << 32); }
        if (lane < 16) LSE[tq * 12 + g * 4 + h] = lse;
    }
#undef DIL_LOAD
}

DI void merge_phase(const bf16* OG, const float* LSE, bf16* AO, int gtid, int NGT) {
    for (int idx0 = gtid; idx0 < M * 64; idx0 += 4 * NGT) {
        u32x4 xa[4], xb[4], xd[4]; float l0[4], l1[4], l2[4]; bf16* op[4];
#pragma unroll
        for (int u = 0; u < 4; ++u) { const int idx = idx0 + u * NGT; const bool ok = idx < M * 64; const int tok = ok ? idx >> 6 : 0, h = (idx >> 4) & 3, c = idx & 15;
            l0[u] = LSE[(size_t)tok * 12 + h]; l1[u] = LSE[(size_t)tok * 12 + 4 + h]; l2[u] = LSE[(size_t)tok * 12 + 8 + h];
            const bf16* p = OG + (size_t)tok * 1536 + h * 128 + 8 * c; xa[u] = *(const u32x4*)p; xb[u] = *(const u32x4*)(p + 512); xd[u] = *(const u32x4*)(p + 1024);
            op[u] = ok ? AO + (size_t)tok * 512 + h * 128 + 8 * c : nullptr; }
#pragma unroll
        for (int u = 0; u < 4; ++u) {
            const float mx = fmaxf(l0[u], fmaxf(l1[u], l2[u])); float w0 = __expf(l0[u] - mx), w1 = __expf(l1[u] - mx), w2 = __expf(l2[u] - mx); const float inv = __builtin_amdgcn_rcpf(w0 + w1 + w2); w0 *= inv; w1 *= inv; w2 *= inv;
            u32x4 o;
#pragma unroll
            for (int q = 0; q < 4; ++q) o[q] = pk2(w0 * lo16(xa[u][q]) + w1 * lo16(xb[u][q]) + w2 * lo16(xd[u][q]), w0 * hi16(xa[u][q]) + w1 * hi16(xb[u][q]) + w2 * hi16(xd[u][q]));
            if (op[u]) *(u32x4*)op[u] = o;
        }
    }
}

#define XK_LOAD(R, b_, h_, hh_) do { _Pragma("unroll") for (int i = 0; i < 8; ++i) { const int p = tid + 512 * i, m = p >> 4, cb = p & 15; R[i] = *(const u32x4*)(memK + (size_t)((b_) * NMEM + m) * D + (h_) * 256 + 128 * (hh_) + 8 * cb); } } while (0)
#define XK_WRITE(R) do { _Pragma("unroll") for (int i = 0; i < 8; ++i) { const int p = tid + 512 * i, m = p >> 4, cb = p & 15; *(LAS u32x4*)(KL + m * KSTR + 16 * cb) = R[i]; } } while (0)
#define XV_LOAD(R, b_, h_, hh_) do { _Pragma("unroll") for (int i = 0; i < 8; ++i) { const int p = tid + 512 * i, dhr = p >> 5, c = p & 31; R[i] = *(const u32x4*)(memVT + (size_t)((h_) * 256 + 128 * (hh_) + dhr) * MROWS + (b_) * NMEM + 8 * c); } } while (0)
#define XV_WRITE(R) do { _Pragma("unroll") for (int i = 0; i < 8; ++i) { const int p = tid + 512 * i, dhr = p >> 5, c = p & 31; u32x2 lo, hi; lo.x = R[i].x; lo.y = R[i].y; hi.x = R[i].z; hi.y = R[i].w; \
        *(LAS u32x2*)(VL + vt_off(dhr, 2 * c)) = lo; *(LAS u32x2*)(VL + vt_off(dhr, 2 * c + 1)) = hi; } } while (0)
DI void xattn_phase(LAS unsigned char* L, const bf16* Qx, const bf16* memK, const bf16* memVT, bf16* Ox, int G, int bid, int tid, unsigned long long& tsec) {
    unsigned long long tl_ = PROBE_DSEC ? __builtin_amdgcn_s_memrealtime() : 0;
    const int wid = __builtin_amdgcn_readfirstlane(tid >> 6), lane = tid & 63, fr = lane & 15, fq = lane >> 4;
    LAS unsigned char* KL = L; LAS unsigned char* VL = L + KL_BYTES;
    u32x4 ra[8], rb[8];
    if (bid < 512) { const int h0 = (bid >> 5) & 3, b0 = bid >> 7; XK_LOAD(ra, b0, h0, 0); XV_LOAD(rb, b0, h0, 0); }
    for (int unit = bid; unit < 512; unit += G) {
        const int j = unit & 31, h = (unit >> 5) & 3, b = unit >> 7;
        const int nun = unit + G < 512 ? unit + G : unit, hn = (nun >> 5) & 3, bn = nun >> 7;
        asm volatile("" : "+v"(ra[0]), "+v"(ra[1]), "+v"(ra[2]), "+v"(ra[3]), "+v"(ra[4]), "+v"(ra[5]), "+v"(ra[6]), "+v"(ra[7]));
        asm volatile("" : "+v"(rb[0]), "+v"(rb[1]), "+v"(rb[2]), "+v"(rb[3]), "+v"(rb[4]), "+v"(rb[5]), "+v"(rb[6]), "+v"(rb[7]));
        const int tok0 = b * T + 128 * j; const size_t tq = (size_t)(tok0 + 16 * wid + fr);
        f32x4 s[16];
#pragma unroll
        for (int kt = 0; kt < 16; ++kt) s[kt] = (f32x4){0.f, 0.f, 0.f, 0.f};
#pragma unroll
        for (int hh = 0; hh < 2; ++hh) {
            __syncthreads();
            XK_WRITE(ra);
            if (hh == 0) { XV_WRITE(rb); XK_LOAD(ra, b, h, 1); XV_LOAD(rb, b, h, 1); }
            else XK_LOAD(ra, bn, hn, 0);
            __syncthreads();
            DSEC(11);
#pragma unroll
            for (int k4 = 0; k4 < 4; ++k4) { const bf16x8 qk = *(const bf16x8*)(Qx + tq * D + h * 256 + 128 * hh + 32 * k4 + 8 * fq);
#pragma unroll
                for (int k8 = 0; k8 < 4; ++k8) { bf16x8 av[4];
#pragma unroll
                    for (int kt = 0; kt < 4; ++kt) av[kt] = *(const LAS bf16x8*)(KL + (16 * (4 * k8 + kt) + fr) * KSTR + (32 * k4 + 8 * fq) * 2);
#pragma unroll
                    for (int kt = 0; kt < 4; ++kt) s[4 * k8 + kt] = MFMA16(av[kt], qk, s[4 * k8 + kt]); } }
        }
        DSEC(12);
        float mx = -INFINITY;
#pragma unroll
        for (int kt = 0; kt < 16; ++kt)
#pragma unroll
            for (int e = 0; e < 4; ++e) { const float v = s[kt][e] * 0.0625f; s[kt][e] = v; mx = fmaxf(mx, v); }
        mx = fmaxf(mx, __shfl_xor(mx, 16)); mx = fmaxf(mx, __shfl_xor(mx, 32));
        float den = 0.f;
#pragma unroll
        for (int kt = 0; kt < 16; ++kt)
#pragma unroll
            for (int e = 0; e < 4; ++e) { const float p = __expf(s[kt][e] - mx); s[kt][e] = p; den += p; }
        den += __shfl_xor(den, 16); den += __shfl_xor(den, 32);
        DSEC(13);
        bf16x8 pf[8];
#pragma unroll
        for (int pp = 0; pp < 8; ++pp) { u32x4 pw; pw.x = pk2(s[2 * pp][0], s[2 * pp][1]); pw.y = pk2(s[2 * pp][2], s[2 * pp][3]); pw.z = pk2(s[2 * pp + 1][0], s[2 * pp + 1][1]); pw.w = pk2(s[2 * pp + 1][2], s[2 * pp + 1][3]); pf[pp] = mk8(pw); }
        const float inv = __builtin_amdgcn_rcpf(den);
#pragma unroll
        for (int hh = 0; hh < 2; ++hh) {
            if (hh == 1) { DSEC(14); __syncthreads(); XV_WRITE(rb); XV_LOAD(rb, bn, hn, 0); __syncthreads(); DSEC(15); }
            f32x4 o[8];
#pragma unroll
            for (int dt = 0; dt < 8; ++dt) o[dt] = (f32x4){0.f, 0.f, 0.f, 0.f};
            const unsigned x0 = (unsigned)(fq ^ (fr >> 3));
            const LAS unsigned char* vev = L + KL_BYTES + fr * VSTR + (x0 << 3); const LAS unsigned char* vod = L + KL_BYTES + fr * VSTR + ((x0 ^ 2u) << 3);
#pragma unroll
            for (int pp = 0; pp < 8; ++pp)
#pragma unroll
                for (int d4 = 0; d4 < 2; ++d4) { bf16x8 vf[4];
#pragma unroll
                    for (int dq = 0; dq < 4; ++dq) { const int dt = 4 * d4 + dq; const LAS unsigned char* vb_ = ((dt & 1) ? vod : vev) + 16 * dt * VSTR + 64 * pp;
                        const s16x4 lo = *(const LAS s16x4*)(vb_ + (((2 * dt) & 4) << 3)), hi = *(const LAS s16x4*)(vb_ + ((((2 * dt) & 4) ^ 4) << 3)); vf[dq] = __builtin_shufflevector(lo, hi, 0, 1, 2, 3, 4, 5, 6, 7); }
#pragma unroll
                    for (int dq = 0; dq < 4; ++dq) o[4 * d4 + dq] = MFMA16(vf[dq], pf[pp], o[4 * d4 + dq]);
                }
            { bf16* op = Ox + tq * D + h * 256 + 128 * hh + 4 * fq;
#pragma unroll
              for (int dt = 0; dt < 8; ++dt) *(unsigned long long*)(op + 16 * dt) = (unsigned long long)pk2(o[dt][0] * inv, o[dt][1] * inv) | ((unsigned long long)pk2(o[dt][2] * inv, o[dt][3] * inv) << 32); }
        }
        DSEC(14);
    }
}
#undef XK_LOAD
#undef XK_WRITE
#undef XV_LOAD
#undef XV_WRITE

constexpr int H1_QA = 0, H1_KA = 64 * 272, H1_VT = 2 * 64 * 272, H1_TOT = H1_VT + 128 * 144;
template <bool DRY> DI void hgrn1_phase(LAS unsigned char* L, bf16* Z2, const float* lbraw, int layer, float* DEC, unsigned long long* OI, int G, int bid, int tid) {
    const int wid = __builtin_amdgcn_readfirstlane(tid >> 6), lane = tid & 63, fr = lane & 15, fq = lane >> 4;
    const int n = tid & 127, rg = tid >> 7, tt = wid & 3, vh = wid >> 2;
    LAS float* TOT = (LAS float*)(L + H1_TOT);
    unsigned short rq[16], rf[16], rv[16];
#define H1_RAW(uu, RQ, RF, RV) do { const int c_ = (uu) & 63, h_ = ((uu) >> 6) & 7, b_ = (uu) >> 9; const bf16* p_ = Z2 + (size_t)(b_ * T + 64 * c_ + 16 * rg) * NH2 + h_ * 128 + n; \
        _Pragma("unroll") for (int r = 0; r < 16; ++r) { RQ[r] = p_[(size_t)r * NH2]; RF[r] = p_[(size_t)r * NH2 + 1024]; RV[r] = p_[(size_t)r * NH2 + 2048]; } } while (0)
    if (bid < 2048) H1_RAW(bid, rq, rf, rv);
    for (int unit = bid; unit < 2048; unit += G) {
        const int c = unit & 63, h = (unit >> 6) & 7, b = unit >> 9, tok0 = b * T + 64 * c, ch = h * 128 + n;
        float lbv = 0.f;
        if (layer > 0) { const float e0 = lbraw[ch], e1 = lbraw[D + ch]; lbv = 1.0f / (1.0f + expf(e0 - e1)); }
        asm volatile("" : "+v"(rq[0]), "+v"(rq[1]), "+v"(rq[2]), "+v"(rq[3]), "+v"(rq[4]), "+v"(rq[5]), "+v"(rq[6]), "+v"(rq[7]), "+v"(rq[8]), "+v"(rq[9]), "+v"(rq[10]), "+v"(rq[11]), "+v"(rq[12]), "+v"(rq[13]), "+v"(rq[14]), "+v"(rq[15]));
        asm volatile("" : "+v"(rf[0]), "+v"(rf[1]), "+v"(rf[2]), "+v"(rf[3]), "+v"(rf[4]), "+v"(rf[5]), "+v"(rf[6]), "+v"(rf[7]), "+v"(rf[8]), "+v"(rf[9]), "+v"(rf[10]), "+v"(rf[11]), "+v"(rf[12]), "+v"(rf[13]), "+v"(rf[14]), "+v"(rf[15]));
        asm volatile("" : "+v"(rv[0]), "+v"(rv[1]), "+v"(rv[2]), "+v"(rv[3]), "+v"(rv[4]), "+v"(rv[5]), "+v"(rv[6]), "+v"(rv[7]), "+v"(rv[8]), "+v"(rv[9]), "+v"(rv[10]), "+v"(rv[11]), "+v"(rv[12]), "+v"(rv[13]), "+v"(rv[14]), "+v"(rv[15]));
        float q[16], cs[16], kg[16]; unsigned short vr[16];
        bf16* base = Z2 + (size_t)(tok0 + 16 * rg) * NH2 + ch;
#pragma unroll
        for (int r = 0; r < 16; ++r) { q[r] = bf2f(rq[r]); cs[r] = bf2f(rf[r]); vr[r] = rv[r]; }
        unsigned short nq[16], nf[16], nv[16];
        { const int nu = unit + G < 2048 ? unit + G : unit; H1_RAW(nu, nq, nf, nv); }
        float run = 0.f;
#pragma unroll
        for (int r = 0; r < 16; ++r) { const float fl = cs[r]; const float sg = __builtin_amdgcn_rcpf(1.0f + __expf(-fl)); const float f = lbv + (1.0f - lbv) * sg;
            kg[r] = (1.0f - lbv) * (1.0f - sg); run += __logf(f); cs[r] = run; }
        TOT[rg * 128 + n] = run;
        __syncthreads();
        const float t0 = TOT[n], t1 = TOT[128 + n], t2 = TOT[256 + n], t3 = TOT[384 + n];
        const float off = rg == 0 ? 0.f : (rg == 1 ? t0 : (rg == 2 ? t0 + t1 : t0 + t1 + t2));
        const float bmid = t0 + t1, blast = (t0 + t1) + (t2 + t3);
        const float qscale = 0.08838834764831845f;
        float kh[16];
#pragma unroll
        for (int r = 0; r < 16; ++r) { const float bt = off + cs[r]; const float qs = q[r] * qscale; const int row = 16 * rg + r;
            if (!DRY) base[(size_t)r * NH2] = (bf16)f2bf(qs * __expf(bt));
            *(LAS unsigned short*)(L + H1_QA + row * 272 + n * 2) = (unsigned short)f2bf(qs * __expf(bt - bmid));
            *(LAS unsigned short*)(L + H1_KA + row * 272 + n * 2) = (unsigned short)f2bf(kg[r] * __expf(bmid - bt));
            kh[r] = kg[r] * __expf(blast - bt); }
        u32x4 k0, k1, v0, v1;
#pragma unroll
        for (int qd = 0; qd < 4; ++qd) { k0[qd] = pk2(kh[2 * qd], kh[2 * qd + 1]); k1[qd] = pk2(kh[8 + 2 * qd], kh[9 + 2 * qd]);
            v0[qd] = (unsigned)vr[2 * qd] | ((unsigned)vr[2 * qd + 1] << 16); v1[qd] = (unsigned)vr[8 + 2 * qd] | ((unsigned)vr[9 + 2 * qd] << 16); }
        bf16* slot = Z2 + (size_t)(tok0 + (n >> 1)) * NH2 + h * 128 + (n & 1) * 64 + 16 * rg;
        if (!DRY) { *(u32x4*)(slot + 1024) = k0; *(u32x4*)(slot + 1024 + 8) = k1;
        *(u32x4*)(slot + 2048) = v0; *(u32x4*)(slot + 2048 + 8) = v1; }
        *(LAS u32x4*)(L + H1_VT + n * 144 + 32 * rg) = v0; *(LAS u32x4*)(L + H1_VT + n * 144 + 32 * rg + 16) = v1;
        if (!DRY && rg == 0) DEC[(size_t)unit * 128 + n] = __expf(blast);
        __syncthreads();
        bf16x8 bq[4];
#pragma unroll
        for (int k4 = 0; k4 < 4; ++k4) bq[k4] = *(const LAS bf16x8*)(L + H1_QA + (16 * tt + fr) * 272 + (32 * k4 + 8 * fq) * 2);
        f32x4 at[4];
#pragma unroll
        for (int st = 0; st < 4; ++st) { at[st] = (f32x4){0.f, 0.f, 0.f, 0.f};
            if (st <= tt) {
#pragma unroll
                for (int k4 = 0; k4 < 4; ++k4) { const bf16x8 av = *(const LAS bf16x8*)(L + H1_KA + (16 * st + fr) * 272 + (32 * k4 + 8 * fq) * 2); at[st] = MFMA16(av, bq[k4], at[st]); }
                if (st == tt) {
#pragma unroll
                    for (int e = 0; e < 4; ++e) if (4 * fq + e > fr) at[st][e] = 0.f; }
            } }
        bf16x8 pf[2];
#pragma unroll
        for (int pp = 0; pp < 2; ++pp) { u32x4 pw; pw.x = pk2(at[2 * pp][0], at[2 * pp][1]); pw.y = pk2(at[2 * pp][2], at[2 * pp][3]); pw.z = pk2(at[2 * pp + 1][0], at[2 * pp + 1][1]); pw.w = pk2(at[2 * pp + 1][2], at[2 * pp + 1][3]); pf[pp] = mk8(pw); }
#pragma unroll
        for (int vi = 0; vi < 4; ++vi) { const int vt = 4 * vh + vi; f32x4 o = (f32x4){0.f, 0.f, 0.f, 0.f};
#pragma unroll
            for (int pp = 0; pp < 2; ++pp) { const LAS unsigned char* vp = L + H1_VT + (16 * vt + fr) * 144 + (32 * pp + 4 * fq) * 2;
                const s16x4 lo = *(const LAS s16x4*)vp, hi = *(const LAS s16x4*)(vp + 32);
                const bf16x8 vb = __builtin_shufflevector(lo, hi, 0, 1, 2, 3, 4, 5, 6, 7); o = MFMA16(vb, pf[pp], o); }
            if (!DRY) OI[((size_t)(unit * 4 + tt) * 8 + vt) * 64 + lane] = (unsigned long long)pk2(o[0], o[1]) | ((unsigned long long)pk2(o[2], o[3]) << 32);
            }
#pragma unroll
        for (int r = 0; r < 16; ++r) { rq[r] = nq[r]; rf[r] = nf[r]; rv[r] = nv[r]; }
    }
#undef H1_RAW
}

constexpr int H2_BUF = 36352, H2_KHT = 17408, H2_DEC = 35840;
template <bool DRY> DI void hgrn2_phase(LAS unsigned char* L, bf16* Z2, const float* DEC, unsigned long long* OIW, int bh2, int tid) {
    const unsigned long long* OI = OIW;
    const int wv = __builtin_amdgcn_readfirstlane(tid >> 6), lane = tid & 63, fr = lane & 15, fq = lane >> 4;
    const int bh = bh2 >> 1, w = 4 * (bh2 & 1) + (wv & 3); const bool cw = wv < 4;
    const int b = bh >> 3, h = bh & 7, unit0 = bh * 64, vcol = 16 * w + fr;
    u32x4 sqA[2], skA[2]; f32x4 sdA = (f32x4){0.f, 0.f, 0.f, 0.f};
#define H2_LOAD(cc, sq, sk, sd) do { const int tok0_ = b * T + 64 * (cc); _Pragma("unroll") for (int i = 0; i < 2; ++i) { const int p = tid + 512 * i, row = p >> 4, cb = p & 15; \
        const bf16* rp = Z2 + (size_t)(tok0_ + row) * NH2 + h * 128 + 8 * cb; sq[i] = *(const u32x4*)rp; sk[i] = *(const u32x4*)(rp + 1024); } \
        if (tid < 32) sd = *(const f32x4*)(DEC + (size_t)(unit0 + (cc)) * 128 + 4 * tid); } while (0)
#define H2_WRITE(bi, sq, sk, sd) do { LAS unsigned char* B_ = L + (bi) * H2_BUF; _Pragma("unroll") for (int i = 0; i < 2; ++i) { const int p = tid + 512 * i, row = p >> 4, cb = p & 15; \
        *(LAS u32x4*)(B_ + row * 272 + 16 * cb) = sq[i]; *(LAS u32x4*)(B_ + H2_KHT + (2 * row + (cb >> 3)) * 144 + 16 * (cb & 7)) = sk[i]; } \
        if (tid < 32) *(LAS f32x4*)(B_ + H2_DEC + 16 * tid) = sd; } while (0)
#define H2_PRIV(cc, VT_, OI_) do { const int tok0_ = b * T + 64 * (cc); \
        const bf16* vp_ = Z2 + (size_t)(tok0_ + (vcol >> 1)) * NH2 + 2048 + h * 128 + (vcol & 1) * 64 + 8 * fq; VT_[0] = *(const u32x4*)vp_; VT_[1] = *(const u32x4*)(vp_ + 32); \
        _Pragma("unroll") for (int tt_ = 0; tt_ < 4; ++tt_) OI_[tt_] = OI[((size_t)((unit0 + (cc)) * 4 + tt_) * 8 + w) * 64 + lane]; } while (0)
    u32x4 vtf[2] = {(u32x4){0u, 0u, 0u, 0u}, (u32x4){0u, 0u, 0u, 0u}}; unsigned long long oi[4] = {0ull, 0ull, 0ull, 0ull};
    u32x4 nvt[2] = {(u32x4){0u, 0u, 0u, 0u}, (u32x4){0u, 0u, 0u, 0u}}; unsigned long long noi[4] = {0ull, 0ull, 0ull, 0ull};
    H2_LOAD(0, sqA, skA, sdA); H2_WRITE(0, sqA, skA, sdA); if (cw) H2_PRIV(0, vtf, oi);
    H2_LOAD(1, sqA, skA, sdA); if (cw) H2_PRIV(1, nvt, noi);
    f32x4 S[8];
#pragma unroll
    for (int nt = 0; nt < 8; ++nt) S[nt] = (f32x4){0.f, 0.f, 0.f, 0.f};
    __syncthreads();
    for (int c = 0; c < 64; ++c) {
        LAS unsigned char* Bc = L + (c & 1) * H2_BUF;
        asm volatile("" : "+v"(vtf[0]), "+v"(vtf[1]), "+v"(oi[0]), "+v"(oi[1]), "+v"(oi[2]), "+v"(oi[3]), "+v"(nvt[0]), "+v"(nvt[1]), "+v"(noi[0]), "+v"(noi[1]), "+v"(noi[2]), "+v"(noi[3]));
        asm volatile("" : "+v"(sqA[0]), "+v"(sqA[1]), "+v"(skA[0]), "+v"(skA[1]), "+v"(sdA));
        u32x4 sqB[2], skB[2]; f32x4 sdB = (f32x4){0.f, 0.f, 0.f, 0.f}; u32x4 nnvt[2] = {(u32x4){0u, 0u, 0u, 0u}, (u32x4){0u, 0u, 0u, 0u}}; unsigned long long nnoi[4] = {0ull, 0ull, 0ull, 0ull};
        const int c2 = c + 2 < 64 ? c + 2 : 63;
        H2_LOAD(c2, sqB, skB, sdB); if (cw) H2_PRIV(c2, nnvt, nnoi);
        if (cw) {
        bf16x8 qa[4][4];
#pragma unroll
        for (int tt = 0; tt < 4; ++tt)
#pragma unroll
            for (int np = 0; np < 4; ++np) { const LAS unsigned char* qp = Bc + (16 * tt + fr) * 272 + (32 * np + 4 * fq) * 2;
                const s16x4 lo = *(const LAS s16x4*)qp, hi = *(const LAS s16x4*)(qp + 32); qa[tt][np] = __builtin_shufflevector(lo, hi, 0, 1, 2, 3, 4, 5, 6, 7); }
        bf16x8 sb[4];
#pragma unroll
        for (int np = 0; np < 4; ++np) { u32x4 pw; pw.x = pk2(S[2 * np][0], S[2 * np][1]); pw.y = pk2(S[2 * np][2], S[2 * np][3]); pw.z = pk2(S[2 * np + 1][0], S[2 * np + 1][1]); pw.w = pk2(S[2 * np + 1][2], S[2 * np + 1][3]); sb[np] = mk8(pw); }
        f32x4 o[4];
#pragma unroll
        for (int tt = 0; tt < 4; ++tt) { const unsigned lo = (unsigned)oi[tt], hi = (unsigned)(oi[tt] >> 32); o[tt] = (f32x4){lo16(lo), hi16(lo), lo16(hi), hi16(hi)}; }
#pragma unroll
        for (int np = 0; np < 4; ++np)
#pragma unroll
            for (int tt = 0; tt < 4; ++tt) o[tt] = MFMA16(sb[np], qa[tt][np], o[tt]);
        if (!DRY) {
#pragma unroll
            for (int tt = 0; tt < 4; ++tt) OIW[((size_t)((unit0 + c) * 4 + tt) * 8 + w) * 64 + lane] = (unsigned long long)pk2(o[tt][0], o[tt][1]) | ((unsigned long long)pk2(o[tt][2], o[tt][3]) << 32);
        } else { asm volatile("" :: "v"(o[0]), "v"(o[1]), "v"(o[2]), "v"(o[3])); }
        bf16x8 ka[8][2];
#pragma unroll
        for (int nt = 0; nt < 8; ++nt)
#pragma unroll
            for (int ks = 0; ks < 2; ++ks) ka[nt][ks] = *(const LAS bf16x8*)(Bc + H2_KHT + (16 * nt + fr) * 144 + (32 * ks + 8 * fq) * 2);
#pragma unroll
        for (int nt = 0; nt < 8; ++nt) { const f32x4 dv = *(const LAS f32x4*)(Bc + H2_DEC + (16 * nt + 4 * fq) * 4); S[nt] = S[nt] * dv; }
#pragma unroll
        for (int ks = 0; ks < 2; ++ks)
#pragma unroll
            for (int nt = 0; nt < 8; ++nt) S[nt] = MFMA16(ka[nt][ks], mk8(vtf[ks]), S[nt]);
        }
        if (c + 1 < 64) H2_WRITE((c + 1) & 1, sqA, skA, sdA);
        vtf[0] = nvt[0]; vtf[1] = nvt[1]; nvt[0] = nnvt[0]; nvt[1] = nnvt[1];
#pragma unroll
        for (int i = 0; i < 4; ++i) { oi[i] = noi[i]; noi[i] = nnoi[i]; }
        sqA[0] = sqB[0]; sqA[1] = sqB[1]; skA[0] = skB[0]; skA[1] = skB[1]; sdA = sdB;
        LBAR();
    }
#undef H2_LOAD
#undef H2_WRITE
#undef H2_PRIV
}
DI void hgrn3_phase(bf16* Z2, const unsigned long long* OI, const float* gain, int gw, int NGW, int lane) {
    const int fr = lane & 15, fq = lane >> 4;
    for (int it = gw; it < 2048 * 4; it += NGW) {
        const int unit = it >> 2, tt = it & 3, c = unit & 63, h = (unit >> 6) & 7, b = unit >> 9;
        bf16* gp = Z2 + (size_t)(b * T + 64 * c + 16 * tt + fr) * NH2 + 3072 + h * 128 + 4 * fq;
        unsigned long long ov[8], gv[8];
#pragma unroll
        for (int vt = 0; vt < 8; ++vt) { ov[vt] = OI[((size_t)(unit * 4 + tt) * 8 + vt) * 64 + lane]; gv[vt] = *(const unsigned long long*)(gp + 16 * vt); }
        float ss = 0.f;
#pragma unroll
        for (int vt = 0; vt < 8; ++vt) { const unsigned lo = (unsigned)ov[vt], hi = (unsigned)(ov[vt] >> 32); ss += (lo16(lo) * lo16(lo) + hi16(lo) * hi16(lo)) + (lo16(hi) * lo16(hi) + hi16(hi) * hi16(hi)); }
        ss += __shfl_xor(ss, 16); ss += __shfl_xor(ss, 32);
        const float rstd = __builtin_amdgcn_rsqf(ss * (1.0f / 128.0f) + EPS);
#pragma unroll
        for (int vt = 0; vt < 8; ++vt) { const f32x4 g4 = *(const f32x4*)(gain + h * 128 + 16 * vt + 4 * fq);
            const unsigned lo = (unsigned)ov[vt], hi = (unsigned)(ov[vt] >> 32), glo = (unsigned)gv[vt], ghi = (unsigned)(gv[vt] >> 32);
            const float of[4] = {lo16(lo), hi16(lo), lo16(hi), hi16(hi)}, gf[4] = {lo16(glo), hi16(glo), lo16(ghi), hi16(ghi)}; float r[4];
#pragma unroll
            for (int e = 0; e < 4; ++e) r[e] = of[e] * rstd * g4[e] * (gf[e] * __builtin_amdgcn_rcpf(1.0f + __expf(-gf[e])));
            *(unsigned long long*)(gp + 16 * vt) = (unsigned long long)pk2(r[0], r[1]) | ((unsigned long long)pk2(r[2], r[3]) << 32); }
    }
}

#define XB_TMO      128
#define XB_XCNT(j)  (256  + 64 * (j))
#define XB_XSUB(j)  (1280 + 64 * (j))
#define XB_XGEN(j)  (2304 + 64 * (j))
#define XB_TOP      3328
#define XB_TOPGEN   3392
#define XCD_BAR_WORDS 3456
#define XB_SPIN_CAP (1u << 18)

__device__ __forceinline__ unsigned xb_ld(unsigned* p)              { return __hip_atomic_load(p, __ATOMIC_RELAXED, __HIP_MEMORY_SCOPE_AGENT); }
__device__ __forceinline__ unsigned xb_add(unsigned* p, unsigned v) { return __hip_atomic_fetch_add(p, v, __ATOMIC_RELAXED, __HIP_MEMORY_SCOPE_AGENT); }
__device__ __forceinline__ unsigned xb_xcc_id() { return (unsigned)__builtin_amdgcn_s_getreg((3 << 11) | 20) & 0xFu; }
#define XB_SPIN(cond, bar) do { unsigned _sp = 0; while (cond) { __builtin_amdgcn_s_sleep(1); \
    if ((++_sp & 255u) == 0u) { if (xb_ld(&(bar)[XB_TMO])) break; if (_sp > XB_SPIN_CAP) { atomicAdd(&(bar)[XB_TMO], 1u); break; } } } } while (0)

struct XcdBarrier {
    unsigned* bar; unsigned x;
    volatile LAS unsigned* st;
};

__device__ __forceinline__ XcdBarrier xcd_barrier_post(unsigned* bar, volatile LAS unsigned* st) {
    XcdBarrier b; b.bar = bar; b.x = xb_xcc_id(); b.st = st;
    if (threadIdx.x == 0) (void)xb_add(&bar[XB_XCNT(b.x)], 1u);
    return b;
}
__device__ __forceinline__ void xcd_barrier_complete(unsigned* bar, unsigned x, unsigned& nloc, unsigned& nx) {
    const unsigned G = gridDim.x * gridDim.y * gridDim.z;
    unsigned sum, cnt, mine, sp = 0u;
    for (;;) {
        sum = 0u; cnt = 0u; mine = 0u;
#pragma unroll
        for (unsigned j = 0; j < 16; ++j) { const unsigned c = xb_ld(&bar[XB_XCNT(j)]); sum += c; cnt += (c > 0u) ? 1u : 0u; mine = (j == x) ? c : mine; }
        if (sum == G) break;
        __builtin_amdgcn_s_sleep(1);
        if ((++sp & 255u) == 0u) { if (xb_ld(&bar[XB_TMO])) break; if (sp > XB_SPIN_CAP) { atomicAdd(&bar[XB_TMO], 1u); break; } }
    }
    nloc = mine > 0u ? mine : 1u; nx = cnt > 0u ? cnt : 1u;
}

__device__ __forceinline__ void xcd_barrier(const XcdBarrier& b) {
    asm volatile("s_waitcnt vmcnt(0)" ::: "memory");
    __syncthreads();
    if (threadIdx.x == 0) {
        unsigned* bar = b.bar;
        __builtin_amdgcn_s_waitcnt(0);
        unsigned nloc = b.st[0], nx = b.st[1];
        if (nloc == 0u) { xcd_barrier_complete(bar, b.x, nloc, nx); b.st[0] = nloc; b.st[1] = nx; }
        const unsigned old = xb_add(&bar[XB_XSUB(b.x)], 1u);
        const unsigned gen = old / nloc;
        if (old + 1u == (gen + 1u) * nloc) {
            __builtin_amdgcn_fence(__ATOMIC_RELEASE, "agent");
            asm volatile("s_waitcnt vmcnt(0)" ::: "memory");
            const unsigned og = xb_add(&bar[XB_TOP], 1u);
            const unsigned tg = og / nx;
            if (og + 1u == (tg + 1u) * nx) xb_add(&bar[XB_TOPGEN], 1u);
            else XB_SPIN(xb_ld(&bar[XB_TOPGEN]) == tg, bar);
            __builtin_amdgcn_fence(__ATOMIC_ACQUIRE, "agent");
            xb_add(&bar[XB_XGEN(b.x)], 1u);
            asm volatile("s_waitcnt vmcnt(0)" ::: "memory");
        } else {
            XB_SPIN(xb_ld(&bar[XB_XGEN(b.x)]) == gen, bar);
            __builtin_amdgcn_fence(__ATOMIC_ACQUIRE, "agent");
            asm volatile("s_waitcnt vmcnt(0)" ::: "memory");
        }
    }
    __syncthreads();
}

#ifndef PROBE_SYNC
#define PROBE_SYNC 0
#endif
#ifndef PROBE_ATT
#define PROBE_ATT 0
#endif
#ifndef PROBE_GEMM
#define PROBE_GEMM 0
#endif
#ifndef PROBE_HG
#define PROBE_HG 0
#endif
#ifndef PROBE_RES
#define PROBE_RES 0
#endif
#ifndef PROBE_TMASK
#define PROBE_TMASK 0
#endif
#ifndef PROBE_CONV
#define PROBE_CONV 0
#endif
#define GSYNC() do { xcd_barrier(xbar); if (PROBE_SYNC) xcd_barrier(xbar); } while (0)
#define REP(n) for (int rep_ = 0; rep_ < 1 + (n); ++rep_)
#define FRESH() size_t zoff_ = 0; asm volatile("" : "+s"(zoff_)); unsigned char* ws = a.ws + zoff_; int tid = threadIdx.x; asm volatile("" : "+v"(tid)); \
    const int lane = tid & 63, wave = __builtin_amdgcn_readfirstlane(tid >> 6); int G = gridDim.x, bid = blockIdx.x; asm volatile("" : "+s"(G), "+s"(bid)); \
    const int gw = bid * 8 + wave, NGW = G * 8, gtid = bid * 512 + tid, NGT = G * 512; float* X = (float*)((unsigned char*)a.out + zoff_); bf16* XLO = (bf16*)X; (void)XLO; \
    bf16* Xb = (bf16*)(ws + WS_XB); float* ssq = (float*)(ws + WS_SSQ); bf16* Z = (bf16*)(ws + WS_Z); \
    (void)lane; (void)gw; (void)NGW; (void)gtid; (void)NGT; (void)Xb; (void)ssq; (void)Z; (void)X;

__global__ void __launch_bounds__(512, 2) fwd_megakernel(Args a) {
    extern __shared__ __attribute__((aligned(16))) unsigned char lds_raw[];
    LAS unsigned char* L = (LAS unsigned char*)lds_raw;
    volatile LAS unsigned* MISC = (volatile LAS unsigned*)(L + LDS_BYTES - 64);
    if (threadIdx.x < 16) MISC[threadIdx.x] = 0u;
    __syncthreads();
    const XcdBarrier xbar = xcd_barrier_post((unsigned*)(a.ws + WS_CTL), MISC);
    unsigned long long t_dsec = 0;
#if PROBE_TMASK
    unsigned long long t_last = __builtin_amdgcn_s_memrealtime(), t_acc = 0;
#define PT(bit) do { const unsigned long long tn_ = __builtin_amdgcn_s_memrealtime(); if ((PROBE_TMASK >> (bit)) & 1) t_acc += tn_ - t_last; t_last = tn_; } while (0)
#else
#define PT(bit) do {} while (0)
#endif

    REP(PROBE_CONV) { FRESH(); conv_weights<0>(a, L, gw, NGW, wave, lane); }
    { FRESH(); prologue_misc(a, gw, NGW, lane, gtid, NGT); }
    if (a.ws == nullptr) cg::this_grid().sync();
    GSYNC();
        PT(0);

    for (int l = 0; l < 2; ++l) {
        REP(PROBE_GEMM) { FRESH(); run_gemm(L, Xb, D, (const bf16*)(ws + W_GU1), D, M, 2 * DFF, D, G, bid, EpiSwiglu{Z, ssq}); }
        GSYNC();
        PT(1);
#if PROBE_RES
        { FRESH(); run_gemm(L, Z, DFF, (const bf16*)(ws + W_DN1), DFF, M, D, DFF, G, bid, EpiResid{l == 0 ? (const float*)a.in[0] : nullptr, Xb, XLO, XLO, ssq, l == 0 ? 0.5f : 0.0f}); }
        GSYNC();
#endif
        { FRESH(); run_gemm(L, Z, DFF, (const bf16*)(ws + W_DN1), DFF, M, D, DFF, G, bid, EpiResid{l == 0 ? (const float*)a.in[0] : nullptr, Xb, XLO, XLO, ssq, 0.5f}); }
        GSYNC();
        PT(2);
        REP(PROBE_GEMM) { FRESH(); run_gemm(L, Xb, D, (const bf16*)(ws + W_IN), D, M, NATT, D, G, bid, EpiRope{Z, ssq, (const float*)(ws + WS_COS), (const float*)(ws + WS_SIN)}); }
        GSYNC();
        PT(1);
        REP(PROBE_ATT & 1) { FRESH(); dil_attn_phase(L, Z, (const float*)(ws + WS_COS), (const float*)(ws + WS_SIN), (bf16*)(ws + WS_OG), (float*)(ws + WS_LSE), G, (G & 7) ? bid : (bid & 7) * (G >> 3) + (bid >> 3), tid, t_dsec); }
        GSYNC();
        PT(5);
        REP(PROBE_GEMM) { FRESH(); run_gemm(L, Xb, D, (const bf16*)(ws + W_IN) + (size_t)NATT * D, D, M, NH2, D, G, bid, EpiZ{Z, NH2, ssq}); }
        { FRESH(); merge_phase((const bf16*)(ws + WS_OG), (const float*)(ws + WS_LSE), (bf16*)(ws + WS_AO), gtid, NGT); }
        GSYNC();
        PT(1);
#if PROBE_HG & 1
        { FRESH(); hgrn1_phase<true>(L, Z, (const float*)a.in[8], l, (float*)(ws + WS_DEC), (unsigned long long*)(ws + WS_OG), G, bid, tid); }
#endif
        { FRESH(); hgrn1_phase<false>(L, Z, (const float*)a.in[8], l, (float*)(ws + WS_DEC), (unsigned long long*)(ws + WS_OG), G, bid, tid); }
        GSYNC();
        PT(6);
        { FRESH();
#if PROBE_HG & 2
          if (bid < 64) { hgrn2_phase<true>(L, Z, (const float*)(ws + WS_DEC), (unsigned long long*)(ws + WS_OG), bid, tid); __syncthreads(); }
#endif
          if (bid < 64) hgrn2_phase<false>(L, Z, (const float*)(ws + WS_DEC), (unsigned long long*)(ws + WS_OG), bid, tid);
          else if (l == 0) {
            const int G2 = G - 64, c2 = bid - 64;
#pragma unroll
            for (int ll = 0; ll < 2; ++ll) {
                const bf16* memN = (const bf16*)(ws + WS_MEMN) + (size_t)ll * MROWS * D; const bf16* Wkv = (const bf16*)(ws + (ll ? WS_WKV1 : W_KV));
                run_gemm(L, memN, D, Wkv, D, MROWS, D, D, G2, (c2 + 32 * ll) % G2, EpiZ{(bf16*)(ws + (ll ? WS_MEMK1 : WS_MEMK)), D, nullptr});
                run_gemm(L, Wkv + (size_t)D * D, D, memN, D, D, MROWS, D, G2, (c2 + 32 * ll + 16) % G2, EpiZ{(bf16*)(ws + (ll ? WS_MEMVT1 : WS_MEMVT)), MROWS, nullptr});
            }
            conv_weights<1>(a, L, c2 * 8 + wave, G2 * 8, wave, lane);
          } else conv_weights<2>(a, L, (bid - 64) * 8 + wave, (G - 64) * 8, wave, lane);
        }
        GSYNC();
        PT(7);
        { FRESH(); hgrn3_phase(Z, (const unsigned long long*)(ws + WS_OG), (const float*)a.in[9] + (size_t)l * D, gw, NGW, lane); }
        REP(PROBE_GEMM) { FRESH(); run_gemm(L, Xb, D, (const bf16*)(ws + W_IN) + (size_t)(NATT + NH2) * D, D, M, 2048, D, G, bid, EpiZ{Z, NH2, ssq}); }
        GSYNC();
        PT(1);
        { FRESH(); run_gemm(L, (const bf16*)(ws + WS_AO), 512, (const bf16*)(ws + W_AB), 512, M, D, 512, G, bid, EpiGate<false>{Z, NH2, Z + 2048, NH2}); }
        { FRESH(); run_gemm(L, Z + 3072, NH2, (const bf16*)(ws + W_HB), D, M, D, D, G, bid, EpiGate<true>{Z + 1024, NH2, Z + 2048, NH2}); }
        GSYNC();
        PT(3);
#if PROBE_RES
        { FRESH(); run_gemm(L, Z + 2048, NH2, (const bf16*)(ws + W_MO), D, M, D, D, G, bid, EpiResid{nullptr, Xb, XLO, XLO, ssq, 0.0f}); }
        GSYNC();
#endif
        { FRESH(); run_gemm(L, Z + 2048, NH2, (const bf16*)(ws + W_MO), D, M, D, D, G, bid, EpiResid{nullptr, Xb, XLO, XLO, ssq, 1.0f}); }
        GSYNC();
        PT(2);
        REP(PROBE_GEMM) { FRESH(); run_gemm(L, Xb, D, (const bf16*)(ws + W_Q), D, M, D, D, G, bid, EpiZ{Z, D, ssq}); }
        GSYNC();
        PT(4);
        REP((PROBE_ATT >> 1) & 1) { FRESH(); xattn_phase(L, Z, (const bf16*)(ws + (l ? WS_MEMK1 : WS_MEMK)), (const bf16*)(ws + (l ? WS_MEMVT1 : WS_MEMVT)), Z + (size_t)M * D, G, (G & 7) ? bid : (bid & 7) * (G >> 3) + (bid >> 3), tid, t_dsec); }
        GSYNC();
        PT(9);
#if PROBE_RES
        { FRESH(); run_gemm(L, Z + (size_t)M * D, D, (const bf16*)(ws + W_O), D, M, D, D, G, bid, EpiResid{nullptr, Xb, XLO, XLO, ssq, 0.0f}); }
        GSYNC();
#endif
        { FRESH(); run_gemm(L, Z + (size_t)M * D, D, (const bf16*)(ws + W_O), D, M, D, D, G, bid, EpiResid{nullptr, Xb, XLO, XLO, ssq, 1.0f}); }
        GSYNC();
        PT(2);
        REP(PROBE_GEMM) { FRESH(); run_gemm(L, Xb, D, (const bf16*)(ws + W_GU2), D, M, 2 * DFF, D, G, bid, EpiSwiglu{Z, ssq}); }
        GSYNC();
        PT(1);
#if PROBE_RES
        { FRESH(); run_gemm(L, Z, DFF, (const bf16*)(ws + W_DN2), DFF, M, D, DFF, G, bid, EpiResid{nullptr, Xb, XLO, XLO, ssq, 0.0f}); }
        GSYNC();
#endif
        { FRESH(); run_gemm(L, Z, DFF, (const bf16*)(ws + W_DN2), DFF, M, D, DFF, G, bid, EpiResid{nullptr, Xb, XLO, l == 1 ? (bf16*)(ws + WS_OG) : XLO, ssq, 0.5f}); }
        GSYNC();
        PT(2);
    }
    { FRESH();
      const float* fg = (const float*)a.in[21]; const bf16* LO = (const bf16*)(ws + WS_OG);
      for (int m0 = gw; m0 < M; m0 += 2 * NGW) {
        const int m1 = m0 + NGW < M ? m0 + NGW : m0;
        unsigned long long hv[2][4], lv[2][4];
#pragma unroll
        for (int rr = 0; rr < 2; ++rr) { const int m = rr ? m1 : m0;
#pragma unroll
            for (int j = 0; j < 4; ++j) { hv[rr][j] = ((const unsigned long long*)(Xb + (size_t)m * D) + lane)[64 * j]; lv[rr][j] = ((const unsigned long long*)(LO + (size_t)m * D) + lane)[64 * j]; } }
#pragma unroll
        for (int rr = 0; rr < 2; ++rr) { const int m = rr ? m1 : m0;
            f32x4* xr = (f32x4*)(X + (size_t)m * D) + lane; const f32x4* gr = (const f32x4*)fg + lane;
            f32x4 v[4]; float s2 = 0.f;
#pragma unroll
            for (int j = 0; j < 4; ++j) { const unsigned h0 = (unsigned)hv[rr][j], h1 = (unsigned)(hv[rr][j] >> 32), l0 = (unsigned)lv[rr][j], l1 = (unsigned)(lv[rr][j] >> 32);
                v[j] = (f32x4){lo16(h0) + lo16(l0), hi16(h0) + hi16(l0), lo16(h1) + lo16(l1), hi16(h1) + hi16(l1)}; s2 += (v[j][0] * v[j][0] + v[j][1] * v[j][1]) + (v[j][2] * v[j][2] + v[j][3] * v[j][3]); }
            const float rs = __builtin_amdgcn_rsqf(wave_sum(s2) * (1.0f / D) + EPS);
#pragma unroll
            for (int j = 0; j < 4; ++j) xr[64 * j] = v[j] * rs * gr[64 * j]; }
      } }
#if PROBE_TMASK
    { const unsigned long long t0_ = __builtin_amdgcn_s_memrealtime(); while (__builtin_amdgcn_s_memrealtime() - t0_ < t_acc) __builtin_amdgcn_s_sleep(8); }
#endif
#if PROBE_DSEC
    { const unsigned long long t0_ = __builtin_amdgcn_s_memrealtime(); while (__builtin_amdgcn_s_memrealtime() - t0_ < t_dsec) __builtin_amdgcn_s_sleep(8); }
#endif
}

extern "C" void kernel_launch(void* const* d_in, const int* in_sizes, int n_in, void* d_out, int out_size, void* d_ws, size_t ws_size, hipStream_t stream) {
    static int grid = 0;
    if (grid == 0) {
        if (n_in != 22 || out_size != M * D || ws_size < WS_END) { fprintf(stderr, "kernel_launch: unexpected shapes (n_in %d out %d ws %zu)\n", n_in, out_size, ws_size); grid = -1; return; }
        int dev = 0, cus = 0, per_cu = 0;
        hipGetDevice(&dev); hipDeviceGetAttribute(&cus, hipDeviceAttributeMultiprocessorCount, dev);
        hipFuncSetAttribute((const void*)fwd_megakernel, hipFuncAttributeMaxDynamicSharedMemorySize, LDS_BYTES);
        hipOccupancyMaxActiveBlocksPerMultiprocessor(&per_cu, (const void*)fwd_megakernel, 512, LDS_BYTES);
        if (per_cu < 1) { fprintf(stderr, "kernel_launch: occupancy query reports %d blocks per CU\n", per_cu); grid = -1; return; }
        grid = cus;
        if (grid < 128) { fprintf(stderr, "kernel_launch: too few CUs (%d)\n", grid); grid = -1; return; }
    }
    if (grid < 0) return;
    if (hipMemsetAsync((char*)d_ws + WS_CTL, 0, CTL_BYTES, stream) != hipSuccess) { fprintf(stderr, "kernel_launch: memset failed\n"); return; }
    Args a{};
    for (int i = 0; i < 22; ++i) a.in[i] = d_in[i];
    a.out = (float*)d_out; a.ws = (unsigned char*)d_ws;
    void* args[] = {&a};
    hipError_t e = hipLaunchCooperativeKernel((const void*)fwd_megakernel, dim3(grid), dim3(512), args, LDS_BYTES, stream);
    if (e != hipSuccess) fprintf(stderr, "cooperative launch failed: %s (grid %d)\n", hipGetErrorString(e), grid);
}
```
